# Optimizing an MI355X kernel written in HIP

```python
import functools
import jax, jax.numpy as jnp
from jax import lax
import numpy as np

D_MODEL = 1024
BATCH = 4
SEQ = 4096
DEPTH = 2
DEC_BATCH = 32
DEC_SEQ = 1
PAST_LEN = 8192
PAGE_SIZE = 128

HEAD_DIM = 128
N_ATT_GROUPS = 3
HEADS_PER_GROUP = 4
WINDOWS = (128, 512, 2048)
DILATIONS = (1, 4, 16)
N_STEPS = 128
N_ATT_HEADS = N_ATT_GROUPS * HEADS_PER_GROUP
ATT_QKV = N_ATT_HEADS * HEAD_DIM
ATT_OUT = HEADS_PER_GROUP * HEAD_DIM
CHUNK = 128
SGU_WIDTH = 512
SGU_GROUPS = 8
SGU_GROUP_DIM = SGU_WIDTH // SGU_GROUPS
D_FF = -(-8 * D_MODEL // (3 * 256)) * 256
SPLITS = (ATT_QKV, 2 * ATT_QKV, 3 * ATT_QKV, 3 * ATT_QKV + SGU_WIDTH,
          3 * ATT_QKV + 2 * SGU_WIDTH, 3 * ATT_QKV + 2 * SGU_WIDTH + D_MODEL)
D_IN = 3 * ATT_QKV + 2 * SGU_WIDTH + 2 * D_MODEL
N_ADA = 6
EPS = 1e-6
NEG_INF = -1e30

kernel_name = "dilated_attn_sgu_gated_hybrid_step"


def rms_norm(x, w):
    xf = x.astype(jnp.float32)
    y = xf * lax.rsqrt(jnp.mean(xf * xf, axis=-1, keepdims=True) + EPS)
    return (y * w.astype(jnp.float32)).astype(x.dtype)


def layer_norm(x, w, b):
    xf = x.astype(jnp.float32)
    mu = jnp.mean(xf, axis=-1, keepdims=True)
    var = jnp.mean(jnp.square(xf - mu), axis=-1, keepdims=True)
    y = (xf - mu) * lax.rsqrt(var + EPS)
    return (y * w.astype(jnp.float32) + b.astype(jnp.float32)).astype(x.dtype)


def alibi_slopes():
    h = np.arange(1, N_ATT_HEADS + 1, dtype=np.float32)
    s = np.power(np.float32(2.0), -8.0 * h / N_ATT_HEADS).astype(np.float32)
    return jnp.asarray(s.reshape(N_ATT_GROUPS, HEADS_PER_GROUP))


def dilated_band_attention(q, k, v, slopes, dil):
    B, S, H, Dh = q.shape
    L = S // dil
    N = B * dil
    nb = -(-L // N_STEPS)
    Lp = nb * N_STEPS

    def to_blocks(t):
        t = t.reshape(B, L, dil, H, Dh).transpose(0, 2, 1, 3, 4).reshape(N, L, H, Dh)
        t = jnp.pad(t, ((0, 0), (0, Lp - L), (0, 0), (0, 0)))
        return t.reshape(N, nb, N_STEPS, H, Dh)

    def with_prev(t):
        prev = jnp.pad(t, ((0, 0), (1, 0), (0, 0), (0, 0), (0, 0)))[:, :-1]
        return jnp.concatenate([prev, t], axis=2)

    qb = to_blocks(q)
    kk = with_prev(to_blocks(k))
    vv = with_prev(to_blocks(v))
    s = jnp.einsum('nbqhd,nbkhd->nbhqk', qb, kk).astype(jnp.float32) * (HEAD_DIM ** -0.5)
    qi = jnp.arange(N_STEPS)[:, None]
    ki = jnp.arange(2 * N_STEPS)[None, :]
    dist = N_STEPS + qi - ki
    key_step = (jnp.arange(nb)[:, None, None] - 1) * N_STEPS + ki[None]
    valid = (dist >= 0) & (dist <= N_STEPS) & (key_step >= 0)
    bias = -slopes[:, None, None] * (dist * dil).astype(jnp.float32)
    s = jnp.where(valid[None, :, None], s + bias[None, None], NEG_INF)
    lse = jax.nn.logsumexp(s, axis=-1)
    p = jnp.exp(s - lse[..., None])
    o = jnp.einsum('nbhqk,nbkhd->nbqhd', p.astype(v.dtype), vv)

    def from_blocks(t):
        t = t.reshape(N, Lp, *t.shape[3:])[:, :L]
        t = t.reshape(B, dil, L, *t.shape[2:])
        t = jnp.swapaxes(t, 1, 2)
        return t.reshape(B, S, *t.shape[3:])

    return from_blocks(o), from_blocks(jnp.swapaxes(lse, 2, 3))


def dilated_cached_attention(q, k_new, v_new, kv_cache, slopes, dil):
    Lc = kv_cache.shape[1]
    T = q.shape[1]
    k_all = jnp.concatenate([kv_cache[:, :, 0].astype(k_new.dtype), k_new], axis=1)
    v_all = jnp.concatenate([kv_cache[:, :, 1].astype(v_new.dtype), v_new], axis=1)
    steps = jnp.arange(N_STEPS + 1)
    idx = Lc + jnp.arange(T)[:, None] - dil * steps[None, :]
    valid = idx >= 0
    idx = jnp.maximum(idx, 0)
    kg = k_all[:, idx]
    vg = v_all[:, idx]
    s = jnp.einsum('bthd,btjhd->bthj', q, kg).astype(jnp.float32) * (HEAD_DIM ** -0.5)
    s = s - slopes[:, None] * (dil * steps).astype(jnp.float32)
    s = jnp.where(valid[:, None, :], s, NEG_INF)
    lse = jax.nn.logsumexp(s, axis=-1)
    p = jnp.exp(s - lse[..., None])
    o = jnp.einsum('bthj,btjhd->bthd', p.astype(vg.dtype), vg)
    return o, lse


def merge_by_denominator(outs, lses):
    alpha = jax.nn.softmax(jnp.stack(lses, axis=0), axis=0)
    return jnp.einsum('gnth,gnthd->nthd', alpha.astype(outs[0].dtype), jnp.stack(outs, axis=0))


def attend_prompt(q, k, v):
    slopes = alibi_slopes()
    S = q.shape[1]
    outs, lses, states = [], [], []
    for g in range(N_ATT_GROUPS):
        o, lse = dilated_band_attention(q[:, :, g], k[:, :, g], v[:, :, g], slopes[g], DILATIONS[g])
        outs.append(o)
        lses.append(lse)
        lw = min(WINDOWS[g], S)
        states.append(jnp.stack([k[:, S - lw:, g], v[:, S - lw:, g]], axis=2))
    return merge_by_denominator(outs, lses), states


def attend_sample(q, k, v, cache1, cache2, cache3):
    slopes = alibi_slopes()
    caches = (cache1, cache2, cache3)
    outs, lses, states = [], [], []
    for g in range(N_ATT_GROUPS):
        o, lse = dilated_cached_attention(q[:, :, g], k[:, :, g], v[:, :, g], caches[g], slopes[g], DILATIONS[g])
        outs.append(o)
        lses.append(lse)
        states.append(jnp.stack([k[:, :, g], v[:, :, g]], axis=2))
    return merge_by_denominator(outs, lses), states


def sgu_prompt(vs, w_s, b_s):
    B, S, _ = vs.shape
    vr = vs.reshape(B, S // CHUNK, CHUNK, SGU_GROUPS, SGU_GROUP_DIM)
    wm = w_s * jnp.tril(jnp.ones((CHUNK, CHUNK), w_s.dtype))
    mixed = jnp.einsum('gts,bnsgc->bntgc', wm, vr) + b_s.T[:, :, None]
    return mixed.reshape(B, S, SGU_WIDTH)


def sgu_sample(vs, w_s, b_s):
    Bd, T, _ = vs.shape
    vr = vs.reshape(Bd, T, SGU_GROUPS, SGU_GROUP_DIM)
    wm = (w_s * jnp.tril(jnp.ones((CHUNK, CHUNK), w_s.dtype)))[:, :T, :T]
    mixed = jnp.einsum('gts,bsgc->btgc', wm, vr) + b_s[:, :T].T[:, :, None]
    return mixed.reshape(Bd, T, SGU_WIDTH)


def trunk_layer(x, c, attend, sgu, w_ada, b_ada, norm1_w, w_in, q_norm_w, k_norm_w,
                sgu_ln_w, sgu_ln_b, w_proj_att, w_proj_sgu, w_out, norm2_w, w_ffn_in, w_ffn_out):
    n, t = x.shape[0], x.shape[1]
    mod = (jax.nn.silu(c) @ w_ada + b_ada)[:, None, :]
    sh1, sc1, g1, sh2, sc2, g2 = jnp.split(mod, N_ADA, axis=-1)
    h = rms_norm(x, norm1_w) * (1 + sc1) + sh1
    z = h @ w_in
    q, k, v, u, vs, ga, gb = jnp.split(z, SPLITS, axis=-1)
    hs = (n, t, N_ATT_GROUPS, HEADS_PER_GROUP, HEAD_DIM)
    q = rms_norm(q.reshape(hs), q_norm_w[:, None, :])
    k = rms_norm(k.reshape(hs), k_norm_w[:, None, :])
    v = v.reshape(hs)
    y_att, att_state = attend(q, k, v)
    u = jax.nn.gelu(u, approximate=False)
    vs = layer_norm(jax.nn.gelu(vs, approximate=False), sgu_ln_w, sgu_ln_b)
    y_sgu = u * sgu(vs)
    merged = (jax.nn.sigmoid(ga) * (y_att.reshape(n, t, ATT_OUT) @ w_proj_att)
              + jax.nn.sigmoid(gb) * (y_sgu @ w_proj_sgu))
    x = x + g1 * (merged @ w_out)
    h2 = rms_norm(x, norm2_w) * (1 + sc2) + sh2
    a, b = jnp.split(h2 @ w_ffn_in, 2, axis=-1)
    x = x + g2 * ((jax.nn.silu(a) * b) @ w_ffn_out)
    return x, att_state, vs


def setup_inputs(seed: int = 0) -> dict:
    key = jax.random.key(seed)
    ks = jax.random.split(key, 24)
    f32 = jnp.float32

    def nrm(k, shape, scale):
        return jax.random.normal(k, shape, f32) * scale

    def cache(k, w):
        return nrm(k, (DEPTH, DEC_BATCH, min(w, PAST_LEN), 2, HEADS_PER_GROUP, HEAD_DIM), 1.0)

    return {
        "x_prompt": nrm(ks[0], (BATCH, SEQ, D_MODEL), 1.0),
        "x_sample": nrm(ks[1], (DEC_BATCH, DEC_SEQ, D_MODEL), 1.0),
        "cache_kv_w128": cache(ks[2], WINDOWS[0]),
        "cache_kv_w512": cache(ks[3], WINDOWS[1]),
        "cache_kv_w2048": cache(ks[4], WINDOWS[2]),
        "c_prompt": nrm(ks[5], (BATCH, D_MODEL), 1.0),
        "c_sample": nrm(ks[6], (DEC_BATCH, D_MODEL), 1.0),
        "w_ada": nrm(ks[7], (DEPTH, D_MODEL, N_ADA * D_MODEL), 0.5 * D_MODEL ** -0.5),
        "b_ada": nrm(ks[8], (DEPTH, N_ADA * D_MODEL), 0.01),
        "norm1_w": 1.0 + nrm(ks[9], (DEPTH, D_MODEL), 0.02),
        "w_in": nrm(ks[10], (DEPTH, D_MODEL, D_IN), D_MODEL ** -0.5),
        "q_norm_w": 1.0 + nrm(ks[11], (DEPTH, N_ATT_GROUPS, HEAD_DIM), 0.02),
        "k_norm_w": 1.0 + nrm(ks[12], (DEPTH, N_ATT_GROUPS, HEAD_DIM), 0.02),
        "sgu_ln_w": 1.0 + nrm(ks[13], (DEPTH, SGU_WIDTH), 0.02),
        "sgu_ln_b": nrm(ks[14], (DEPTH, SGU_WIDTH), 0.01),
        "w_spatial": nrm(ks[15], (DEPTH, SGU_GROUPS, CHUNK, CHUNK), CHUNK ** -0.5),
        "b_spatial": 1.0 + nrm(ks[16], (DEPTH, SGU_GROUPS, CHUNK), 0.1),
        "w_proj_att": nrm(ks[17], (DEPTH, ATT_OUT, D_MODEL), ATT_OUT ** -0.5),
        "w_proj_sgu": nrm(ks[18], (DEPTH, SGU_WIDTH, D_MODEL), SGU_WIDTH ** -0.5),
        "w_out": nrm(ks[19], (DEPTH, D_MODEL, D_MODEL), D_MODEL ** -0.5),
        "norm2_w": 1.0 + nrm(ks[20], (DEPTH, D_MODEL), 0.02),
        "w_ffn_in": nrm(ks[21], (DEPTH, D_MODEL, 2 * D_FF), D_MODEL ** -0.5),
        "w_ffn_out": nrm(ks[22], (DEPTH, D_FF, D_MODEL), D_FF ** -0.5),
    }


def reference(x_prompt, x_sample, cache_kv_w128, cache_kv_w512, cache_kv_w2048, c_prompt, c_sample,
              w_ada, b_ada, norm1_w, w_in, q_norm_w, k_norm_w, sgu_ln_w, sgu_ln_b, w_spatial, b_spatial,
              w_proj_att, w_proj_sgu, w_out, norm2_w, w_ffn_in, w_ffn_out):
    def layer_weights(l):
        return (w_ada[l], b_ada[l], norm1_w[l], w_in[l], q_norm_w[l], k_norm_w[l], sgu_ln_w[l], sgu_ln_b[l],
                w_proj_att[l], w_proj_sgu[l], w_out[l], norm2_w[l], w_ffn_in[l], w_ffn_out[l])

    xp = x_prompt
    p_kv1, p_kv2, p_kv3 = [], [], []
    for l in range(DEPTH):
        sgu = functools.partial(sgu_prompt, w_s=w_spatial[l], b_s=b_spatial[l])
        xp, st, _ = trunk_layer(xp, c_prompt, attend_prompt, sgu, *layer_weights(l))
        p_kv1.append(st[0])
        p_kv2.append(st[1])
        p_kv3.append(st[2])

    xs = x_sample
    s_kv1, s_kv2, s_kv3, s_v = [], [], [], []
    for l in range(DEPTH):
        attend = functools.partial(attend_sample, cache1=cache_kv_w128[l], cache2=cache_kv_w512[l],
                                   cache3=cache_kv_w2048[l])
        sgu = functools.partial(sgu_sample, w_s=w_spatial[l], b_s=b_spatial[l])
        xs, st, vrows = trunk_layer(xs, c_sample, attend, sgu, *layer_weights(l))
        s_kv1.append(st[0])
        s_kv2.append(st[1])
        s_kv3.append(st[2])
        s_v.append(vrows)

    return (xp, xs,
            jnp.stack(p_kv1), jnp.stack(p_kv2), jnp.stack(p_kv3),
            jnp.stack(s_kv1), jnp.stack(s_kv2), jnp.stack(s_kv3),
            jnp.stack(s_v))
```

```cpp
#include <hip/hip_runtime.h>
#include <hip/hip_cooperative_groups.h>
#include <cstdio>
#include <cstdint>
namespace cg = cooperative_groups;
namespace pg8 {
#define PG8_LAS __attribute__((address_space(3)))
typedef unsigned short bf16_t;
typedef short bf16x8 __attribute__((ext_vector_type(8)));
typedef float f32x4 __attribute__((ext_vector_type(4)));
typedef unsigned u32x4 __attribute__((ext_vector_type(4)));
constexpr int BM = 256, BK = 64, HALF = 128, HTB = HALF * BK * 2  , STAGE_BYTES = 8 * HTB, NXCD = 8, WGM = 8;

__host__ __device__ __forceinline__ int lds_byte(int r, int c) { const int st = (r >> 4) * 2 + (c >> 5), rr = r & 15, cc = c & 31, ob = rr * 64 + cc * 2; return st * 1024 + (ob ^ (((ob >> 9) & 1) << 5)); }
__host__ __device__ __forceinline__ void stage_rc(int b, int& R, int& C) { const int st = b / 1024, sb = b % 1024, swz = sb ^ (((sb >> 9) & 1) << 5); R = (st >> 1) * 16 + swz / 64; C = (st & 1) * 32 + (swz % 64) / 2; }
__host__ __device__ __forceinline__ int perm32(int rho) { const int n = rho >> 4, i = rho & 15; return 8 * (i >> 2) + 4 * n + (i & 3); }

struct Unit { int pm, pn; };
struct Gemm { const bf16_t* A; const bf16_t* Bt; int M, N, K; };

struct StaticOrder {
    int nM, nN, nwg, G, c;
    __host__ __device__ void init(int M, int N, int G_, int c_) { nM = M / BM; nN = N / BM; nwg = nM * nN; G = G_; c = c_; }
    __host__ __device__ bool next(int i, Unit& u) const {
        const long L = (long)i * G + c; if (L >= nwg) return false;
        int wgid = (int)L; { const int q = nwg / NXCD, r = nwg % NXCD, xcd = wgid % NXCD, off = wgid / NXCD; wgid = (xcd < r ? xcd * (q + 1) : r * (q + 1) + (xcd - r) * q) + off; }
        const int nig = WGM * nN, gid = wgid / nig, fm = gid * WGM, gsz = (nM - fm) < WGM ? (nM - fm) : WGM;
        u.pm = fm + ((wgid % nig) % gsz); u.pn = (wgid % nig) / gsz; return true;
    }
    __device__ __forceinline__ void a_ready(const Unit&) const {}
    __device__ __forceinline__ void done(const Unit&) const {}
};

typedef __bf16 bf16x2_hw __attribute__((ext_vector_type(2)));
typedef float f32x2_hw __attribute__((ext_vector_type(2)));
__device__ __forceinline__ unsigned cvt_pk_bf16(float lo, float hi) { const f32x2_hw v = {lo, hi}; return __builtin_bit_cast(unsigned, __builtin_convertvector(v, bf16x2_hw)); }
typedef float f32x2 __attribute__((ext_vector_type(2)));
__device__ __forceinline__ f32x2 gelu_pk(f32x2 v) {
    const f32x2 av = __builtin_elementwise_abs(v), d = av * 0.2316418882f + 1.0f;
    f32x2 t; t.x = __builtin_amdgcn_rcpf(d.x); t.y = __builtin_amdgcn_rcpf(d.y);
    f32x2 q = t * 0.5307027145f + (-0.7265760135f); q = q * t + 0.7107068705f; q = q * t + (-0.142248368f); q = q * t + 0.127414796f; q = q * t;
    const f32x2 s = (v * v) * (-0.72134752044f);
    f32x2 e; e.x = __builtin_amdgcn_exp2f(s.x); e.y = __builtin_amdgcn_exp2f(s.y);
    const f32x2 m = v * (q * e), r = v - m;
    f32x2 o; o.x = v.x < 0.f ? m.x : r.x; o.y = v.y < 0.f ? m.y : r.y; return o;
}

template <int ACT  > struct EpiBf16 {
    static constexpr bool PERM = true, AFTER_DRAIN = false; static_assert(ACT == 0 || ACT == 1, "EpiBf16: ACT is 0 (none) or 1 (gelu_pk)");
    bf16_t* O; int ldc; const float* bias; int split_cols; size_t split_stride; float scale0;
    __device__ __forceinline__ void operator()(const f32x4 (&acc)[2][2][4][2], const Unit& u, int wr, int wc, int fr, int fq) const {
        const int row0 = u.pm * BM + wr * 64 + fr; int colt = u.pn * BM; bf16_t* base = O;
        float sc = 1.f; if (split_cols) { const int t = colt / split_cols; base += (size_t)t * split_stride; colt -= t * split_cols; if (t == 0) sc = scale0; }
        const int col0 = colt + wc * 32 + 8 * fq, bcol0 = u.pn * BM + wc * 32 + 8 * fq;
        f32x4 bv[2][2];
#pragma unroll
        for (int bj = 0; bj < 2; ++bj)
#pragma unroll
            for (int n = 0; n < 2; ++n) bv[bj][n] = bias ? *(const f32x4*)(bias + bcol0 + bj * HALF + 4 * n) : (f32x4){0.f, 0.f, 0.f, 0.f};
#pragma unroll
        for (int ai = 0; ai < 2; ++ai)
#pragma unroll
            for (int m = 0; m < 4; ++m) { bf16_t* rowp = base + (size_t)(row0 + ai * HALF + m * 16) * ldc + col0;
#pragma unroll
                for (int bj = 0; bj < 2; ++bj) { f32x4 v0 = acc[ai][bj][m][0] + bv[bj][0], v1 = acc[ai][bj][m][1] + bv[bj][1];
                    if (ACT == 1) { f32x2 a = gelu_pk((f32x2){v0[0], v0[1]}), b = gelu_pk((f32x2){v0[2], v0[3]}), c = gelu_pk((f32x2){v1[0], v1[1]}), d = gelu_pk((f32x2){v1[2], v1[3]});
                        v0 = (f32x4){a.x, a.y, b.x, b.y}; v1 = (f32x4){c.x, c.y, d.x, d.y}; }
                    v0 = v0 * sc; v1 = v1 * sc; u32x4 w; w.x = cvt_pk_bf16(v0[0], v0[1]); w.y = cvt_pk_bf16(v0[2], v0[3]); w.z = cvt_pk_bf16(v1[0], v1[1]); w.w = cvt_pk_bf16(v1[2], v1[3]);
                    *(u32x4*)(rowp + bj * HALF) = w; } }
    }
};

struct PanelStats {
    unsigned* xbuf;
    unsigned* cnt;
    unsigned* tmo;
    int ntn; float eps;
    unsigned code;
    __device__ __forceinline__ bool run(const f32x4 (&v)[2][2][4][2], const Unit& u, int wr, int wc, int fr, int fq, PG8_LAS unsigned char* lds, int wid, int lane) const {
        typedef float f32x2v __attribute__((ext_vector_type(2)));
        PG8_LAS f32x2v* P = (PG8_LAS f32x2v*)lds;
        PG8_LAS f32x2v* S = (PG8_LAS f32x2v*)(lds + 8192);
        PG8_LAS unsigned* flag = (PG8_LAS unsigned*)(lds + 8192 + 2048);
#pragma unroll
        for (int ai = 0; ai < 2; ++ai)
#pragma unroll
            for (int m = 0; m < 4; ++m) {
                float s = 0.f;
#pragma unroll
                for (int bj = 0; bj < 2; ++bj)
#pragma unroll
                    for (int n = 0; n < 2; ++n) { const f32x4 x = v[ai][bj][m][n]; s += (x[0] + x[1]) + (x[2] + x[3]); }
                s += __shfl_xor(s, 16); s += __shfl_xor(s, 32);
                const float mw = s * (1.0f / 64.0f); float q = 0.f;
#pragma unroll
                for (int bj = 0; bj < 2; ++bj)
#pragma unroll
                    for (int n = 0; n < 2; ++n) { const f32x4 d = v[ai][bj][m][n] - mw; q += (d[0] * d[0] + d[1] * d[1]) + (d[2] * d[2] + d[3] * d[3]); }
                q += __shfl_xor(q, 16); q += __shfl_xor(q, 32);
                if (fq == 0) P[(ai * HALF + wr * 64 + m * 16 + fr) * 4 + wc] = (f32x2v){mw, q};
            }
        asm volatile("s_waitcnt lgkmcnt(0)" ::: "memory"); __builtin_amdgcn_s_barrier(); asm volatile("" ::: "memory");
#if defined(BROKEN_EXCHANGE_NO_WAIT)
#warning BROKEN CONTROL BUILD: the row-statistics exchange does not wait; results are wrong by design
        if (blockIdx.x >= 64) { const long long t0_ = clock64(); while (clock64() - t0_ < 60000) __builtin_amdgcn_s_sleep(8); }
#endif
        const int row = wid * 32 + (lane & 31);
        if (lane < 32) {
            const f32x2v a = P[row * 4 + 0], b = P[row * 4 + 1], c = P[row * 4 + 2], d = P[row * 4 + 3];
            const float mt = (a.x + b.x + c.x + d.x) * 0.25f;
            const float da = a.x - mt, db = b.x - mt, dc = c.x - mt, dd = d.x - mt;
            const float m2 = (a.y + b.y) + (c.y + d.y) + 64.0f * ((da * da + db * db) + (dc * dc + dd * dd));
            unsigned long long* slot = (unsigned long long*)xbuf + ((size_t)(u.pm * BM + row) * 4 + u.pn);
            __hip_atomic_store(slot, ((unsigned long long)__float_as_uint(m2) << 32) | __float_as_uint(mt), __ATOMIC_RELAXED, __HIP_MEMORY_SCOPE_AGENT);
        }
        asm volatile("s_waitcnt vmcnt(0)" ::: "memory");
        if (lane == 0) __hip_atomic_fetch_add(cnt + 64 * u.pm, 1u, __ATOMIC_RELAXED, __HIP_MEMORY_SCOPE_AGENT);
        if (wid == 0) {
            bool dead = false; const unsigned long long t0 = __builtin_amdgcn_s_memrealtime(); const unsigned want = 8u * (unsigned)ntn;
            for (;;) {
#if defined(BROKEN_EXCHANGE_NO_WAIT)
                break;
#endif
                if ((unsigned)__builtin_amdgcn_readfirstlane(__hip_atomic_load(cnt + 64 * u.pm, __ATOMIC_RELAXED, __HIP_MEMORY_SCOPE_AGENT)) >= want) break;
                if (__builtin_amdgcn_s_memrealtime() - t0 > 2000000ull) {
                    if (lane == 0) { unsigned expect = 0u; __hip_atomic_compare_exchange_strong(tmo + 1, &expect, code | (unsigned)(u.pm & 0xff), __ATOMIC_RELAXED, __ATOMIC_RELAXED, __HIP_MEMORY_SCOPE_AGENT);
                                     __hip_atomic_store(tmo, 1u, __ATOMIC_RELAXED, __HIP_MEMORY_SCOPE_AGENT); }
                    dead = true; break; }
                __builtin_amdgcn_s_sleep(2);
            }
            __builtin_amdgcn_fence(__ATOMIC_ACQUIRE, "agent");
            if (lane == 0) flag[0] = dead ? 1u : 0u;
        }
        asm volatile("s_waitcnt vmcnt(0) lgkmcnt(0)" ::: "memory"); __builtin_amdgcn_s_barrier(); asm volatile("" ::: "memory");
        const bool bad = flag[0] != 0u;
        if (lane < 32) {
            const unsigned long long* slot = (const unsigned long long*)xbuf + (size_t)(u.pm * BM + row) * 4; float mt[4], m2[4]; float ms = 0.f;
#pragma unroll
            for (int t = 0; t < 4; ++t) { if (t < ntn) { const unsigned long long w = __hip_atomic_load(slot + t, __ATOMIC_RELAXED, __HIP_MEMORY_SCOPE_AGENT); mt[t] = __uint_as_float((unsigned)w); m2[t] = __uint_as_float((unsigned)(w >> 32)); } else { mt[t] = 0.f; m2[t] = 0.f; } ms += mt[t]; }
            const float mean = ms / (float)ntn; float q = 0.f;
#pragma unroll
            for (int t = 0; t < 4; ++t) if (t < ntn) { const float dm = mt[t] - mean; q += m2[t] + 256.0f * dm * dm; }
            S[row] = (f32x2v){mean, 1.0f / sqrtf(q / (256.0f * (float)ntn) + eps)};
        }
        asm volatile("s_waitcnt lgkmcnt(0)" ::: "memory"); __builtin_amdgcn_s_barrier(); asm volatile("" ::: "memory");
        return bad;
    }
};
struct EpiLnRes {
    static constexpr bool PERM = false, AFTER_DRAIN = true;
    const float* base; float* out; int ldc; const float* bias; PanelStats st; unsigned poison;
    __device__ __forceinline__ void fused(f32x4 (&acc)[2][2][4][2], const Unit& u, int wr, int wc, int fr, int fq, PG8_LAS unsigned char* lds, int wid, int lane) const {
        typedef float f32x2v __attribute__((ext_vector_type(2)));
        const PG8_LAS f32x2v* S = (const PG8_LAS f32x2v*)(lds + 8192);
        const int col0 = u.pn * BM + wc * 32 + 4 * fq;
#pragma unroll
        for (int bj = 0; bj < 2; ++bj)
#pragma unroll
            for (int n = 0; n < 2; ++n) { const f32x4 bv = bias ? *(const f32x4*)(bias + col0 + bj * HALF + n * 16) : (f32x4){0.f, 0.f, 0.f, 0.f};
#pragma unroll
                for (int ai = 0; ai < 2; ++ai)
#pragma unroll
                    for (int m = 0; m < 4; ++m) acc[ai][bj][m][n] += bv; }
        f32x4 pre[4][2][2];
#pragma unroll
        for (int m = 0; m < 4; ++m) { const size_t off = (size_t)(u.pm * BM + wr * 64 + m * 16 + fr) * ldc + col0;
#pragma unroll
            for (int bj = 0; bj < 2; ++bj)
#pragma unroll
                for (int n = 0; n < 2; ++n) pre[m][bj][n] = *(const f32x4*)(base + off + bj * HALF + n * 16); }
        const bool bad = st.run(acc, u, wr, wc, fr, fq, lds, wid, lane) || poison != 0u;
        const float qnan = __builtin_nanf("");
#pragma unroll
        for (int ai = 0; ai < 2; ++ai)
#pragma unroll
            for (int m = 0; m < 4; ++m) { const int r = ai * HALF + wr * 64 + m * 16 + fr; const f32x2v sr = S[r]; const size_t off = (size_t)(u.pm * BM + r) * ldc + col0;
#pragma unroll
                for (int bj = 0; bj < 2; ++bj)
#pragma unroll
                    for (int n = 0; n < 2; ++n) { const f32x4 bs = ai == 0 ? pre[m][bj][n] : *(const f32x4*)(base + off + bj * HALF + n * 16); f32x4 o = bs + (acc[ai][bj][m][n] - sr.x) * sr.y;
                        if (bad) o = (f32x4){qnan, qnan, qnan, qnan}; *(f32x4*)(out + off + bj * HALF + n * 16) = o; }
                if (m & 1) asm volatile("" ::: "memory"); }
    }
};
struct EpiLnResLn {
    static constexpr bool PERM = false, AFTER_DRAIN = true;
    const float* base; float* out; bf16_t* xn; int ldc; const float* bias; PanelStats st1, st2; unsigned poison;
    __device__ __forceinline__ void fused(f32x4 (&acc)[2][2][4][2], const Unit& u, int wr, int wc, int fr, int fq, PG8_LAS unsigned char* lds, int wid, int lane) const {
        typedef float f32x2v __attribute__((ext_vector_type(2))); typedef unsigned u32x2v __attribute__((ext_vector_type(2)));
        const PG8_LAS f32x2v* S = (const PG8_LAS f32x2v*)(lds + 8192);
        const int col0 = u.pn * BM + wc * 32 + 4 * fq;
#pragma unroll
        for (int bj = 0; bj < 2; ++bj)
#pragma unroll
            for (int n = 0; n < 2; ++n) { const f32x4 bv = bias ? *(const f32x4*)(bias + col0 + bj * HALF + n * 16) : (f32x4){0.f, 0.f, 0.f, 0.f};
#pragma unroll
                for (int ai = 0; ai < 2; ++ai)
#pragma unroll
                    for (int m = 0; m < 4; ++m) acc[ai][bj][m][n] += bv; }
        bool bad = st1.run(acc, u, wr, wc, fr, fq, lds, wid, lane) || poison != 0u;
        const float qnan = __builtin_nanf("");
#pragma unroll
        for (int ai = 0; ai < 2; ++ai)
#pragma unroll
            for (int m = 0; m < 4; ++m) { const int r = ai * HALF + wr * 64 + m * 16 + fr; const f32x2v sr = S[r]; const size_t off = (size_t)(u.pm * BM + r) * ldc + col0;
#pragma unroll
                for (int bj = 0; bj < 2; ++bj)
#pragma unroll
                    for (int n = 0; n < 2; ++n) { const f32x4 bs = *(const f32x4*)(base + off + bj * HALF + n * 16); acc[ai][bj][m][n] = bs + (acc[ai][bj][m][n] - sr.x) * sr.y; }
                asm volatile("" : "+v"(acc[ai][0][m][0]), "+v"(acc[ai][0][m][1]), "+v"(acc[ai][1][m][0]), "+v"(acc[ai][1][m][1]));
                if (m & 1) asm volatile("" ::: "memory"); }
        const bool bad1 = bad;
        bad = st2.run(acc, u, wr, wc, fr, fq, lds, wid, lane) || bad;
#pragma unroll
        for (int ai = 0; ai < 2; ++ai)
#pragma unroll
            for (int m = 0; m < 4; ++m) { const int r = ai * HALF + wr * 64 + m * 16 + fr; const f32x2v sr = S[r]; const size_t off = (size_t)(u.pm * BM + r) * ldc + col0;
#pragma unroll
                for (int bj = 0; bj < 2; ++bj)
#pragma unroll
                    for (int n = 0; n < 2; ++n) { const f32x4 x1 = acc[ai][bj][m][n]; *(f32x4*)(out + off + bj * HALF + n * 16) = bad1 ? (f32x4){qnan, qnan, qnan, qnan} : x1;
                        const f32x4 o = (x1 - sr.x) * sr.y; u32x2v w; w.x = cvt_pk_bf16(o[0], o[1]); w.y = cvt_pk_bf16(o[2], o[3]);
                        if (bad) { w.x = 0x7fc07fc0u; w.y = 0x7fc07fc0u; } *(u32x2v*)(xn + off + bj * HALF + n * 16) = w; }
                asm volatile("" ::: "memory"); }
    }
};

template <class Epi, class Sched, bool ALIGN_EPI = false, bool SP2 = false>
__device__ __forceinline__ void gemm_phase(PG8_LAS unsigned char* lds, const Gemm g, const Sched& S, const Epi& E) {
    int tid_ = threadIdx.x; asm volatile("" : "+v"(tid_));
    const int tid = tid_, wid = __builtin_amdgcn_readfirstlane(tid >> 6), lane = tid & 63, wr = wid >> 2, wc = wid & 3, fr = lane & 15, fq = lane >> 4;
    const int K = g.K, nt = K / BK;
    unsigned voffA[2], voffB[2];
#pragma unroll
    for (int i = 0; i < 2; ++i) { int R, C; stage_rc(tid * 16 + i * 8192, R, C); const int Rb = Epi::PERM ? ((R & ~31) + perm32(R & 31)) : R;
        voffA[i] = (unsigned)(R * K + C) * 2u; voffB[i] = (unsigned)(Rb * K + C) * 2u; }
    const size_t kstep = (size_t)(BK * 2);
    const size_t hstep = (size_t)HALF * K * 2;
    const size_t tstep = 2 * hstep;
    const unsigned ldsw = (unsigned)wid * 1024u;
    const int aoff = lds_byte(wr * 64 + fr, fq * 8), boff = lds_byte(wc * 32 + fr, fq * 8);
#define PG8_SA(b, h) (((b) * 2 + (h)) * HTB)
#define PG8_SB(b, h) ((4 + (b) * 2 + (h)) * HTB)
#define PG8_STAGE(bufoff, gbase, voff) do { _Pragma("unroll") for (int _i = 0; _i < 2; ++_i) \
        __builtin_amdgcn_global_load_lds((const unsigned*)((const char*)(gbase) + (voff)[_i]), (PG8_LAS unsigned*)(lds + (bufoff) + ldsw + _i * 8192), 16, 0, 0); } while (0)
#define PG8_LDA(dst, b, h) do { _Pragma("unroll") for (int m = 0; m < 4; ++m) _Pragma("unroll") for (int k = 0; k < 2; ++k) dst[m][k] = *(const PG8_LAS bf16x8*)(lds + PG8_SA(b, h) + aoff + m * 2048 + k * 1024); } while (0)
#define PG8_LDB(dst, b, h) do { _Pragma("unroll") for (int n = 0; n < 2; ++n) _Pragma("unroll") for (int k = 0; k < 2; ++k) dst[n][k] = *(const PG8_LAS bf16x8*)(lds + PG8_SB(b, h) + boff + n * 2048 + k * 1024); } while (0)
#define PG8_MMA(ai, bj, At, Bt) do { __builtin_amdgcn_s_setprio(1); _Pragma("unroll") for (int m = 0; m < 4; ++m) _Pragma("unroll") for (int n = 0; n < 2; ++n) _Pragma("unroll") for (int k = 0; k < 2; ++k) \
        acc[ai][bj][m][n] = __builtin_amdgcn_mfma_f32_16x16x32_bf16(Bt[n][k], At[m][k], acc[ai][bj][m][n], 0, 0, 0); __builtin_amdgcn_s_setprio(0); } while (0)
#define PG8_WAIT_V(n) asm volatile("s_waitcnt vmcnt(" #n ")" ::: "memory")
#define PG8_WAIT_L(n) asm volatile("s_waitcnt lgkmcnt(" #n ")" ::: "memory")
#define PG8_BAR __builtin_amdgcn_s_barrier()
#define PG8_SCHED __builtin_amdgcn_sched_barrier(0)
    Unit cur, nxt; int ui = 0;
    if (!S.next(0, cur)) return;
    f32x4 acc[2][2][4][2];
#pragma unroll
    for (int a = 0; a < 2; ++a)
#pragma unroll
        for (int b = 0; b < 2; ++b)
#pragma unroll
            for (int m = 0; m < 4; ++m)
#pragma unroll
                for (int n = 0; n < 2; ++n) acc[a][b][m][n] = (f32x4){0.f, 0.f, 0.f, 0.f};
    bf16x8 At[4][2], B0[2][2], B1[2][2];
    const char* cA = (const char*)g.A + (size_t)cur.pm * tstep; const char* cB = (const char*)g.Bt + (size_t)cur.pn * tstep;
    S.a_ready(cur);
    if constexpr (SP2) {
        PG8_STAGE(PG8_SB(0, 0), cB, voffB); PG8_STAGE(PG8_SB(0, 1), cB + hstep, voffB); PG8_STAGE(PG8_SA(0, 0), cA, voffA); PG8_STAGE(PG8_SA(0, 1), cA + hstep, voffA);
        if (wr == 1) PG8_BAR;
        PG8_WAIT_V(2); PG8_BAR;
        PG8_STAGE(PG8_SB(1, 0), cB + kstep, voffB); PG8_STAGE(PG8_SA(1, 0), cA + kstep, voffA); PG8_STAGE(PG8_SB(1, 1), cB + hstep + kstep, voffB);
        PG8_WAIT_V(6); PG8_BAR;
    } else {
        PG8_STAGE(PG8_SB(0, 0), cB, voffB); PG8_STAGE(PG8_SA(0, 0), cA, voffA); PG8_STAGE(PG8_SB(0, 1), cB + hstep, voffB); PG8_STAGE(PG8_SA(0, 1), cA + hstep, voffA);
        if (wr == 1) PG8_BAR;
        PG8_WAIT_V(4); PG8_BAR;
        PG8_STAGE(PG8_SB(1, 0), cB + kstep, voffB); PG8_STAGE(PG8_SA(1, 0), cA + kstep, voffA); PG8_STAGE(PG8_SB(1, 1), cB + hstep + kstep, voffB);
        PG8_WAIT_V(6); PG8_BAR;
    }
    for (;;) {
        const bool has_next = S.next(ui + 1, nxt);
        const char* nA = has_next ? (const char*)g.A + (size_t)nxt.pm * tstep : cA; const char* nB = has_next ? (const char*)g.Bt + (size_t)nxt.pn * tstep : cB;
        for (int t = 0; t < nt; t += 2) {
            const bool last = (t == nt - 2);
            const char* a1 = cA + (size_t)(t + 1) * kstep;
            const char* a2 = last ? nA : cA + (size_t)(t + 2) * kstep; const char* b2 = last ? nB : cB + (size_t)(t + 2) * kstep;
            const char* a3 = a2 + kstep; const char* b3 = b2 + kstep;
            if (last && has_next) S.a_ready(nxt);
            if constexpr (SP2) {
            PG8_LDB(B0, 0, 0); PG8_LDB(B1, 0, 1); PG8_SCHED; PG8_LDA(At, 0, 0); PG8_STAGE(PG8_SA(1, 1), a1 + hstep, voffA);
            PG8_WAIT_V(8); PG8_WAIT_L(0); PG8_BAR; PG8_MMA(0, 0, At, B0); PG8_MMA(0, 1, At, B1); PG8_BAR; PG8_SCHED;
            PG8_LDA(At, 0, 1); PG8_STAGE(PG8_SB(0, 0), b2, voffB); PG8_STAGE(PG8_SB(0, 1), b2 + hstep, voffB); PG8_STAGE(PG8_SA(0, 0), a2, voffA);
            PG8_WAIT_V(8); PG8_WAIT_L(0); PG8_BAR; PG8_MMA(1, 0, At, B0); PG8_MMA(1, 1, At, B1); PG8_BAR; PG8_SCHED;
            PG8_LDB(B0, 1, 0); PG8_LDB(B1, 1, 1); PG8_SCHED; PG8_LDA(At, 1, 0); PG8_STAGE(PG8_SA(0, 1), a2 + hstep, voffA);
            PG8_WAIT_V(8); PG8_WAIT_L(0); PG8_BAR; PG8_MMA(0, 0, At, B0); PG8_MMA(0, 1, At, B1); PG8_BAR; PG8_SCHED;
            PG8_LDA(At, 1, 1); PG8_STAGE(PG8_SB(1, 0), b3, voffB); PG8_STAGE(PG8_SB(1, 1), b3 + hstep, voffB); PG8_STAGE(PG8_SA(1, 0), a3, voffA);
            PG8_WAIT_V(8); PG8_WAIT_L(0); PG8_BAR; PG8_MMA(1, 0, At, B0); PG8_MMA(1, 1, At, B1); PG8_BAR; PG8_SCHED;
            } else {
            PG8_LDB(B0, 0, 0); PG8_SCHED; PG8_LDA(At, 0, 0); PG8_STAGE(PG8_SA(1, 1), a1 + hstep, voffA);
            PG8_WAIT_L(8); PG8_BAR; PG8_WAIT_L(0); PG8_MMA(0, 0, At, B0); PG8_BAR; PG8_SCHED;
            PG8_LDB(B1, 0, 1); PG8_STAGE(PG8_SB(0, 0), b2, voffB);
            PG8_BAR; PG8_WAIT_L(0); PG8_MMA(0, 1, At, B1); PG8_BAR;
            PG8_LDA(At, 0, 1); PG8_STAGE(PG8_SA(0, 0), a2, voffA);
            PG8_BAR; PG8_WAIT_L(0); PG8_MMA(1, 0, At, B0); PG8_BAR; PG8_SCHED;
            PG8_STAGE(PG8_SB(0, 1), b2 + hstep, voffB);
            PG8_WAIT_V(6); PG8_BAR; PG8_MMA(1, 1, At, B1); PG8_BAR;
            PG8_LDB(B0, 1, 0); PG8_SCHED; PG8_LDA(At, 1, 0); PG8_STAGE(PG8_SA(0, 1), a2 + hstep, voffA);
            PG8_WAIT_L(8); PG8_BAR; PG8_WAIT_L(0); PG8_MMA(0, 0, At, B0); PG8_BAR; PG8_SCHED;
            PG8_LDB(B1, 1, 1); PG8_STAGE(PG8_SB(1, 0), b3, voffB);
            PG8_BAR; PG8_WAIT_L(0); PG8_MMA(0, 1, At, B1); PG8_BAR;
            PG8_LDA(At, 1, 1); PG8_STAGE(PG8_SA(1, 0), a3, voffA);
            PG8_BAR; PG8_WAIT_L(0); PG8_MMA(1, 0, At, B0); PG8_BAR; PG8_SCHED;
            PG8_STAGE(PG8_SB(1, 1), b3 + hstep, voffB);
            PG8_WAIT_V(6); PG8_BAR; PG8_MMA(1, 1, At, B1); PG8_BAR;
            }
        }
        if constexpr (ALIGN_EPI) { if (wr == 0) PG8_BAR; }
        if constexpr (!Epi::AFTER_DRAIN) { E(acc, cur, wr, wc, fr, fq); S.done(cur); }
        if (!has_next) break;
#pragma unroll
        for (int a = 0; a < 2; ++a)
#pragma unroll
            for (int b = 0; b < 2; ++b)
#pragma unroll
                for (int m = 0; m < 4; ++m)
#pragma unroll
                    for (int n = 0; n < 2; ++n) acc[a][b][m][n] = (f32x4){0.f, 0.f, 0.f, 0.f};
        cur = nxt; cA = nA; cB = nB; ++ui;
        if constexpr (ALIGN_EPI) { if (wr == 1) PG8_BAR; }
    }
    PG8_WAIT_V(0);
    if constexpr (!ALIGN_EPI) { if (wr == 0) PG8_BAR; }
    PG8_BAR;
    if constexpr (Epi::AFTER_DRAIN) { E.fused(acc, cur, wr, wc, fr, fq, lds, wid, lane); S.done(cur); }
#undef PG8_SA
#undef PG8_SB
#undef PG8_STAGE
#undef PG8_LDA
#undef PG8_LDB
#undef PG8_MMA
#undef PG8_WAIT_V
#undef PG8_WAIT_L
#undef PG8_BAR
#undef PG8_SCHED
}
}

#define LAS __attribute__((address_space(3)))
typedef unsigned short bf16;
typedef float f32x4 __attribute__((ext_vector_type(4)));
typedef float f32x2 __attribute__((ext_vector_type(2)));
typedef short bf16x8 __attribute__((ext_vector_type(8)));
typedef short s16x4 __attribute__((ext_vector_type(4)));
typedef short v4i16_t __attribute__((ext_vector_type(4)));
typedef unsigned u32x4 __attribute__((ext_vector_type(4)));
typedef unsigned u32x2 __attribute__((ext_vector_type(2)));

constexpr int NWAVES = 8, NTHREADS = 512;
constexpr int DM = 1024, SEQ = 4096, NBATCH = 4, MP = NBATCH * SEQ, NSMP = 32, MV = MP + NSMP, MT = 16640;
constexpr int DIN = 7680, QKV = 1536, DFF = 2816, NADA = 6144;
constexpr size_t O_YP = 0, O_YS = 16777216, O_KV0P = 16809984, O_KV1P = 17858560, O_KV2P = 22052864,
                 O_KV0S = 38830080, O_KV1S = 38895616, O_KV2S = 38961152, O_SV = 39026688, O_END = 39059456;
constexpr float LOG2E = 1.4426950408889634f;
constexpr float QSCALE = 0.08838834764831845f * LOG2E;

constexpr size_t MiB = 1u << 20;
constexpr size_t alm(size_t x) { return (x + MiB - 1) / MiB * MiB; }
constexpr size_t WS_WADA = 1 * MiB;
constexpr size_t WS_WL0 = WS_WADA + alm(2ull * NADA * DM * 2);
constexpr size_t WL_WIN = 0;
constexpr size_t WL_WPA = WL_WIN + alm((size_t)DIN * DM * 2);
constexpr size_t WL_WPS = WL_WPA + alm(1024ull * 512 * 2);
constexpr size_t WL_WOUT = WL_WPS + alm(1024ull * 512 * 2);
constexpr size_t WL_WFI = WL_WOUT + alm(1024ull * 1024 * 2);
constexpr size_t WL_WFO = WL_WFI + alm(5632ull * 1024 * 2);
constexpr size_t WL_WSP = WL_WFO + alm(1024ull * DFF * 2);
constexpr size_t WL_SIZE = WL_WSP + alm(8ull * 128 * 128 * 2);
constexpr size_t WS_MOD = WS_WL0 + 2 * WL_SIZE;
constexpr size_t WS_SC = WS_MOD + alm(2ull * 36 * NADA * 4);
constexpr size_t WS_XN = WS_SC + alm(256ull * DM * 2);
constexpr size_t WS_Q = WS_XN + alm((size_t)MT * DM * 2);
constexpr size_t WS_K = WS_Q + alm((size_t)MT * QKV * 2);
constexpr size_t WS_V = WS_K + alm((size_t)MT * QKV * 2);
constexpr size_t WS_U = WS_V + alm((size_t)MT * QKV * 2);
constexpr size_t WS_VS = WS_U + alm((size_t)MT * 512 * 2);
constexpr size_t WS_G = WS_VS + alm((size_t)MT * 512 * 2);
constexpr size_t WS_OG = WS_G + alm((size_t)MT * 2048 * 2);
constexpr size_t WS_DG = WS_OG + alm((size_t)MT * QKV * 2);
constexpr size_t WS_YA = WS_DG + alm((size_t)MT * 12 * 4);
constexpr size_t WS_YS = WS_YA + alm((size_t)MT * 512 * 2);
constexpr size_t WS_T1 = WS_YS + alm((size_t)MT * 512 * 2);
constexpr size_t WS_MG = WS_T1 + alm((size_t)MT * DM * 4);
constexpr size_t WS_X1 = WS_MG + alm((size_t)MT * DM * 2);
constexpr size_t WS_X2 = WS_X1 + alm((size_t)MT * DM * 4);
constexpr size_t WS_H = WS_X2 + alm((size_t)MT * DM * 4);
constexpr size_t WS_END = WS_H + alm((size_t)MT * DFF * 2);

constexpr int LDS_RING = 0, LDS_EXCH = 131072, LDS_BYTES = 155648;

__device__ __forceinline__ float bf2f(unsigned short h) { return __uint_as_float((unsigned)h << 16); }
__device__ __forceinline__ unsigned pk2(float lo, float hi) { return pg8::cvt_pk_bf16(lo, hi); }
__device__ __forceinline__ float fast_exp2(float x) { return __builtin_amdgcn_exp2f(x); }
__device__ __forceinline__ float sigmoidf_(float x) { return __builtin_amdgcn_rcpf(1.0f + fast_exp2(-x * LOG2E)); }
__device__ __forceinline__ float wave_sum(float v) {
#pragma unroll
    for (int o = 1; o < 64; o <<= 1) v += __shfl_xor(v, o);
    return v;
}
__device__ __forceinline__ float wave_max(float v) {
#pragma unroll
    for (int o = 1; o < 64; o <<= 1) v = fmaxf(v, __shfl_xor(v, o));
    return v;
}
__device__ __forceinline__ s16x4 vtr(const LAS unsigned char* p) { return __builtin_bit_cast(s16x4, __builtin_amdgcn_ds_read_tr16_b64_v4i16((LAS v4i16_t*)p)); }
#define LDS_WAIT() asm volatile("s_waitcnt lgkmcnt(0)" ::: "memory")

__device__ __forceinline__ int mod_row(int row) { return row < MP ? (row >> 12) : 4 + (row - MP); }

__device__ __forceinline__ __attribute__((address_space(1))) float* kv_out_ptr(__attribute__((address_space(1))) float* out, int layer, int g, int row, int kvi, int hh) {
    if (row < MP) {
        const int b = row >> 12, t = row & 4095, lw = 128 << (2 * g), tt = t - (SEQ - lw);
        if (tt < 0) return nullptr;
        const size_t base = g == 0 ? O_KV0P : (g == 1 ? O_KV1P : O_KV2P);
        return out + base + ((((size_t)(layer * NBATCH + b) * lw + tt) * 2 + kvi) * 4 + hh) * 128;
    } else if (row < MV) {
        const int b = row - MP;
        const size_t base = g == 0 ? O_KV0S : (g == 1 ? O_KV1S : O_KV2S);
        return out + base + (((size_t)(layer * NSMP + b) * 2 + kvi) * 4 + hh) * 128;
    }
    return nullptr;
}

using pg8::Unit;
typedef pg8::f32x4 (AccT)[2][2][4][2];

__device__ __forceinline__ void st8_bf16g(__attribute__((address_space(1))) bf16* p, f32x4 v0, f32x4 v1) {
    u32x4 w; w.x = pk2(v0[0], v0[1]); w.y = pk2(v0[2], v0[3]); w.z = pk2(v1[0], v1[1]); w.w = pk2(v1[2], v1[3]);
    *(__attribute__((address_space(1))) u32x4*)p = w;
}
__device__ __forceinline__ void st8_bf16(bf16* p, f32x4 v0, f32x4 v1) {
    u32x4 w; w.x = pk2(v0[0], v0[1]); w.y = pk2(v0[2], v0[3]); w.z = pk2(v1[0], v1[1]); w.w = pk2(v1[2], v1[3]);
    *(u32x4*)p = w;
}

#define LAUNDER_S(x) asm volatile("" : "+s"(x))
#define GP(T, p) ((T*)(__attribute__((address_space(1))) T*)(p))
struct EpiAda {
    static constexpr bool PERM = true, AFTER_DRAIN = false;
    float* MOD; const float* b_ada;
    __device__ __forceinline__ void operator()(const pg8::f32x4 (&acc)[2][2][4][2], const Unit& u, int wr, int wc, int fr_, int fq_) const {
        int fr = fr_, fq = fq_; asm volatile("" : "+v"(fr), "+v"(fq));
        if (u.pm != 0 || wr != 0) return;
#pragma unroll
        for (int m = 0; m < 3; ++m) {
            const int row = m * 16 + fr;
            if (row >= 36) continue;
#pragma unroll
            for (int bj = 0; bj < 2; ++bj) {
                const int col = u.pn * 256 + bj * 128 + wc * 32 + 8 * fq;
                const int layer = col / NADA, c = col - layer * NADA;
                const float* bp = b_ada + (size_t)layer * NADA + c;
                float* op = MOD + ((size_t)layer * 36 + row) * NADA + c;
                *(f32x4*)op = acc[0][bj][m][0] + *(const f32x4*)bp;
                *(f32x4*)(op + 4) = acc[0][bj][m][1] + *(const f32x4*)(bp + 4);
            }
        }
    }
};

struct EpiIn {
    static constexpr bool PERM = true, AFTER_DRAIN = false;
    unsigned char* wsb; const float* qw; const float* kw; float* out; int layer; LAS float* P;
    __device__ __forceinline__ void operator()(const pg8::f32x4 (&acc)[2][2][4][2], const Unit& u, int wr, int wc, int fr_, int fq_) const {
        int fr = fr_, fq = fq_; asm volatile("" : "+v"(fr), "+v"(fq));
        unsigned char* wsl = wsb; const float* qwl = qw; const float* kwl = kw; float* outl = out; LAUNDER_S(wsl); LAUNDER_S(qwl); LAUNDER_S(kwl); LAUNDER_S(outl);
        typedef __attribute__((address_space(1))) bf16 gbf; typedef __attribute__((address_space(1))) float gfl;
        gbf *Q = (gbf*)(wsl + WS_Q), *K = (gbf*)(wsl + WS_K), *V = (gbf*)(wsl + WS_V), *U = (gbf*)(wsl + WS_U), *VS = (gbf*)(wsl + WS_VS), *G = (gbf*)(wsl + WS_G);
        gfl* outg = (gfl*)outl;
        const int pn = u.pn;
        const int cw = wc * 32 + 8 * fq;
        const int rowb = u.pm * 256 + wr * 64 + fr;
        if (pn < 12) {
            const bool isk = pn >= 6;
#pragma unroll
            for (int ai = 0; ai < 2; ++ai)
#pragma unroll
                for (int m = 0; m < 4; ++m)
#pragma unroll
                    for (int bj = 0; bj < 2; ++bj) {
                        const pg8::f32x4 a = acc[ai][bj][m][0], b = acc[ai][bj][m][1];
                        float s = (a[0] * a[0] + a[1] * a[1]) + (a[2] * a[2] + a[3] * a[3]) + (b[0] * b[0] + b[1] * b[1]) + (b[2] * b[2] + b[3] * b[3]);
                        s += __shfl_xor(s, 16); s += __shfl_xor(s, 32);
                        if (fq == 0) P[(ai * 128 + wr * 64 + m * 16 + fr) * 8 + bj * 4 + wc] = s;
                    }
            asm volatile("s_waitcnt lgkmcnt(0)" ::: "memory"); __builtin_amdgcn_s_barrier(); asm volatile("" ::: "memory");
#pragma unroll
            for (int bj = 0; bj < 2; ++bj) {
                const int head = 2 * (isk ? pn - 6 : pn) + bj, g = head >> 2, hh = head & 3;
                const __attribute__((address_space(1))) float* wv = (const __attribute__((address_space(1))) float*)(isk ? kwl : qwl) + g * 128 + cw;
                pg8::f32x4 w0 = *(const __attribute__((address_space(1))) f32x4*)wv, w1 = *(const __attribute__((address_space(1))) f32x4*)(wv + 4);
                if (!isk) { w0 = w0 * QSCALE; w1 = w1 * QSCALE; }
                gbf* dst = (isk ? K : Q) + head * 128 + cw;
#pragma unroll
                for (int ai = 0; ai < 2; ++ai)
#pragma unroll
                    for (int m = 0; m < 4; ++m) {
                        const int rl = ai * 128 + wr * 64 + m * 16 + fr, row = u.pm * 256 + rl;
                        const f32x4 pv = *(const LAS f32x4*)(P + rl * 8 + bj * 4);
                        const float rstd = 1.0f / sqrtf(((pv[0] + pv[1]) + (pv[2] + pv[3])) * (1.0f / 128.0f) + 1e-6f);
                        const pg8::f32x4 v0 = acc[ai][bj][m][0] * rstd * w0, v1 = acc[ai][bj][m][1] * rstd * w1;
                        st8_bf16g(dst + (size_t)row * QKV, v0, v1);
                        if (isk) { gfl* o = kv_out_ptr(outg, layer, g, row, 0, hh); if (o) { *(__attribute__((address_space(1))) f32x4*)(o + cw) = v0; *(__attribute__((address_space(1))) f32x4*)(o + cw + 4) = v1; } }
                    }
            }
        } else if (pn < 18) {
#pragma unroll
            for (int bj = 0; bj < 2; ++bj) {
                const int head = 2 * (pn - 12) + bj, g = head >> 2, hh = head & 3;
                gbf* dst = V + head * 128 + cw;
#pragma unroll
                for (int ai = 0; ai < 2; ++ai)
#pragma unroll
                    for (int m = 0; m < 4; ++m) {
                        const int row = rowb + ai * 128 + m * 16;
                        const pg8::f32x4 v0 = acc[ai][bj][m][0], v1 = acc[ai][bj][m][1];
                        st8_bf16g(dst + (size_t)row * QKV, v0, v1);
                        gfl* o = kv_out_ptr(outg, layer, g, row, 1, hh); if (o) { *(__attribute__((address_space(1))) f32x4*)(o + cw) = v0; *(__attribute__((address_space(1))) f32x4*)(o + cw + 4) = v1; }
                    }
            }
        } else if (pn < 22) {
            gbf* base = (pn < 20 ? U : VS) + ((pn - 18) & 1) * 256 + cw;
#pragma unroll
            for (int bj = 0; bj < 2; ++bj)
#pragma unroll
                for (int ai = 0; ai < 2; ++ai)
#pragma unroll
                    for (int m = 0; m < 4; ++m) {
                        const int row = rowb + ai * 128 + m * 16;
                        const pg8::f32x4 v0 = acc[ai][bj][m][0], v1 = acc[ai][bj][m][1];
                        const pg8::f32x2 a = pg8::gelu_pk((pg8::f32x2){v0[0], v0[1]}), b = pg8::gelu_pk((pg8::f32x2){v0[2], v0[3]}),
                                         c = pg8::gelu_pk((pg8::f32x2){v1[0], v1[1]}), d = pg8::gelu_pk((pg8::f32x2){v1[2], v1[3]});
                        st8_bf16g(base + (size_t)row * 512 + bj * 128, (f32x4){a.x, a.y, b.x, b.y}, (f32x4){c.x, c.y, d.x, d.y});
                    }
        } else {
            gbf* base = G + (pn - 22) * 256 + cw;
#pragma unroll
            for (int bj = 0; bj < 2; ++bj)
#pragma unroll
                for (int ai = 0; ai < 2; ++ai)
#pragma unroll
                    for (int m = 0; m < 4; ++m) {
                        const int row = rowb + ai * 128 + m * 16;
                        const pg8::f32x4 v0 = acc[ai][bj][m][0], v1 = acc[ai][bj][m][1];
                        st8_bf16g(base + (size_t)row * 2048 + bj * 128,
                                 (f32x4){sigmoidf_(v0[0]), sigmoidf_(v0[1]), sigmoidf_(v0[2]), sigmoidf_(v0[3])},
                                 (f32x4){sigmoidf_(v1[0]), sigmoidf_(v1[1]), sigmoidf_(v1[2]), sigmoidf_(v1[3])});
                    }
        }
    }
};

struct EpiGate1 {
    static constexpr bool PERM = true, AFTER_DRAIN = false;
    const bf16* G; float* T1;
    __device__ __forceinline__ void operator()(const pg8::f32x4 (&acc)[2][2][4][2], const Unit& u, int wr, int wc, int fr_, int fq_) const {
        int fr = fr_, fq = fq_; asm volatile("" : "+v"(fr), "+v"(fq));
        const int col0 = u.pn * 256 + wc * 32 + 8 * fq, rowb = u.pm * 256 + wr * 64 + fr;
#pragma unroll
        for (int ai = 0; ai < 2; ++ai)
#pragma unroll
            for (int m = 0; m < 4; ++m) {
                const int row = rowb + ai * 128 + m * 16;
#pragma unroll
                for (int bj = 0; bj < 2; ++bj) {
                    const int col = col0 + bj * 128;
                    const u32x4 gv = *(const u32x4*)(G + (size_t)row * 2048 + col);
                    const f32x4 g0 = {__uint_as_float(gv.x << 16), __uint_as_float(gv.x & 0xffff0000u), __uint_as_float(gv.y << 16), __uint_as_float(gv.y & 0xffff0000u)};
                    const f32x4 g1 = {__uint_as_float(gv.z << 16), __uint_as_float(gv.z & 0xffff0000u), __uint_as_float(gv.w << 16), __uint_as_float(gv.w & 0xffff0000u)};
                    float* o = T1 + (size_t)row * DM + col;
                    *(f32x4*)o = g0 * acc[ai][bj][m][0]; *(f32x4*)(o + 4) = g1 * acc[ai][bj][m][1];
                }
            }
    }
};
struct EpiGate2 {
    static constexpr bool PERM = true, AFTER_DRAIN = false;
    const bf16* G; const float* T1; bf16* MG;
    __device__ __forceinline__ void operator()(const pg8::f32x4 (&acc)[2][2][4][2], const Unit& u, int wr, int wc, int fr_, int fq_) const {
        int fr = fr_, fq = fq_; asm volatile("" : "+v"(fr), "+v"(fq));
        const int col0 = u.pn * 256 + wc * 32 + 8 * fq, rowb = u.pm * 256 + wr * 64 + fr;
#pragma unroll
        for (int ai = 0; ai < 2; ++ai)
#pragma unroll
            for (int m = 0; m < 4; ++m) {
                const int row = rowb + ai * 128 + m * 16;
#pragma unroll
                for (int bj = 0; bj < 2; ++bj) {
                    const int col = col0 + bj * 128;
                    const u32x4 gv = *(const u32x4*)(G + (size_t)row * 2048 + 1024 + col);
                    const f32x4 g0 = {__uint_as_float(gv.x << 16), __uint_as_float(gv.x & 0xffff0000u), __uint_as_float(gv.y << 16), __uint_as_float(gv.y & 0xffff0000u)};
                    const f32x4 g1 = {__uint_as_float(gv.z << 16), __uint_as_float(gv.z & 0xffff0000u), __uint_as_float(gv.w << 16), __uint_as_float(gv.w & 0xffff0000u)};
                    const float* t = T1 + (size_t)row * DM + col;
                    const f32x4 t0 = *(const f32x4*)t, t1 = *(const f32x4*)(t + 4);
                    st8_bf16(MG + (size_t)row * DM + col, t0 + g0 * acc[ai][bj][m][0], t1 + g1 * acc[ai][bj][m][1]);
                }
            }
    }
};
struct EpiRes {
    static constexpr bool PERM = true, AFTER_DRAIN = false;
    const float* bp; const float* bs; float* op; float* os; const float* gate;
    __device__ __forceinline__ void operator()(const pg8::f32x4 (&acc)[2][2][4][2], const Unit& u, int wr, int wc, int fr_, int fq_) const {
        int fr = fr_, fq = fq_; asm volatile("" : "+v"(fr), "+v"(fq));
        const int col0 = u.pn * 256 + wc * 32 + 8 * fq, rowb = u.pm * 256 + wr * 64 + fr;
#pragma unroll
        for (int ai = 0; ai < 2; ++ai)
#pragma unroll
            for (int m = 0; m < 4; ++m) {
                const int row = rowb + ai * 128 + m * 16;
                if (row < MV) {
                    const float* b = row < MP ? bp + (size_t)row * DM : bs + (size_t)(row - MP) * DM;
                    float* o = row < MP ? op + (size_t)row * DM : os + (size_t)(row - MP) * DM;
                    const float* gt = gate + (size_t)mod_row(row) * NADA;
#pragma unroll
                    for (int bj = 0; bj < 2; ++bj) {
                        const int col = col0 + bj * 128;
                        const f32x4 b0 = *(const f32x4*)(b + col), b1 = *(const f32x4*)(b + col + 4);
                        const f32x4 g0 = *(const f32x4*)(gt + col), g1 = *(const f32x4*)(gt + col + 4);
                        *(f32x4*)(o + col) = b0 + g0 * acc[ai][bj][m][0]; *(f32x4*)(o + col + 4) = b1 + g1 * acc[ai][bj][m][1];
                    }
                }
            }
    }
};
struct EpiSwiglu {
    static constexpr bool PERM = true, AFTER_DRAIN = false;
    bf16* H;
    __device__ __forceinline__ void operator()(const pg8::f32x4 (&acc)[2][2][4][2], const Unit& u, int wr, int wc, int fr_, int fq_) const {
        int fr = fr_, fq = fq_; asm volatile("" : "+v"(fr), "+v"(fq));
        const int col = u.pn * 128 + wc * 32 + 8 * fq, rowb = u.pm * 256 + wr * 64 + fr;
#pragma unroll
        for (int ai = 0; ai < 2; ++ai)
#pragma unroll
            for (int m = 0; m < 4; ++m) {
                const int row = rowb + ai * 128 + m * 16;
                f32x4 r0, r1;
#pragma unroll
                for (int e = 0; e < 4; ++e) {
                    const float a0 = acc[ai][0][m][0][e], a1 = acc[ai][0][m][1][e];
                    r0[e] = a0 * sigmoidf_(a0) * acc[ai][1][m][0][e];
                    r1[e] = a1 * sigmoidf_(a1) * acc[ai][1][m][1][e];
                }
                st8_bf16(H + (size_t)row * DFF + col, r0, r1);
            }
    }
};

__device__ __forceinline__ void transpose_item(const float* W, int K, int N, bf16* WT, int mode, LAS float* scr, int item, int lane) {
    const int nblk = N / 32, kb = item / nblk, nb = item % nblk, k0 = 64 * kb, n0 = 32 * nb;
#pragma unroll 8
    for (int i = 0; i < 32; ++i) { const int kk = 2 * i + (lane >> 5); scr[kk * 33 + (lane & 31)] = W[(size_t)(k0 + kk) * N + n0 + (lane & 31)]; }
    LDS_WAIT(); asm volatile("" ::: "memory");
    int drow0 = n0;
    if (mode == 1) { const int bj = n0 >= DFF ? 1 : 0; const int j0 = n0 - bj * DFF; drow0 = (j0 >> 7) * 256 + bj * 128 + (j0 & 127); }
    const int c = lane & 7;
#pragma unroll
    for (int j = 0; j < 4; ++j) { const int n = (lane >> 3) + 8 * j; const LAS float* s = scr + (8 * c) * 33 + n;
        u32x4 o; o.x = pk2(s[0 * 33], s[1 * 33]); o.y = pk2(s[2 * 33], s[3 * 33]); o.z = pk2(s[4 * 33], s[5 * 33]); o.w = pk2(s[6 * 33], s[7 * 33]);
        *(u32x4*)(WT + (size_t)(drow0 + n) * K + k0 + 8 * c) = o; }
    LDS_WAIT(); asm volatile("" ::: "memory");
}

__device__ __forceinline__ void norm_mod_phase(const float* xp, const float* xs, const float* nw, const float* modl, int sh_off, bf16* XN, int gw, int NGW, int lane) {
    for (int row = gw; row < MT; row += NGW) {
        unsigned long long* o8 = (unsigned long long*)(XN + (size_t)row * DM) + lane;
        if (row >= MV) {
#pragma unroll
            for (int j = 0; j < 4; ++j) o8[64 * j] = 0ull;
            continue;
        }
        const float* xrow = row < MP ? xp + (size_t)row * DM : xs + (size_t)(row - MP) * DM;
        const f32x4* xr = (const f32x4*)xrow + lane;
        f32x4 v[4]; float s = 0.f;
#pragma unroll
        for (int j = 0; j < 4; ++j) { v[j] = xr[64 * j]; s += (v[j].x * v[j].x + v[j].y * v[j].y) + (v[j].z * v[j].z + v[j].w * v[j].w); }
        const float rstd = 1.0f / sqrtf(wave_sum(s) * (1.0f / DM) + 1e-6f);
        const float* mr = modl + (size_t)mod_row(row) * NADA + sh_off;
#pragma unroll
        for (int j = 0; j < 4; ++j) {
            const int col = 4 * lane + 256 * j;
            const f32x4 w = *(const f32x4*)(nw + col), shv = *(const f32x4*)(mr + col), scv = *(const f32x4*)(mr + 1024 + col);
            const f32x4 y = v[j] * rstd * w * (scv + 1.0f) + shv;
            o8[64 * j] = (unsigned long long)pk2(y.x, y.y) | ((unsigned long long)pk2(y.z, y.w) << 32);
        }
    }
}

constexpr int KV_STRIDE = 272;
constexpr int ATT_K_OFF = 0, ATT_V_OFF = 256 * KV_STRIDE;
__device__ __forceinline__ float alibi_slope(int head12) { return exp2f(-8.0f * (float)(head12 + 1) / 12.0f); }

__device__ __forceinline__ void attn_unit(LAS unsigned char* lds, const bf16* Q, const bf16* K, const bf16* V, bf16* OG, float* DG, int unit, float cshift, int wid, int lane, int tid) {
    const int g = unit >> 9, r9 = unit & 511, sh = 2 * g, d = 1 << sh, nb = 32 >> sh;
    const int qb = r9 % nb; int t2 = r9 / nb; const int r = t2 % d; t2 /= d; const int h = t2 & 3, b = t2 >> 2;
    const int hc = (g * 4 + h) * 128;
    {
        const int ch = tid & 15, r0 = tid >> 4;
        u32x4 kv[8], vv[8];
#pragma unroll
        for (int it = 0; it < 8; ++it) {
            const int j = r0 + 32 * it, mk = 128 * qb - 128 + j;
            if (qb > 0 || it >= 4) {
                const size_t off = ((size_t)b * SEQ + (size_t)mk * d + r) * QKV + hc + ch * 8;
                kv[it] = *(const u32x4*)(K + off); vv[it] = *(const u32x4*)(V + off);
            } else { kv[it] = (u32x4){0u, 0u, 0u, 0u}; vv[it] = (u32x4){0u, 0u, 0u, 0u}; }
        }
#pragma unroll
        for (int it = 0; it < 8; ++it) {
            const int j = r0 + 32 * it;
            *(LAS u32x4*)(lds + ATT_K_OFF + j * KV_STRIDE + ch * 16) = kv[it];
            *(LAS u32x4*)(lds + ATT_V_OFF + j * KV_STRIDE + ch * 16) = vv[it];
        }
    }
    const int ql = lane & 15, gq = lane >> 4;
    const int qi = 16 * wid + ql;
    const size_t qrow = (size_t)b * SEQ + (size_t)(128 * qb + qi) * d + r;
    bf16x8 qf[4];
#pragma unroll
    for (int kk = 0; kk < 4; ++kk) qf[kk] = *(const bf16x8*)(Q + qrow * QKV + hc + 32 * kk + 8 * gq);
    const float slope2 = alibi_slope(g * 4 + h) * LOG2E * (float)d;
    __syncthreads();
    f32x4 accO[8];
#pragma unroll
    for (int dt = 0; dt < 8; ++dt) accO[dt] = (f32x4){0.f, 0.f, 0.f, 0.f};
    float dsum = 0.f;
    const LAS unsigned char* kbase = lds + ATT_K_OFF + (16 * wid + ql) * KV_STRIDE + gq * 16;
    const LAS unsigned char* vbase = lds + ATT_V_OFF + (16 * wid + 4 * gq + (ql >> 2)) * KV_STRIDE + (ql & 3) * 8;
#pragma unroll
    for (int kt2 = 0; kt2 < 5; ++kt2) {
        const int ja = 16 * wid + 32 * kt2;
        f32x4 sa = {0.f, 0.f, 0.f, 0.f}, sb = {0.f, 0.f, 0.f, 0.f};
#pragma unroll
        for (int kk = 0; kk < 4; ++kk) {
            const bf16x8 ka = *(const LAS bf16x8*)(kbase + (32 * kt2) * KV_STRIDE + kk * 64);
            sa = __builtin_amdgcn_mfma_f32_16x16x32_bf16(ka, qf[kk], sa, 0, 0, 0);
        }
        if (kt2 < 4) {
#pragma unroll
            for (int kk = 0; kk < 4; ++kk) {
                const bf16x8 kb = *(const LAS bf16x8*)(kbase + (32 * kt2 + 16) * KV_STRIDE + kk * 64);
                sb = __builtin_amdgcn_mfma_f32_16x16x32_bf16(kb, qf[kk], sb, 0, 0, 0);
            }
        }
        float pa[4], pb[4];
#pragma unroll
        for (int jj = 0; jj < 4; ++jj) {
            const int j = ja + 4 * gq + jj, dist = 128 + qi - j;
            const bool ok = dist >= 0 && dist <= 128 && (128 * qb - 128 + j) >= 0;
            pa[jj] = ok ? fast_exp2(sa[jj] - slope2 * (float)dist - cshift) : 0.f;
            const int j2 = j + 16, dist2 = dist - 16;
            const bool ok2 = (kt2 < 4) && dist2 >= 0 && dist2 <= 128 && (128 * qb - 128 + j2) >= 0;
            pb[jj] = ok2 ? fast_exp2(sb[jj] - slope2 * (float)dist2 - cshift) : 0.f;
            dsum += pa[jj] + pb[jj];
        }
        u32x4 pw; pw.x = pk2(pa[0], pa[1]); pw.y = pk2(pa[2], pa[3]); pw.z = pk2(pb[0], pb[1]); pw.w = pk2(pb[2], pb[3]);
        const bf16x8 pfrag = __builtin_bit_cast(bf16x8, pw);
        const int rb = (kt2 < 4) ? (32 * kt2 + 16) : (32 * kt2);
#pragma unroll
        for (int dt = 0; dt < 8; ++dt) {
            const s16x4 lo = vtr(vbase + (32 * kt2) * KV_STRIDE + dt * 32);
            const s16x4 hi = vtr(vbase + rb * KV_STRIDE + dt * 32);
            const bf16x8 vf = {lo[0], lo[1], lo[2], lo[3], hi[0], hi[1], hi[2], hi[3]};
            accO[dt] = __builtin_amdgcn_mfma_f32_16x16x32_bf16(vf, pfrag, accO[dt], 0, 0, 0);
        }
    }
    dsum += __shfl_xor(dsum, 16); dsum += __shfl_xor(dsum, 32);
    const float inv = 1.0f / dsum;
    bf16* op = OG + qrow * QKV + g * 512 + h * 128 + 4 * gq;
#pragma unroll
    for (int dt = 0; dt < 8; ++dt) {
        u32x2 w; w.x = pk2(accO[dt][0] * inv, accO[dt][1] * inv); w.y = pk2(accO[dt][2] * inv, accO[dt][3] * inv);
        *(u32x2*)(op + dt * 16) = w;
    }
    if (gq == 0) DG[qrow * 12 + g * 4 + h] = dsum;
    __syncthreads();
}

__device__ __forceinline__ void attn_sample_item(LAS unsigned char* lds, const bf16* Q, const bf16* K, const bf16* V, const float* c0, const float* c1, const float* c2, int layer, bf16* YA, int item, int wid, int lane) {
    const int b = item >> 2, h = item & 3;
    LAS float* sc = (LAS float*)lds;
    LAS float* part = (LAS float*)(lds + 2048);
    const size_t row = (size_t)MP + b;
    float q0[3], q1[3];
#pragma unroll
    for (int g = 0; g < 3; ++g) { const unsigned qq = *(const unsigned*)(Q + row * QKV + (g * 4 + h) * 128 + 2 * lane); q0[g] = __uint_as_float(qq << 16); q1[g] = __uint_as_float(qq & 0xffff0000u); }
    for (int j = wid; j < 387; j += 8) {
        const int g = j / 129, step = j - g * 129, d = 1 << (2 * g), lc = 128 << (2 * g);
        float k0, k1;
        if (step == 0) { const unsigned kk = *(const unsigned*)(K + row * QKV + (g * 4 + h) * 128 + 2 * lane); k0 = __uint_as_float(kk << 16); k1 = __uint_as_float(kk & 0xffff0000u); }
        else { const float* cp = (g == 0 ? c0 : (g == 1 ? c1 : c2)) + ((((size_t)(layer * NSMP + b) * lc + (lc - d * step)) * 2 + 0) * 4 + h) * 128 + 2 * lane; const f32x2 kv = *(const f32x2*)cp; k0 = kv.x; k1 = kv.y; }
        const float qa = g == 0 ? q0[0] : (g == 1 ? q0[1] : q0[2]), qb = g == 0 ? q1[0] : (g == 1 ? q1[1] : q1[2]);
        float s = wave_sum(qa * k0 + qb * k1);
        s -= alibi_slope(g * 4 + h) * LOG2E * (float)(d * step);
        if (lane == 0) sc[j] = s;
    }
    LDS_WAIT(); __syncthreads();
    float mx = -3.0e38f;
    for (int j = lane; j < 387; j += 64) mx = fmaxf(mx, sc[j]);
    mx = wave_max(mx);
    float den = 0.f;
    for (int j = lane; j < 387; j += 64) den += fast_exp2(sc[j] - mx);
    den = wave_sum(den);
    float n0 = 0.f, n1 = 0.f;
    for (int j = wid; j < 387; j += 8) {
        const int g = j / 129, step = j - g * 129, d = 1 << (2 * g), lc = 128 << (2 * g);
        float v0, v1;
        if (step == 0) { const unsigned vv = *(const unsigned*)(V + row * QKV + (g * 4 + h) * 128 + 2 * lane); v0 = __uint_as_float(vv << 16); v1 = __uint_as_float(vv & 0xffff0000u); }
        else { const float* cp = (g == 0 ? c0 : (g == 1 ? c1 : c2)) + ((((size_t)(layer * NSMP + b) * lc + (lc - d * step)) * 2 + 1) * 4 + h) * 128 + 2 * lane; const f32x2 vv = *(const f32x2*)cp; v0 = vv.x; v1 = vv.y; }
        const float p = fast_exp2(sc[j] - mx);
        n0 += p * v0; n1 += p * v1;
    }
    part[wid * 128 + 2 * lane] = n0; part[wid * 128 + 2 * lane + 1] = n1;
    LDS_WAIT(); __syncthreads();
    if (wid == 0) {
        float a0 = 0.f, a1 = 0.f;
#pragma unroll
        for (int w = 0; w < 8; ++w) { a0 += part[w * 128 + 2 * lane]; a1 += part[w * 128 + 2 * lane + 1]; }
        const float inv = 1.0f / den;
        *(unsigned*)(YA + row * 512 + h * 128 + 2 * lane) = pk2(a0 * inv, a1 * inv);
    }
    LDS_WAIT(); __syncthreads();
}

constexpr int SG_STRIDE = 144;
constexpr int SG_SLAB = 128 * SG_STRIDE;
constexpr int SG_STATS = 4 * SG_SLAB;
__device__ __forceinline__ void sgu_unit(LAS unsigned char* lds, const bf16* U, const bf16* VS, const float* lnw, const float* lnb, const bf16* WSP, const float* bsp, bf16* YS, int unit, int wid, int lane) {
    const int half = unit & 1, bn = unit >> 1;
    const size_t R0 = (size_t)bn * 128;
    LAS f32x2* stats = (LAS f32x2*)(lds + SG_STATS);
    for (int i = 0; i < 16; ++i) {
        const int rl = 16 * wid + i;
        const u32x4 x = *(const u32x4*)(VS + (R0 + rl) * 512 + 8 * lane);
        const float f[8] = {__uint_as_float(x.x << 16), __uint_as_float(x.x & 0xffff0000u), __uint_as_float(x.y << 16), __uint_as_float(x.y & 0xffff0000u),
                            __uint_as_float(x.z << 16), __uint_as_float(x.z & 0xffff0000u), __uint_as_float(x.w << 16), __uint_as_float(x.w & 0xffff0000u)};
        float s = 0.f, s2 = 0.f;
#pragma unroll
        for (int e = 0; e < 8; ++e) { s += f[e]; s2 += f[e] * f[e]; }
        s = wave_sum(s); s2 = wave_sum(s2);
        const float mean = s * (1.0f / 512.0f), var = fmaxf(s2 * (1.0f / 512.0f) - mean * mean, 0.f);
        if (lane == 0) stats[rl] = (f32x2){mean, 1.0f / sqrtf(var + 1e-6f)};
    }
    LDS_WAIT(); __syncthreads();
    const int gl = wid & 3, th = wid >> 2, grp = half * 4 + gl, c0 = grp * 64;
    LAS unsigned char* slab = lds + gl * SG_SLAB;
    {
        const int cc = (lane & 7) * 8;
        const f32x4 w0 = *(const f32x4*)(lnw + c0 + cc), w1 = *(const f32x4*)(lnw + c0 + cc + 4), b0 = *(const f32x4*)(lnb + c0 + cc), b1 = *(const f32x4*)(lnb + c0 + cc + 4);
#pragma unroll
        for (int it = 0; it < 8; ++it) {
            const int rl = th * 64 + it * 8 + (lane >> 3);
            const u32x4 x = *(const u32x4*)(VS + (R0 + rl) * 512 + c0 + cc);
            const f32x2 st = stats[rl];
            f32x4 a = {__uint_as_float(x.x << 16), __uint_as_float(x.x & 0xffff0000u), __uint_as_float(x.y << 16), __uint_as_float(x.y & 0xffff0000u)};
            f32x4 c = {__uint_as_float(x.z << 16), __uint_as_float(x.z & 0xffff0000u), __uint_as_float(x.w << 16), __uint_as_float(x.w & 0xffff0000u)};
            a = (a - st.x) * st.y * w0 + b0; c = (c - st.x) * st.y * w1 + b1;
            u32x4 o; o.x = pk2(a[0], a[1]); o.y = pk2(a[2], a[3]); o.z = pk2(c[0], c[1]); o.w = pk2(c[2], c[3]);
            *(LAS u32x4*)(slab + rl * SG_STRIDE + cc * 2) = o;
        }
    }
    LDS_WAIT(); __syncthreads();
    const int ql = lane & 15, gq = lane >> 4;
    const LAS unsigned char* abase = slab + (8 * gq + (ql >> 2)) * SG_STRIDE + (ql & 3) * 8;
    const bf16* wg = WSP + (size_t)grp * 128 * 128;
#pragma unroll
    for (int ti = 0; ti < 4; ++ti) {
        const int tt = th == 0 ? (ti == 0 ? 0 : (ti == 1 ? 3 : (ti == 2 ? 4 : 7))) : (ti == 0 ? 1 : (ti == 1 ? 2 : (ti == 2 ? 5 : 6)));
        const int t = 16 * tt + ql;
        f32x4 acc[4];
#pragma unroll
        for (int ct = 0; ct < 4; ++ct) acc[ct] = (f32x4){0.f, 0.f, 0.f, 0.f};
        for (int kk = 0; kk <= (tt >> 1); ++kk) {
            const bf16x8 wf = *(const bf16x8*)(wg + (size_t)t * 128 + 32 * kk + 8 * gq);
#pragma unroll
            for (int ct = 0; ct < 4; ++ct) {
                const s16x4 lo = vtr(abase + (32 * kk) * SG_STRIDE + ct * 32);
                const s16x4 hi = vtr(abase + (32 * kk + 4) * SG_STRIDE + ct * 32);
                const bf16x8 af = {lo[0], lo[1], lo[2], lo[3], hi[0], hi[1], hi[2], hi[3]};
                acc[ct] = __builtin_amdgcn_mfma_f32_16x16x32_bf16(af, wf, acc[ct], 0, 0, 0);
            }
        }
        const float bias = bsp[grp * 128 + t];
#pragma unroll
        for (int ct = 0; ct < 4; ++ct) {
            const size_t off = (R0 + t) * 512 + c0 + ct * 16 + 4 * gq;
            const u32x2 uu = *(const u32x2*)(U + off);
            const float u0 = __uint_as_float(uu.x << 16), u1 = __uint_as_float(uu.x & 0xffff0000u), u2 = __uint_as_float(uu.y << 16), u3 = __uint_as_float(uu.y & 0xffff0000u);
            u32x2 o; o.x = pk2(u0 * (acc[ct][0] + bias), u1 * (acc[ct][1] + bias)); o.y = pk2(u2 * (acc[ct][2] + bias), u3 * (acc[ct][3] + bias));
            *(u32x2*)(YS + off) = o;
        }
    }
    LDS_WAIT(); __syncthreads();
}

__device__ __forceinline__ void sgu_sample_row(const bf16* U, const bf16* VS, const float* lnw, const float* lnb, const float* wsp_f32, const float* bsp, bf16* YS, float* out_sv, int b, int lane) {
    const size_t row = (size_t)MP + b;
    const u32x4 x = *(const u32x4*)(VS + row * 512 + 8 * lane);
    float f[8] = {__uint_as_float(x.x << 16), __uint_as_float(x.x & 0xffff0000u), __uint_as_float(x.y << 16), __uint_as_float(x.y & 0xffff0000u),
                  __uint_as_float(x.z << 16), __uint_as_float(x.z & 0xffff0000u), __uint_as_float(x.w << 16), __uint_as_float(x.w & 0xffff0000u)};
    float s = 0.f, s2 = 0.f;
#pragma unroll
    for (int e = 0; e < 8; ++e) { s += f[e]; s2 += f[e] * f[e]; }
    s = wave_sum(s); s2 = wave_sum(s2);
    const float mean = s * (1.0f / 512.0f), var = fmaxf(s2 * (1.0f / 512.0f) - mean * mean, 0.f), rstd = 1.0f / sqrtf(var + 1e-6f);
    const int c = 8 * lane, grp = c >> 6;
    const float w00 = wsp_f32[(size_t)grp * 128 * 128], b0 = bsp[grp * 128];
    const u32x4 uu = *(const u32x4*)(U + row * 512 + c);
    const float uf[8] = {__uint_as_float(uu.x << 16), __uint_as_float(uu.x & 0xffff0000u), __uint_as_float(uu.y << 16), __uint_as_float(uu.y & 0xffff0000u),
                         __uint_as_float(uu.z << 16), __uint_as_float(uu.z & 0xffff0000u), __uint_as_float(uu.w << 16), __uint_as_float(uu.w & 0xffff0000u)};
    float y[8];
#pragma unroll
    for (int e = 0; e < 8; ++e) { const float vn = (f[e] - mean) * rstd * lnw[c + e] + lnb[c + e]; out_sv[c + e] = vn; y[e] = uf[e] * (w00 * vn + b0); }
    u32x4 o; o.x = pk2(y[0], y[1]); o.y = pk2(y[2], y[3]); o.z = pk2(y[4], y[5]); o.w = pk2(y[6], y[7]);
    *(u32x4*)(YS + row * 512 + c) = o;
}

__device__ __forceinline__ void merge_row(const bf16* OG, const float* DG, bf16* YA, int row, int lane) {
    const int h = lane >> 4;
    const float d0 = DG[(size_t)row * 12 + h], d1 = DG[(size_t)row * 12 + 4 + h], d2 = DG[(size_t)row * 12 + 8 + h];
    const float inv = 1.0f / (d0 + d1 + d2);
    const float a0 = d0 * inv, a1 = d1 * inv, a2 = d2 * inv;
    const bf16* p = OG + (size_t)row * QKV + 8 * lane;
    const u32x4 x0 = *(const u32x4*)p, x1 = *(const u32x4*)(p + 512), x2 = *(const u32x4*)(p + 1024);
    u32x4 o;
#define MRG(c) pk2(a0 * __uint_as_float(x0.c << 16) + a1 * __uint_as_float(x1.c << 16) + a2 * __uint_as_float(x2.c << 16), \
                   a0 * __uint_as_float(x0.c & 0xffff0000u) + a1 * __uint_as_float(x1.c & 0xffff0000u) + a2 * __uint_as_float(x2.c & 0xffff0000u))
    o.x = MRG(x); o.y = MRG(y); o.z = MRG(z); o.w = MRG(w);
#undef MRG
    *(u32x4*)(YA + (size_t)row * 512 + 8 * lane) = o;
}

#define PHON(k) if constexpr (((PHM) >> (k)) & 1)
#define GSYNC() do { if constexpr (COOP) cg::this_grid().sync(); } while (0)
#define GAS __attribute__((address_space(1)))
#define CAS __attribute__((address_space(4)))
struct Args { GAS const float* in[23]; GAS float* out; GAS unsigned char* ws; };

#define PHASE_ENV() \
    CAS const Args* ap = (CAS const Args*)__builtin_amdgcn_kernarg_segment_ptr(); asm volatile("" : "+s"(ap)); \
    int tid = threadIdx.x; asm volatile("" : "+v"(tid)); \
    const int lane = tid & 63, wid = __builtin_amdgcn_readfirstlane(tid >> 6); \
    int G_ = gridDim.x, bx_ = blockIdx.x; asm volatile("" : "+s"(G_), "+s"(bx_)); const int G = G_, bx = bx_; const int gw = bx * NWAVES + wid, NGW = G * NWAVES; \
    unsigned char* const ws = (unsigned char*)ap->ws; (void)lane; (void)wid; (void)gw; (void)NGW; (void)ws; (void)G; (void)bx
#define WL(l) (ws + WS_WL0 + (size_t)(l) * WL_SIZE)

template <int PHM, bool COOP>
__global__ void __launch_bounds__(NTHREADS, 2) fwd_megakernel(Args args_unused, int l_lo, int l_hi) {
    extern __shared__ __attribute__((aligned(16))) unsigned char lds_raw[];
    LAS unsigned char* lds = (LAS unsigned char*)lds_raw;

    PHON(0) {
        PHASE_ENV();
        bf16* WADA = (bf16*)(ws + WS_WADA); bf16* SC = (bf16*)(ws + WS_SC);
        LAS float* scr = (LAS float*)(lds + wid * 16384);
        constexpr int I_ADA = 16 * 192, I_IN = 16 * 240, I_PA = 8 * 32, I_OUT = 16 * 32, I_FI = 16 * 176, I_FO = 44 * 32;
        constexpr int I_LAYER = I_ADA + I_IN + 2 * I_PA + I_OUT + I_FI + I_FO;
        for (int it = gw; it < 2 * I_LAYER; it += NGW) {
            const int l = it / I_LAYER; int r = it - l * I_LAYER;
            unsigned char* wl = WL(l);
            if (r < I_ADA) { transpose_item(((const float*)ap->in[7]) + (size_t)l * DM * NADA, DM, NADA, WADA + (size_t)l * NADA * DM, 0, scr, r, lane); continue; } r -= I_ADA;
            if (r < I_IN) { transpose_item(((const float*)ap->in[10]) + (size_t)l * DM * DIN, DM, DIN, (bf16*)(wl + WL_WIN), 0, scr, r, lane); continue; } r -= I_IN;
            if (r < I_PA) { transpose_item(((const float*)ap->in[17]) + (size_t)l * 512 * DM, 512, DM, (bf16*)(wl + WL_WPA), 0, scr, r, lane); continue; } r -= I_PA;
            if (r < I_PA) { transpose_item(((const float*)ap->in[18]) + (size_t)l * 512 * DM, 512, DM, (bf16*)(wl + WL_WPS), 0, scr, r, lane); continue; } r -= I_PA;
            if (r < I_OUT) { transpose_item(((const float*)ap->in[19]) + (size_t)l * DM * DM, DM, DM, (bf16*)(wl + WL_WOUT), 0, scr, r, lane); continue; } r -= I_OUT;
            if (r < I_FI) { transpose_item(((const float*)ap->in[21]) + (size_t)l * DM * 2 * DFF, DM, 2 * DFF, (bf16*)(wl + WL_WFI), 1, scr, r, lane); continue; } r -= I_FI;
            transpose_item(((const float*)ap->in[22]) + (size_t)l * DFF * DM, DFF, DM, (bf16*)(wl + WL_WFO), 0, scr, r, lane);
        }
        const int gt = bx * NTHREADS + tid, NGT = G * NTHREADS;
        const float* wsp = ((const float*)ap->in[15]);
        for (int i = gt; i < 2 * 8 * 128 * 128; i += NGT) {
            const int l = i >> 17, r = i & 131071, t = (r >> 7) & 127, s = r & 127;
            const float w = wsp[i];
            ((bf16*)(WL(l) + WL_WSP))[r] = (bf16)(s <= t ? (pk2(w, 0.f) & 0xffffu) : 0u);
        }
        const float* cpr = ((const float*)ap->in[5]); const float* csm = ((const float*)ap->in[6]);
        for (int i = gt; i < 256 * DM; i += NGT) {
            const int r = i >> 10, k = i & 1023;
            float v = 0.f;
            if (r < 4) v = cpr[r * DM + k]; else if (r < 36) v = csm[(r - 4) * DM + k];
            SC[i] = (bf16)(pk2(v * sigmoidf_(v), 0.f) & 0xffffu);
        }
    }
    GSYNC();
    PHON(1) {
        PHASE_ENV();
        pg8::Gemm g{(const bf16*)(ws + WS_SC), (const bf16*)(ws + WS_WADA), 256, 2 * NADA, DM}; pg8::StaticOrder S; S.init(256, 2 * NADA, G, bx);
        EpiAda E{(float*)(ws + WS_MOD), ((const float*)ap->in[8])};
        pg8::gemm_phase<EpiAda, pg8::StaticOrder, true, true>(lds + LDS_RING, g, S, E);
    }
    GSYNC();

    for (int l = l_lo; l < l_hi; ++l) {
        PHON(2) {
            PHASE_ENV();
            const float* X2 = (const float*)(ws + WS_X2);
            const float* xin_p = l == 0 ? ((const float*)ap->in[0]) : X2;
            const float* xin_s = l == 0 ? ((const float*)ap->in[1]) : X2 + (size_t)MP * DM;
            norm_mod_phase(xin_p, xin_s, ((const float*)ap->in[9]) + l * DM, (const float*)(ws + WS_MOD) + (size_t)l * 36 * NADA, 0, (bf16*)(ws + WS_XN), gw, NGW, lane);
        }
        GSYNC();
        PHON(3) {
            PHASE_ENV();
            pg8::Gemm g{(const bf16*)(ws + WS_XN), (const bf16*)(WL(l) + WL_WIN), MT, DIN, DM}; pg8::StaticOrder S; S.init(MT, DIN, G, bx);
            EpiIn E{ws, ((const float*)ap->in[11]) + l * 384, ((const float*)ap->in[12]) + l * 384, ((float*)ap->out), l, (LAS float*)(lds + LDS_EXCH)};
            pg8::gemm_phase<EpiIn, pg8::StaticOrder, true, true>(lds + LDS_RING, g, S, E);
        }
        GSYNC();
        PHON(4) {
            PHASE_ENV();
            const bf16 *Qb = (const bf16*)(ws + WS_Q), *Kb = (const bf16*)(ws + WS_K), *Vb = (const bf16*)(ws + WS_V);
            float mq = 0.f, mk = 0.f;
            for (int i = lane; i < 384; i += 64) { mq = fmaxf(mq, fabsf(((const float*)ap->in[11])[l * 384 + i])); mk = fmaxf(mk, fabsf(((const float*)ap->in[12])[l * 384 + i])); }
            mq = wave_max(mq); mk = wave_max(mk);
            const float cshift = 11.3137085f * LOG2E * mq * mk;
            for (int u = bx; u < 1536; u += G) attn_unit(lds, Qb, Kb, Vb, (bf16*)(ws + WS_OG), (float*)(ws + WS_DG), u, cshift, wid, lane, tid);
        }
        PHON(4) {
            PHASE_ENV();
            if (bx >= G / 2) {
                for (int it = bx - G / 2; it < NSMP * 4; it += G - G / 2)
                    attn_sample_item(lds, (const bf16*)(ws + WS_Q), (const bf16*)(ws + WS_K), (const bf16*)(ws + WS_V), ((const float*)ap->in[2]), ((const float*)ap->in[3]), ((const float*)ap->in[4]), l, (bf16*)(ws + WS_YA), it, wid, lane);
            }
        }
        GSYNC();
        PHON(5) {
            PHASE_ENV();
            const bf16 *Ub = (const bf16*)(ws + WS_U), *VSb = (const bf16*)(ws + WS_VS); bf16 *YS = (bf16*)(ws + WS_YS);
            const bf16* WSP = (const bf16*)(WL(l) + WL_WSP);
            const float* lnw = ((const float*)ap->in[13]) + l * 512; const float* lnb = ((const float*)ap->in[14]) + l * 512; const float* bsp = ((const float*)ap->in[16]) + l * 8 * 128;
            for (int u = bx; u < 256; u += G) sgu_unit(lds, Ub, VSb, lnw, lnb, WSP, bsp, YS, u, wid, lane);
            for (int b = gw; b < NSMP; b += NGW) sgu_sample_row(Ub, VSb, lnw, lnb, ((const float*)ap->in[15]) + (size_t)l * 8 * 128 * 128, bsp, YS, ((float*)ap->out) + O_SV + (size_t)(l * NSMP + b) * 512, b, lane);
            for (int row = gw; row < MP; row += NGW) merge_row((const bf16*)(ws + WS_OG), (const float*)(ws + WS_DG), (bf16*)(ws + WS_YA), row, lane);
        }
        GSYNC();
        PHON(6) {
            PHASE_ENV();
            pg8::StaticOrder S; S.init(MT, DM, G, bx);
            pg8::Gemm g{(const bf16*)(ws + WS_YA), (const bf16*)(WL(l) + WL_WPA), MT, DM, 512}; EpiGate1 E{(const bf16*)(ws + WS_G), (float*)(ws + WS_T1)};
            pg8::gemm_phase<EpiGate1, pg8::StaticOrder, true, true>(lds + LDS_RING, g, S, E);
        }
        PHON(6) {
            PHASE_ENV();
            pg8::StaticOrder S; S.init(MT, DM, G, bx);
            pg8::Gemm g{(const bf16*)(ws + WS_YS), (const bf16*)(WL(l) + WL_WPS), MT, DM, 512}; EpiGate2 E{(const bf16*)(ws + WS_G), (const float*)(ws + WS_T1), (bf16*)(ws + WS_MG)};
            pg8::gemm_phase<EpiGate2, pg8::StaticOrder, true, true>(lds + LDS_RING, g, S, E);
        }
        GSYNC();
        PHON(7) {
            PHASE_ENV();
            const float* X2 = (const float*)(ws + WS_X2); float* X1 = (float*)(ws + WS_X1);
            const float* xin_p = l == 0 ? ((const float*)ap->in[0]) : X2;
            const float* xin_s = l == 0 ? ((const float*)ap->in[1]) : X2 + (size_t)MP * DM;
            pg8::Gemm g{(const bf16*)(ws + WS_MG), (const bf16*)(WL(l) + WL_WOUT), MT, DM, DM}; pg8::StaticOrder S; S.init(MT, DM, G, bx);
            EpiRes E{xin_p, xin_s, X1, X1 + (size_t)MP * DM, (const float*)(ws + WS_MOD) + (size_t)l * 36 * NADA + 2048};
            pg8::gemm_phase<EpiRes, pg8::StaticOrder, true, true>(lds + LDS_RING, g, S, E);
        }
        GSYNC();
        PHON(8) {
            PHASE_ENV();
            const float* X1 = (const float*)(ws + WS_X1);
            norm_mod_phase(X1, X1 + (size_t)MP * DM, ((const float*)ap->in[20]) + l * DM, (const float*)(ws + WS_MOD) + (size_t)l * 36 * NADA, 3072, (bf16*)(ws + WS_XN), gw, NGW, lane);
        }
        GSYNC();
        PHON(9) {
            PHASE_ENV();
            pg8::Gemm g{(const bf16*)(ws + WS_XN), (const bf16*)(WL(l) + WL_WFI), MT, 2 * DFF, DM}; pg8::StaticOrder S; S.init(MT, 2 * DFF, G, bx);
            EpiSwiglu E{(bf16*)(ws + WS_H)};
            pg8::gemm_phase<EpiSwiglu, pg8::StaticOrder, true, true>(lds + LDS_RING, g, S, E);
        }
        GSYNC();
        PHON(10) {
            PHASE_ENV();
            const float* X1 = (const float*)(ws + WS_X1); float* X2 = (float*)(ws + WS_X2);
            float* xout_p = l == 0 ? X2 : ((float*)ap->out) + O_YP;
            float* xout_s = l == 0 ? X2 + (size_t)MP * DM : ((float*)ap->out) + O_YS;
            pg8::Gemm g{(const bf16*)(ws + WS_H), (const bf16*)(WL(l) + WL_WFO), MT, DM, DFF}; pg8::StaticOrder S; S.init(MT, DM, G, bx);
            EpiRes E{X1, X1 + (size_t)MP * DM, xout_p, xout_s, (const float*)(ws + WS_MOD) + (size_t)l * 36 * NADA + 5120};
            pg8::gemm_phase<EpiRes, pg8::StaticOrder, true, true>(lds + LDS_RING, g, S, E);
        }
        if (l + 1 < l_hi) GSYNC();
    }
}


#ifdef EXP_MASK
__global__ void __launch_bounds__(256) dbg_checksum(const unsigned char* ws, float* out) {
    const int lane = threadIdx.x & 63, gw = (blockIdx.x * 256 + threadIdx.x) >> 6, ngw = gridDim.x * 4;
    struct B { size_t off; int cols; int isf; };
    const B bufs[16] = {{WS_XN, 1024, 0}, {WS_Q, 1536, 0}, {WS_K, 1536, 0}, {WS_V, 1536, 0}, {WS_U, 512, 0}, {WS_VS, 512, 0}, {WS_G, 2048, 0}, {WS_OG, 1536, 0},
                        {WS_DG, 12, 1}, {WS_YA, 512, 0}, {WS_YS, 512, 0}, {WS_T1, 1024, 1}, {WS_MG, 1024, 0}, {WS_X1, 1024, 1}, {WS_H, 2816, 0}, {WS_X2, 1024, 1}};
    for (int b = 0; b < 16; ++b) {
        if (!((EXP_MASK >> b) & 1)) continue;
        for (int row = gw; row < MV; row += ngw) {
            float s = 0.f;
            for (int c = lane; c < bufs[b].cols; c += 64) {
                const float v = bufs[b].isf ? ((const float*)(ws + bufs[b].off))[(size_t)row * bufs[b].cols + c] : bf2f(((const bf16*)(ws + bufs[b].off))[(size_t)row * bufs[b].cols + c]);
                s += v * (float)(1 + (c % 7));
            }
            s = wave_sum(s);
            if (lane == 0) out[(size_t)b * MT + row] = s;
        }
    }
    if ((EXP_MASK >> 16) & 1) for (int i = blockIdx.x * 256 + threadIdx.x; i < 72 * NADA; i += gridDim.x * 256) out[16 * MT + i] = ((const float*)(ws + WS_MOD))[i];
}
#endif
#ifndef N_LAUNCH_MODE
#define N_LAUNCH_MODE 1
#endif
template <int PHM> static void launch_phase(const Args& a, int l_lo, int l_hi, int grid, hipStream_t stream) {
    static bool attr = false;
    if (!attr) { (void)hipFuncSetAttribute((const void*)fwd_megakernel<PHM, false>, hipFuncAttributeMaxDynamicSharedMemorySize, LDS_BYTES); attr = true; }
    hipLaunchKernelGGL((fwd_megakernel<PHM, false>), dim3(grid), dim3(NTHREADS), LDS_BYTES, stream, a, l_lo, l_hi);
}
extern "C" void kernel_launch(void* const* d_in, const int* in_sizes, int n_in, void* d_out, int out_size, void* d_ws, size_t ws_size, hipStream_t stream) {
    static int grid = 0;
    if (grid == 0) {
        if (n_in != 23 || (size_t)out_size != O_END || ws_size < WS_END) { fprintf(stderr, "kernel_launch: unexpected shapes (n_in %d out %d ws %zu need %zu)\n", n_in, out_size, ws_size, (size_t)WS_END); grid = -1; return; }
        int dev = 0, cus = 0, per_cu = 0;
        (void)hipGetDevice(&dev);
        (void)hipDeviceGetAttribute(&cus, hipDeviceAttributeMultiprocessorCount, dev);
#if N_LAUNCH_MODE == 1
        if (hipFuncSetAttribute((const void*)fwd_megakernel<0x7FF, true>, hipFuncAttributeMaxDynamicSharedMemorySize, LDS_BYTES) != hipSuccess) { fprintf(stderr, "kernel_launch: hipFuncSetAttribute failed\n"); grid = -1; return; }
        (void)hipOccupancyMaxActiveBlocksPerMultiprocessor(&per_cu, (const void*)fwd_megakernel<0x7FF, true>, NTHREADS, LDS_BYTES);
        (void)hipGetLastError();
        if (per_cu < 1) fprintf(stderr, "kernel_launch: occupancy query says %d blocks per CU\n", per_cu);
#endif
        grid = cus;
    }
    if (grid < 0) return;
    Args a{};
    for (int i = 0; i < 23; ++i) a.in[i] = (GAS const float*)d_in[i];
    a.out = (GAS float*)d_out; a.ws = (GAS unsigned char*)d_ws;
#if N_LAUNCH_MODE == 1
    int l_lo = 0, l_hi = 2;
    void* kargs[] = {&a, &l_lo, &l_hi};
    hipError_t e = hipLaunchCooperativeKernel((const void*)fwd_megakernel<0x7FF, true>, dim3(grid), dim3(NTHREADS), kargs, LDS_BYTES, stream);
    if (e != hipSuccess) fprintf(stderr, "cooperative launch failed: %s (grid %d)\n", hipGetErrorString(e), grid);
#else
#ifdef EXP_MASK
    (void)hipMemsetAsync(d_out, 0, (size_t)out_size * 4, stream);
#endif
    launch_phase<0x001>(a, 0, 0, grid, stream);
    launch_phase<0x002>(a, 0, 0, grid, stream);
#ifdef EXP_MASK
    const int NL = 1;
#else
    const int NL = 2;
#endif
    for (int l = 0; l < NL; ++l) {
        launch_phase<0x004>(a, l, l + 1, grid, stream);
        launch_phase<0x008>(a, l, l + 1, grid, stream);
        launch_phase<0x010>(a, l, l + 1, grid, stream);
        launch_phase<0x020>(a, l, l + 1, grid, stream);
        launch_phase<0x040>(a, l, l + 1, grid, stream);
        launch_phase<0x080>(a, l, l + 1, grid, stream);
        launch_phase<0x100>(a, l, l + 1, grid, stream);
        launch_phase<0x200>(a, l, l + 1, grid, stream);
        launch_phase<0x400>(a, l, l + 1, grid, stream);
    }
#ifdef EXP_MASK
    hipLaunchKernelGGL(dbg_checksum, dim3(1024), dim3(256), 0, stream, (const unsigned char*)d_ws, (float*)d_out);
#endif
#endif
}
```

```cpp
#include <hip/hip_runtime.h>
#include <hip/hip_cooperative_groups.h>
#include <cstdio>
#include <cstdint>
namespace cg = cooperative_groups;
namespace pg8 {
#define PG8_LAS __attribute__((address_space(3)))
typedef unsigned short bf16_t;
typedef short bf16x8 __attribute__((ext_vector_type(8)));
typedef float f32x4 __attribute__((ext_vector_type(4)));
typedef unsigned u32x4 __attribute__((ext_vector_type(4)));
constexpr int BM = 256, BK = 64, HALF = 128, HTB = HALF * BK * 2  , STAGE_BYTES = 8 * HTB, NXCD = 8, WGM = 8;

__host__ __device__ __forceinline__ int lds_byte(int r, int c) { const int st = (r >> 4) * 2 + (c >> 5), rr = r & 15, cc = c & 31, ob = rr * 64 + cc * 2; return st * 1024 + (ob ^ (((ob >> 9) & 1) << 5)); }
__host__ __device__ __forceinline__ void stage_rc(int b, int& R, int& C) { const int st = b / 1024, sb = b % 1024, swz = sb ^ (((sb >> 9) & 1) << 5); R = (st >> 1) * 16 + swz / 64; C = (st & 1) * 32 + (swz % 64) / 2; }
__host__ __device__ __forceinline__ int perm32(int rho) { const int n = rho >> 4, i = rho & 15; return 8 * (i >> 2) + 4 * n + (i & 3); }

struct Unit { int pm, pn; };
struct Gemm { const bf16_t* A; const bf16_t* Bt; int M, N, K; };

struct StaticOrder {
    int nM, nN, nwg, G, c;
    __host__ __device__ void init(int M, int N, int G_, int c_) { nM = M / BM; nN = N / BM; nwg = nM * nN; G = G_; c = c_; }
    __host__ __device__ bool next(int i, Unit& u) const {
        const long L = (long)i * G + c; if (L >= nwg) return false;
        int wgid = (int)L; { const int q = nwg / NXCD, r = nwg % NXCD, xcd = wgid % NXCD, off = wgid / NXCD; wgid = (xcd < r ? xcd * (q + 1) : r * (q + 1) + (xcd - r) * q) + off; }
        const int nig = WGM * nN, gid = wgid / nig, fm = gid * WGM, gsz = (nM - fm) < WGM ? (nM - fm) : WGM;
        u.pm = fm + ((wgid % nig) % gsz); u.pn = (wgid % nig) / gsz; return true;
    }
    __device__ __forceinline__ void a_ready(const Unit&) const {}
    __device__ __forceinline__ void done(const Unit&) const {}
};

typedef __bf16 bf16x2_hw __attribute__((ext_vector_type(2)));
typedef float f32x2_hw __attribute__((ext_vector_type(2)));
__device__ __forceinline__ unsigned cvt_pk_bf16(float lo, float hi) { const f32x2_hw v = {lo, hi}; return __builtin_bit_cast(unsigned, __builtin_convertvector(v, bf16x2_hw)); }
typedef float f32x2 __attribute__((ext_vector_type(2)));
__device__ __forceinline__ f32x2 gelu_pk(f32x2 v) {
    const f32x2 av = __builtin_elementwise_abs(v), d = av * 0.2316418882f + 1.0f;
    f32x2 t; t.x = __builtin_amdgcn_rcpf(d.x); t.y = __builtin_amdgcn_rcpf(d.y);
    f32x2 q = t * 0.5307027145f + (-0.7265760135f); q = q * t + 0.7107068705f; q = q * t + (-0.142248368f); q = q * t + 0.127414796f; q = q * t;
    const f32x2 s = (v * v) * (-0.72134752044f);
    f32x2 e; e.x = __builtin_amdgcn_exp2f(s.x); e.y = __builtin_amdgcn_exp2f(s.y);
    const f32x2 m = v * (q * e), r = v - m;
    f32x2 o; o.x = v.x < 0.f ? m.x : r.x; o.y = v.y < 0.f ? m.y : r.y; return o;
}

template <int ACT  > struct EpiBf16 {
    static constexpr bool PERM = true, AFTER_DRAIN = false; static_assert(ACT == 0 || ACT == 1, "EpiBf16: ACT is 0 (none) or 1 (gelu_pk)");
    bf16_t* O; int ldc; const float* bias; int split_cols; size_t split_stride; float scale0;
    __device__ __forceinline__ void operator()(const f32x4 (&acc)[2][2][4][2], const Unit& u, int wr, int wc, int fr, int fq) const {
        const int row0 = u.pm * BM + wr * 64 + fr; int colt = u.pn * BM; bf16_t* base = O;
        float sc = 1.f; if (split_cols) { const int t = colt / split_cols; base += (size_t)t * split_stride; colt -= t * split_cols; if (t == 0) sc = scale0; }
        const int col0 = colt + wc * 32 + 8 * fq, bcol0 = u.pn * BM + wc * 32 + 8 * fq;
        f32x4 bv[2][2];
#pragma unroll
        for (int bj = 0; bj < 2; ++bj)
#pragma unroll
            for (int n = 0; n < 2; ++n) bv[bj][n] = bias ? *(const f32x4*)(bias + bcol0 + bj * HALF + 4 * n) : (f32x4){0.f, 0.f, 0.f, 0.f};
#pragma unroll
        for (int ai = 0; ai < 2; ++ai)
#pragma unroll
            for (int m = 0; m < 4; ++m) { bf16_t* rowp = base + (size_t)(row0 + ai * HALF + m * 16) * ldc + col0;
#pragma unroll
                for (int bj = 0; bj < 2; ++bj) { f32x4 v0 = acc[ai][bj][m][0] + bv[bj][0], v1 = acc[ai][bj][m][1] + bv[bj][1];
                    if (ACT == 1) { f32x2 a = gelu_pk((f32x2){v0[0], v0[1]}), b = gelu_pk((f32x2){v0[2], v0[3]}), c = gelu_pk((f32x2){v1[0], v1[1]}), d = gelu_pk((f32x2){v1[2], v1[3]});
                        v0 = (f32x4){a.x, a.y, b.x, b.y}; v1 = (f32x4){c.x, c.y, d.x, d.y}; }
                    v0 = v0 * sc; v1 = v1 * sc; u32x4 w; w.x = cvt_pk_bf16(v0[0], v0[1]); w.y = cvt_pk_bf16(v0[2], v0[3]); w.z = cvt_pk_bf16(v1[0], v1[1]); w.w = cvt_pk_bf16(v1[2], v1[3]);
                    *(u32x4*)(rowp + bj * HALF) = w; } }
    }
};

struct PanelStats {
    unsigned* xbuf;
    unsigned* cnt;
    unsigned* tmo;
    int ntn; float eps;
    unsigned code;
    __device__ __forceinline__ bool run(const f32x4 (&v)[2][2][4][2], const Unit& u, int wr, int wc, int fr, int fq, PG8_LAS unsigned char* lds, int wid, int lane) const {
        typedef float f32x2v __attribute__((ext_vector_type(2)));
        PG8_LAS f32x2v* P = (PG8_LAS f32x2v*)lds;
        PG8_LAS f32x2v* S = (PG8_LAS f32x2v*)(lds + 8192);
        PG8_LAS unsigned* flag = (PG8_LAS unsigned*)(lds + 8192 + 2048);
#pragma unroll
        for (int ai = 0; ai < 2; ++ai)
#pragma unroll
            for (int m = 0; m < 4; ++m) {
                float s = 0.f;
#pragma unroll
                for (int bj = 0; bj < 2; ++bj)
#pragma unroll
                    for (int n = 0; n < 2; ++n) { const f32x4 x = v[ai][bj][m][n]; s += (x[0] + x[1]) + (x[2] + x[3]); }
                s += __shfl_xor(s, 16); s += __shfl_xor(s, 32);
                const float mw = s * (1.0f / 64.0f); float q = 0.f;
#pragma unroll
                for (int bj = 0; bj < 2; ++bj)
#pragma unroll
                    for (int n = 0; n < 2; ++n) { const f32x4 d = v[ai][bj][m][n] - mw; q += (d[0] * d[0] + d[1] * d[1]) + (d[2] * d[2] + d[3] * d[3]); }
                q += __shfl_xor(q, 16); q += __shfl_xor(q, 32);
                if (fq == 0) P[(ai * HALF + wr * 64 + m * 16 + fr) * 4 + wc] = (f32x2v){mw, q};
            }
        asm volatile("s_waitcnt lgkmcnt(0)" ::: "memory"); __builtin_amdgcn_s_barrier(); asm volatile("" ::: "memory");
#if defined(BROKEN_EXCHANGE_NO_WAIT)
#warning BROKEN CONTROL BUILD: the row-statistics exchange does not wait; results are wrong by design
        if (blockIdx.x >= 64) { const long long t0_ = clock64(); while (clock64() - t0_ < 60000) __builtin_amdgcn_s_sleep(8); }
#endif
        const int row = wid * 32 + (lane & 31);
        if (lane < 32) {
            const f32x2v a = P[row * 4 + 0], b = P[row * 4 + 1], c = P[row * 4 + 2], d = P[row * 4 + 3];
            const float mt = (a.x + b.x + c.x + d.x) * 0.25f;
            const float da = a.x - mt, db = b.x - mt, dc = c.x - mt, dd = d.x - mt;
            const float m2 = (a.y + b.y) + (c.y + d.y) + 64.0f * ((da * da + db * db) + (dc * dc + dd * dd));
            unsigned long long* slot = (unsigned long long*)xbuf + ((size_t)(u.pm * BM + row) * 4 + u.pn);
            __hip_atomic_store(slot, ((unsigned long long)__float_as_uint(m2) << 32) | __float_as_uint(mt), __ATOMIC_RELAXED, __HIP_MEMORY_SCOPE_AGENT);
        }
        asm volatile("s_waitcnt vmcnt(0)" ::: "memory");
        if (lane == 0) __hip_atomic_fetch_add(cnt + 64 * u.pm, 1u, __ATOMIC_RELAXED, __HIP_MEMORY_SCOPE_AGENT);
        if (wid == 0) {
            bool dead = false; const unsigned long long t0 = __builtin_amdgcn_s_memrealtime(); const unsigned want = 8u * (unsigned)ntn;
            for (;;) {
#if defined(BROKEN_EXCHANGE_NO_WAIT)
                break;
#endif
                if ((unsigned)__builtin_amdgcn_readfirstlane(__hip_atomic_load(cnt + 64 * u.pm, __ATOMIC_RELAXED, __HIP_MEMORY_SCOPE_AGENT)) >= want) break;
                if (__builtin_amdgcn_s_memrealtime() - t0 > 2000000ull) {
                    if (lane == 0) { unsigned expect = 0u; __hip_atomic_compare_exchange_strong(tmo + 1, &expect, code | (unsigned)(u.pm & 0xff), __ATOMIC_RELAXED, __ATOMIC_RELAXED, __HIP_MEMORY_SCOPE_AGENT);
                                     __hip_atomic_store(tmo, 1u, __ATOMIC_RELAXED, __HIP_MEMORY_SCOPE_AGENT); }
                    dead = true; break; }
                __builtin_amdgcn_s_sleep(2);
            }
            __builtin_amdgcn_fence(__ATOMIC_ACQUIRE, "agent");
            if (lane == 0) flag[0] = dead ? 1u : 0u;
        }
        asm volatile("s_waitcnt vmcnt(0) lgkmcnt(0)" ::: "memory"); __builtin_amdgcn_s_barrier(); asm volatile("" ::: "memory");
        const bool bad = flag[0] != 0u;
        if (lane < 32) {
            const unsigned long long* slot = (const unsigned long long*)xbuf + (size_t)(u.pm * BM + row) * 4; float mt[4], m2[4]; float ms = 0.f;
#pragma unroll
            for (int t = 0; t < 4; ++t) { if (t < ntn) { const unsigned long long w = __hip_atomic_load(slot + t, __ATOMIC_RELAXED, __HIP_MEMORY_SCOPE_AGENT); mt[t] = __uint_as_float((unsigned)w); m2[t] = __uint_as_float((unsigned)(w >> 32)); } else { mt[t] = 0.f; m2[t] = 0.f; } ms += mt[t]; }
            const float mean = ms / (float)ntn; float q = 0.f;
#pragma unroll
            for (int t = 0; t < 4; ++t) if (t < ntn) { const float dm = mt[t] - mean; q += m2[t] + 256.0f * dm * dm; }
            S[row] = (f32x2v){mean, 1.0f / sqrtf(q / (256.0f * (float)ntn) + eps)};
        }
        asm volatile("s_waitcnt lgkmcnt(0)" ::: "memory"); __builtin_amdgcn_s_barrier(); asm volatile("" ::: "memory");
        return bad;
    }
};
struct EpiLnRes {
    static constexpr bool PERM = false, AFTER_DRAIN = true;
    const float* base; float* out; int ldc; const float* bias; PanelStats st; unsigned poison;
    __device__ __forceinline__ void fused(f32x4 (&acc)[2][2][4][2], const Unit& u, int wr, int wc, int fr, int fq, PG8_LAS unsigned char* lds, int wid, int lane) const {
        typedef float f32x2v __attribute__((ext_vector_type(2)));
        const PG8_LAS f32x2v* S = (const PG8_LAS f32x2v*)(lds + 8192);
        const int col0 = u.pn * BM + wc * 32 + 4 * fq;
#pragma unroll
        for (int bj = 0; bj < 2; ++bj)
#pragma unroll
            for (int n = 0; n < 2; ++n) { const f32x4 bv = bias ? *(const f32x4*)(bias + col0 + bj * HALF + n * 16) : (f32x4){0.f, 0.f, 0.f, 0.f};
#pragma unroll
                for (int ai = 0; ai < 2; ++ai)
#pragma unroll
                    for (int m = 0; m < 4; ++m) acc[ai][bj][m][n] += bv; }
        f32x4 pre[4][2][2];
#pragma unroll
        for (int m = 0; m < 4; ++m) { const size_t off = (size_t)(u.pm * BM + wr * 64 + m * 16 + fr) * ldc + col0;
#pragma unroll
            for (int bj = 0; bj < 2; ++bj)
#pragma unroll
                for (int n = 0; n < 2; ++n) pre[m][bj][n] = *(const f32x4*)(base + off + bj * HALF + n * 16); }
        const bool bad = st.run(acc, u, wr, wc, fr, fq, lds, wid, lane) || poison != 0u;
        const float qnan = __builtin_nanf("");
#pragma unroll
        for (int ai = 0; ai < 2; ++ai)
#pragma unroll
            for (int m = 0; m < 4; ++m) { const int r = ai * HALF + wr * 64 + m * 16 + fr; const f32x2v sr = S[r]; const size_t off = (size_t)(u.pm * BM + r) * ldc + col0;
#pragma unroll
                for (int bj = 0; bj < 2; ++bj)
#pragma unroll
                    for (int n = 0; n < 2; ++n) { const f32x4 bs = ai == 0 ? pre[m][bj][n] : *(const f32x4*)(base + off + bj * HALF + n * 16); f32x4 o = bs + (acc[ai][bj][m][n] - sr.x) * sr.y;
                        if (bad) o = (f32x4){qnan, qnan, qnan, qnan}; *(f32x4*)(out + off + bj * HALF + n * 16) = o; }
                if (m & 1) asm volatile("" ::: "memory"); }
    }
};
struct EpiLnResLn {
    static constexpr bool PERM = false, AFTER_DRAIN = true;
    const float* base; float* out; bf16_t* xn; int ldc; const float* bias; PanelStats st1, st2; unsigned poison;
    __device__ __forceinline__ void fused(f32x4 (&acc)[2][2][4][2], const Unit& u, int wr, int wc, int fr, int fq, PG8_LAS unsigned char* lds, int wid, int lane) const {
        typedef float f32x2v __attribute__((ext_vector_type(2))); typedef unsigned u32x2v __attribute__((ext_vector_type(2)));
        const PG8_LAS f32x2v* S = (const PG8_LAS f32x2v*)(lds + 8192);
        const int col0 = u.pn * BM + wc * 32 + 4 * fq;
#pragma unroll
        for (int bj = 0; bj < 2; ++bj)
#pragma unroll
            for (int n = 0; n < 2; ++n) { const f32x4 bv = bias ? *(const f32x4*)(bias + col0 + bj * HALF + n * 16) : (f32x4){0.f, 0.f, 0.f, 0.f};
#pragma unroll
                for (int ai = 0; ai < 2; ++ai)
#pragma unroll
                    for (int m = 0; m < 4; ++m) acc[ai][bj][m][n] += bv; }
        bool bad = st1.run(acc, u, wr, wc, fr, fq, lds, wid, lane) || poison != 0u;
        const float qnan = __builtin_nanf("");
#pragma unroll
        for (int ai = 0; ai < 2; ++ai)
#pragma unroll
            for (int m = 0; m < 4; ++m) { const int r = ai * HALF + wr * 64 + m * 16 + fr; const f32x2v sr = S[r]; const size_t off = (size_t)(u.pm * BM + r) * ldc + col0;
#pragma unroll
                for (int bj = 0; bj < 2; ++bj)
#pragma unroll
                    for (int n = 0; n < 2; ++n) { const f32x4 bs = *(const f32x4*)(base + off + bj * HALF + n * 16); acc[ai][bj][m][n] = bs + (acc[ai][bj][m][n] - sr.x) * sr.y; }
                asm volatile("" : "+v"(acc[ai][0][m][0]), "+v"(acc[ai][0][m][1]), "+v"(acc[ai][1][m][0]), "+v"(acc[ai][1][m][1]));
                if (m & 1) asm volatile("" ::: "memory"); }
        const bool bad1 = bad;
        bad = st2.run(acc, u, wr, wc, fr, fq, lds, wid, lane) || bad;
#pragma unroll
        for (int ai = 0; ai < 2; ++ai)
#pragma unroll
            for (int m = 0; m < 4; ++m) { const int r = ai * HALF + wr * 64 + m * 16 + fr; const f32x2v sr = S[r]; const size_t off = (size_t)(u.pm * BM + r) * ldc + col0;
#pragma unroll
                for (int bj = 0; bj < 2; ++bj)
#pragma unroll
                    for (int n = 0; n < 2; ++n) { const f32x4 x1 = acc[ai][bj][m][n]; *(f32x4*)(out + off + bj * HALF + n * 16) = bad1 ? (f32x4){qnan, qnan, qnan, qnan} : x1;
                        const f32x4 o = (x1 - sr.x) * sr.y; u32x2v w; w.x = cvt_pk_bf16(o[0], o[1]); w.y = cvt_pk_bf16(o[2], o[3]);
                        if (bad) { w.x = 0x7fc07fc0u; w.y = 0x7fc07fc0u; } *(u32x2v*)(xn + off + bj * HALF + n * 16) = w; }
                asm volatile("" ::: "memory"); }
    }
};

template <class Epi, class Sched, bool ALIGN_EPI = false, bool SP2 = false>
__device__ __forceinline__ void gemm_phase(PG8_LAS unsigned char* lds, const Gemm g, const Sched& S, const Epi& E) {
    int tid_ = threadIdx.x; asm volatile("" : "+v"(tid_));
    const int tid = tid_, wid = __builtin_amdgcn_readfirstlane(tid >> 6), lane = tid & 63, wr = wid >> 2, wc = wid & 3, fr = lane & 15, fq = lane >> 4;
    const int K = g.K, nt = K / BK;
    unsigned voffA[2], voffB[2];
#pragma unroll
    for (int i = 0; i < 2; ++i) { int R, C; stage_rc(tid * 16 + i * 8192, R, C); const int Rb = Epi::PERM ? ((R & ~31) + perm32(R & 31)) : R;
        voffA[i] = (unsigned)(R * K + C) * 2u; voffB[i] = (unsigned)(Rb * K + C) * 2u; }
    const size_t kstep = (size_t)(BK * 2);
    const size_t hstep = (size_t)HALF * K * 2;
    const size_t tstep = 2 * hstep;
    const unsigned ldsw = (unsigned)wid * 1024u;
    const int aoff = lds_byte(wr * 64 + fr, fq * 8), boff = lds_byte(wc * 32 + fr, fq * 8);
#define PG8_SA(b, h) (((b) * 2 + (h)) * HTB)
#define PG8_SB(b, h) ((4 + (b) * 2 + (h)) * HTB)
#define PG8_STAGE(bufoff, gbase, voff) do { _Pragma("unroll") for (int _i = 0; _i < 2; ++_i) \
        __builtin_amdgcn_global_load_lds((const unsigned*)((const char*)(gbase) + (voff)[_i]), (PG8_LAS unsigned*)(lds + (bufoff) + ldsw + _i * 8192), 16, 0, 0); } while (0)
#define PG8_LDA(dst, b, h) do { _Pragma("unroll") for (int m = 0; m < 4; ++m) _Pragma("unroll") for (int k = 0; k < 2; ++k) dst[m][k] = *(const PG8_LAS bf16x8*)(lds + PG8_SA(b, h) + aoff + m * 2048 + k * 1024); } while (0)
#define PG8_LDB(dst, b, h) do { _Pragma("unroll") for (int n = 0; n < 2; ++n) _Pragma("unroll") for (int k = 0; k < 2; ++k) dst[n][k] = *(const PG8_LAS bf16x8*)(lds + PG8_SB(b, h) + boff + n * 2048 + k * 1024); } while (0)
#define PG8_MMA(ai, bj, At, Bt) do { __builtin_amdgcn_s_setprio(1); _Pragma("unroll") for (int m = 0; m < 4; ++m) _Pragma("unroll") for (int n = 0; n < 2; ++n) _Pragma("unroll") for (int k = 0; k < 2; ++k) \
        acc[ai][bj][m][n] = __builtin_amdgcn_mfma_f32_16x16x32_bf16(Bt[n][k], At[m][k], acc[ai][bj][m][n], 0, 0, 0); __builtin_amdgcn_s_setprio(0); } while (0)
#define PG8_WAIT_V(n) asm volatile("s_waitcnt vmcnt(" #n ")" ::: "memory")
#define PG8_WAIT_L(n) asm volatile("s_waitcnt lgkmcnt(" #n ")" ::: "memory")
#define PG8_BAR __builtin_amdgcn_s_barrier()
#define PG8_SCHED __builtin_amdgcn_sched_barrier(0)
    Unit cur, nxt; int ui = 0;
    if (!S.next(0, cur)) return;
    f32x4 acc[2][2][4][2];
#pragma unroll
    for (int a = 0; a < 2; ++a)
#pragma unroll
        for (int b = 0; b < 2; ++b)
#pragma unroll
            for (int m = 0; m < 4; ++m)
#pragma unroll
                for (int n = 0; n < 2; ++n) acc[a][b][m][n] = (f32x4){0.f, 0.f, 0.f, 0.f};
    bf16x8 At[4][2], B0[2][2], B1[2][2];
    const char* cA = (const char*)g.A + (size_t)cur.pm * tstep; const char* cB = (const char*)g.Bt + (size_t)cur.pn * tstep;
    S.a_ready(cur);
    if constexpr (SP2) {
        PG8_STAGE(PG8_SB(0, 0), cB, voffB); PG8_STAGE(PG8_SB(0, 1), cB + hstep, voffB); PG8_STAGE(PG8_SA(0, 0), cA, voffA); PG8_STAGE(PG8_SA(0, 1), cA + hstep, voffA);
        if (wr == 1) PG8_BAR;
        PG8_WAIT_V(2); PG8_BAR;
        PG8_STAGE(PG8_SB(1, 0), cB + kstep, voffB); PG8_STAGE(PG8_SA(1, 0), cA + kstep, voffA); PG8_STAGE(PG8_SB(1, 1), cB + hstep + kstep, voffB);
        PG8_WAIT_V(6); PG8_BAR;
    } else {
        PG8_STAGE(PG8_SB(0, 0), cB, voffB); PG8_STAGE(PG8_SA(0, 0), cA, voffA); PG8_STAGE(PG8_SB(0, 1), cB + hstep, voffB); PG8_STAGE(PG8_SA(0, 1), cA + hstep, voffA);
        if (wr == 1) PG8_BAR;
        PG8_WAIT_V(4); PG8_BAR;
        PG8_STAGE(PG8_SB(1, 0), cB + kstep, voffB); PG8_STAGE(PG8_SA(1, 0), cA + kstep, voffA); PG8_STAGE(PG8_SB(1, 1), cB + hstep + kstep, voffB);
        PG8_WAIT_V(6); PG8_BAR;
    }
    for (;;) {
        const bool has_next = S.next(ui + 1, nxt);
        const char* nA = has_next ? (const char*)g.A + (size_t)nxt.pm * tstep : cA; const char* nB = has_next ? (const char*)g.Bt + (size_t)nxt.pn * tstep : cB;
        for (int t = 0; t < nt; t += 2) {
            const bool last = (t == nt - 2);
            const char* a1 = cA + (size_t)(t + 1) * kstep;
            const char* a2 = last ? nA : cA + (size_t)(t + 2) * kstep; const char* b2 = last ? nB : cB + (size_t)(t + 2) * kstep;
            const char* a3 = a2 + kstep; const char* b3 = b2 + kstep;
            if (last && has_next) S.a_ready(nxt);
            if constexpr (SP2) {
            PG8_LDB(B0, 0, 0); PG8_LDB(B1, 0, 1); PG8_SCHED; PG8_LDA(At, 0, 0); PG8_STAGE(PG8_SA(1, 1), a1 + hstep, voffA);
            PG8_WAIT_V(8); PG8_WAIT_L(0); PG8_BAR; PG8_MMA(0, 0, At, B0); PG8_MMA(0, 1, At, B1); PG8_BAR; PG8_SCHED;
            PG8_LDA(At, 0, 1); PG8_STAGE(PG8_SB(0, 0), b2, voffB); PG8_STAGE(PG8_SB(0, 1), b2 + hstep, voffB); PG8_STAGE(PG8_SA(0, 0), a2, voffA);
            PG8_WAIT_V(8); PG8_WAIT_L(0); PG8_BAR; PG8_MMA(1, 0, At, B0); PG8_MMA(1, 1, At, B1); PG8_BAR; PG8_SCHED;
            PG8_LDB(B0, 1, 0); PG8_LDB(B1, 1, 1); PG8_SCHED; PG8_LDA(At, 1, 0); PG8_STAGE(PG8_SA(0, 1), a2 + hstep, voffA);
            PG8_WAIT_V(8); PG8_WAIT_L(0); PG8_BAR; PG8_MMA(0, 0, At, B0); PG8_MMA(0, 1, At, B1); PG8_BAR; PG8_SCHED;
            PG8_LDA(At, 1, 1); PG8_STAGE(PG8_SB(1, 0), b3, voffB); PG8_STAGE(PG8_SB(1, 1), b3 + hstep, voffB); PG8_STAGE(PG8_SA(1, 0), a3, voffA);
            PG8_WAIT_V(8); PG8_WAIT_L(0); PG8_BAR; PG8_MMA(1, 0, At, B0); PG8_MMA(1, 1, At, B1); PG8_BAR; PG8_SCHED;
            } else {
            PG8_LDB(B0, 0, 0); PG8_SCHED; PG8_LDA(At, 0, 0); PG8_STAGE(PG8_SA(1, 1), a1 + hstep, voffA);
            PG8_WAIT_L(8); PG8_BAR; PG8_WAIT_L(0); PG8_MMA(0, 0, At, B0); PG8_BAR; PG8_SCHED;
            PG8_LDB(B1, 0, 1); PG8_STAGE(PG8_SB(0, 0), b2, voffB);
            PG8_BAR; PG8_WAIT_L(0); PG8_MMA(0, 1, At, B1); PG8_BAR;
            PG8_LDA(At, 0, 1); PG8_STAGE(PG8_SA(0, 0), a2, voffA);
            PG8_BAR; PG8_WAIT_L(0); PG8_MMA(1, 0, At, B0); PG8_BAR; PG8_SCHED;
            PG8_STAGE(PG8_SB(0, 1), b2 + hstep, voffB);
            PG8_WAIT_V(6); PG8_BAR; PG8_MMA(1, 1, At, B1); PG8_BAR;
            PG8_LDB(B0, 1, 0); PG8_SCHED; PG8_LDA(At, 1, 0); PG8_STAGE(PG8_SA(0, 1), a2 + hstep, voffA);
            PG8_WAIT_L(8); PG8_BAR; PG8_WAIT_L(0); PG8_MMA(0, 0, At, B0); PG8_BAR; PG8_SCHED;
            PG8_LDB(B1, 1, 1); PG8_STAGE(PG8_SB(1, 0), b3, voffB);
            PG8_BAR; PG8_WAIT_L(0); PG8_MMA(0, 1, At, B1); PG8_BAR;
            PG8_LDA(At, 1, 1); PG8_STAGE(PG8_SA(1, 0), a3, voffA);
            PG8_BAR; PG8_WAIT_L(0); PG8_MMA(1, 0, At, B0); PG8_BAR; PG8_SCHED;
            PG8_STAGE(PG8_SB(1, 1), b3 + hstep, voffB);
            PG8_WAIT_V(6); PG8_BAR; PG8_MMA(1, 1, At, B1); PG8_BAR;
            }
        }
        if constexpr (ALIGN_EPI) { if (wr == 0) PG8_BAR; }
        if constexpr (!Epi::AFTER_DRAIN) { E(acc, cur, wr, wc, fr, fq); S.done(cur); }
        if (!has_next) break;
#pragma unroll
        for (int a = 0; a < 2; ++a)
#pragma unroll
            for (int b = 0; b < 2; ++b)
#pragma unroll
                for (int m = 0; m < 4; ++m)
#pragma unroll
                    for (int n = 0; n < 2; ++n) acc[a][b][m][n] = (f32x4){0.f, 0.f, 0.f, 0.f};
        cur = nxt; cA = nA; cB = nB; ++ui;
        if constexpr (ALIGN_EPI) { if (wr == 1) PG8_BAR; }
    }
    PG8_WAIT_V(0);
    if constexpr (!ALIGN_EPI) { if (wr == 0) PG8_BAR; }
    PG8_BAR;
    if constexpr (Epi::AFTER_DRAIN) { E.fused(acc, cur, wr, wc, fr, fq, lds, wid, lane); S.done(cur); }
#undef PG8_SA
#undef PG8_SB
#undef PG8_STAGE
#undef PG8_LDA
#undef PG8_LDB
#undef PG8_MMA
#undef PG8_WAIT_V
#undef PG8_WAIT_L
#undef PG8_BAR
#undef PG8_SCHED
}
}

#define LAS __attribute__((address_space(3)))
typedef unsigned short bf16;
typedef float f32x4 __attribute__((ext_vector_type(4)));
typedef float f32x2 __attribute__((ext_vector_type(2)));
typedef short bf16x8 __attribute__((ext_vector_type(8)));
typedef short s16x4 __attribute__((ext_vector_type(4)));
typedef short v4i16_t __attribute__((ext_vector_type(4)));
typedef unsigned u32x4 __attribute__((ext_vector_type(4)));
typedef unsigned u32x2 __attribute__((ext_vector_type(2)));

constexpr int NWAVES = 8, NTHREADS = 512;
constexpr int DM = 1024, SEQ = 4096, NBATCH = 4, MP = NBATCH * SEQ, NSMP = 32, MV = MP + NSMP, MT = 16640;
constexpr int DIN = 7680, QKV = 1536, DFF = 2816, NADA = 6144;
constexpr size_t O_YP = 0, O_YS = 16777216, O_KV0P = 16809984, O_KV1P = 17858560, O_KV2P = 22052864,
                 O_KV0S = 38830080, O_KV1S = 38895616, O_KV2S = 38961152, O_SV = 39026688, O_END = 39059456;
constexpr float LOG2E = 1.4426950408889634f;
constexpr float QSCALE = 0.08838834764831845f * LOG2E;

constexpr size_t MiB = 1u << 20;
constexpr size_t alm(size_t x) { return (x + MiB - 1) / MiB * MiB; }
constexpr size_t WS_WADA = 1 * MiB;
constexpr size_t WS_WL0 = WS_WADA + alm(2ull * NADA * DM * 2);
constexpr size_t WL_WIN = 0;
constexpr size_t WL_WPA = WL_WIN + alm((size_t)DIN * DM * 2);
constexpr size_t WL_WPS = WL_WPA + alm(1024ull * 512 * 2);
constexpr size_t WL_WOUT = WL_WPS + alm(1024ull * 512 * 2);
constexpr size_t WL_WFI = WL_WOUT + alm(1024ull * 1024 * 2);
constexpr size_t WL_WFO = WL_WFI + alm(5632ull * 1024 * 2);
constexpr size_t WL_WSP = WL_WFO + alm(1024ull * DFF * 2);
constexpr size_t WL_SIZE = WL_WSP + alm(8ull * 128 * 128 * 2);
constexpr size_t WS_MOD = WS_WL0 + 2 * WL_SIZE;
constexpr size_t WS_SC = WS_MOD + alm(2ull * 36 * NADA * 4);
constexpr size_t WS_XN = WS_SC + alm(256ull * DM * 2);
constexpr size_t WS_Q = WS_XN + alm((size_t)MT * DM * 2);
constexpr size_t WS_K = WS_Q + alm((size_t)MT * QKV * 2);
constexpr size_t WS_V = WS_K + alm((size_t)MT * QKV * 2);
constexpr size_t WS_U = WS_V + alm((size_t)MT * QKV * 2);
constexpr size_t WS_VS = WS_U + alm((size_t)MT * 512 * 2);
constexpr size_t WS_G = WS_VS + alm((size_t)MT * 512 * 2);
constexpr size_t WS_OG = WS_G + alm((size_t)MT * 2048 * 2);
constexpr size_t WS_DG = WS_OG + alm((size_t)MT * QKV * 2);
constexpr size_t WS_YA = WS_DG + alm((size_t)MT * 12 * 4);
constexpr size_t WS_YS = WS_YA + alm((size_t)MT * 512 * 2);
constexpr size_t WS_T1 = WS_YS + alm((size_t)MT * 512 * 2);
constexpr size_t WS_MG = WS_T1 + alm((size_t)MT * DM * 4);
constexpr size_t WS_X1 = WS_MG + alm((size_t)MT * DM * 2);
constexpr size_t WS_X2 = WS_X1 + alm((size_t)MT * DM * 4);
constexpr size_t WS_H = WS_X2 + alm((size_t)MT * DM * 4);
constexpr size_t WS_END = WS_H + alm((size_t)MT * DFF * 2);

constexpr int LDS_RING = 0, LDS_EXCH = 131072, LDS_BYTES = 155648;

__device__ __forceinline__ float bf2f(unsigned short h) { return __uint_as_float((unsigned)h << 16); }
__device__ __forceinline__ unsigned pk2(float lo, float hi) { return pg8::cvt_pk_bf16(lo, hi); }
__device__ __forceinline__ float fast_exp2(float x) { return __builtin_amdgcn_exp2f(x); }
__device__ __forceinline__ float sigmoidf_(float x) { return __builtin_amdgcn_rcpf(1.0f + fast_exp2(-x * LOG2E)); }
__device__ __forceinline__ float wave_sum(float v) {
#pragma unroll
    for (int o = 1; o < 64; o <<= 1) v += __shfl_xor(v, o);
    return v;
}
__device__ __forceinline__ float wave_max(float v) {
#pragma unroll
    for (int o = 1; o < 64; o <<= 1) v = fmaxf(v, __shfl_xor(v, o));
    return v;
}
__device__ __forceinline__ s16x4 vtr(const LAS unsigned char* p) { return __builtin_bit_cast(s16x4, __builtin_amdgcn_ds_read_tr16_b64_v4i16((LAS v4i16_t*)p)); }
#define LDS_WAIT() asm volatile("s_waitcnt lgkmcnt(0)" ::: "memory")

__device__ __forceinline__ int mod_row(int row) { return row < MP ? (row >> 12) : 4 + (row - MP); }

__device__ __forceinline__ __attribute__((address_space(1))) float* kv_out_ptr(__attribute__((address_space(1))) float* out, int layer, int g, int row, int kvi, int hh) {
    if (row < MP) {
        const int b = row >> 12, t = row & 4095, lw = 128 << (2 * g), tt = t - (SEQ - lw);
        if (tt < 0) return nullptr;
        const size_t base = g == 0 ? O_KV0P : (g == 1 ? O_KV1P : O_KV2P);
        return out + base + ((((size_t)(layer * NBATCH + b) * lw + tt) * 2 + kvi) * 4 + hh) * 128;
    } else if (row < MV) {
        const int b = row - MP;
        const size_t base = g == 0 ? O_KV0S : (g == 1 ? O_KV1S : O_KV2S);
        return out + base + (((size_t)(layer * NSMP + b) * 2 + kvi) * 4 + hh) * 128;
    }
    return nullptr;
}

using pg8::Unit;
typedef pg8::f32x4 (AccT)[2][2][4][2];

__device__ __forceinline__ void st8_bf16g(__attribute__((address_space(1))) bf16* p, f32x4 v0, f32x4 v1) {
    u32x4 w; w.x = pk2(v0[0], v0[1]); w.y = pk2(v0[2], v0[3]); w.z = pk2(v1[0], v1[1]); w.w = pk2(v1[2], v1[3]);
    *(__attribute__((address_space(1))) u32x4*)p = w;
}
__device__ __forceinline__ void st8_bf16(bf16* p, f32x4 v0, f32x4 v1) {
    u32x4 w; w.x = pk2(v0[0], v0[1]); w.y = pk2(v0[2], v0[3]); w.z = pk2(v1[0], v1[1]); w.w = pk2(v1[2], v1[3]);
    *(u32x4*)p = w;
}

#define LAUNDER_S(x) asm volatile("" : "+s"(x))
#define GP(T, p) ((T*)(__attribute__((address_space(1))) T*)(p))
struct EpiAda {
    static constexpr bool PERM = true, AFTER_DRAIN = false;
    float* MOD; const float* b_ada;
    __device__ __forceinline__ void operator()(const pg8::f32x4 (&acc)[2][2][4][2], const Unit& u, int wr, int wc, int fr_, int fq_) const {
        int fr = fr_, fq = fq_; asm volatile("" : "+v"(fr), "+v"(fq));
        if (u.pm != 0 || wr != 0) return;
#pragma unroll
        for (int m = 0; m < 3; ++m) {
            const int row = m * 16 + fr;
            if (row >= 36) continue;
#pragma unroll
            for (int bj = 0; bj < 2; ++bj) {
                const int col = u.pn * 256 + bj * 128 + wc * 32 + 8 * fq;
                const int layer = col / NADA, c = col - layer * NADA;
                const float* bp = b_ada + (size_t)layer * NADA + c;
                float* op = MOD + ((size_t)layer * 36 + row) * NADA + c;
                *(f32x4*)op = acc[0][bj][m][0] + *(const f32x4*)bp;
                *(f32x4*)(op + 4) = acc[0][bj][m][1] + *(const f32x4*)(bp + 4);
            }
        }
    }
};

struct EpiIn {
    static constexpr bool PERM = true, AFTER_DRAIN = false;
    unsigned char* wsb; const float* qw; const float* kw; float* out; int layer; LAS float* P;
    __device__ __forceinline__ void operator()(const pg8::f32x4 (&acc)[2][2][4][2], const Unit& u, int wr, int wc, int fr_, int fq_) const {
        int fr = fr_, fq = fq_; asm volatile("" : "+v"(fr), "+v"(fq));
        unsigned char* wsl = wsb; const float* qwl = qw; const float* kwl = kw; float* outl = out; LAUNDER_S(wsl); LAUNDER_S(qwl); LAUNDER_S(kwl); LAUNDER_S(outl);
        typedef __attribute__((address_space(1))) bf16 gbf; typedef __attribute__((address_space(1))) float gfl;
        gbf *Q = (gbf*)(wsl + WS_Q), *K = (gbf*)(wsl + WS_K), *V = (gbf*)(wsl + WS_V), *U = (gbf*)(wsl + WS_U), *VS = (gbf*)(wsl + WS_VS), *G = (gbf*)(wsl + WS_G);
        gfl* outg = (gfl*)outl;
        const int pn = u.pn;
        const int cw = wc * 32 + 8 * fq;
        const int rowb = u.pm * 256 + wr * 64 + fr;
        if (pn < 12) {
            const bool isk = pn >= 6;
#pragma unroll
            for (int ai = 0; ai < 2; ++ai)
#pragma unroll
                for (int m = 0; m < 4; ++m)
#pragma unroll
                    for (int bj = 0; bj < 2; ++bj) {
                        const pg8::f32x4 a = acc[ai][bj][m][0], b = acc[ai][bj][m][1];
                        float s = (a[0] * a[0] + a[1] * a[1]) + (a[2] * a[2] + a[3] * a[3]) + (b[0] * b[0] + b[1] * b[1]) + (b[2] * b[2] + b[3] * b[3]);
                        s += __shfl_xor(s, 16); s += __shfl_xor(s, 32);
                        if (fq == 0) P[(ai * 128 + wr * 64 + m * 16 + fr) * 8 + bj * 4 + wc] = s;
                    }
            asm volatile("s_waitcnt lgkmcnt(0)" ::: "memory"); __builtin_amdgcn_s_barrier(); asm volatile("" ::: "memory");
#pragma unroll
            for (int bj = 0; bj < 2; ++bj) {
                const int head = 2 * (isk ? pn - 6 : pn) + bj, g = head >> 2, hh = head & 3;
                const __attribute__((address_space(1))) float* wv = (const __attribute__((address_space(1))) float*)(isk ? kwl : qwl) + g * 128 + cw;
                pg8::f32x4 w0 = *(const __attribute__((address_space(1))) f32x4*)wv, w1 = *(const __attribute__((address_space(1))) f32x4*)(wv + 4);
                if (!isk) { w0 = w0 * QSCALE; w1 = w1 * QSCALE; }
                gbf* dst = (isk ? K : Q) + head * 128 + cw;
#pragma unroll
                for (int ai = 0; ai < 2; ++ai)
#pragma unroll
                    for (int m = 0; m < 4; ++m) {
                        const int rl = ai * 128 + wr * 64 + m * 16 + fr, row = u.pm * 256 + rl;
                        const f32x4 pv = *(const LAS f32x4*)(P + rl * 8 + bj * 4);
                        const float rstd = 1.0f / sqrtf(((pv[0] + pv[1]) + (pv[2] + pv[3])) * (1.0f / 128.0f) + 1e-6f);
                        const pg8::f32x4 v0 = acc[ai][bj][m][0] * rstd * w0, v1 = acc[ai][bj][m][1] * rstd * w1;
                        st8_bf16g(dst + (size_t)row * QKV, v0, v1);
                        if (isk) { gfl* o = kv_out_ptr(outg, layer, g, row, 0, hh); if (o) { *(__attribute__((address_space(1))) f32x4*)(o + cw) = v0; *(__attribute__((address_space(1))) f32x4*)(o + cw + 4) = v1; } }
                    }
            }
        } else if (pn < 18) {
#pragma unroll
            for (int bj = 0; bj < 2; ++bj) {
                const int head = 2 * (pn - 12) + bj, g = head >> 2, hh = head & 3;
                gbf* dst = V + head * 128 + cw;
#pragma unroll
                for (int ai = 0; ai < 2; ++ai)
#pragma unroll
                    for (int m = 0; m < 4; ++m) {
                        const int row = rowb + ai * 128 + m * 16;
                        const pg8::f32x4 v0 = acc[ai][bj][m][0], v1 = acc[ai][bj][m][1];
                        st8_bf16g(dst + (size_t)row * QKV, v0, v1);
                        gfl* o = kv_out_ptr(outg, layer, g, row, 1, hh); if (o) { *(__attribute__((address_space(1))) f32x4*)(o + cw) = v0; *(__attribute__((address_space(1))) f32x4*)(o + cw + 4) = v1; }
                    }
            }
        } else if (pn < 22) {
            gbf* base = (pn < 20 ? U : VS) + ((pn - 18) & 1) * 256 + cw;
#pragma unroll
            for (int bj = 0; bj < 2; ++bj)
#pragma unroll
                for (int ai = 0; ai < 2; ++ai)
#pragma unroll
                    for (int m = 0; m < 4; ++m) {
                        const int row = rowb + ai * 128 + m * 16;
                        const pg8::f32x4 v0 = acc[ai][bj][m][0], v1 = acc[ai][bj][m][1];
                        const pg8::f32x2 a = pg8::gelu_pk((pg8::f32x2){v0[0], v0[1]}), b = pg8::gelu_pk((pg8::f32x2){v0[2], v0[3]}),
                                         c = pg8::gelu_pk((pg8::f32x2){v1[0], v1[1]}), d = pg8::gelu_pk((pg8::f32x2){v1[2], v1[3]});
                        st8_bf16g(base + (size_t)row * 512 + bj * 128, (f32x4){a.x, a.y, b.x, b.y}, (f32x4){c.x, c.y, d.x, d.y});
                    }
        } else {
            gbf* base = G + (pn - 22) * 256 + cw;
#pragma unroll
            for (int bj = 0; bj < 2; ++bj)
#pragma unroll
                for (int ai = 0; ai < 2; ++ai)
#pragma unroll
                    for (int m = 0; m < 4; ++m) {
                        const int row = rowb + ai * 128 + m * 16;
                        const pg8::f32x4 v0 = acc[ai][bj][m][0], v1 = acc[ai][bj][m][1];
                        st8_bf16g(base + (size_t)row * 2048 + bj * 128,
                                 (f32x4){sigmoidf_(v0[0]), sigmoidf_(v0[1]), sigmoidf_(v0[2]), sigmoidf_(v0[3])},
                                 (f32x4){sigmoidf_(v1[0]), sigmoidf_(v1[1]), sigmoidf_(v1[2]), sigmoidf_(v1[3])});
                    }
        }
    }
};

struct EpiGate1 {
    static constexpr bool PERM = true, AFTER_DRAIN = false;
    const bf16* G; float* T1;
    __device__ __forceinline__ void operator()(const pg8::f32x4 (&acc)[2][2][4][2], const Unit& u, int wr, int wc, int fr_, int fq_) const {
        int fr = fr_, fq = fq_; asm volatile("" : "+v"(fr), "+v"(fq));
        const int col0 = u.pn * 256 + wc * 32 + 8 * fq, rowb = u.pm * 256 + wr * 64 + fr;
#pragma unroll
        for (int ai = 0; ai < 2; ++ai)
#pragma unroll
            for (int m = 0; m < 4; ++m) {
                const int row = rowb + ai * 128 + m * 16;
#pragma unroll
                for (int bj = 0; bj < 2; ++bj) {
                    const int col = col0 + bj * 128;
                    const u32x4 gv = *(const u32x4*)(G + (size_t)row * 2048 + col);
                    const f32x4 g0 = {__uint_as_float(gv.x << 16), __uint_as_float(gv.x & 0xffff0000u), __uint_as_float(gv.y << 16), __uint_as_float(gv.y & 0xffff0000u)};
                    const f32x4 g1 = {__uint_as_float(gv.z << 16), __uint_as_float(gv.z & 0xffff0000u), __uint_as_float(gv.w << 16), __uint_as_float(gv.w & 0xffff0000u)};
                    float* o = T1 + (size_t)row * DM + col;
                    *(f32x4*)o = g0 * acc[ai][bj][m][0]; *(f32x4*)(o + 4) = g1 * acc[ai][bj][m][1];
                }
            }
    }
};
struct EpiGate2 {
    static constexpr bool PERM = true, AFTER_DRAIN = false;
    const bf16* G; const float* T1; bf16* MG;
    __device__ __forceinline__ void operator()(const pg8::f32x4 (&acc)[2][2][4][2], const Unit& u, int wr, int wc, int fr_, int fq_) const {
        int fr = fr_, fq = fq_; asm volatile("" : "+v"(fr), "+v"(fq));
        const int col0 = u.pn * 256 + wc * 32 + 8 * fq, rowb = u.pm * 256 + wr * 64 + fr;
#pragma unroll
        for (int ai = 0; ai < 2; ++ai)
#pragma unroll
            for (int m = 0; m < 4; ++m) {
                const int row = rowb + ai * 128 + m * 16;
#pragma unroll
                for (int bj = 0; bj < 2; ++bj) {
                    const int col = col0 + bj * 128;
                    const u32x4 gv = *(const u32x4*)(G + (size_t)row * 2048 + 1024 + col);
                    const f32x4 g0 = {__uint_as_float(gv.x << 16), __uint_as_float(gv.x & 0xffff0000u), __uint_as_float(gv.y << 16), __uint_as_float(gv.y & 0xffff0000u)};
                    const f32x4 g1 = {__uint_as_float(gv.z << 16), __uint_as_float(gv.z & 0xffff0000u), __uint_as_float(gv.w << 16), __uint_as_float(gv.w & 0xffff0000u)};
                    const float* t = T1 + (size_t)row * DM + col;
                    const f32x4 t0 = *(const f32x4*)t, t1 = *(const f32x4*)(t + 4);
                    st8_bf16(MG + (size_t)row * DM + col, t0 + g0 * acc[ai][bj][m][0], t1 + g1 * acc[ai][bj][m][1]);
                }
            }
    }
};
struct EpiRes {
    static constexpr bool PERM = true, AFTER_DRAIN = false;
    const float* bp; const float* bs; float* op; float* os; const float* gate;
    __device__ __forceinline__ void operator()(const pg8::f32x4 (&acc)[2][2][4][2], const Unit& u, int wr, int wc, int fr_, int fq_) const {
        int fr = fr_, fq = fq_; asm volatile("" : "+v"(fr), "+v"(fq));
        const int col0 = u.pn * 256 + wc * 32 + 8 * fq, rowb = u.pm * 256 + wr * 64 + fr;
#pragma unroll
        for (int ai = 0; ai < 2; ++ai)
#pragma unroll
            for (int m = 0; m < 4; ++m) {
                const int row = rowb + ai * 128 + m * 16;
                if (row < MV) {
                    const float* b = row < MP ? bp + (size_t)row * DM : bs + (size_t)(row - MP) * DM;
                    float* o = row < MP ? op + (size_t)row * DM : os + (size_t)(row - MP) * DM;
                    const float* gt = gate + (size_t)mod_row(row) * NADA;
#pragma unroll
                    for (int bj = 0; bj < 2; ++bj) {
                        const int col = col0 + bj * 128;
                        const f32x4 b0 = *(const f32x4*)(b + col), b1 = *(const f32x4*)(b + col + 4);
                        const f32x4 g0 = *(const f32x4*)(gt + col), g1 = *(const f32x4*)(gt + col + 4);
                        *(f32x4*)(o + col) = b0 + g0 * acc[ai][bj][m][0]; *(f32x4*)(o + col + 4) = b1 + g1 * acc[ai][bj][m][1];
                    }
                }
            }
    }
};
struct EpiSwiglu {
    static constexpr bool PERM = true, AFTER_DRAIN = false;
    bf16* H;
    __device__ __forceinline__ void operator()(const pg8::f32x4 (&acc)[2][2][4][2], const Unit& u, int wr, int wc, int fr_, int fq_) const {
        int fr = fr_, fq = fq_; asm volatile("" : "+v"(fr), "+v"(fq));
        const int col = u.pn * 128 + wc * 32 + 8 * fq, rowb = u.pm * 256 + wr * 64 + fr;
#pragma unroll
        for (int ai = 0; ai < 2; ++ai)
#pragma unroll
            for (int m = 0; m < 4; ++m) {
                const int row = rowb + ai * 128 + m * 16;
                f32x4 r0, r1;
#pragma unroll
                for (int e = 0; e < 4; ++e) {
                    const float a0 = acc[ai][0][m][0][e], a1 = acc[ai][0][m][1][e];
                    r0[e] = a0 * sigmoidf_(a0) * acc[ai][1][m][0][e];
                    r1[e] = a1 * sigmoidf_(a1) * acc[ai][1][m][1][e];
                }
                st8_bf16(H + (size_t)row * DFF + col, r0, r1);
            }
    }
};

__device__ __forceinline__ void transpose_item(const float* W, int K, int N, bf16* WT, int mode, LAS float* scr, int item, int lane) {
    const int nblk = N / 32, kb = item / nblk, nb = item % nblk, k0 = 64 * kb, n0 = 32 * nb;
#pragma unroll 8
    for (int i = 0; i < 32; ++i) { const int kk = 2 * i + (lane >> 5); scr[kk * 33 + (lane & 31)] = W[(size_t)(k0 + kk) * N + n0 + (lane & 31)]; }
    LDS_WAIT(); asm volatile("" ::: "memory");
    int drow0 = n0;
    if (mode == 1) { const int bj = n0 >= DFF ? 1 : 0; const int j0 = n0 - bj * DFF; drow0 = (j0 >> 7) * 256 + bj * 128 + (j0 & 127); }
    const int c = lane & 7;
#pragma unroll
    for (int j = 0; j < 4; ++j) { const int n = (lane >> 3) + 8 * j; const LAS float* s = scr + (8 * c) * 33 + n;
        u32x4 o; o.x = pk2(s[0 * 33], s[1 * 33]); o.y = pk2(s[2 * 33], s[3 * 33]); o.z = pk2(s[4 * 33], s[5 * 33]); o.w = pk2(s[6 * 33], s[7 * 33]);
        *(u32x4*)(WT + (size_t)(drow0 + n) * K + k0 + 8 * c) = o; }
    LDS_WAIT(); asm volatile("" ::: "memory");
}

__device__ __forceinline__ void norm_mod_phase(const float* xp, const float* xs, const float* nw, const float* modl, int sh_off, bf16* XN, int gw, int NGW, int lane) {
    for (int row = gw; row < MT; row += NGW) {
        unsigned long long* o8 = (unsigned long long*)(XN + (size_t)row * DM) + lane;
        if (row >= MV) {
#pragma unroll
            for (int j = 0; j < 4; ++j) o8[64 * j] = 0ull;
            continue;
        }
        const float* xrow = row < MP ? xp + (size_t)row * DM : xs + (size_t)(row - MP) * DM;
        const f32x4* xr = (const f32x4*)xrow + lane;
        f32x4 v[4]; float s = 0.f;
#pragma unroll
        for (int j = 0; j < 4; ++j) { v[j] = xr[64 * j]; s += (v[j].x * v[j].x + v[j].y * v[j].y) + (v[j].z * v[j].z + v[j].w * v[j].w); }
        const float rstd = 1.0f / sqrtf(wave_sum(s) * (1.0f / DM) + 1e-6f);
        const float* mr = modl + (size_t)mod_row(row) * NADA + sh_off;
#pragma unroll
        for (int j = 0; j < 4; ++j) {
            const int col = 4 * lane + 256 * j;
            const f32x4 w = *(const f32x4*)(nw + col), shv = *(const f32x4*)(mr + col), scv = *(const f32x4*)(mr + 1024 + col);
            const f32x4 y = v[j] * rstd * w * (scv + 1.0f) + shv;
            o8[64 * j] = (unsigned long long)pk2(y.x, y.y) | ((unsigned long long)pk2(y.z, y.w) << 32);
        }
    }
}

constexpr int KV_STRIDE = 272;
constexpr int ATT_K_OFF = 0, ATT_V_OFF = 256 * KV_STRIDE;
__device__ __forceinline__ float alibi_slope(int head12) { return exp2f(-8.0f * (float)(head12 + 1) / 12.0f); }

__device__ __forceinline__ void attn_unit(LAS unsigned char* lds, const bf16* Q, const bf16* K, const bf16* V, bf16* OG, float* DG, int unit, float cshift, int wid, int lane, int tid) {
    const int g = unit >> 9, r9 = unit & 511, sh = 2 * g, d = 1 << sh, nb = 32 >> sh;
    const int qb = r9 % nb; int t2 = r9 / nb; const int r = t2 % d; t2 /= d; const int h = t2 & 3, b = t2 >> 2;
    const int hc = (g * 4 + h) * 128;
    {
        const int ch = tid & 15, r0 = tid >> 4;
        u32x4 kv[8], vv[8];
#pragma unroll
        for (int it = 0; it < 8; ++it) {
            const int j = r0 + 32 * it, mk = 128 * qb - 128 + j;
            if (qb > 0 || it >= 4) {
                const size_t off = ((size_t)b * SEQ + (size_t)mk * d + r) * QKV + hc + ch * 8;
                kv[it] = *(const u32x4*)(K + off); vv[it] = *(const u32x4*)(V + off);
            } else { kv[it] = (u32x4){0u, 0u, 0u, 0u}; vv[it] = (u32x4){0u, 0u, 0u, 0u}; }
        }
#pragma unroll
        for (int it = 0; it < 8; ++it) {
            const int j = r0 + 32 * it;
            *(LAS u32x4*)(lds + ATT_K_OFF + j * KV_STRIDE + ch * 16) = kv[it];
            *(LAS u32x4*)(lds + ATT_V_OFF + j * KV_STRIDE + ch * 16) = vv[it];
        }
    }
    const int ql = lane & 15, gq = lane >> 4;
    const int qi = 16 * wid + ql;
    const size_t qrow = (size_t)b * SEQ + (size_t)(128 * qb + qi) * d + r;
    bf16x8 qf[4];
#pragma unroll
    for (int kk = 0; kk < 4; ++kk) qf[kk] = *(const bf16x8*)(Q + qrow * QKV + hc + 32 * kk + 8 * gq);
    const float slope2 = alibi_slope(g * 4 + h) * LOG2E * (float)d;
    __syncthreads();
    f32x4 accO[8];
#pragma unroll
    for (int dt = 0; dt < 8; ++dt) accO[dt] = (f32x4){0.f, 0.f, 0.f, 0.f};
    float dsum = 0.f;
    const LAS unsigned char* kbase = lds + ATT_K_OFF + (16 * wid + ql) * KV_STRIDE + gq * 16;
    const LAS unsigned char* vbase = lds + ATT_V_OFF + (16 * wid + 4 * gq + (ql >> 2)) * KV_STRIDE + (ql & 3) * 8;
#pragma unroll
    for (int kt2 = 0; kt2 < 5; ++kt2) {
        const int ja = 16 * wid + 32 * kt2;
        f32x4 sa = {0.f, 0.f, 0.f, 0.f}, sb = {0.f, 0.f, 0.f, 0.f};
#pragma unroll
        for (int kk = 0; kk < 4; ++kk) {
            const bf16x8 ka = *(const LAS bf16x8*)(kbase + (32 * kt2) * KV_STRIDE + kk * 64);
            sa = __builtin_amdgcn_mfma_f32_16x16x32_bf16(ka, qf[kk], sa, 0, 0, 0);
        }
        if (kt2 < 4) {
#pragma unroll
            for (int kk = 0; kk < 4; ++kk) {
                const bf16x8 kb = *(const LAS bf16x8*)(kbase + (32 * kt2 + 16) * KV_STRIDE + kk * 64);
                sb = __builtin_amdgcn_mfma_f32_16x16x32_bf16(kb, qf[kk], sb, 0, 0, 0);
            }
        }
        float pa[4], pb[4];
#pragma unroll
        for (int jj = 0; jj < 4; ++jj) {
            const int j = ja + 4 * gq + jj, dist = 128 + qi - j;
            const bool ok = dist >= 0 && dist <= 128 && (128 * qb - 128 + j) >= 0;
            pa[jj] = ok ? fast_exp2(sa[jj] - slope2 * (float)dist - cshift) : 0.f;
            const int j2 = j + 16, dist2 = dist - 16;
            const bool ok2 = (kt2 < 4) && dist2 >= 0 && dist2 <= 128 && (128 * qb - 128 + j2) >= 0;
            pb[jj] = ok2 ? fast_exp2(sb[jj] - slope2 * (float)dist2 - cshift) : 0.f;
            dsum += pa[jj] + pb[jj];
        }
        u32x4 pw; pw.x = pk2(pa[0], pa[1]); pw.y = pk2(pa[2], pa[3]); pw.z = pk2(pb[0], pb[1]); pw.w = pk2(pb[2], pb[3]);
        const bf16x8 pfrag = __builtin_bit_cast(bf16x8, pw);
        const int rb = (kt2 < 4) ? (32 * kt2 + 16) : (32 * kt2);
#pragma unroll
        for (int dt = 0; dt < 8; ++dt) {
            const s16x4 lo = vtr(vbase + (32 * kt2) * KV_STRIDE + dt * 32);
            const s16x4 hi = vtr(vbase + rb * KV_STRIDE + dt * 32);
            const bf16x8 vf = {lo[0], lo[1], lo[2], lo[3], hi[0], hi[1], hi[2], hi[3]};
            accO[dt] = __builtin_amdgcn_mfma_f32_16x16x32_bf16(vf, pfrag, accO[dt], 0, 0, 0);
        }
    }
    dsum += __shfl_xor(dsum, 16); dsum += __shfl_xor(dsum, 32);
    const float inv = 1.0f / dsum;
    bf16* op = OG + qrow * QKV + g * 512 + h * 128 + 4 * gq;
#pragma unroll
    for (int dt = 0; dt < 8; ++dt) {
        u32x2 w; w.x = pk2(accO[dt][0] * inv, accO[dt][1] * inv); w.y = pk2(accO[dt][2] * inv, accO[dt][3] * inv);
        *(u32x2*)(op + dt * 16) = w;
    }
    if (gq == 0) DG[qrow * 12 + g * 4 + h] = dsum;
    __syncthreads();
}

__device__ __forceinline__ void attn_sample_item(LAS unsigned char* lds, const bf16* Q, const bf16* K, const bf16* V, const float* c0, const float* c1, const float* c2, int layer, bf16* YA, int item, int wid, int lane) {
    const int b = item >> 2, h = item & 3;
    LAS float* sc = (LAS float*)lds;
    LAS float* part = (LAS float*)(lds + 2048);
    const size_t row = (size_t)MP + b;
    float q0[3], q1[3];
#pragma unroll
    for (int g = 0; g < 3; ++g) { const unsigned qq = *(const unsigned*)(Q + row * QKV + (g * 4 + h) * 128 + 2 * lane); q0[g] = __uint_as_float(qq << 16); q1[g] = __uint_as_float(qq & 0xffff0000u); }
    for (int j = wid; j < 387; j += 8) {
        const int g = j / 129, step = j - g * 129, d = 1 << (2 * g), lc = 128 << (2 * g);
        float k0, k1;
        if (step == 0) { const unsigned kk = *(const unsigned*)(K + row * QKV + (g * 4 + h) * 128 + 2 * lane); k0 = __uint_as_float(kk << 16); k1 = __uint_as_float(kk & 0xffff0000u); }
        else { const float* cp = (g == 0 ? c0 : (g == 1 ? c1 : c2)) + ((((size_t)(layer * NSMP + b) * lc + (lc - d * step)) * 2 + 0) * 4 + h) * 128 + 2 * lane; const f32x2 kv = *(const f32x2*)cp; k0 = kv.x; k1 = kv.y; }
        const float qa = g == 0 ? q0[0] : (g == 1 ? q0[1] : q0[2]), qb = g == 0 ? q1[0] : (g == 1 ? q1[1] : q1[2]);
        float s = wave_sum(qa * k0 + qb * k1);
        s -= alibi_slope(g * 4 + h) * LOG2E * (float)(d * step);
        if (lane == 0) sc[j] = s;
    }
    LDS_WAIT(); __syncthreads();
    float mx = -3.0e38f;
    for (int j = lane; j < 387; j += 64) mx = fmaxf(mx, sc[j]);
    mx = wave_max(mx);
    float den = 0.f;
    for (int j = lane; j < 387; j += 64) den += fast_exp2(sc[j] - mx);
    den = wave_sum(den);
    float n0 = 0.f, n1 = 0.f;
    for (int j = wid; j < 387; j += 8) {
        const int g = j / 129, step = j - g * 129, d = 1 << (2 * g), lc = 128 << (2 * g);
        float v0, v1;
        if (step == 0) { const unsigned vv = *(const unsigned*)(V + row * QKV + (g * 4 + h) * 128 + 2 * lane); v0 = __uint_as_float(vv << 16); v1 = __uint_as_float(vv & 0xffff0000u); }
        else { const float* cp = (g == 0 ? c0 : (g == 1 ? c1 : c2)) + ((((size_t)(layer * NSMP + b) * lc + (lc - d * step)) * 2 + 1) * 4 + h) * 128 + 2 * lane; const f32x2 vv = *(const f32x2*)cp; v0 = vv.x; v1 = vv.y; }
        const float p = fast_exp2(sc[j] - mx);
        n0 += p * v0; n1 += p * v1;
    }
    part[wid * 128 + 2 * lane] = n0; part[wid * 128 + 2 * lane + 1] = n1;
    LDS_WAIT(); __syncthreads();
    if (wid == 0) {
        float a0 = 0.f, a1 = 0.f;
#pragma unroll
        for (int w = 0; w < 8; ++w) { a0 += part[w * 128 + 2 * lane]; a1 += part[w * 128 + 2 * lane + 1]; }
        const float inv = 1.0f / den;
        *(unsigned*)(YA + row * 512 + h * 128 + 2 * lane) = pk2(a0 * inv, a1 * inv);
    }
    LDS_WAIT(); __syncthreads();
}

constexpr int SG_STRIDE = 144;
constexpr int SG_SLAB = 128 * SG_STRIDE;
constexpr int SG_STATS = 4 * SG_SLAB;
__device__ __forceinline__ void sgu_unit(LAS unsigned char* lds, const bf16* U, const bf16* VS, const float* lnw, const float* lnb, const bf16* WSP, const float* bsp, bf16* YS, int unit, int wid, int lane) {
    const int half = unit & 1, bn = unit >> 1;
    const size_t R0 = (size_t)bn * 128;
    LAS f32x2* stats = (LAS f32x2*)(lds + SG_STATS);
    for (int i = 0; i < 16; ++i) {
        const int rl = 16 * wid + i;
        const u32x4 x = *(const u32x4*)(VS + (R0 + rl) * 512 + 8 * lane);
        const float f[8] = {__uint_as_float(x.x << 16), __uint_as_float(x.x & 0xffff0000u), __uint_as_float(x.y << 16), __uint_as_float(x.y & 0xffff0000u),
                            __uint_as_float(x.z << 16), __uint_as_float(x.z & 0xffff0000u), __uint_as_float(x.w << 16), __uint_as_float(x.w & 0xffff0000u)};
        float s = 0.f, s2 = 0.f;
#pragma unroll
        for (int e = 0; e < 8; ++e) { s += f[e]; s2 += f[e] * f[e]; }
        s = wave_sum(s); s2 = wave_sum(s2);
        const float mean = s * (1.0f / 512.0f), var = fmaxf(s2 * (1.0f / 512.0f) - mean * mean, 0.f);
        if (lane == 0) stats[rl] = (f32x2){mean, 1.0f / sqrtf(var + 1e-6f)};
    }
    LDS_WAIT(); __syncthreads();
    const int gl = wid & 3, th = wid >> 2, grp = half * 4 + gl, c0 = grp * 64;
    LAS unsigned char* slab = lds + gl * SG_SLAB;
    {
        const int cc = (lane & 7) * 8;
        const f32x4 w0 = *(const f32x4*)(lnw + c0 + cc), w1 = *(const f32x4*)(lnw + c0 + cc + 4), b0 = *(const f32x4*)(lnb + c0 + cc), b1 = *(const f32x4*)(lnb + c0 + cc + 4);
#pragma unroll
        for (int it = 0; it < 8; ++it) {
            const int rl = th * 64 + it * 8 + (lane >> 3);
            const u32x4 x = *(const u32x4*)(VS + (R0 + rl) * 512 + c0 + cc);
            const f32x2 st = stats[rl];
            f32x4 a = {__uint_as_float(x.x << 16), __uint_as_float(x.x & 0xffff0000u), __uint_as_float(x.y << 16), __uint_as_float(x.y & 0xffff0000u)};
            f32x4 c = {__uint_as_float(x.z << 16), __uint_as_float(x.z & 0xffff0000u), __uint_as_float(x.w << 16), __uint_as_float(x.w & 0xffff0000u)};
            a = (a - st.x) * st.y * w0 + b0; c = (c - st.x) * st.y * w1 + b1;
            u32x4 o; o.x = pk2(a[0], a[1]); o.y = pk2(a[2], a[3]); o.z = pk2(c[0], c[1]); o.w = pk2(c[2], c[3]);
            *(LAS u32x4*)(slab + rl * SG_STRIDE + cc * 2) = o;
        }
    }
    LDS_WAIT(); __syncthreads();
    const int ql = lane & 15, gq = lane >> 4;
    const LAS unsigned char* abase = slab + (8 * gq + (ql >> 2)) * SG_STRIDE + (ql & 3) * 8;
    const bf16* wg = WSP + (size_t)grp * 128 * 128;
#pragma unroll
    for (int ti = 0; ti < 4; ++ti) {
        const int tt = th == 0 ? (ti == 0 ? 0 : (ti == 1 ? 3 : (ti == 2 ? 4 : 7))) : (ti == 0 ? 1 : (ti == 1 ? 2 : (ti == 2 ? 5 : 6)));
        const int t = 16 * tt + ql;
        f32x4 acc[4];
#pragma unroll
        for (int ct = 0; ct < 4; ++ct) acc[ct] = (f32x4){0.f, 0.f, 0.f, 0.f};
        for (int kk = 0; kk <= (tt >> 1); ++kk) {
            const bf16x8 wf = *(const bf16x8*)(wg + (size_t)t * 128 + 32 * kk + 8 * gq);
#pragma unroll
            for (int ct = 0; ct < 4; ++ct) {
                const s16x4 lo = vtr(abase + (32 * kk) * SG_STRIDE + ct * 32);
                const s16x4 hi = vtr(abase + (32 * kk + 4) * SG_STRIDE + ct * 32);
                const bf16x8 af = {lo[0], lo[1], lo[2], lo[3], hi[0], hi[1], hi[2], hi[3]};
                acc[ct] = __builtin_amdgcn_mfma_f32_16x16x32_bf16(af, wf, acc[ct], 0, 0, 0);
            }
        }
        const float bias = bsp[grp * 128 + t];
#pragma unroll
        for (int ct = 0; ct < 4; ++ct) {
            const size_t off = (R0 + t) * 512 + c0 + ct * 16 + 4 * gq;
            const u32x2 uu = *(const u32x2*)(U + off);
            const float u0 = __uint_as_float(uu.x << 16), u1 = __uint_as_float(uu.x & 0xffff0000u), u2 = __uint_as_float(uu.y << 16), u3 = __uint_as_float(uu.y & 0xffff0000u);
            u32x2 o; o.x = pk2(u0 * (acc[ct][0] + bias), u1 * (acc[ct][1] + bias)); o.y = pk2(u2 * (acc[ct][2] + bias), u3 * (acc[ct][3] + bias));
            *(u32x2*)(YS + off) = o;
        }
    }
    LDS_WAIT(); __syncthreads();
}

__device__ __forceinline__ void sgu_sample_row(const bf16* U, const bf16* VS, const float* lnw, const float* lnb, const float* wsp_f32, const float* bsp, bf16* YS, float* out_sv, int b, int lane) {
    const size_t row = (size_t)MP + b;
    const u32x4 x = *(const u32x4*)(VS + row * 512 + 8 * lane);
    float f[8] = {__uint_as_float(x.x << 16), __uint_as_float(x.x & 0xffff0000u), __uint_as_float(x.y << 16), __uint_as_float(x.y & 0xffff0000u),
                  __uint_as_float(x.z << 16), __uint_as_float(x.z & 0xffff0000u), __uint_as_float(x.w << 16), __uint_as_float(x.w & 0xffff0000u)};
    float s = 0.f, s2 = 0.f;
#pragma unroll
    for (int e = 0; e < 8; ++e) { s += f[e]; s2 += f[e] * f[e]; }
    s = wave_sum(s); s2 = wave_sum(s2);
    const float mean = s * (1.0f / 512.0f), var = fmaxf(s2 * (1.0f / 512.0f) - mean * mean, 0.f), rstd = 1.0f / sqrtf(var + 1e-6f);
    const int c = 8 * lane, grp = c >> 6;
    const float w00 = wsp_f32[(size_t)grp * 128 * 128], b0 = bsp[grp * 128];
    const u32x4 uu = *(const u32x4*)(U + row * 512 + c);
    const float uf[8] = {__uint_as_float(uu.x << 16), __uint_as_float(uu.x & 0xffff0000u), __uint_as_float(uu.y << 16), __uint_as_float(uu.y & 0xffff0000u),
                         __uint_as_float(uu.z << 16), __uint_as_float(uu.z & 0xffff0000u), __uint_as_float(uu.w << 16), __uint_as_float(uu.w & 0xffff0000u)};
    float y[8];
#pragma unroll
    for (int e = 0; e < 8; ++e) { const float vn = (f[e] - mean) * rstd * lnw[c + e] + lnb[c + e]; out_sv[c + e] = vn; y[e] = uf[e] * (w00 * vn + b0); }
    u32x4 o; o.x = pk2(y[0], y[1]); o.y = pk2(y[2], y[3]); o.z = pk2(y[4], y[5]); o.w = pk2(y[6], y[7]);
    *(u32x4*)(YS + row * 512 + c) = o;
}

__device__ __forceinline__ void merge_row(const bf16* OG, const float* DG, bf16* YA, int row, int lane) {
    const int h = lane >> 4;
    const float d0 = DG[(size_t)row * 12 + h], d1 = DG[(size_t)row * 12 + 4 + h], d2 = DG[(size_t)row * 12 + 8 + h];
    const float inv = 1.0f / (d0 + d1 + d2);
    const float a0 = d0 * inv, a1 = d1 * inv, a2 = d2 * inv;
    const bf16* p = OG + (size_t)row * QKV + 8 * lane;
    const u32x4 x0 = *(const u32x4*)p, x1 = *(const u32x4*)(p + 512), x2 = *(const u32x4*)(p + 1024);
    u32x4 o;
#define MRG(c) pk2(a0 * __uint_as_float(x0.c << 16) + a1 * __uint_as_float(x1.c << 16) + a2 * __uint_as_float(x2.c << 16), \
                   a0 * __uint_as_float(x0.c & 0xffff0000u) + a1 * __uint_as_float(x1.c & 0xffff0000u) + a2 * __uint_as_float(x2.c & 0xffff0000u))
    o.x = MRG(x); o.y = MRG(y); o.z = MRG(z); o.w = MRG(w);
#undef MRG
    *(u32x4*)(YA + (size_t)row * 512 + 8 * lane) = o;
}


#define RLX_AGENT __ATOMIC_RELAXED, __HIP_MEMORY_SCOPE_AGENT
#define XB_TMO      128
#define XB_XCNT(j)  (256  + 64 * (j))
#define XB_XSUB(j)  (1280 + 64 * (j))
#define XB_XGEN(j)  (2304 + 64 * (j))
#define XB_TOP      3328
#define XB_TOPGEN   3392
#define XCD_BAR_WORDS 3456
#define XB_SPIN_CAP (1u << 18)

__device__ __forceinline__ unsigned xb_ld(unsigned* p)              { return __hip_atomic_load(p, __ATOMIC_RELAXED, __HIP_MEMORY_SCOPE_AGENT); }
__device__ __forceinline__ unsigned xb_add(unsigned* p, unsigned v) { return __hip_atomic_fetch_add(p, v, __ATOMIC_RELAXED, __HIP_MEMORY_SCOPE_AGENT); }
__device__ __forceinline__ unsigned xb_xcc_id() { return (unsigned)__builtin_amdgcn_s_getreg((3 << 11) | 20) & 0xFu; }
#define XB_SPIN(cond, bar) do { unsigned _sp = 0; while (cond) { __builtin_amdgcn_s_sleep(1); \
    if ((++_sp & 255u) == 0u) { if (xb_ld(&(bar)[XB_TMO])) break; if (_sp > XB_SPIN_CAP) { atomicAdd(&(bar)[XB_TMO], 1u); break; } } } } while (0)

struct XcdBarrier {
    unsigned* bar; unsigned x;
    volatile LAS unsigned* st;
};

__device__ __forceinline__ XcdBarrier xcd_barrier_post(unsigned* bar, volatile LAS unsigned* st) {
    XcdBarrier b; b.bar = bar; b.x = xb_xcc_id(); b.st = st;
    if (threadIdx.x == 0) (void)xb_add(&bar[XB_XCNT(b.x)], 1u);
    return b;
}
__device__ __forceinline__ void xcd_barrier_complete(unsigned* bar, unsigned x, unsigned& nloc, unsigned& nx) {
    const unsigned G = gridDim.x * gridDim.y * gridDim.z;
    unsigned sum, cnt, mine, sp = 0u;
    for (;;) {
        sum = 0u; cnt = 0u; mine = 0u;
#pragma unroll
        for (unsigned j = 0; j < 16; ++j) { const unsigned c = xb_ld(&bar[XB_XCNT(j)]); sum += c; cnt += (c > 0u) ? 1u : 0u; mine = (j == x) ? c : mine; }
        if (sum == G) break;
        __builtin_amdgcn_s_sleep(1);
        if ((++sp & 255u) == 0u) { if (xb_ld(&bar[XB_TMO])) break; if (sp > XB_SPIN_CAP) { atomicAdd(&bar[XB_TMO], 1u); break; } }
    }
    nloc = mine > 0u ? mine : 1u; nx = cnt > 0u ? cnt : 1u;
}

__device__ __forceinline__ void xcd_barrier(const XcdBarrier& b) {
    asm volatile("s_waitcnt vmcnt(0)" ::: "memory");
    __syncthreads();
    if (threadIdx.x == 0) {
        unsigned* bar = b.bar;
        __builtin_amdgcn_s_waitcnt(0);
        unsigned nloc = b.st[0], nx = b.st[1];
        if (nloc == 0u) { xcd_barrier_complete(bar, b.x, nloc, nx); b.st[0] = nloc; b.st[1] = nx; }
        const unsigned old = xb_add(&bar[XB_XSUB(b.x)], 1u);
        const unsigned gen = old / nloc;
        if (old + 1u == (gen + 1u) * nloc) {
            __builtin_amdgcn_fence(__ATOMIC_RELEASE, "agent");
            asm volatile("s_waitcnt vmcnt(0)" ::: "memory");
            const unsigned og = xb_add(&bar[XB_TOP], 1u);
            const unsigned tg = og / nx;
            if (og + 1u == (tg + 1u) * nx) xb_add(&bar[XB_TOPGEN], 1u);
            else XB_SPIN(xb_ld(&bar[XB_TOPGEN]) == tg, bar);
            __builtin_amdgcn_fence(__ATOMIC_ACQUIRE, "agent");
            xb_add(&bar[XB_XGEN(b.x)], 1u);
            asm volatile("s_waitcnt vmcnt(0)" ::: "memory");
        } else {
            XB_SPIN(xb_ld(&bar[XB_XGEN(b.x)]) == gen, bar);
            __builtin_amdgcn_fence(__ATOMIC_ACQUIRE, "agent");
            asm volatile("s_waitcnt vmcnt(0)" ::: "memory");
        }
    }
    __syncthreads();
}

constexpr int LDS_MISC = LDS_EXCH + 8192;
constexpr size_t WS_CTL = 0, CTL_ZERO_BYTES = 65536;
#define PHON(k) if constexpr (((PHM) >> (k)) & 1)
#define GSYNC() do { if constexpr (COOP) { CAS const Args* ap_ = (CAS const Args*)__builtin_amdgcn_kernarg_segment_ptr(); asm volatile("" : "+s"(ap_)); \
    XcdBarrier xb_; xb_.bar = (unsigned*)((unsigned char*)ap_->ws + WS_CTL); xb_.x = xb_xcc_id(); xb_.st = (volatile LAS unsigned*)(lds + LDS_MISC); xcd_barrier(xb_); } } while (0)
#define GSYNC_CG() do { if constexpr (COOP) cg::this_grid().sync(); } while (0)
#define GAS __attribute__((address_space(1)))
#define CAS __attribute__((address_space(4)))
struct Args { GAS const float* in[23]; GAS float* out; GAS unsigned char* ws; };

#define PHASE_ENV() \
    CAS const Args* ap = (CAS const Args*)__builtin_amdgcn_kernarg_segment_ptr(); asm volatile("" : "+s"(ap)); \
    int tid = threadIdx.x; asm volatile("" : "+v"(tid)); \
    const int lane = tid & 63, wid = __builtin_amdgcn_readfirstlane(tid >> 6); \
    int G_ = gridDim.x, bx_ = blockIdx.x; asm volatile("" : "+s"(G_), "+s"(bx_)); const int G = G_, bx = bx_; const int gw = bx * NWAVES + wid, NGW = G * NWAVES; \
    unsigned char* const ws = (unsigned char*)ap->ws; (void)lane; (void)wid; (void)gw; (void)NGW; (void)ws; (void)G; (void)bx
#define WL(l) (ws + WS_WL0 + (size_t)(l) * WL_SIZE)

template <int PHM, bool COOP>
__global__ void __launch_bounds__(NTHREADS, 2) fwd_megakernel(Args args_unused, int l_lo, int l_hi) {
    extern __shared__ __attribute__((aligned(16))) unsigned char lds_raw[];
    LAS unsigned char* lds = (LAS unsigned char*)lds_raw;
    if constexpr (COOP) {
        PHASE_ENV();
        if (tid < 32) ((LAS unsigned*)(lds + LDS_MISC))[tid] = 0u;
        __syncthreads();
        (void)xcd_barrier_post((unsigned*)(ws + WS_CTL), (volatile LAS unsigned*)(lds + LDS_MISC));
    }

    PHON(0) {
        PHASE_ENV();
        bf16* WADA = (bf16*)(ws + WS_WADA); bf16* SC = (bf16*)(ws + WS_SC);
        LAS float* scr = (LAS float*)(lds + wid * 16384);
        constexpr int I_ADA = 16 * 192, I_IN = 16 * 240, I_PA = 8 * 32, I_OUT = 16 * 32, I_FI = 16 * 176, I_FO = 44 * 32;
        constexpr int I_LAYER = I_ADA + I_IN + 2 * I_PA + I_OUT + I_FI + I_FO;
        for (int it = gw; it < 2 * I_LAYER; it += NGW) {
            const int l = it / I_LAYER; int r = it - l * I_LAYER;
            unsigned char* wl = WL(l);
            if (r < I_ADA) { transpose_item(((const float*)ap->in[7]) + (size_t)l * DM * NADA, DM, NADA, WADA + (size_t)l * NADA * DM, 0, scr, r, lane); continue; } r -= I_ADA;
            if (r < I_IN) { transpose_item(((const float*)ap->in[10]) + (size_t)l * DM * DIN, DM, DIN, (bf16*)(wl + WL_WIN), 0, scr, r, lane); continue; } r -= I_IN;
            if (r < I_PA) { transpose_item(((const float*)ap->in[17]) + (size_t)l * 512 * DM, 512, DM, (bf16*)(wl + WL_WPA), 0, scr, r, lane); continue; } r -= I_PA;
            if (r < I_PA) { transpose_item(((const float*)ap->in[18]) + (size_t)l * 512 * DM, 512, DM, (bf16*)(wl + WL_WPS), 0, scr, r, lane); continue; } r -= I_PA;
            if (r < I_OUT) { transpose_item(((const float*)ap->in[19]) + (size_t)l * DM * DM, DM, DM, (bf16*)(wl + WL_WOUT), 0, scr, r, lane); continue; } r -= I_OUT;
            if (r < I_FI) { transpose_item(((const float*)ap->in[21]) + (size_t)l * DM * 2 * DFF, DM, 2 * DFF, (bf16*)(wl + WL_WFI), 1, scr, r, lane); continue; } r -= I_FI;
            transpose_item(((const float*)ap->in[22]) + (size_t)l * DFF * DM, DFF, DM, (bf16*)(wl + WL_WFO), 0, scr, r, lane);
        }
        const int gt = bx * NTHREADS + tid, NGT = G * NTHREADS;
        const float* wsp = ((const float*)ap->in[15]);
        for (int i = gt; i < 2 * 8 * 128 * 128; i += NGT) {
            const int l = i >> 17, r = i & 131071, t = (r >> 7) & 127, s = r & 127;
            const float w = wsp[i];
            ((bf16*)(WL(l) + WL_WSP))[r] = (bf16)(s <= t ? (pk2(w, 0.f) & 0xffffu) : 0u);
        }
        const float* cpr = ((const float*)ap->in[5]); const float* csm = ((const float*)ap->in[6]);
        for (int i = gt; i < 256 * DM; i += NGT) {
            const int r = i >> 10, k = i & 1023;
            float v = 0.f;
            if (r < 4) v = cpr[r * DM + k]; else if (r < 36) v = csm[(r - 4) * DM + k];
            SC[i] = (bf16)(pk2(v * sigmoidf_(v), 0.f) & 0xffffu);
        }
    }
    GSYNC_CG();
    PHON(1) {
        PHASE_ENV();
        pg8::Gemm g{(const bf16*)(ws + WS_SC), (const bf16*)(ws + WS_WADA), 256, 2 * NADA, DM}; pg8::StaticOrder S; S.init(256, 2 * NADA, G, bx);
        EpiAda E{(float*)(ws + WS_MOD), ((const float*)ap->in[8])};
        pg8::gemm_phase<EpiAda, pg8::StaticOrder, true, true>(lds + LDS_RING, g, S, E);
    }
    GSYNC();

    for (int l = l_lo; l < l_hi; ++l) {
        PHON(2) {
            PHASE_ENV();
            const float* X2 = (const float*)(ws + WS_X2);
            const float* xin_p = l == 0 ? ((const float*)ap->in[0]) : X2;
            const float* xin_s = l == 0 ? ((const float*)ap->in[1]) : X2 + (size_t)MP * DM;
            norm_mod_phase(xin_p, xin_s, ((const float*)ap->in[9]) + l * DM, (const float*)(ws + WS_MOD) + (size_t)l * 36 * NADA, 0, (bf16*)(ws + WS_XN), gw, NGW, lane);
        }
        GSYNC();
        PHON(3) {
            PHASE_ENV();
            pg8::Gemm g{(const bf16*)(ws + WS_XN), (const bf16*)(WL(l) + WL_WIN), MT, DIN, DM}; pg8::StaticOrder S; S.init(MT, DIN, G, bx);
            EpiIn E{ws, ((const float*)ap->in[11]) + l * 384, ((const float*)ap->in[12]) + l * 384, ((float*)ap->out), l, (LAS float*)(lds + LDS_EXCH)};
            pg8::gemm_phase<EpiIn, pg8::StaticOrder, true, true>(lds + LDS_RING, g, S, E);
        }
        GSYNC();
        PHON(4) {
            PHASE_ENV();
            const bf16 *Qb = (const bf16*)(ws + WS_Q), *Kb = (const bf16*)(ws + WS_K), *Vb = (const bf16*)(ws + WS_V);
            float mq = 0.f, mk = 0.f;
            for (int i = lane; i < 384; i += 64) { mq = fmaxf(mq, fabsf(((const float*)ap->in[11])[l * 384 + i])); mk = fmaxf(mk, fabsf(((const float*)ap->in[12])[l * 384 + i])); }
            mq = wave_max(mq); mk = wave_max(mk);
            const float cshift = 11.3137085f * LOG2E * mq * mk;
            for (int u = bx; u < 1536; u += G) attn_unit(lds, Qb, Kb, Vb, (bf16*)(ws + WS_OG), (float*)(ws + WS_DG), u, cshift, wid, lane, tid);
        }
        PHON(4) {
            PHASE_ENV();
            if (bx >= G / 2) {
                for (int it = bx - G / 2; it < NSMP * 4; it += G - G / 2)
                    attn_sample_item(lds, (const bf16*)(ws + WS_Q), (const bf16*)(ws + WS_K), (const bf16*)(ws + WS_V), ((const float*)ap->in[2]), ((const float*)ap->in[3]), ((const float*)ap->in[4]), l, (bf16*)(ws + WS_YA), it, wid, lane);
            }
        }
        GSYNC();
        PHON(5) {
            PHASE_ENV();
            const bf16 *Ub = (const bf16*)(ws + WS_U), *VSb = (const bf16*)(ws + WS_VS); bf16 *YS = (bf16*)(ws + WS_YS);
            const bf16* WSP = (const bf16*)(WL(l) + WL_WSP);
            const float* lnw = ((const float*)ap->in[13]) + l * 512; const float* lnb = ((const float*)ap->in[14]) + l * 512; const float* bsp = ((const float*)ap->in[16]) + l * 8 * 128;
            for (int u = bx; u < 256; u += G) sgu_unit(lds, Ub, VSb, lnw, lnb, WSP, bsp, YS, u, wid, lane);
            for (int b = gw; b < NSMP; b += NGW) sgu_sample_row(Ub, VSb, lnw, lnb, ((const float*)ap->in[15]) + (size_t)l * 8 * 128 * 128, bsp, YS, ((float*)ap->out) + O_SV + (size_t)(l * NSMP + b) * 512, b, lane);
            for (int row = gw; row < MP; row += NGW) merge_row((const bf16*)(ws + WS_OG), (const float*)(ws + WS_DG), (bf16*)(ws + WS_YA), row, lane);
        }
        GSYNC();
        PHON(6) {
            PHASE_ENV();
            pg8::StaticOrder S; S.init(MT, DM, G, bx);
            pg8::Gemm g{(const bf16*)(ws + WS_YA), (const bf16*)(WL(l) + WL_WPA), MT, DM, 512}; EpiGate1 E{(const bf16*)(ws + WS_G), (float*)(ws + WS_T1)};
            pg8::gemm_phase<EpiGate1, pg8::StaticOrder, true, true>(lds + LDS_RING, g, S, E);
        }
        PHON(6) {
            PHASE_ENV();
            pg8::StaticOrder S; S.init(MT, DM, G, bx);
            pg8::Gemm g{(const bf16*)(ws + WS_YS), (const bf16*)(WL(l) + WL_WPS), MT, DM, 512}; EpiGate2 E{(const bf16*)(ws + WS_G), (const float*)(ws + WS_T1), (bf16*)(ws + WS_MG)};
            pg8::gemm_phase<EpiGate2, pg8::StaticOrder, true, true>(lds + LDS_RING, g, S, E);
        }
        GSYNC();
        PHON(7) {
            PHASE_ENV();
            const float* X2 = (const float*)(ws + WS_X2); float* X1 = (float*)(ws + WS_X1);
            const float* xin_p = l == 0 ? ((const float*)ap->in[0]) : X2;
            const float* xin_s = l == 0 ? ((const float*)ap->in[1]) : X2 + (size_t)MP * DM;
            pg8::Gemm g{(const bf16*)(ws + WS_MG), (const bf16*)(WL(l) + WL_WOUT), MT, DM, DM}; pg8::StaticOrder S; S.init(MT, DM, G, bx);
            EpiRes E{xin_p, xin_s, X1, X1 + (size_t)MP * DM, (const float*)(ws + WS_MOD) + (size_t)l * 36 * NADA + 2048};
            pg8::gemm_phase<EpiRes, pg8::StaticOrder, true, true>(lds + LDS_RING, g, S, E);
        }
        GSYNC();
        PHON(8) {
            PHASE_ENV();
            const float* X1 = (const float*)(ws + WS_X1);
            norm_mod_phase(X1, X1 + (size_t)MP * DM, ((const float*)ap->in[20]) + l * DM, (const float*)(ws + WS_MOD) + (size_t)l * 36 * NADA, 3072, (bf16*)(ws + WS_XN), gw, NGW, lane);
        }
        GSYNC();
        PHON(9) {
            PHASE_ENV();
            pg8::Gemm g{(const bf16*)(ws + WS_XN), (const bf16*)(WL(l) + WL_WFI), MT, 2 * DFF, DM}; pg8::StaticOrder S; S.init(MT, 2 * DFF, G, bx);
            EpiSwiglu E{(bf16*)(ws + WS_H)};
            pg8::gemm_phase<EpiSwiglu, pg8::StaticOrder, true, true>(lds + LDS_RING, g, S, E);
        }
        GSYNC();
        PHON(10) {
            PHASE_ENV();
            const float* X1 = (const float*)(ws + WS_X1); float* X2 = (float*)(ws + WS_X2);
            float* xout_p = l == 0 ? X2 : ((float*)ap->out) + O_YP;
            float* xout_s = l == 0 ? X2 + (size_t)MP * DM : ((float*)ap->out) + O_YS;
            pg8::Gemm g{(const bf16*)(ws + WS_H), (const bf16*)(WL(l) + WL_WFO), MT, DM, DFF}; pg8::StaticOrder S; S.init(MT, DM, G, bx);
            EpiRes E{X1, X1 + (size_t)MP * DM, xout_p, xout_s, (const float*)(ws + WS_MOD) + (size_t)l * 36 * NADA + 5120};
            pg8::gemm_phase<EpiRes, pg8::StaticOrder, true, true>(lds + LDS_RING, g, S, E);
        }
        if (l + 1 < l_hi) GSYNC();
    }
}


#ifdef EXP_MASK
__global__ void __launch_bounds__(256) dbg_checksum(const unsigned char* ws, float* out) {
    const int lane = threadIdx.x & 63, gw = (blockIdx.x * 256 + threadIdx.x) >> 6, ngw = gridDim.x * 4;
    struct B { size_t off; int cols; int isf; };
    const B bufs[16] = {{WS_XN, 1024, 0}, {WS_Q, 1536, 0}, {WS_K, 1536, 0}, {WS_V, 1536, 0}, {WS_U, 512, 0}, {WS_VS, 512, 0}, {WS_G, 2048, 0}, {WS_OG, 1536, 0},
                        {WS_DG, 12, 1}, {WS_YA, 512, 0}, {WS_YS, 512, 0}, {WS_T1, 1024, 1}, {WS_MG, 1024, 0}, {WS_X1, 1024, 1}, {WS_H, 2816, 0}, {WS_X2, 1024, 1}};
    for (int b = 0; b < 16; ++b) {
        if (!((EXP_MASK >> b) & 1)) continue;
        for (int row = gw; row < MV; row += ngw) {
            float s = 0.f;
            for (int c = lane; c < bufs[b].cols; c += 64) {
                const float v = bufs[b].isf ? ((const float*)(ws + bufs[b].off))[(size_t)row * bufs[b].cols + c] : bf2f(((const bf16*)(ws + bufs[b].off))[(size_t)row * bufs[b].cols + c]);
                s += v * (float)(1 + (c % 7));
            }
            s = wave_sum(s);
            if (lane == 0) out[(size_t)b * MT + row] = s;
        }
    }
    if ((EXP_MASK >> 16) & 1) for (int i = blockIdx.x * 256 + threadIdx.x; i < 72 * NADA; i += gridDim.x * 256) out[16 * MT + i] = ((const float*)(ws + WS_MOD))[i];
}
#endif
#ifndef N_LAUNCH_MODE
#define N_LAUNCH_MODE 1
#endif
template <int PHM> static void launch_phase(const Args& a, int l_lo, int l_hi, int grid, hipStream_t stream) {
    static bool attr = false;
    if (!attr) { (void)hipFuncSetAttribute((const void*)fwd_megakernel<PHM, false>, hipFuncAttributeMaxDynamicSharedMemorySize, LDS_BYTES); attr = true; }
    hipLaunchKernelGGL((fwd_megakernel<PHM, false>), dim3(grid), dim3(NTHREADS), LDS_BYTES, stream, a, l_lo, l_hi);
}
extern "C" void kernel_launch(void* const* d_in, const int* in_sizes, int n_in, void* d_out, int out_size, void* d_ws, size_t ws_size, hipStream_t stream) {
    static int grid = 0;
    if (grid == 0) {
        if (n_in != 23 || (size_t)out_size != O_END || ws_size < WS_END) { fprintf(stderr, "kernel_launch: unexpected shapes (n_in %d out %d ws %zu need %zu)\n", n_in, out_size, ws_size, (size_t)WS_END); grid = -1; return; }
        int dev = 0, cus = 0, per_cu = 0;
        (void)hipGetDevice(&dev);
        (void)hipDeviceGetAttribute(&cus, hipDeviceAttributeMultiprocessorCount, dev);
#if N_LAUNCH_MODE == 1
        if (hipFuncSetAttribute((const void*)fwd_megakernel<0x7FF, true>, hipFuncAttributeMaxDynamicSharedMemorySize, LDS_BYTES) != hipSuccess) { fprintf(stderr, "kernel_launch: hipFuncSetAttribute failed\n"); grid = -1; return; }
        (void)hipOccupancyMaxActiveBlocksPerMultiprocessor(&per_cu, (const void*)fwd_megakernel<0x7FF, true>, NTHREADS, LDS_BYTES);
        (void)hipGetLastError();
        if (per_cu < 1) fprintf(stderr, "kernel_launch: occupancy query says %d blocks per CU\n", per_cu);
#endif
        grid = cus;
    }
    if (grid < 0) return;
    Args a{};
    for (int i = 0; i < 23; ++i) a.in[i] = (GAS const float*)d_in[i];
    a.out = (GAS float*)d_out; a.ws = (GAS unsigned char*)d_ws;
#if N_LAUNCH_MODE == 1
    (void)hipMemsetAsync((unsigned char*)d_ws + WS_CTL, 0, CTL_ZERO_BYTES, stream);
    int l_lo = 0, l_hi = 2;
    void* kargs[] = {&a, &l_lo, &l_hi};
    hipError_t e = hipLaunchCooperativeKernel((const void*)fwd_megakernel<0x7FF, true>, dim3(grid), dim3(NTHREADS), kargs, LDS_BYTES, stream);
    if (e != hipSuccess) fprintf(stderr, "cooperative launch failed: %s (grid %d)\n", hipGetErrorString(e), grid);
#else
#ifdef EXP_MASK
    (void)hipMemsetAsync(d_out, 0, (size_t)out_size * 4, stream);
#endif
    launch_phase<0x001>(a, 0, 0, grid, stream);
    launch_phase<0x002>(a, 0, 0, grid, stream);
#ifdef EXP_MASK
    const int NL = 1;
#else
    const int NL = 2;
#endif
    for (int l = 0; l < NL; ++l) {
        launch_phase<0x004>(a, l, l + 1, grid, stream);
        launch_phase<0x008>(a, l, l + 1, grid, stream);
        launch_phase<0x010>(a, l, l + 1, grid, stream);
        launch_phase<0x020>(a, l, l + 1, grid, stream);
        launch_phase<0x040>(a, l, l + 1, grid, stream);
        launch_phase<0x080>(a, l, l + 1, grid, stream);
        launch_phase<0x100>(a, l, l + 1, grid, stream);
        launch_phase<0x200>(a, l, l + 1, grid, stream);
        launch_phase<0x400>(a, l, l + 1, grid, stream);
    }
#ifdef EXP_MASK
    hipLaunchKernelGGL(dbg_checksum, dim3(1024), dim3(256), 0, stream, (const unsigned char*)d_ws, (float*)d_out);
#endif
#endif
}
```

```cpp
#include <hip/hip_runtime.h>
#include <hip/hip_cooperative_groups.h>
#include <cstdio>
#include <cstdint>
namespace cg = cooperative_groups;
namespace pg8 {
#define PG8_LAS __attribute__((address_space(3)))
typedef unsigned short bf16_t;
typedef short bf16x8 __attribute__((ext_vector_type(8)));
typedef float f32x4 __attribute__((ext_vector_type(4)));
typedef unsigned u32x4 __attribute__((ext_vector_type(4)));
constexpr int BM = 256, BK = 64, HALF = 128, HTB = HALF * BK * 2  , STAGE_BYTES = 8 * HTB, NXCD = 8, WGM = 8;

__host__ __device__ __forceinline__ int lds_byte(int r, int c) { const int st = (r >> 4) * 2 + (c >> 5), rr = r & 15, cc = c & 31, ob = rr * 64 + cc * 2; return st * 1024 + (ob ^ (((ob >> 9) & 1) << 5)); }
__host__ __device__ __forceinline__ void stage_rc(int b, int& R, int& C) { const int st = b / 1024, sb = b % 1024, swz = sb ^ (((sb >> 9) & 1) << 5); R = (st >> 1) * 16 + swz / 64; C = (st & 1) * 32 + (swz % 64) / 2; }
__host__ __device__ __forceinline__ int perm32(int rho) { const int n = rho >> 4, i = rho & 15; return 8 * (i >> 2) + 4 * n + (i & 3); }

struct Unit { int pm, pn; };
struct Gemm { const bf16_t* A; const bf16_t* Bt; int M, N, K; };

struct StaticOrder {
    int nM, nN, nwg, G, c;
    __host__ __device__ void init(int M, int N, int G_, int c_) { nM = M / BM; nN = N / BM; nwg = nM * nN; G = G_; c = c_; }
    __host__ __device__ bool next(int i, Unit& u) const {
        const long L = (long)i * G + c; if (L >= nwg) return false;
        int wgid = (int)L; { const int q = nwg / NXCD, r = nwg % NXCD, xcd = wgid % NXCD, off = wgid / NXCD; wgid = (xcd < r ? xcd * (q + 1) : r * (q + 1) + (xcd - r) * q) + off; }
        const int nig = WGM * nN, gid = wgid / nig, fm = gid * WGM, gsz = (nM - fm) < WGM ? (nM - fm) : WGM;
        u.pm = fm + ((wgid % nig) % gsz); u.pn = (wgid % nig) / gsz; return true;
    }
    __device__ __forceinline__ void a_ready(const Unit&) const {}
    __device__ __forceinline__ void done(const Unit&) const {}
};

typedef __bf16 bf16x2_hw __attribute__((ext_vector_type(2)));
typedef float f32x2_hw __attribute__((ext_vector_type(2)));
__device__ __forceinline__ unsigned cvt_pk_bf16(float lo, float hi) { const f32x2_hw v = {lo, hi}; return __builtin_bit_cast(unsigned, __builtin_convertvector(v, bf16x2_hw)); }
typedef float f32x2 __attribute__((ext_vector_type(2)));
__device__ __forceinline__ f32x2 gelu_pk(f32x2 v) {
    const f32x2 av = __builtin_elementwise_abs(v), d = av * 0.2316418882f + 1.0f;
    f32x2 t; t.x = __builtin_amdgcn_rcpf(d.x); t.y = __builtin_amdgcn_rcpf(d.y);
    f32x2 q = t * 0.5307027145f + (-0.7265760135f); q = q * t + 0.7107068705f; q = q * t + (-0.142248368f); q = q * t + 0.127414796f; q = q * t;
    const f32x2 s = (v * v) * (-0.72134752044f);
    f32x2 e; e.x = __builtin_amdgcn_exp2f(s.x); e.y = __builtin_amdgcn_exp2f(s.y);
    const f32x2 m = v * (q * e), r = v - m;
    f32x2 o; o.x = v.x < 0.f ? m.x : r.x; o.y = v.y < 0.f ? m.y : r.y; return o;
}

template <int ACT  > struct EpiBf16 {
    static constexpr bool PERM = true, AFTER_DRAIN = false; static_assert(ACT == 0 || ACT == 1, "EpiBf16: ACT is 0 (none) or 1 (gelu_pk)");
    bf16_t* O; int ldc; const float* bias; int split_cols; size_t split_stride; float scale0;
    __device__ __forceinline__ void operator()(const f32x4 (&acc)[2][2][4][2], const Unit& u, int wr, int wc, int fr, int fq) const {
        const int row0 = u.pm * BM + wr * 64 + fr; int colt = u.pn * BM; bf16_t* base = O;
        float sc = 1.f; if (split_cols) { const int t = colt / split_cols; base += (size_t)t * split_stride; colt -= t * split_cols; if (t == 0) sc = scale0; }
        const int col0 = colt + wc * 32 + 8 * fq, bcol0 = u.pn * BM + wc * 32 + 8 * fq;
        f32x4 bv[2][2];
#pragma unroll
        for (int bj = 0; bj < 2; ++bj)
#pragma unroll
            for (int n = 0; n < 2; ++n) bv[bj][n] = bias ? *(const f32x4*)(bias + bcol0 + bj * HALF + 4 * n) : (f32x4){0.f, 0.f, 0.f, 0.f};
#pragma unroll
        for (int ai = 0; ai < 2; ++ai)
#pragma unroll
            for (int m = 0; m < 4; ++m) { bf16_t* rowp = base + (size_t)(row0 + ai * HALF + m * 16) * ldc + col0;
#pragma unroll
                for (int bj = 0; bj < 2; ++bj) { f32x4 v0 = acc[ai][bj][m][0] + bv[bj][0], v1 = acc[ai][bj][m][1] + bv[bj][1];
                    if (ACT == 1) { f32x2 a = gelu_pk((f32x2){v0[0], v0[1]}), b = gelu_pk((f32x2){v0[2], v0[3]}), c = gelu_pk((f32x2){v1[0], v1[1]}), d = gelu_pk((f32x2){v1[2], v1[3]});
                        v0 = (f32x4){a.x, a.y, b.x, b.y}; v1 = (f32x4){c.x, c.y, d.x, d.y}; }
                    v0 = v0 * sc; v1 = v1 * sc; u32x4 w; w.x = cvt_pk_bf16(v0[0], v0[1]); w.y = cvt_pk_bf16(v0[2], v0[3]); w.z = cvt_pk_bf16(v1[0], v1[1]); w.w = cvt_pk_bf16(v1[2], v1[3]);
                    *(u32x4*)(rowp + bj * HALF) = w; } }
    }
};

struct PanelStats {
    unsigned* xbuf;
    unsigned* cnt;
    unsigned* tmo;
    int ntn; float eps;
    unsigned code;
    __device__ __forceinline__ bool run(const f32x4 (&v)[2][2][4][2], const Unit& u, int wr, int wc, int fr, int fq, PG8_LAS unsigned char* lds, int wid, int lane) const {
        typedef float f32x2v __attribute__((ext_vector_type(2)));
        PG8_LAS f32x2v* P = (PG8_LAS f32x2v*)lds;
        PG8_LAS f32x2v* S = (PG8_LAS f32x2v*)(lds + 8192);
        PG8_LAS unsigned* flag = (PG8_LAS unsigned*)(lds + 8192 + 2048);
#pragma unroll
        for (int ai = 0; ai < 2; ++ai)
#pragma unroll
            for (int m = 0; m < 4; ++m) {
                float s = 0.f;
#pragma unroll
                for (int bj = 0; bj < 2; ++bj)
#pragma unroll
                    for (int n = 0; n < 2; ++n) { const f32x4 x = v[ai][bj][m][n]; s += (x[0] + x[1]) + (x[2] + x[3]); }
                s += __shfl_xor(s, 16); s += __shfl_xor(s, 32);
                const float mw = s * (1.0f / 64.0f); float q = 0.f;
#pragma unroll
                for (int bj = 0; bj < 2; ++bj)
#pragma unroll
                    for (int n = 0; n < 2; ++n) { const f32x4 d = v[ai][bj][m][n] - mw; q += (d[0] * d[0] + d[1] * d[1]) + (d[2] * d[2] + d[3] * d[3]); }
                q += __shfl_xor(q, 16); q += __shfl_xor(q, 32);
                if (fq == 0) P[(ai * HALF + wr * 64 + m * 16 + fr) * 4 + wc] = (f32x2v){mw, q};
            }
        asm volatile("s_waitcnt lgkmcnt(0)" ::: "memory"); __builtin_amdgcn_s_barrier(); asm volatile("" ::: "memory");
#if defined(BROKEN_EXCHANGE_NO_WAIT)
#warning BROKEN CONTROL BUILD: the row-statistics exchange does not wait; results are wrong by design
        if (blockIdx.x >= 64) { const long long t0_ = clock64(); while (clock64() - t0_ < 60000) __builtin_amdgcn_s_sleep(8); }
#endif
        const int row = wid * 32 + (lane & 31);
        if (lane < 32) {
            const f32x2v a = P[row * 4 + 0], b = P[row * 4 + 1], c = P[row * 4 + 2], d = P[row * 4 + 3];
            const float mt = (a.x + b.x + c.x + d.x) * 0.25f;
            const float da = a.x - mt, db = b.x - mt, dc = c.x - mt, dd = d.x - mt;
            const float m2 = (a.y + b.y) + (c.y + d.y) + 64.0f * ((da * da + db * db) + (dc * dc + dd * dd));
            unsigned long long* slot = (unsigned long long*)xbuf + ((size_t)(u.pm * BM + row) * 4 + u.pn);
            __hip_atomic_store(slot, ((unsigned long long)__float_as_uint(m2) << 32) | __float_as_uint(mt), __ATOMIC_RELAXED, __HIP_MEMORY_SCOPE_AGENT);
        }
        asm volatile("s_waitcnt vmcnt(0)" ::: "memory");
        if (lane == 0) __hip_atomic_fetch_add(cnt + 64 * u.pm, 1u, __ATOMIC_RELAXED, __HIP_MEMORY_SCOPE_AGENT);
        if (wid == 0) {
            bool dead = false; const unsigned long long t0 = __builtin_amdgcn_s_memrealtime(); const unsigned want = 8u * (unsigned)ntn;
            for (;;) {
#if defined(BROKEN_EXCHANGE_NO_WAIT)
                break;
#endif
                if ((unsigned)__builtin_amdgcn_readfirstlane(__hip_atomic_load(cnt + 64 * u.pm, __ATOMIC_RELAXED, __HIP_MEMORY_SCOPE_AGENT)) >= want) break;
                if (__builtin_amdgcn_s_memrealtime() - t0 > 2000000ull) {
                    if (lane == 0) { unsigned expect = 0u; __hip_atomic_compare_exchange_strong(tmo + 1, &expect, code | (unsigned)(u.pm & 0xff), __ATOMIC_RELAXED, __ATOMIC_RELAXED, __HIP_MEMORY_SCOPE_AGENT);
                                     __hip_atomic_store(tmo, 1u, __ATOMIC_RELAXED, __HIP_MEMORY_SCOPE_AGENT); }
                    dead = true; break; }
                __builtin_amdgcn_s_sleep(2);
            }
            __builtin_amdgcn_fence(__ATOMIC_ACQUIRE, "agent");
            if (lane == 0) flag[0] = dead ? 1u : 0u;
        }
        asm volatile("s_waitcnt vmcnt(0) lgkmcnt(0)" ::: "memory"); __builtin_amdgcn_s_barrier(); asm volatile("" ::: "memory");
        const bool bad = flag[0] != 0u;
        if (lane < 32) {
            const unsigned long long* slot = (const unsigned long long*)xbuf + (size_t)(u.pm * BM + row) * 4; float mt[4], m2[4]; float ms = 0.f;
#pragma unroll
            for (int t = 0; t < 4; ++t) { if (t < ntn) { const unsigned long long w = __hip_atomic_load(slot + t, __ATOMIC_RELAXED, __HIP_MEMORY_SCOPE_AGENT); mt[t] = __uint_as_float((unsigned)w); m2[t] = __uint_as_float((unsigned)(w >> 32)); } else { mt[t] = 0.f; m2[t] = 0.f; } ms += mt[t]; }
            const float mean = ms / (float)ntn; float q = 0.f;
#pragma unroll
            for (int t = 0; t < 4; ++t) if (t < ntn) { const float dm = mt[t] - mean; q += m2[t] + 256.0f * dm * dm; }
            S[row] = (f32x2v){mean, 1.0f / sqrtf(q / (256.0f * (float)ntn) + eps)};
        }
        asm volatile("s_waitcnt lgkmcnt(0)" ::: "memory"); __builtin_amdgcn_s_barrier(); asm volatile("" ::: "memory");
        return bad;
    }
};
struct EpiLnRes {
    static constexpr bool PERM = false, AFTER_DRAIN = true;
    const float* base; float* out; int ldc; const float* bias; PanelStats st; unsigned poison;
    __device__ __forceinline__ void fused(f32x4 (&acc)[2][2][4][2], const Unit& u, int wr, int wc, int fr, int fq, PG8_LAS unsigned char* lds, int wid, int lane) const {
        typedef float f32x2v __attribute__((ext_vector_type(2)));
        const PG8_LAS f32x2v* S = (const PG8_LAS f32x2v*)(lds + 8192);
        const int col0 = u.pn * BM + wc * 32 + 4 * fq;
#pragma unroll
        for (int bj = 0; bj < 2; ++bj)
#pragma unroll
            for (int n = 0; n < 2; ++n) { const f32x4 bv = bias ? *(const f32x4*)(bias + col0 + bj * HALF + n * 16) : (f32x4){0.f, 0.f, 0.f, 0.f};
#pragma unroll
                for (int ai = 0; ai < 2; ++ai)
#pragma unroll
                    for (int m = 0; m < 4; ++m) acc[ai][bj][m][n] += bv; }
        f32x4 pre[4][2][2];
#pragma unroll
        for (int m = 0; m < 4; ++m) { const size_t off = (size_t)(u.pm * BM + wr * 64 + m * 16 + fr) * ldc + col0;
#pragma unroll
            for (int bj = 0; bj < 2; ++bj)
#pragma unroll
                for (int n = 0; n < 2; ++n) pre[m][bj][n] = *(const f32x4*)(base + off + bj * HALF + n * 16); }
        const bool bad = st.run(acc, u, wr, wc, fr, fq, lds, wid, lane) || poison != 0u;
        const float qnan = __builtin_nanf("");
#pragma unroll
        for (int ai = 0; ai < 2; ++ai)
#pragma unroll
            for (int m = 0; m < 4; ++m) { const int r = ai * HALF + wr * 64 + m * 16 + fr; const f32x2v sr = S[r]; const size_t off = (size_t)(u.pm * BM + r) * ldc + col0;
#pragma unroll
                for (int bj = 0; bj < 2; ++bj)
#pragma unroll
                    for (int n = 0; n < 2; ++n) { const f32x4 bs = ai == 0 ? pre[m][bj][n] : *(const f32x4*)(base + off + bj * HALF + n * 16); f32x4 o = bs + (acc[ai][bj][m][n] - sr.x) * sr.y;
                        if (bad) o = (f32x4){qnan, qnan, qnan, qnan}; *(f32x4*)(out + off + bj * HALF + n * 16) = o; }
                if (m & 1) asm volatile("" ::: "memory"); }
    }
};
struct EpiLnResLn {
    static constexpr bool PERM = false, AFTER_DRAIN = true;
    const float* base; float* out; bf16_t* xn; int ldc; const float* bias; PanelStats st1, st2; unsigned poison;
    __device__ __forceinline__ void fused(f32x4 (&acc)[2][2][4][2], const Unit& u, int wr, int wc, int fr, int fq, PG8_LAS unsigned char* lds, int wid, int lane) const {
        typedef float f32x2v __attribute__((ext_vector_type(2))); typedef unsigned u32x2v __attribute__((ext_vector_type(2)));
        const PG8_LAS f32x2v* S = (const PG8_LAS f32x2v*)(lds + 8192);
        const int col0 = u.pn * BM + wc * 32 + 4 * fq;
#pragma unroll
        for (int bj = 0; bj < 2; ++bj)
#pragma unroll
            for (int n = 0; n < 2; ++n) { const f32x4 bv = bias ? *(const f32x4*)(bias + col0 + bj * HALF + n * 16) : (f32x4){0.f, 0.f, 0.f, 0.f};
#pragma unroll
                for (int ai = 0; ai < 2; ++ai)
#pragma unroll
                    for (int m = 0; m < 4; ++m) acc[ai][bj][m][n] += bv; }
        bool bad = st1.run(acc, u, wr, wc, fr, fq, lds, wid, lane) || poison != 0u;
        const float qnan = __builtin_nanf("");
#pragma unroll
        for (int ai = 0; ai < 2; ++ai)
#pragma unroll
            for (int m = 0; m < 4; ++m) { const int r = ai * HALF + wr * 64 + m * 16 + fr; const f32x2v sr = S[r]; const size_t off = (size_t)(u.pm * BM + r) * ldc + col0;
#pragma unroll
                for (int bj = 0; bj < 2; ++bj)
#pragma unroll
                    for (int n = 0; n < 2; ++n) { const f32x4 bs = *(const f32x4*)(base + off + bj * HALF + n * 16); acc[ai][bj][m][n] = bs + (acc[ai][bj][m][n] - sr.x) * sr.y; }
                asm volatile("" : "+v"(acc[ai][0][m][0]), "+v"(acc[ai][0][m][1]), "+v"(acc[ai][1][m][0]), "+v"(acc[ai][1][m][1]));
                if (m & 1) asm volatile("" ::: "memory"); }
        const bool bad1 = bad;
        bad = st2.run(acc, u, wr, wc, fr, fq, lds, wid, lane) || bad;
#pragma unroll
        for (int ai = 0; ai < 2; ++ai)
#pragma unroll
            for (int m = 0; m < 4; ++m) { const int r = ai * HALF + wr * 64 + m * 16 + fr; const f32x2v sr = S[r]; const size_t off = (size_t)(u.pm * BM + r) * ldc + col0;
#pragma unroll
                for (int bj = 0; bj < 2; ++bj)
#pragma unroll
                    for (int n = 0; n < 2; ++n) { const f32x4 x1 = acc[ai][bj][m][n]; *(f32x4*)(out + off + bj * HALF + n * 16) = bad1 ? (f32x4){qnan, qnan, qnan, qnan} : x1;
                        const f32x4 o = (x1 - sr.x) * sr.y; u32x2v w; w.x = cvt_pk_bf16(o[0], o[1]); w.y = cvt_pk_bf16(o[2], o[3]);
                        if (bad) { w.x = 0x7fc07fc0u; w.y = 0x7fc07fc0u; } *(u32x2v*)(xn + off + bj * HALF + n * 16) = w; }
                asm volatile("" ::: "memory"); }
    }
};

template <class Epi, class Sched, bool ALIGN_EPI = false, bool SP2 = false>
__device__ __forceinline__ void gemm_phase(PG8_LAS unsigned char* lds, const Gemm g, const Sched& S, const Epi& E) {
    int tid_ = threadIdx.x; asm volatile("" : "+v"(tid_));
    const int tid = tid_, wid = __builtin_amdgcn_readfirstlane(tid >> 6), lane = tid & 63, wr = wid >> 2, wc = wid & 3, fr = lane & 15, fq = lane >> 4;
    const int K = g.K, nt = K / BK;
    unsigned voffA[2], voffB[2];
#pragma unroll
    for (int i = 0; i < 2; ++i) { int R, C; stage_rc(tid * 16 + i * 8192, R, C); const int Rb = Epi::PERM ? ((R & ~31) + perm32(R & 31)) : R;
        voffA[i] = (unsigned)(R * K + C) * 2u; voffB[i] = (unsigned)(Rb * K + C) * 2u; }
    const size_t kstep = (size_t)(BK * 2);
    const size_t hstep = (size_t)HALF * K * 2;
    const size_t tstep = 2 * hstep;
    const unsigned ldsw = (unsigned)wid * 1024u;
    const int aoff = lds_byte(wr * 64 + fr, fq * 8), boff = lds_byte(wc * 32 + fr, fq * 8);
#define PG8_SA(b, h) (((b) * 2 + (h)) * HTB)
#define PG8_SB(b, h) ((4 + (b) * 2 + (h)) * HTB)
#define PG8_STAGE(bufoff, gbase, voff) do { _Pragma("unroll") for (int _i = 0; _i < 2; ++_i) \
        __builtin_amdgcn_global_load_lds((const unsigned*)((const char*)(gbase) + (voff)[_i]), (PG8_LAS unsigned*)(lds + (bufoff) + ldsw + _i * 8192), 16, 0, 0); } while (0)
#define PG8_LDA(dst, b, h) do { _Pragma("unroll") for (int m = 0; m < 4; ++m) _Pragma("unroll") for (int k = 0; k < 2; ++k) dst[m][k] = *(const PG8_LAS bf16x8*)(lds + PG8_SA(b, h) + aoff + m * 2048 + k * 1024); } while (0)
#define PG8_LDB(dst, b, h) do { _Pragma("unroll") for (int n = 0; n < 2; ++n) _Pragma("unroll") for (int k = 0; k < 2; ++k) dst[n][k] = *(const PG8_LAS bf16x8*)(lds + PG8_SB(b, h) + boff + n * 2048 + k * 1024); } while (0)
#define PG8_MMA(ai, bj, At, Bt) do { __builtin_amdgcn_s_setprio(1); _Pragma("unroll") for (int m = 0; m < 4; ++m) _Pragma("unroll") for (int n = 0; n < 2; ++n) _Pragma("unroll") for (int k = 0; k < 2; ++k) \
        acc[ai][bj][m][n] = __builtin_amdgcn_mfma_f32_16x16x32_bf16(Bt[n][k], At[m][k], acc[ai][bj][m][n], 0, 0, 0); __builtin_amdgcn_s_setprio(0); } while (0)
#define PG8_WAIT_V(n) asm volatile("s_waitcnt vmcnt(" #n ")" ::: "memory")
#define PG8_WAIT_L(n) asm volatile("s_waitcnt lgkmcnt(" #n ")" ::: "memory")
#define PG8_BAR __builtin_amdgcn_s_barrier()
#define PG8_SCHED __builtin_amdgcn_sched_barrier(0)
    Unit cur, nxt; int ui = 0;
    if (!S.next(0, cur)) return;
    f32x4 acc[2][2][4][2];
#pragma unroll
    for (int a = 0; a < 2; ++a)
#pragma unroll
        for (int b = 0; b < 2; ++b)
#pragma unroll
            for (int m = 0; m < 4; ++m)
#pragma unroll
                for (int n = 0; n < 2; ++n) acc[a][b][m][n] = (f32x4){0.f, 0.f, 0.f, 0.f};
    bf16x8 At[4][2], B0[2][2], B1[2][2];
    const char* cA = (const char*)g.A + (size_t)cur.pm * tstep; const char* cB = (const char*)g.Bt + (size_t)cur.pn * tstep;
    S.a_ready(cur);
    if constexpr (SP2) {
        PG8_STAGE(PG8_SB(0, 0), cB, voffB); PG8_STAGE(PG8_SB(0, 1), cB + hstep, voffB); PG8_STAGE(PG8_SA(0, 0), cA, voffA); PG8_STAGE(PG8_SA(0, 1), cA + hstep, voffA);
        if (wr == 1) PG8_BAR;
        PG8_WAIT_V(2); PG8_BAR;
        PG8_STAGE(PG8_SB(1, 0), cB + kstep, voffB); PG8_STAGE(PG8_SA(1, 0), cA + kstep, voffA); PG8_STAGE(PG8_SB(1, 1), cB + hstep + kstep, voffB);
        PG8_WAIT_V(6); PG8_BAR;
    } else {
        PG8_STAGE(PG8_SB(0, 0), cB, voffB); PG8_STAGE(PG8_SA(0, 0), cA, voffA); PG8_STAGE(PG8_SB(0, 1), cB + hstep, voffB); PG8_STAGE(PG8_SA(0, 1), cA + hstep, voffA);
        if (wr == 1) PG8_BAR;
        PG8_WAIT_V(4); PG8_BAR;
        PG8_STAGE(PG8_SB(1, 0), cB + kstep, voffB); PG8_STAGE(PG8_SA(1, 0), cA + kstep, voffA); PG8_STAGE(PG8_SB(1, 1), cB + hstep + kstep, voffB);
        PG8_WAIT_V(6); PG8_BAR;
    }
    for (;;) {
        const bool has_next = S.next(ui + 1, nxt);
        const char* nA = has_next ? (const char*)g.A + (size_t)nxt.pm * tstep : cA; const char* nB = has_next ? (const char*)g.Bt + (size_t)nxt.pn * tstep : cB;
        for (int t = 0; t < nt; t += 2) {
            const bool last = (t == nt - 2);
            const char* a1 = cA + (size_t)(t + 1) * kstep;
            const char* a2 = last ? nA : cA + (size_t)(t + 2) * kstep; const char* b2 = last ? nB : cB + (size_t)(t + 2) * kstep;
            const char* a3 = a2 + kstep; const char* b3 = b2 + kstep;
            if (last && has_next) S.a_ready(nxt);
            if constexpr (SP2) {
            PG8_LDB(B0, 0, 0); PG8_LDB(B1, 0, 1); PG8_SCHED; PG8_LDA(At, 0, 0); PG8_STAGE(PG8_SA(1, 1), a1 + hstep, voffA);
            PG8_WAIT_V(8); PG8_WAIT_L(0); PG8_BAR; PG8_MMA(0, 0, At, B0); PG8_MMA(0, 1, At, B1); PG8_BAR; PG8_SCHED;
            PG8_LDA(At, 0, 1); PG8_STAGE(PG8_SB(0, 0), b2, voffB); PG8_STAGE(PG8_SB(0, 1), b2 + hstep, voffB); PG8_STAGE(PG8_SA(0, 0), a2, voffA);
            PG8_WAIT_V(8); PG8_WAIT_L(0); PG8_BAR; PG8_MMA(1, 0, At, B0); PG8_MMA(1, 1, At, B1); PG8_BAR; PG8_SCHED;
            PG8_LDB(B0, 1, 0); PG8_LDB(B1, 1, 1); PG8_SCHED; PG8_LDA(At, 1, 0); PG8_STAGE(PG8_SA(0, 1), a2 + hstep, voffA);
            PG8_WAIT_V(8); PG8_WAIT_L(0); PG8_BAR; PG8_MMA(0, 0, At, B0); PG8_MMA(0, 1, At, B1); PG8_BAR; PG8_SCHED;
            PG8_LDA(At, 1, 1); PG8_STAGE(PG8_SB(1, 0), b3, voffB); PG8_STAGE(PG8_SB(1, 1), b3 + hstep, voffB); PG8_STAGE(PG8_SA(1, 0), a3, voffA);
            PG8_WAIT_V(8); PG8_WAIT_L(0); PG8_BAR; PG8_MMA(1, 0, At, B0); PG8_MMA(1, 1, At, B1); PG8_BAR; PG8_SCHED;
            } else {
            PG8_LDB(B0, 0, 0); PG8_SCHED; PG8_LDA(At, 0, 0); PG8_STAGE(PG8_SA(1, 1), a1 + hstep, voffA);
            PG8_WAIT_L(8); PG8_BAR; PG8_WAIT_L(0); PG8_MMA(0, 0, At, B0); PG8_BAR; PG8_SCHED;
            PG8_LDB(B1, 0, 1); PG8_STAGE(PG8_SB(0, 0), b2, voffB);
            PG8_BAR; PG8_WAIT_L(0); PG8_MMA(0, 1, At, B1); PG8_BAR;
            PG8_LDA(At, 0, 1); PG8_STAGE(PG8_SA(0, 0), a2, voffA);
            PG8_BAR; PG8_WAIT_L(0); PG8_MMA(1, 0, At, B0); PG8_BAR; PG8_SCHED;
            PG8_STAGE(PG8_SB(0, 1), b2 + hstep, voffB);
            PG8_WAIT_V(6); PG8_BAR; PG8_MMA(1, 1, At, B1); PG8_BAR;
            PG8_LDB(B0, 1, 0); PG8_SCHED; PG8_LDA(At, 1, 0); PG8_STAGE(PG8_SA(0, 1), a2 + hstep, voffA);
            PG8_WAIT_L(8); PG8_BAR; PG8_WAIT_L(0); PG8_MMA(0, 0, At, B0); PG8_BAR; PG8_SCHED;
            PG8_LDB(B1, 1, 1); PG8_STAGE(PG8_SB(1, 0), b3, voffB);
            PG8_BAR; PG8_WAIT_L(0); PG8_MMA(0, 1, At, B1); PG8_BAR;
            PG8_LDA(At, 1, 1); PG8_STAGE(PG8_SA(1, 0), a3, voffA);
            PG8_BAR; PG8_WAIT_L(0); PG8_MMA(1, 0, At, B0); PG8_BAR; PG8_SCHED;
            PG8_STAGE(PG8_SB(1, 1), b3 + hstep, voffB);
            PG8_WAIT_V(6); PG8_BAR; PG8_MMA(1, 1, At, B1); PG8_BAR;
            }
        }
        if constexpr (ALIGN_EPI) { if (wr == 0) PG8_BAR; }
        if constexpr (!Epi::AFTER_DRAIN) { E(acc, cur, wr, wc, fr, fq); S.done(cur); }
        if (!has_next) break;
#pragma unroll
        for (int a = 0; a < 2; ++a)
#pragma unroll
            for (int b = 0; b < 2; ++b)
#pragma unroll
                for (int m = 0; m < 4; ++m)
#pragma unroll
                    for (int n = 0; n < 2; ++n) acc[a][b][m][n] = (f32x4){0.f, 0.f, 0.f, 0.f};
        cur = nxt; cA = nA; cB = nB; ++ui;
        if constexpr (ALIGN_EPI) { if (wr == 1) PG8_BAR; }
    }
    PG8_WAIT_V(0);
    if constexpr (!ALIGN_EPI) { if (wr == 0) PG8_BAR; }
    PG8_BAR;
    if constexpr (Epi::AFTER_DRAIN) { E.fused(acc, cur, wr, wc, fr, fq, lds, wid, lane); S.done(cur); }
#undef PG8_SA
#undef PG8_SB
#undef PG8_STAGE
#undef PG8_LDA
#undef PG8_LDB
#undef PG8_MMA
#undef PG8_WAIT_V
#undef PG8_WAIT_L
#undef PG8_BAR
#undef PG8_SCHED
}
}

#define LAS __attribute__((address_space(3)))
typedef unsigned short bf16;
typedef float f32x4 __attribute__((ext_vector_type(4)));
typedef float f32x2 __attribute__((ext_vector_type(2)));
typedef short bf16x8 __attribute__((ext_vector_type(8)));
typedef short s16x4 __attribute__((ext_vector_type(4)));
typedef short v4i16_t __attribute__((ext_vector_type(4)));
typedef unsigned u32x4 __attribute__((ext_vector_type(4)));
typedef unsigned u32x2 __attribute__((ext_vector_type(2)));

constexpr int NWAVES = 8, NTHREADS = 512;
constexpr int DM = 1024, SEQ = 4096, NBATCH = 4, MP = NBATCH * SEQ, NSMP = 32, MV = MP + NSMP, MT = 16640;
constexpr int DIN = 7680, QKV = 1536, DFF = 2816, NADA = 6144;
constexpr size_t O_YP = 0, O_YS = 16777216, O_KV0P = 16809984, O_KV1P = 17858560, O_KV2P = 22052864,
                 O_KV0S = 38830080, O_KV1S = 38895616, O_KV2S = 38961152, O_SV = 39026688, O_END = 39059456;
constexpr float LOG2E = 1.4426950408889634f;
constexpr float QSCALE = 0.08838834764831845f * LOG2E;

constexpr size_t MiB = 1u << 20;
constexpr size_t alm(size_t x) { return (x + MiB - 1) / MiB * MiB; }
constexpr size_t WS_WADA = 1 * MiB;
constexpr size_t WS_WL0 = WS_WADA + alm(2ull * NADA * DM * 2);
constexpr size_t WL_WIN = 0;
constexpr size_t WL_WPA = WL_WIN + alm((size_t)DIN * DM * 2);
constexpr size_t WL_WPS = WL_WPA + alm(1024ull * 512 * 2);
constexpr size_t WL_WOUT = WL_WPS + alm(1024ull * 512 * 2);
constexpr size_t WL_WFI = WL_WOUT + alm(1024ull * 1024 * 2);
constexpr size_t WL_WFO = WL_WFI + alm(5632ull * 1024 * 2);
constexpr size_t WL_WSP = WL_WFO + alm(1024ull * DFF * 2);
constexpr size_t WL_SIZE = WL_WSP + alm(8ull * 128 * 128 * 2);
constexpr size_t WS_MOD = WS_WL0 + 2 * WL_SIZE;
constexpr size_t WS_SC = WS_MOD + alm(2ull * 36 * NADA * 4);
constexpr size_t WS_XN = WS_SC + alm(256ull * DM * 2);
constexpr size_t WS_Q = WS_XN + alm((size_t)MT * DM * 2);
constexpr size_t WS_K = WS_Q + alm((size_t)MT * QKV * 2);
constexpr size_t WS_V = WS_K + alm((size_t)MT * QKV * 2);
constexpr size_t WS_U = WS_V + alm((size_t)MT * QKV * 2);
constexpr size_t WS_VS = WS_U + alm((size_t)MT * 512 * 2);
constexpr size_t WS_G = WS_VS + alm((size_t)MT * 512 * 2);
constexpr size_t WS_OG = WS_G + alm((size_t)MT * 2048 * 2);
constexpr size_t WS_DG = WS_OG + alm((size_t)MT * QKV * 2);
constexpr size_t WS_YA = WS_DG + alm((size_t)MT * 12 * 4);
constexpr size_t WS_YS = WS_YA + alm((size_t)MT * 512 * 2);
constexpr size_t WS_T1 = WS_YS + alm((size_t)MT * 512 * 2);
constexpr size_t WS_MG = WS_T1 + alm((size_t)MT * DM * 4);
constexpr size_t WS_X1 = WS_MG + alm((size_t)MT * DM * 2);
constexpr size_t WS_X2 = WS_X1 + alm((size_t)MT * DM * 4);
constexpr size_t WS_H = WS_X2 + alm((size_t)MT * DM * 4);
constexpr size_t WS_END = WS_H + alm((size_t)MT * DFF * 2);

constexpr int LDS_RING = 0, LDS_EXCH = 131072, LDS_BYTES = 155648;

__device__ __forceinline__ float bf2f(unsigned short h) { return __uint_as_float((unsigned)h << 16); }
__device__ __forceinline__ unsigned pk2(float lo, float hi) { return pg8::cvt_pk_bf16(lo, hi); }
__device__ __forceinline__ float fast_exp2(float x) { return __builtin_amdgcn_exp2f(x); }
__device__ __forceinline__ float sigmoidf_(float x) { return __builtin_amdgcn_rcpf(1.0f + fast_exp2(-x * LOG2E)); }
__device__ __forceinline__ float wave_sum(float v) {
#pragma unroll
    for (int o = 1; o < 64; o <<= 1) v += __shfl_xor(v, o);
    return v;
}
__device__ __forceinline__ float wave_max(float v) {
#pragma unroll
    for (int o = 1; o < 64; o <<= 1) v = fmaxf(v, __shfl_xor(v, o));
    return v;
}
__device__ __forceinline__ s16x4 vtr(const LAS unsigned char* p) { return __builtin_bit_cast(s16x4, __builtin_amdgcn_ds_read_tr16_b64_v4i16((LAS v4i16_t*)p)); }
#define LDS_WAIT() asm volatile("s_waitcnt lgkmcnt(0)" ::: "memory")

__device__ __forceinline__ int mod_row(int row) { return row < MP ? (row >> 12) : 4 + (row - MP); }

__device__ __forceinline__ __attribute__((address_space(1))) float* kv_out_ptr(__attribute__((address_space(1))) float* out, int layer, int g, int row, int kvi, int hh) {
    if (row < MP) {
        const int b = row >> 12, t = row & 4095, lw = 128 << (2 * g), tt = t - (SEQ - lw);
        if (tt < 0) return nullptr;
        const size_t base = g == 0 ? O_KV0P : (g == 1 ? O_KV1P : O_KV2P);
        return out + base + ((((size_t)(layer * NBATCH + b) * lw + tt) * 2 + kvi) * 4 + hh) * 128;
    } else if (row < MV) {
        const int b = row - MP;
        const size_t base = g == 0 ? O_KV0S : (g == 1 ? O_KV1S : O_KV2S);
        return out + base + (((size_t)(layer * NSMP + b) * 2 + kvi) * 4 + hh) * 128;
    }
    return nullptr;
}

using pg8::Unit;
typedef pg8::f32x4 (AccT)[2][2][4][2];

__device__ __forceinline__ void st8_bf16g(__attribute__((address_space(1))) bf16* p, f32x4 v0, f32x4 v1) {
    u32x4 w; w.x = pk2(v0[0], v0[1]); w.y = pk2(v0[2], v0[3]); w.z = pk2(v1[0], v1[1]); w.w = pk2(v1[2], v1[3]);
    *(__attribute__((address_space(1))) u32x4*)p = w;
}
__device__ __forceinline__ void st8_bf16(bf16* p, f32x4 v0, f32x4 v1) {
    u32x4 w; w.x = pk2(v0[0], v0[1]); w.y = pk2(v0[2], v0[3]); w.z = pk2(v1[0], v1[1]); w.w = pk2(v1[2], v1[3]);
    *(u32x4*)p = w;
}

#define LAUNDER_S(x) asm volatile("" : "+s"(x))
#define GP(T, p) ((T*)(__attribute__((address_space(1))) T*)(p))
struct EpiAda {
    static constexpr bool PERM = true, AFTER_DRAIN = false;
    float* MOD; const float* b_ada;
    __device__ __forceinline__ void operator()(const pg8::f32x4 (&acc)[2][2][4][2], const Unit& u, int wr, int wc, int fr_, int fq_) const {
        int fr = fr_, fq = fq_; asm volatile("" : "+v"(fr), "+v"(fq));
        if (u.pm != 0 || wr != 0) return;
#pragma unroll
        for (int m = 0; m < 3; ++m) {
            const int row = m * 16 + fr;
            if (row >= 36) continue;
#pragma unroll
            for (int bj = 0; bj < 2; ++bj) {
                const int col = u.pn * 256 + bj * 128 + wc * 32 + 8 * fq;
                const int layer = col / NADA, c = col - layer * NADA;
                const float* bp = b_ada + (size_t)layer * NADA + c;
                float* op = MOD + ((size_t)layer * 36 + row) * NADA + c;
                *(f32x4*)op = acc[0][bj][m][0] + *(const f32x4*)bp;
                *(f32x4*)(op + 4) = acc[0][bj][m][1] + *(const f32x4*)(bp + 4);
            }
        }
    }
};

struct EpiIn {
    static constexpr bool PERM = true, AFTER_DRAIN = false;
    unsigned char* wsb; const float* qw; const float* kw; float* out; int layer; LAS float* P;
    __device__ __forceinline__ void operator()(const pg8::f32x4 (&acc)[2][2][4][2], const Unit& u, int wr, int wc, int fr_, int fq_) const {
        int fr = fr_, fq = fq_; asm volatile("" : "+v"(fr), "+v"(fq));
        unsigned char* wsl = wsb; const float* qwl = qw; const float* kwl = kw; float* outl = out; LAUNDER_S(wsl); LAUNDER_S(qwl); LAUNDER_S(kwl); LAUNDER_S(outl);
        typedef __attribute__((address_space(1))) bf16 gbf; typedef __attribute__((address_space(1))) float gfl;
        gbf *Q = (gbf*)(wsl + WS_Q), *K = (gbf*)(wsl + WS_K), *V = (gbf*)(wsl + WS_V), *U = (gbf*)(wsl + WS_U), *VS = (gbf*)(wsl + WS_VS), *G = (gbf*)(wsl + WS_G);
        gfl* outg = (gfl*)outl;
        const int pn = u.pn;
        const int cw = wc * 32 + 8 * fq;
        const int rowb = u.pm * 256 + wr * 64 + fr;
        if (pn < 12) {
            const bool isk = pn >= 6;
#pragma unroll
            for (int ai = 0; ai < 2; ++ai)
#pragma unroll
                for (int m = 0; m < 4; ++m)
#pragma unroll
                    for (int bj = 0; bj < 2; ++bj) {
                        const pg8::f32x4 a = acc[ai][bj][m][0], b = acc[ai][bj][m][1];
                        float s = (a[0] * a[0] + a[1] * a[1]) + (a[2] * a[2] + a[3] * a[3]) + (b[0] * b[0] + b[1] * b[1]) + (b[2] * b[2] + b[3] * b[3]);
                        s += __shfl_xor(s, 16); s += __shfl_xor(s, 32);
                        if (fq == 0) P[(ai * 128 + wr * 64 + m * 16 + fr) * 8 + bj * 4 + wc] = s;
                    }
            asm volatile("s_waitcnt lgkmcnt(0)" ::: "memory"); __builtin_amdgcn_s_barrier(); asm volatile("" ::: "memory");
#pragma unroll
            for (int bj = 0; bj < 2; ++bj) {
                const int head = 2 * (isk ? pn - 6 : pn) + bj, g = head >> 2, hh = head & 3;
                const __attribute__((address_space(1))) float* wv = (const __attribute__((address_space(1))) float*)(isk ? kwl : qwl) + g * 128 + cw;
                pg8::f32x4 w0 = *(const __attribute__((address_space(1))) f32x4*)wv, w1 = *(const __attribute__((address_space(1))) f32x4*)(wv + 4);
                if (!isk) { w0 = w0 * QSCALE; w1 = w1 * QSCALE; }
                gbf* dst = (isk ? K : Q) + head * 128 + cw;
#pragma unroll
                for (int ai = 0; ai < 2; ++ai)
#pragma unroll
                    for (int m = 0; m < 4; ++m) {
                        const int rl = ai * 128 + wr * 64 + m * 16 + fr, row = u.pm * 256 + rl;
                        const f32x4 pv = *(const LAS f32x4*)(P + rl * 8 + bj * 4);
                        const float rstd = 1.0f / sqrtf(((pv[0] + pv[1]) + (pv[2] + pv[3])) * (1.0f / 128.0f) + 1e-6f);
                        const pg8::f32x4 v0 = acc[ai][bj][m][0] * rstd * w0, v1 = acc[ai][bj][m][1] * rstd * w1;
                        st8_bf16g(dst + (size_t)row * QKV, v0, v1);
                        if (isk) { gfl* o = kv_out_ptr(outg, layer, g, row, 0, hh); if (o) { *(__attribute__((address_space(1))) f32x4*)(o + cw) = v0; *(__attribute__((address_space(1))) f32x4*)(o + cw + 4) = v1; } }
                    }
            }
        } else if (pn < 18) {
#pragma unroll
            for (int bj = 0; bj < 2; ++bj) {
                const int head = 2 * (pn - 12) + bj, g = head >> 2, hh = head & 3;
                gbf* dst = V + head * 128 + cw;
#pragma unroll
                for (int ai = 0; ai < 2; ++ai)
#pragma unroll
                    for (int m = 0; m < 4; ++m) {
                        const int row = rowb + ai * 128 + m * 16;
                        const pg8::f32x4 v0 = acc[ai][bj][m][0], v1 = acc[ai][bj][m][1];
                        st8_bf16g(dst + (size_t)row * QKV, v0, v1);
                        gfl* o = kv_out_ptr(outg, layer, g, row, 1, hh); if (o) { *(__attribute__((address_space(1))) f32x4*)(o + cw) = v0; *(__attribute__((address_space(1))) f32x4*)(o + cw + 4) = v1; }
                    }
            }
        } else if (pn < 22) {
            gbf* base = (pn < 20 ? U : VS) + ((pn - 18) & 1) * 256 + cw;
#pragma unroll
            for (int bj = 0; bj < 2; ++bj)
#pragma unroll
                for (int ai = 0; ai < 2; ++ai)
#pragma unroll
                    for (int m = 0; m < 4; ++m) {
                        const int row = rowb + ai * 128 + m * 16;
                        const pg8::f32x4 v0 = acc[ai][bj][m][0], v1 = acc[ai][bj][m][1];
                        const pg8::f32x2 a = pg8::gelu_pk((pg8::f32x2){v0[0], v0[1]}), b = pg8::gelu_pk((pg8::f32x2){v0[2], v0[3]}),
                                         c = pg8::gelu_pk((pg8::f32x2){v1[0], v1[1]}), d = pg8::gelu_pk((pg8::f32x2){v1[2], v1[3]});
                        st8_bf16g(base + (size_t)row * 512 + bj * 128, (f32x4){a.x, a.y, b.x, b.y}, (f32x4){c.x, c.y, d.x, d.y});
                    }
        } else {
            gbf* base = G + (pn - 22) * 256 + cw;
#pragma unroll
            for (int bj = 0; bj < 2; ++bj)
#pragma unroll
                for (int ai = 0; ai < 2; ++ai)
#pragma unroll
                    for (int m = 0; m < 4; ++m) {
                        const int row = rowb + ai * 128 + m * 16;
                        const pg8::f32x4 v0 = acc[ai][bj][m][0], v1 = acc[ai][bj][m][1];
                        st8_bf16g(base + (size_t)row * 2048 + bj * 128,
                                 (f32x4){sigmoidf_(v0[0]), sigmoidf_(v0[1]), sigmoidf_(v0[2]), sigmoidf_(v0[3])},
                                 (f32x4){sigmoidf_(v1[0]), sigmoidf_(v1[1]), sigmoidf_(v1[2]), sigmoidf_(v1[3])});
                    }
        }
    }
};

struct EpiGate1 {
    static constexpr bool PERM = true, AFTER_DRAIN = false;
    const bf16* G; float* T1;
    __device__ __forceinline__ void operator()(const pg8::f32x4 (&acc)[2][2][4][2], const Unit& u, int wr, int wc, int fr_, int fq_) const {
        int fr = fr_, fq = fq_; asm volatile("" : "+v"(fr), "+v"(fq));
        const int col0 = u.pn * 256 + wc * 32 + 8 * fq, rowb = u.pm * 256 + wr * 64 + fr;
#pragma unroll
        for (int ai = 0; ai < 2; ++ai)
#pragma unroll
            for (int m = 0; m < 4; ++m) {
                const int row = rowb + ai * 128 + m * 16;
#pragma unroll
                for (int bj = 0; bj < 2; ++bj) {
                    const int col = col0 + bj * 128;
                    const u32x4 gv = *(const u32x4*)(G + (size_t)row * 2048 + col);
                    const f32x4 g0 = {__uint_as_float(gv.x << 16), __uint_as_float(gv.x & 0xffff0000u), __uint_as_float(gv.y << 16), __uint_as_float(gv.y & 0xffff0000u)};
                    const f32x4 g1 = {__uint_as_float(gv.z << 16), __uint_as_float(gv.z & 0xffff0000u), __uint_as_float(gv.w << 16), __uint_as_float(gv.w & 0xffff0000u)};
                    float* o = T1 + (size_t)row * DM + col;
                    *(f32x4*)o = g0 * acc[ai][bj][m][0]; *(f32x4*)(o + 4) = g1 * acc[ai][bj][m][1];
                }
            }
    }
};
struct EpiGate2 {
    static constexpr bool PERM = true, AFTER_DRAIN = false;
    const bf16* G; const float* T1; bf16* MG;
    __device__ __forceinline__ void operator()(const pg8::f32x4 (&acc)[2][2][4][2], const Unit& u, int wr, int wc, int fr_, int fq_) const {
        int fr = fr_, fq = fq_; asm volatile("" : "+v"(fr), "+v"(fq));
        const int col0 = u.pn * 256 + wc * 32 + 8 * fq, rowb = u.pm * 256 + wr * 64 + fr;
#pragma unroll
        for (int ai = 0; ai < 2; ++ai)
#pragma unroll
            for (int m = 0; m < 4; ++m) {
                const int row = rowb + ai * 128 + m * 16;
#pragma unroll
                for (int bj = 0; bj < 2; ++bj) {
                    const int col = col0 + bj * 128;
                    const u32x4 gv = *(const u32x4*)(G + (size_t)row * 2048 + 1024 + col);
                    const f32x4 g0 = {__uint_as_float(gv.x << 16), __uint_as_float(gv.x & 0xffff0000u), __uint_as_float(gv.y << 16), __uint_as_float(gv.y & 0xffff0000u)};
                    const f32x4 g1 = {__uint_as_float(gv.z << 16), __uint_as_float(gv.z & 0xffff0000u), __uint_as_float(gv.w << 16), __uint_as_float(gv.w & 0xffff0000u)};
                    const float* t = T1 + (size_t)row * DM + col;
                    const f32x4 t0 = *(const f32x4*)t, t1 = *(const f32x4*)(t + 4);
                    st8_bf16(MG + (size_t)row * DM + col, t0 + g0 * acc[ai][bj][m][0], t1 + g1 * acc[ai][bj][m][1]);
                }
            }
    }
};
struct EpiRes {
    static constexpr bool PERM = true, AFTER_DRAIN = false;
    const float* bp; const float* bs; float* op; float* os; const float* gate;
    __device__ __forceinline__ void operator()(const pg8::f32x4 (&acc)[2][2][4][2], const Unit& u, int wr, int wc, int fr_, int fq_) const {
        int fr = fr_, fq = fq_; asm volatile("" : "+v"(fr), "+v"(fq));
        const int col0 = u.pn * 256 + wc * 32 + 8 * fq, rowb = u.pm * 256 + wr * 64 + fr;
#pragma unroll
        for (int ai = 0; ai < 2; ++ai)
#pragma unroll
            for (int m = 0; m < 4; ++m) {
                const int row = rowb + ai * 128 + m * 16;
                if (row < MV) {
                    const float* b = row < MP ? bp + (size_t)row * DM : bs + (size_t)(row - MP) * DM;
                    float* o = row < MP ? op + (size_t)row * DM : os + (size_t)(row - MP) * DM;
                    const float* gt = gate + (size_t)mod_row(row) * NADA;
#pragma unroll
                    for (int bj = 0; bj < 2; ++bj) {
                        const int col = col0 + bj * 128;
                        const f32x4 b0 = *(const f32x4*)(b + col), b1 = *(const f32x4*)(b + col + 4);
                        const f32x4 g0 = *(const f32x4*)(gt + col), g1 = *(const f32x4*)(gt + col + 4);
                        *(f32x4*)(o + col) = b0 + g0 * acc[ai][bj][m][0]; *(f32x4*)(o + col + 4) = b1 + g1 * acc[ai][bj][m][1];
                    }
                }
            }
    }
};
struct EpiSwiglu {
    static constexpr bool PERM = true, AFTER_DRAIN = false;
    bf16* H;
    __device__ __forceinline__ void operator()(const pg8::f32x4 (&acc)[2][2][4][2], const Unit& u, int wr, int wc, int fr_, int fq_) const {
        int fr = fr_, fq = fq_; asm volatile("" : "+v"(fr), "+v"(fq));
        const int col = u.pn * 128 + wc * 32 + 8 * fq, rowb = u.pm * 256 + wr * 64 + fr;
#pragma unroll
        for (int ai = 0; ai < 2; ++ai)
#pragma unroll
            for (int m = 0; m < 4; ++m) {
                const int row = rowb + ai * 128 + m * 16;
                f32x4 r0, r1;
#pragma unroll
                for (int e = 0; e < 4; ++e) {
                    const float a0 = acc[ai][0][m][0][e], a1 = acc[ai][0][m][1][e];
                    r0[e] = a0 * sigmoidf_(a0) * acc[ai][1][m][0][e];
                    r1[e] = a1 * sigmoidf_(a1) * acc[ai][1][m][1][e];
                }
                st8_bf16(H + (size_t)row * DFF + col, r0, r1);
            }
    }
};

__device__ __forceinline__ void transpose_item(const float* W, int K, int N, bf16* WT, int mode, LAS float* scr, int item, int lane) {
    const int nblk = N / 32, kb = item / nblk, nb = item % nblk, k0 = 64 * kb, n0 = 32 * nb;
#pragma unroll 8
    for (int i = 0; i < 32; ++i) { const int kk = 2 * i + (lane >> 5); scr[kk * 33 + (lane & 31)] = W[(size_t)(k0 + kk) * N + n0 + (lane & 31)]; }
    LDS_WAIT(); asm volatile("" ::: "memory");
    int drow0 = n0;
    if (mode == 1) { const int bj = n0 >= DFF ? 1 : 0; const int j0 = n0 - bj * DFF; drow0 = (j0 >> 7) * 256 + bj * 128 + (j0 & 127); }
    const int c = lane & 7;
#pragma unroll
    for (int j = 0; j < 4; ++j) { const int n = (lane >> 3) + 8 * j; const LAS float* s = scr + (8 * c) * 33 + n;
        u32x4 o; o.x = pk2(s[0 * 33], s[1 * 33]); o.y = pk2(s[2 * 33], s[3 * 33]); o.z = pk2(s[4 * 33], s[5 * 33]); o.w = pk2(s[6 * 33], s[7 * 33]);
        *(u32x4*)(WT + (size_t)(drow0 + n) * K + k0 + 8 * c) = o; }
    LDS_WAIT(); asm volatile("" ::: "memory");
}

__device__ __forceinline__ void norm_mod_phase(const float* xp, const float* xs, const float* nw, const float* modl, int sh_off, bf16* XN, int gw, int NGW, int lane) {
    for (int row = gw; row < MT; row += NGW) {
        unsigned long long* o8 = (unsigned long long*)(XN + (size_t)row * DM) + lane;
        if (row >= MV) {
#pragma unroll
            for (int j = 0; j < 4; ++j) o8[64 * j] = 0ull;
            continue;
        }
        const float* xrow = row < MP ? xp + (size_t)row * DM : xs + (size_t)(row - MP) * DM;
        const f32x4* xr = (const f32x4*)xrow + lane;
        f32x4 v[4]; float s = 0.f;
#pragma unroll
        for (int j = 0; j < 4; ++j) { v[j] = xr[64 * j]; s += (v[j].x * v[j].x + v[j].y * v[j].y) + (v[j].z * v[j].z + v[j].w * v[j].w); }
        const float rstd = 1.0f / sqrtf(wave_sum(s) * (1.0f / DM) + 1e-6f);
        const float* mr = modl + (size_t)mod_row(row) * NADA + sh_off;
#pragma unroll
        for (int j = 0; j < 4; ++j) {
            const int col = 4 * lane + 256 * j;
            const f32x4 w = *(const f32x4*)(nw + col), shv = *(const f32x4*)(mr + col), scv = *(const f32x4*)(mr + 1024 + col);
            const f32x4 y = v[j] * rstd * w * (scv + 1.0f) + shv;
            o8[64 * j] = (unsigned long long)pk2(y.x, y.y) | ((unsigned long long)pk2(y.z, y.w) << 32);
        }
    }
}

constexpr int KV_STRIDE = 272;
constexpr int ATT_K_OFF = 0, ATT_V_OFF = 256 * KV_STRIDE;
__device__ __forceinline__ float alibi_slope(int head12) { return exp2f(-8.0f * (float)(head12 + 1) / 12.0f); }

__device__ __forceinline__ void attn_unit(LAS unsigned char* lds, const bf16* Q, const bf16* K, const bf16* V, bf16* OG, float* DG, int unit, float cshift, int wid, int lane, int tid) {
    const int g = unit >> 9, r9 = unit & 511, sh = 2 * g, d = 1 << sh, nb = 32 >> sh;
    const int qb = r9 % nb; int t2 = r9 / nb; const int r = t2 % d; t2 /= d; const int h = t2 & 3, b = t2 >> 2;
    const int hc = (g * 4 + h) * 128;
    {
        const int ch = tid & 15, r0 = tid >> 4;
        u32x4 kv[8], vv[8];
#pragma unroll
        for (int it = 0; it < 8; ++it) {
            const int j = r0 + 32 * it, mk = 128 * qb - 128 + j;
            if (qb > 0 || it >= 4) {
                const size_t off = ((size_t)b * SEQ + (size_t)mk * d + r) * QKV + hc + ch * 8;
                kv[it] = *(const u32x4*)(K + off); vv[it] = *(const u32x4*)(V + off);
            } else { kv[it] = (u32x4){0u, 0u, 0u, 0u}; vv[it] = (u32x4){0u, 0u, 0u, 0u}; }
        }
#pragma unroll
        for (int it = 0; it < 8; ++it) {
            const int j = r0 + 32 * it;
            *(LAS u32x4*)(lds + ATT_K_OFF + j * KV_STRIDE + ch * 16) = kv[it];
            *(LAS u32x4*)(lds + ATT_V_OFF + j * KV_STRIDE + ch * 16) = vv[it];
        }
    }
    const int ql = lane & 15, gq = lane >> 4;
    const int qi = 16 * wid + ql;
    const size_t qrow = (size_t)b * SEQ + (size_t)(128 * qb + qi) * d + r;
    bf16x8 qf[4];
#pragma unroll
    for (int kk = 0; kk < 4; ++kk) qf[kk] = *(const bf16x8*)(Q + qrow * QKV + hc + 32 * kk + 8 * gq);
    const float slope2 = alibi_slope(g * 4 + h) * LOG2E * (float)d;
    __syncthreads();
    f32x4 accO[8];
#pragma unroll
    for (int dt = 0; dt < 8; ++dt) accO[dt] = (f32x4){0.f, 0.f, 0.f, 0.f};
    float dsum = 0.f;
    const LAS unsigned char* kbase = lds + ATT_K_OFF + (16 * wid + ql) * KV_STRIDE + gq * 16;
    const LAS unsigned char* vbase = lds + ATT_V_OFF + (16 * wid + 4 * gq + (ql >> 2)) * KV_STRIDE + (ql & 3) * 8;
#pragma unroll
    for (int kt2 = 0; kt2 < 5; ++kt2) {
        const int ja = 16 * wid + 32 * kt2;
        f32x4 sa = {0.f, 0.f, 0.f, 0.f}, sb = {0.f, 0.f, 0.f, 0.f};
#pragma unroll
        for (int kk = 0; kk < 4; ++kk) {
            const bf16x8 ka = *(const LAS bf16x8*)(kbase + (32 * kt2) * KV_STRIDE + kk * 64);
            sa = __builtin_amdgcn_mfma_f32_16x16x32_bf16(ka, qf[kk], sa, 0, 0, 0);
        }
        if (kt2 < 4) {
#pragma unroll
            for (int kk = 0; kk < 4; ++kk) {
                const bf16x8 kb = *(const LAS bf16x8*)(kbase + (32 * kt2 + 16) * KV_STRIDE + kk * 64);
                sb = __builtin_amdgcn_mfma_f32_16x16x32_bf16(kb, qf[kk], sb, 0, 0, 0);
            }
        }
        float pa[4], pb[4];
#pragma unroll
        for (int jj = 0; jj < 4; ++jj) {
            const int j = ja + 4 * gq + jj, dist = 128 + qi - j;
            const bool ok = dist >= 0 && dist <= 128 && (128 * qb - 128 + j) >= 0;
            pa[jj] = ok ? fast_exp2(sa[jj] - slope2 * (float)dist - cshift) : 0.f;
            const int j2 = j + 16, dist2 = dist - 16;
            const bool ok2 = (kt2 < 4) && dist2 >= 0 && dist2 <= 128 && (128 * qb - 128 + j2) >= 0;
            pb[jj] = ok2 ? fast_exp2(sb[jj] - slope2 * (float)dist2 - cshift) : 0.f;
            dsum += pa[jj] + pb[jj];
        }
        u32x4 pw; pw.x = pk2(pa[0], pa[1]); pw.y = pk2(pa[2], pa[3]); pw.z = pk2(pb[0], pb[1]); pw.w = pk2(pb[2], pb[3]);
        const bf16x8 pfrag = __builtin_bit_cast(bf16x8, pw);
        const int rb = (kt2 < 4) ? (32 * kt2 + 16) : (32 * kt2);
#pragma unroll
        for (int dt = 0; dt < 8; ++dt) {
            const s16x4 lo = vtr(vbase + (32 * kt2) * KV_STRIDE + dt * 32);
            const s16x4 hi = vtr(vbase + rb * KV_STRIDE + dt * 32);
            const bf16x8 vf = {lo[0], lo[1], lo[2], lo[3], hi[0], hi[1], hi[2], hi[3]};
            accO[dt] = __builtin_amdgcn_mfma_f32_16x16x32_bf16(vf, pfrag, accO[dt], 0, 0, 0);
        }
    }
    dsum += __shfl_xor(dsum, 16); dsum += __shfl_xor(dsum, 32);
    const float inv = 1.0f / dsum;
    bf16* op = OG + qrow * QKV + g * 512 + h * 128 + 4 * gq;
#pragma unroll
    for (int dt = 0; dt < 8; ++dt) {
        u32x2 w; w.x = pk2(accO[dt][0] * inv, accO[dt][1] * inv); w.y = pk2(accO[dt][2] * inv, accO[dt][3] * inv);
        *(u32x2*)(op + dt * 16) = w;
    }
    if (gq == 0) DG[qrow * 12 + g * 4 + h] = dsum;
    __syncthreads();
}

__device__ __forceinline__ void attn_sample_item(LAS unsigned char* lds, const bf16* Q, const bf16* K, const bf16* V, const float* c0, const float* c1, const float* c2, int layer, bf16* YA, int item, int wid, int lane) {
    const int b = item >> 2, h = item & 3;
    LAS float* sc = (LAS float*)lds;
    LAS float* part = (LAS float*)(lds + 2048);
    const size_t row = (size_t)MP + b;
    float q0[3], q1[3];
#pragma unroll
    for (int g = 0; g < 3; ++g) { const unsigned qq = *(const unsigned*)(Q + row * QKV + (g * 4 + h) * 128 + 2 * lane); q0[g] = __uint_as_float(qq << 16); q1[g] = __uint_as_float(qq & 0xffff0000u); }
    for (int j = wid; j < 387; j += 8) {
        const int g = j / 129, step = j - g * 129, d = 1 << (2 * g), lc = 128 << (2 * g);
        float k0, k1;
        if (step == 0) { const unsigned kk = *(const unsigned*)(K + row * QKV + (g * 4 + h) * 128 + 2 * lane); k0 = __uint_as_float(kk << 16); k1 = __uint_as_float(kk & 0xffff0000u); }
        else { const float* cp = (g == 0 ? c0 : (g == 1 ? c1 : c2)) + ((((size_t)(layer * NSMP + b) * lc + (lc - d * step)) * 2 + 0) * 4 + h) * 128 + 2 * lane; const f32x2 kv = *(const f32x2*)cp; k0 = kv.x; k1 = kv.y; }
        const float qa = g == 0 ? q0[0] : (g == 1 ? q0[1] : q0[2]), qb = g == 0 ? q1[0] : (g == 1 ? q1[1] : q1[2]);
        float s = wave_sum(qa * k0 + qb * k1);
        s -= alibi_slope(g * 4 + h) * LOG2E * (float)(d * step);
        if (lane == 0) sc[j] = s;
    }
    LDS_WAIT(); __syncthreads();
    float mx = -3.0e38f;
    for (int j = lane; j < 387; j += 64) mx = fmaxf(mx, sc[j]);
    mx = wave_max(mx);
    float den = 0.f;
    for (int j = lane; j < 387; j += 64) den += fast_exp2(sc[j] - mx);
    den = wave_sum(den);
    float n0 = 0.f, n1 = 0.f;
    for (int j = wid; j < 387; j += 8) {
        const int g = j / 129, step = j - g * 129, d = 1 << (2 * g), lc = 128 << (2 * g);
        float v0, v1;
        if (step == 0) { const unsigned vv = *(const unsigned*)(V + row * QKV + (g * 4 + h) * 128 + 2 * lane); v0 = __uint_as_float(vv << 16); v1 = __uint_as_float(vv & 0xffff0000u); }
        else { const float* cp = (g == 0 ? c0 : (g == 1 ? c1 : c2)) + ((((size_t)(layer * NSMP + b) * lc + (lc - d * step)) * 2 + 1) * 4 + h) * 128 + 2 * lane; const f32x2 vv = *(const f32x2*)cp; v0 = vv.x; v1 = vv.y; }
        const float p = fast_exp2(sc[j] - mx);
        n0 += p * v0; n1 += p * v1;
    }
    part[wid * 128 + 2 * lane] = n0; part[wid * 128 + 2 * lane + 1] = n1;
    LDS_WAIT(); __syncthreads();
    if (wid == 0) {
        float a0 = 0.f, a1 = 0.f;
#pragma unroll
        for (int w = 0; w < 8; ++w) { a0 += part[w * 128 + 2 * lane]; a1 += part[w * 128 + 2 * lane + 1]; }
        const float inv = 1.0f / den;
        *(unsigned*)(YA + row * 512 + h * 128 + 2 * lane) = pk2(a0 * inv, a1 * inv);
    }
    LDS_WAIT(); __syncthreads();
}

constexpr int SG_STRIDE = 144;
constexpr int SG_SLAB = 128 * SG_STRIDE;
constexpr int SG_STATS = 4 * SG_SLAB;
__device__ __forceinline__ void sgu_unit(LAS unsigned char* lds, const bf16* U, const bf16* VS, const float* lnw, const float* lnb, const bf16* WSP, const float* bsp, bf16* YS, int unit, int wid, int lane) {
    const int half = unit & 1, bn = unit >> 1;
    const size_t R0 = (size_t)bn * 128;
    LAS f32x2* stats = (LAS f32x2*)(lds + SG_STATS);
    for (int i = 0; i < 16; ++i) {
        const int rl = 16 * wid + i;
        const u32x4 x = *(const u32x4*)(VS + (R0 + rl) * 512 + 8 * lane);
        const float f[8] = {__uint_as_float(x.x << 16), __uint_as_float(x.x & 0xffff0000u), __uint_as_float(x.y << 16), __uint_as_float(x.y & 0xffff0000u),
                            __uint_as_float(x.z << 16), __uint_as_float(x.z & 0xffff0000u), __uint_as_float(x.w << 16), __uint_as_float(x.w & 0xffff0000u)};
        float s = 0.f, s2 = 0.f;
#pragma unroll
        for (int e = 0; e < 8; ++e) { s += f[e]; s2 += f[e] * f[e]; }
        s = wave_sum(s); s2 = wave_sum(s2);
        const float mean = s * (1.0f / 512.0f), var = fmaxf(s2 * (1.0f / 512.0f) - mean * mean, 0.f);
        if (lane == 0) stats[rl] = (f32x2){mean, 1.0f / sqrtf(var + 1e-6f)};
    }
    LDS_WAIT(); __syncthreads();
    const int gl = wid & 3, th = wid >> 2, grp = half * 4 + gl, c0 = grp * 64;
    LAS unsigned char* slab = lds + gl * SG_SLAB;
    {
        const int cc = (lane & 7) * 8;
        const f32x4 w0 = *(const f32x4*)(lnw + c0 + cc), w1 = *(const f32x4*)(lnw + c0 + cc + 4), b0 = *(const f32x4*)(lnb + c0 + cc), b1 = *(const f32x4*)(lnb + c0 + cc + 4);
#pragma unroll
        for (int it = 0; it < 8; ++it) {
            const int rl = th * 64 + it * 8 + (lane >> 3);
            const u32x4 x = *(const u32x4*)(VS + (R0 + rl) * 512 + c0 + cc);
            const f32x2 st = stats[rl];
            f32x4 a = {__uint_as_float(x.x << 16), __uint_as_float(x.x & 0xffff0000u), __uint_as_float(x.y << 16), __uint_as_float(x.y & 0xffff0000u)};
            f32x4 c = {__uint_as_float(x.z << 16), __uint_as_float(x.z & 0xffff0000u), __uint_as_float(x.w << 16), __uint_as_float(x.w & 0xffff0000u)};
            a = (a - st.x) * st.y * w0 + b0; c = (c - st.x) * st.y * w1 + b1;
            u32x4 o; o.x = pk2(a[0], a[1]); o.y = pk2(a[2], a[3]); o.z = pk2(c[0], c[1]); o.w = pk2(c[2], c[3]);
            *(LAS u32x4*)(slab + rl * SG_STRIDE + cc * 2) = o;
        }
    }
    LDS_WAIT(); __syncthreads();
    const int ql = lane & 15, gq = lane >> 4;
    const LAS unsigned char* abase = slab + (8 * gq + (ql >> 2)) * SG_STRIDE + (ql & 3) * 8;
    const bf16* wg = WSP + (size_t)grp * 128 * 128;
#pragma unroll
    for (int ti = 0; ti < 4; ++ti) {
        const int tt = th == 0 ? (ti == 0 ? 0 : (ti == 1 ? 3 : (ti == 2 ? 4 : 7))) : (ti == 0 ? 1 : (ti == 1 ? 2 : (ti == 2 ? 5 : 6)));
        const int t = 16 * tt + ql;
        f32x4 acc[4];
#pragma unroll
        for (int ct = 0; ct < 4; ++ct) acc[ct] = (f32x4){0.f, 0.f, 0.f, 0.f};
        for (int kk = 0; kk <= (tt >> 1); ++kk) {
            const bf16x8 wf = *(const bf16x8*)(wg + (size_t)t * 128 + 32 * kk + 8 * gq);
#pragma unroll
            for (int ct = 0; ct < 4; ++ct) {
                const s16x4 lo = vtr(abase + (32 * kk) * SG_STRIDE + ct * 32);
                const s16x4 hi = vtr(abase + (32 * kk + 4) * SG_STRIDE + ct * 32);
                const bf16x8 af = {lo[0], lo[1], lo[2], lo[3], hi[0], hi[1], hi[2], hi[3]};
                acc[ct] = __builtin_amdgcn_mfma_f32_16x16x32_bf16(af, wf, acc[ct], 0, 0, 0);
            }
        }
        const float bias = bsp[grp * 128 + t];
#pragma unroll
        for (int ct = 0; ct < 4; ++ct) {
            const size_t off = (R0 + t) * 512 + c0 + ct * 16 + 4 * gq;
            const u32x2 uu = *(const u32x2*)(U + off);
            const float u0 = __uint_as_float(uu.x << 16), u1 = __uint_as_float(uu.x & 0xffff0000u), u2 = __uint_as_float(uu.y << 16), u3 = __uint_as_float(uu.y & 0xffff0000u);
            u32x2 o; o.x = pk2(u0 * (acc[ct][0] + bias), u1 * (acc[ct][1] + bias)); o.y = pk2(u2 * (acc[ct][2] + bias), u3 * (acc[ct][3] + bias));
            *(u32x2*)(YS + off) = o;
        }
    }
    LDS_WAIT(); __syncthreads();
}

__device__ __forceinline__ void sgu_sample_row(const bf16* U, const bf16* VS, const float* lnw, const float* lnb, const float* wsp_f32, const float* bsp, bf16* YS, float* out_sv, int b, int lane) {
    const size_t row = (size_t)MP + b;
    const u32x4 x = *(const u32x4*)(VS + row * 512 + 8 * lane);
    float f[8] = {__uint_as_float(x.x << 16), __uint_as_float(x.x & 0xffff0000u), __uint_as_float(x.y << 16), __uint_as_float(x.y & 0xffff0000u),
                  __uint_as_float(x.z << 16), __uint_as_float(x.z & 0xffff0000u), __uint_as_float(x.w << 16), __uint_as_float(x.w & 0xffff0000u)};
    float s = 0.f, s2 = 0.f;
#pragma unroll
    for (int e = 0; e < 8; ++e) { s += f[e]; s2 += f[e] * f[e]; }
    s = wave_sum(s); s2 = wave_sum(s2);
    const float mean = s * (1.0f / 512.0f), var = fmaxf(s2 * (1.0f / 512.0f) - mean * mean, 0.f), rstd = 1.0f / sqrtf(var + 1e-6f);
    const int c = 8 * lane, grp = c >> 6;
    const float w00 = wsp_f32[(size_t)grp * 128 * 128], b0 = bsp[grp * 128];
    const u32x4 uu = *(const u32x4*)(U + row * 512 + c);
    const float uf[8] = {__uint_as_float(uu.x << 16), __uint_as_float(uu.x & 0xffff0000u), __uint_as_float(uu.y << 16), __uint_as_float(uu.y & 0xffff0000u),
                         __uint_as_float(uu.z << 16), __uint_as_float(uu.z & 0xffff0000u), __uint_as_float(uu.w << 16), __uint_as_float(uu.w & 0xffff0000u)};
    float y[8];
#pragma unroll
    for (int e = 0; e < 8; ++e) { const float vn = (f[e] - mean) * rstd * lnw[c + e] + lnb[c + e]; out_sv[c + e] = vn; y[e] = uf[e] * (w00 * vn + b0); }
    u32x4 o; o.x = pk2(y[0], y[1]); o.y = pk2(y[2], y[3]); o.z = pk2(y[4], y[5]); o.w = pk2(y[6], y[7]);
    *(u32x4*)(YS + row * 512 + c) = o;
}

__device__ __forceinline__ void merge_row(const bf16* OG, const float* DG, bf16* YA, int row, int lane) {
    const int h = lane >> 4;
    const float d0 = DG[(size_t)row * 12 + h], d1 = DG[(size_t)row * 12 + 4 + h], d2 = DG[(size_t)row * 12 + 8 + h];
    const float inv = 1.0f / (d0 + d1 + d2);
    const float a0 = d0 * inv, a1 = d1 * inv, a2 = d2 * inv;
    const bf16* p = OG + (size_t)row * QKV + 8 * lane;
    const u32x4 x0 = *(const u32x4*)p, x1 = *(const u32x4*)(p + 512), x2 = *(const u32x4*)(p + 1024);
    u32x4 o;
#define MRG(c) pk2(a0 * __uint_as_float(x0.c << 16) + a1 * __uint_as_float(x1.c << 16) + a2 * __uint_as_float(x2.c << 16), \
                   a0 * __uint_as_float(x0.c & 0xffff0000u) + a1 * __uint_as_float(x1.c & 0xffff0000u) + a2 * __uint_as_float(x2.c & 0xffff0000u))
    o.x = MRG(x); o.y = MRG(y); o.z = MRG(z); o.w = MRG(w);
#undef MRG
    *(u32x4*)(YA + (size_t)row * 512 + 8 * lane) = o;
}


typedef float f32x16 __attribute__((ext_vector_type(16)));
template <class EpiS>
__device__ __forceinline__ void skinny_gemm(LAS unsigned char* lds, const bf16* A, const bf16* Bt, int K, int j, const EpiS& e, int wid, int lane, int tid) {
    const int r = lane & 31, hi = lane >> 5, ks = K >> 3;
    const bf16* ap = A + (size_t)r * K + wid * ks + 8 * hi;
    const bf16* bp = Bt + (size_t)(32 * j + r) * K + wid * ks + 8 * hi;
    f32x16 acc;
#pragma unroll
    for (int i = 0; i < 16; ++i) acc[i] = 0.f;
#pragma unroll 4
    for (int k = 0; k < ks; k += 16) {
        const bf16x8 a = *(const bf16x8*)(ap + k), b = *(const bf16x8*)(bp + k);
        acc = __builtin_amdgcn_mfma_f32_32x32x16_bf16(a, b, acc, 0, 0, 0);
    }
    LAS float* red = (LAS float*)lds;
#pragma unroll
    for (int i = 0; i < 16; ++i) red[wid * 1056 + ((i & 3) + 8 * (i >> 2) + 4 * hi) * 33 + r] = acc[i];
    LDS_WAIT(); __syncthreads();
    for (int e2 = tid; e2 < 1024; e2 += NTHREADS) {
        const int row = e2 >> 5, col = e2 & 31;
        float sum = 0.f;
#pragma unroll
        for (int w = 0; w < 8; ++w) sum += red[w * 1056 + row * 33 + col];
        e(row, 32 * j + col, sum);
    }
    LDS_WAIT(); __syncthreads();
}
struct SkGate1 { const bf16* G; float* T1; __device__ __forceinline__ void operator()(int sr, int col, float v) const { const size_t row = (size_t)MP + sr; T1[row * DM + col] = bf2f(G[row * 2048 + col]) * v; } };
struct SkGate2 { const bf16* G; const float* T1; bf16* MG; __device__ __forceinline__ void operator()(int sr, int col, float v) const { const size_t row = (size_t)MP + sr; MG[row * DM + col] = (bf16)(pk2(T1[row * DM + col] + bf2f(G[row * 2048 + 1024 + col]) * v, 0.f) & 0xffffu); } };
struct SkRes { const float* bs; float* os; const float* gate; __device__ __forceinline__ void operator()(int sr, int col, float v) const { os[(size_t)sr * DM + col] = bs[(size_t)sr * DM + col] + gate[(size_t)(4 + sr) * NADA + col] * v; } };


#define RLX_AGENT __ATOMIC_RELAXED, __HIP_MEMORY_SCOPE_AGENT
#define XB_TMO      128
#define XB_XCNT(j)  (256  + 64 * (j))
#define XB_XSUB(j)  (1280 + 64 * (j))
#define XB_XGEN(j)  (2304 + 64 * (j))
#define XB_TOP      3328
#define XB_TOPGEN   3392
#define XCD_BAR_WORDS 3456
#define XB_SPIN_CAP (1u << 18)

__device__ __forceinline__ unsigned xb_ld(unsigned* p)              { return __hip_atomic_load(p, __ATOMIC_RELAXED, __HIP_MEMORY_SCOPE_AGENT); }
__device__ __forceinline__ unsigned xb_add(unsigned* p, unsigned v) { return __hip_atomic_fetch_add(p, v, __ATOMIC_RELAXED, __HIP_MEMORY_SCOPE_AGENT); }
__device__ __forceinline__ unsigned xb_xcc_id() { return (unsigned)__builtin_amdgcn_s_getreg((3 << 11) | 20) & 0xFu; }
#define XB_SPIN(cond, bar) do { unsigned _sp = 0; while (cond) { __builtin_amdgcn_s_sleep(1); \
    if ((++_sp & 255u) == 0u) { if (xb_ld(&(bar)[XB_TMO])) break; if (_sp > XB_SPIN_CAP) { atomicAdd(&(bar)[XB_TMO], 1u); break; } } } } while (0)

struct XcdBarrier {
    unsigned* bar; unsigned x;
    volatile LAS unsigned* st;
};

__device__ __forceinline__ XcdBarrier xcd_barrier_post(unsigned* bar, volatile LAS unsigned* st) {
    XcdBarrier b; b.bar = bar; b.x = xb_xcc_id(); b.st = st;
    if (threadIdx.x == 0) (void)xb_add(&bar[XB_XCNT(b.x)], 1u);
    return b;
}
__device__ __forceinline__ void xcd_barrier_complete(unsigned* bar, unsigned x, unsigned& nloc, unsigned& nx) {
    const unsigned G = gridDim.x * gridDim.y * gridDim.z;
    unsigned sum, cnt, mine, sp = 0u;
    for (;;) {
        sum = 0u; cnt = 0u; mine = 0u;
#pragma unroll
        for (unsigned j = 0; j < 16; ++j) { const unsigned c = xb_ld(&bar[XB_XCNT(j)]); sum += c; cnt += (c > 0u) ? 1u : 0u; mine = (j == x) ? c : mine; }
        if (sum == G) break;
        __builtin_amdgcn_s_sleep(1);
        if ((++sp & 255u) == 0u) { if (xb_ld(&bar[XB_TMO])) break; if (sp > XB_SPIN_CAP) { atomicAdd(&bar[XB_TMO], 1u); break; } }
    }
    nloc = mine > 0u ? mine : 1u; nx = cnt > 0u ? cnt : 1u;
}

__device__ __forceinline__ void xcd_barrier(const XcdBarrier& b) {
    asm volatile("s_waitcnt vmcnt(0)" ::: "memory");
    __syncthreads();
    if (threadIdx.x == 0) {
        unsigned* bar = b.bar;
        __builtin_amdgcn_s_waitcnt(0);
        unsigned nloc = b.st[0], nx = b.st[1];
        if (nloc == 0u) { xcd_barrier_complete(bar, b.x, nloc, nx); b.st[0] = nloc; b.st[1] = nx; }
        const unsigned old = xb_add(&bar[XB_XSUB(b.x)], 1u);
        const unsigned gen = old / nloc;
        if (old + 1u == (gen + 1u) * nloc) {
            __builtin_amdgcn_fence(__ATOMIC_RELEASE, "agent");
            asm volatile("s_waitcnt vmcnt(0)" ::: "memory");
            const unsigned og = xb_add(&bar[XB_TOP], 1u);
            const unsigned tg = og / nx;
            if (og + 1u == (tg + 1u) * nx) xb_add(&bar[XB_TOPGEN], 1u);
            else XB_SPIN(xb_ld(&bar[XB_TOPGEN]) == tg, bar);
            __builtin_amdgcn_fence(__ATOMIC_ACQUIRE, "agent");
            xb_add(&bar[XB_XGEN(b.x)], 1u);
            asm volatile("s_waitcnt vmcnt(0)" ::: "memory");
        } else {
            XB_SPIN(xb_ld(&bar[XB_XGEN(b.x)]) == gen, bar);
            __builtin_amdgcn_fence(__ATOMIC_ACQUIRE, "agent");
            asm volatile("s_waitcnt vmcnt(0)" ::: "memory");
        }
    }
    __syncthreads();
}

constexpr int LDS_MISC = LDS_EXCH + 8192;
constexpr size_t WS_CTL = 0, CTL_ZERO_BYTES = 65536;
#define PHON(k) if constexpr (((PHM) >> (k)) & 1)
#define GSYNC() do { if constexpr (COOP) { CAS const Args* ap_ = (CAS const Args*)__builtin_amdgcn_kernarg_segment_ptr(); asm volatile("" : "+s"(ap_)); \
    XcdBarrier xb_; xb_.bar = (unsigned*)((unsigned char*)ap_->ws + WS_CTL); xb_.x = xb_xcc_id(); xb_.st = (volatile LAS unsigned*)(lds + LDS_MISC); xcd_barrier(xb_); } } while (0)
#define GSYNC_CG() do { if constexpr (COOP) cg::this_grid().sync(); } while (0)
#define GAS __attribute__((address_space(1)))
#define CAS __attribute__((address_space(4)))
struct Args { GAS const float* in[23]; GAS float* out; GAS unsigned char* ws; };

#define PHASE_ENV() \
    CAS const Args* ap = (CAS const Args*)__builtin_amdgcn_kernarg_segment_ptr(); asm volatile("" : "+s"(ap)); \
    int tid = threadIdx.x; asm volatile("" : "+v"(tid)); \
    const int lane = tid & 63, wid = __builtin_amdgcn_readfirstlane(tid >> 6); \
    int G_ = gridDim.x, bx_ = blockIdx.x; asm volatile("" : "+s"(G_), "+s"(bx_)); const int G = G_, bx = bx_; const int gw = bx * NWAVES + wid, NGW = G * NWAVES; \
    unsigned char* const ws = (unsigned char*)ap->ws; (void)lane; (void)wid; (void)gw; (void)NGW; (void)ws; (void)G; (void)bx
#define WL(l) (ws + WS_WL0 + (size_t)(l) * WL_SIZE)

template <int PHM, bool COOP>
__global__ void __launch_bounds__(NTHREADS, 2) fwd_megakernel(Args args_unused, int l_lo, int l_hi) {
    extern __shared__ __attribute__((aligned(16))) unsigned char lds_raw[];
    LAS unsigned char* lds = (LAS unsigned char*)lds_raw;
    if constexpr (COOP) {
        PHASE_ENV();
        if (tid < 32) ((LAS unsigned*)(lds + LDS_MISC))[tid] = 0u;
        __syncthreads();
        (void)xcd_barrier_post((unsigned*)(ws + WS_CTL), (volatile LAS unsigned*)(lds + LDS_MISC));
    }

    PHON(0) {
        PHASE_ENV();
        bf16* WADA = (bf16*)(ws + WS_WADA); bf16* SC = (bf16*)(ws + WS_SC);
        LAS float* scr = (LAS float*)(lds + wid * 16384);
        constexpr int I_ADA = 16 * 192, I_IN = 16 * 240, I_PA = 8 * 32, I_OUT = 16 * 32, I_FI = 16 * 176, I_FO = 44 * 32;
        constexpr int I_LAYER = I_ADA + I_IN + 2 * I_PA + I_OUT + I_FI + I_FO;
        for (int it = gw; it < 2 * I_LAYER; it += NGW) {
            const int l = it / I_LAYER; int r = it - l * I_LAYER;
            unsigned char* wl = WL(l);
            if (r < I_ADA) { transpose_item(((const float*)ap->in[7]) + (size_t)l * DM * NADA, DM, NADA, WADA + (size_t)l * NADA * DM, 0, scr, r, lane); continue; } r -= I_ADA;
            if (r < I_IN) { transpose_item(((const float*)ap->in[10]) + (size_t)l * DM * DIN, DM, DIN, (bf16*)(wl + WL_WIN), 0, scr, r, lane); continue; } r -= I_IN;
            if (r < I_PA) { transpose_item(((const float*)ap->in[17]) + (size_t)l * 512 * DM, 512, DM, (bf16*)(wl + WL_WPA), 0, scr, r, lane); continue; } r -= I_PA;
            if (r < I_PA) { transpose_item(((const float*)ap->in[18]) + (size_t)l * 512 * DM, 512, DM, (bf16*)(wl + WL_WPS), 0, scr, r, lane); continue; } r -= I_PA;
            if (r < I_OUT) { transpose_item(((const float*)ap->in[19]) + (size_t)l * DM * DM, DM, DM, (bf16*)(wl + WL_WOUT), 0, scr, r, lane); continue; } r -= I_OUT;
            if (r < I_FI) { transpose_item(((const float*)ap->in[21]) + (size_t)l * DM * 2 * DFF, DM, 2 * DFF, (bf16*)(wl + WL_WFI), 1, scr, r, lane); continue; } r -= I_FI;
            transpose_item(((const float*)ap->in[22]) + (size_t)l * DFF * DM, DFF, DM, (bf16*)(wl + WL_WFO), 0, scr, r, lane);
        }
        const int gt = bx * NTHREADS + tid, NGT = G * NTHREADS;
        const float* wsp = ((const float*)ap->in[15]);
        for (int i = gt; i < 2 * 8 * 128 * 128; i += NGT) {
            const int l = i >> 17, r = i & 131071, t = (r >> 7) & 127, s = r & 127;
            const float w = wsp[i];
            ((bf16*)(WL(l) + WL_WSP))[r] = (bf16)(s <= t ? (pk2(w, 0.f) & 0xffffu) : 0u);
        }
        const float* cpr = ((const float*)ap->in[5]); const float* csm = ((const float*)ap->in[6]);
        for (int i = gt; i < 256 * DM; i += NGT) {
            const int r = i >> 10, k = i & 1023;
            float v = 0.f;
            if (r < 4) v = cpr[r * DM + k]; else if (r < 36) v = csm[(r - 4) * DM + k];
            SC[i] = (bf16)(pk2(v * sigmoidf_(v), 0.f) & 0xffffu);
        }
    }
    GSYNC_CG();
    PHON(1) {
        PHASE_ENV();
        pg8::Gemm g{(const bf16*)(ws + WS_SC), (const bf16*)(ws + WS_WADA), 256, 2 * NADA, DM}; pg8::StaticOrder S; S.init(256, 2 * NADA, G, bx);
        EpiAda E{(float*)(ws + WS_MOD), ((const float*)ap->in[8])};
        pg8::gemm_phase<EpiAda, pg8::StaticOrder, true, true>(lds + LDS_RING, g, S, E);
    }
    GSYNC();

    for (int l = l_lo; l < l_hi; ++l) {
        PHON(2) {
            PHASE_ENV();
            const float* X2 = (const float*)(ws + WS_X2);
            const float* xin_p = l == 0 ? ((const float*)ap->in[0]) : X2;
            const float* xin_s = l == 0 ? ((const float*)ap->in[1]) : X2 + (size_t)MP * DM;
            norm_mod_phase(xin_p, xin_s, ((const float*)ap->in[9]) + l * DM, (const float*)(ws + WS_MOD) + (size_t)l * 36 * NADA, 0, (bf16*)(ws + WS_XN), gw, NGW, lane);
        }
        GSYNC();
        PHON(3) {
            PHASE_ENV();
            pg8::Gemm g{(const bf16*)(ws + WS_XN), (const bf16*)(WL(l) + WL_WIN), MT, DIN, DM}; pg8::StaticOrder S; S.init(MT, DIN, G, bx);
            EpiIn E{ws, ((const float*)ap->in[11]) + l * 384, ((const float*)ap->in[12]) + l * 384, ((float*)ap->out), l, (LAS float*)(lds + LDS_EXCH)};
            pg8::gemm_phase<EpiIn, pg8::StaticOrder, true, true>(lds + LDS_RING, g, S, E);
        }
        GSYNC();
        PHON(4) {
            PHASE_ENV();
            const bf16 *Qb = (const bf16*)(ws + WS_Q), *Kb = (const bf16*)(ws + WS_K), *Vb = (const bf16*)(ws + WS_V);
            float mq = 0.f, mk = 0.f;
            for (int i = lane; i < 384; i += 64) { mq = fmaxf(mq, fabsf(((const float*)ap->in[11])[l * 384 + i])); mk = fmaxf(mk, fabsf(((const float*)ap->in[12])[l * 384 + i])); }
            mq = wave_max(mq); mk = wave_max(mk);
            const float cshift = 11.3137085f * LOG2E * mq * mk;
            for (int u = bx; u < 1536; u += G) attn_unit(lds, Qb, Kb, Vb, (bf16*)(ws + WS_OG), (float*)(ws + WS_DG), u, cshift, wid, lane, tid);
        }
        PHON(4) {
            PHASE_ENV();
            if (bx >= G / 2) {
                for (int it = bx - G / 2; it < NSMP * 4; it += G - G / 2)
                    attn_sample_item(lds, (const bf16*)(ws + WS_Q), (const bf16*)(ws + WS_K), (const bf16*)(ws + WS_V), ((const float*)ap->in[2]), ((const float*)ap->in[3]), ((const float*)ap->in[4]), l, (bf16*)(ws + WS_YA), it, wid, lane);
            }
        }
        GSYNC();
        PHON(5) {
            PHASE_ENV();
            const bf16 *Ub = (const bf16*)(ws + WS_U), *VSb = (const bf16*)(ws + WS_VS); bf16 *YS = (bf16*)(ws + WS_YS);
            const bf16* WSP = (const bf16*)(WL(l) + WL_WSP);
            const float* lnw = ((const float*)ap->in[13]) + l * 512; const float* lnb = ((const float*)ap->in[14]) + l * 512; const float* bsp = ((const float*)ap->in[16]) + l * 8 * 128;
            for (int u = bx; u < 256; u += G) sgu_unit(lds, Ub, VSb, lnw, lnb, WSP, bsp, YS, u, wid, lane);
            for (int b = gw; b < NSMP; b += NGW) sgu_sample_row(Ub, VSb, lnw, lnb, ((const float*)ap->in[15]) + (size_t)l * 8 * 128 * 128, bsp, YS, ((float*)ap->out) + O_SV + (size_t)(l * NSMP + b) * 512, b, lane);
            for (int row = gw; row < MP; row += NGW) merge_row((const bf16*)(ws + WS_OG), (const float*)(ws + WS_DG), (bf16*)(ws + WS_YA), row, lane);
        }
        GSYNC();
        PHON(6) {
            PHASE_ENV();
            pg8::StaticOrder S; S.init(MP, DM, G, bx);
            pg8::Gemm g{(const bf16*)(ws + WS_YA), (const bf16*)(WL(l) + WL_WPA), MP, DM, 512}; EpiGate1 E{(const bf16*)(ws + WS_G), (float*)(ws + WS_T1)};
            pg8::gemm_phase<EpiGate1, pg8::StaticOrder, true, true>(lds + LDS_RING, g, S, E);
        }
        PHON(6) {
            PHASE_ENV();
            if (bx < 32) { SkGate1 e{(const bf16*)(ws + WS_G), (float*)(ws + WS_T1)};
                skinny_gemm(lds, (const bf16*)(ws + WS_YA) + (size_t)MP * 512, (const bf16*)(WL(l) + WL_WPA), 512, bx, e, wid, lane, tid); }
        }
        PHON(6) {
            PHASE_ENV();
            pg8::StaticOrder S; S.init(MP, DM, G, bx);
            pg8::Gemm g{(const bf16*)(ws + WS_YS), (const bf16*)(WL(l) + WL_WPS), MP, DM, 512}; EpiGate2 E{(const bf16*)(ws + WS_G), (const float*)(ws + WS_T1), (bf16*)(ws + WS_MG)};
            pg8::gemm_phase<EpiGate2, pg8::StaticOrder, true, true>(lds + LDS_RING, g, S, E);
        }
        PHON(6) {
            PHASE_ENV();
            if (bx < 32) { SkGate2 e{(const bf16*)(ws + WS_G), (const float*)(ws + WS_T1), (bf16*)(ws + WS_MG)};
                skinny_gemm(lds, (const bf16*)(ws + WS_YS) + (size_t)MP * 512, (const bf16*)(WL(l) + WL_WPS), 512, bx, e, wid, lane, tid); }
        }
        GSYNC();
        PHON(7) {
            PHASE_ENV();
            const float* X2 = (const float*)(ws + WS_X2); float* X1 = (float*)(ws + WS_X1);
            const float* xin_p = l == 0 ? ((const float*)ap->in[0]) : X2;
            const float* xin_s = l == 0 ? ((const float*)ap->in[1]) : X2 + (size_t)MP * DM;
            pg8::Gemm g{(const bf16*)(ws + WS_MG), (const bf16*)(WL(l) + WL_WOUT), MP, DM, DM}; pg8::StaticOrder S; S.init(MP, DM, G, bx);
            EpiRes E{xin_p, xin_s, X1, X1 + (size_t)MP * DM, (const float*)(ws + WS_MOD) + (size_t)l * 36 * NADA + 2048};
            pg8::gemm_phase<EpiRes, pg8::StaticOrder, true, true>(lds + LDS_RING, g, S, E);
        }
        PHON(7) {
            PHASE_ENV();
            if (bx < 32) { const float* X2 = (const float*)(ws + WS_X2);
                SkRes e{l == 0 ? ((const float*)ap->in[1]) : X2 + (size_t)MP * DM, (float*)(ws + WS_X1) + (size_t)MP * DM, (const float*)(ws + WS_MOD) + (size_t)l * 36 * NADA + 2048};
                skinny_gemm(lds, (const bf16*)(ws + WS_MG) + (size_t)MP * DM, (const bf16*)(WL(l) + WL_WOUT), DM, bx, e, wid, lane, tid); }
        }
        GSYNC();
        PHON(8) {
            PHASE_ENV();
            const float* X1 = (const float*)(ws + WS_X1);
            norm_mod_phase(X1, X1 + (size_t)MP * DM, ((const float*)ap->in[20]) + l * DM, (const float*)(ws + WS_MOD) + (size_t)l * 36 * NADA, 3072, (bf16*)(ws + WS_XN), gw, NGW, lane);
        }
        GSYNC();
        PHON(9) {
            PHASE_ENV();
            pg8::Gemm g{(const bf16*)(ws + WS_XN), (const bf16*)(WL(l) + WL_WFI), MT, 2 * DFF, DM}; pg8::StaticOrder S; S.init(MT, 2 * DFF, G, bx);
            EpiSwiglu E{(bf16*)(ws + WS_H)};
            pg8::gemm_phase<EpiSwiglu, pg8::StaticOrder, true, true>(lds + LDS_RING, g, S, E);
        }
        GSYNC();
        PHON(10) {
            PHASE_ENV();
            const float* X1 = (const float*)(ws + WS_X1); float* X2 = (float*)(ws + WS_X2);
            float* xout_p = l == 0 ? X2 : ((float*)ap->out) + O_YP;
            float* xout_s = l == 0 ? X2 + (size_t)MP * DM : ((float*)ap->out) + O_YS;
            pg8::Gemm g{(const bf16*)(ws + WS_H), (const bf16*)(WL(l) + WL_WFO), MP, DM, DFF}; pg8::StaticOrder S; S.init(MP, DM, G, bx);
            EpiRes E{X1, X1 + (size_t)MP * DM, xout_p, xout_s, (const float*)(ws + WS_MOD) + (size_t)l * 36 * NADA + 5120};
            pg8::gemm_phase<EpiRes, pg8::StaticOrder, true, true>(lds + LDS_RING, g, S, E);
        }
        PHON(10) {
            PHASE_ENV();
            if (bx < 32) { float* X2 = (float*)(ws + WS_X2);
                SkRes e{(const float*)(ws + WS_X1) + (size_t)MP * DM, l == 0 ? X2 + (size_t)MP * DM : ((float*)ap->out) + O_YS, (const float*)(ws + WS_MOD) + (size_t)l * 36 * NADA + 5120};
                skinny_gemm(lds, (const bf16*)(ws + WS_H) + (size_t)MP * DFF, (const bf16*)(WL(l) + WL_WFO), DFF, bx, e, wid, lane, tid); }
        }
        if (l + 1 < l_hi) GSYNC();
    }
}


#ifdef EXP_MASK
__global__ void __launch_bounds__(256) dbg_checksum(const unsigned char* ws, float* out) {
    const int lane = threadIdx.x & 63, gw = (blockIdx.x * 256 + threadIdx.x) >> 6, ngw = gridDim.x * 4;
    struct B { size_t off; int cols; int isf; };
    const B bufs[16] = {{WS_XN, 1024, 0}, {WS_Q, 1536, 0}, {WS_K, 1536, 0}, {WS_V, 1536, 0}, {WS_U, 512, 0}, {WS_VS, 512, 0}, {WS_G, 2048, 0}, {WS_OG, 1536, 0},
                        {WS_DG, 12, 1}, {WS_YA, 512, 0}, {WS_YS, 512, 0}, {WS_T1, 1024, 1}, {WS_MG, 1024, 0}, {WS_X1, 1024, 1}, {WS_H, 2816, 0}, {WS_X2, 1024, 1}};
    for (int b = 0; b < 16; ++b) {
        if (!((EXP_MASK >> b) & 1)) continue;
        for (int row = gw; row < MV; row += ngw) {
            float s = 0.f;
            for (int c = lane; c < bufs[b].cols; c += 64) {
                const float v = bufs[b].isf ? ((const float*)(ws + bufs[b].off))[(size_t)row * bufs[b].cols + c] : bf2f(((const bf16*)(ws + bufs[b].off))[(size_t)row * bufs[b].cols + c]);
                s += v * (float)(1 + (c % 7));
            }
            s = wave_sum(s);
            if (lane == 0) out[(size_t)b * MT + row] = s;
        }
    }
    if ((EXP_MASK >> 16) & 1) for (int i = blockIdx.x * 256 + threadIdx.x; i < 72 * NADA; i += gridDim.x * 256) out[16 * MT + i] = ((const float*)(ws + WS_MOD))[i];
}
#endif
#ifndef N_LAUNCH_MODE
#define N_LAUNCH_MODE 1
#endif
template <int PHM> static void launch_phase(const Args& a, int l_lo, int l_hi, int grid, hipStream_t stream) {
    static bool attr = false;
    if (!attr) { (void)hipFuncSetAttribute((const void*)fwd_megakernel<PHM, false>, hipFuncAttributeMaxDynamicSharedMemorySize, LDS_BYTES); attr = true; }
    hipLaunchKernelGGL((fwd_megakernel<PHM, false>), dim3(grid), dim3(NTHREADS), LDS_BYTES, stream, a, l_lo, l_hi);
}
extern "C" void kernel_launch(void* const* d_in, const int* in_sizes, int n_in, void* d_out, int out_size, void* d_ws, size_t ws_size, hipStream_t stream) {
    static int grid = 0;
    if (grid == 0) {
        if (n_in != 23 || (size_t)out_size != O_END || ws_size < WS_END) { fprintf(stderr, "kernel_launch: unexpected shapes (n_in %d out %d ws %zu need %zu)\n", n_in, out_size, ws_size, (size_t)WS_END); grid = -1; return; }
        int dev = 0, cus = 0, per_cu = 0;
        (void)hipGetDevice(&dev);
        (void)hipDeviceGetAttribute(&cus, hipDeviceAttributeMultiprocessorCount, dev);
#if N_LAUNCH_MODE == 1
        if (hipFuncSetAttribute((const void*)fwd_megakernel<0x7FF, true>, hipFuncAttributeMaxDynamicSharedMemorySize, LDS_BYTES) != hipSuccess) { fprintf(stderr, "kernel_launch: hipFuncSetAttribute failed\n"); grid = -1; return; }
        (void)hipOccupancyMaxActiveBlocksPerMultiprocessor(&per_cu, (const void*)fwd_megakernel<0x7FF, true>, NTHREADS, LDS_BYTES);
        (void)hipGetLastError();
        if (per_cu < 1) fprintf(stderr, "kernel_launch: occupancy query says %d blocks per CU\n", per_cu);
#endif
        grid = cus;
    }
    if (grid < 0) return;
    Args a{};
    for (int i = 0; i < 23; ++i) a.in[i] = (GAS const float*)d_in[i];
    a.out = (GAS float*)d_out; a.ws = (GAS unsigned char*)d_ws;
#if N_LAUNCH_MODE == 1
    (void)hipMemsetAsync((unsigned char*)d_ws + WS_CTL, 0, CTL_ZERO_BYTES, stream);
    int l_lo = 0, l_hi = 2;
    void* kargs[] = {&a, &l_lo, &l_hi};
    hipError_t e = hipLaunchCooperativeKernel((const void*)fwd_megakernel<0x7FF, true>, dim3(grid), dim3(NTHREADS), kargs, LDS_BYTES, stream);
    if (e != hipSuccess) fprintf(stderr, "cooperative launch failed: %s (grid %d)\n", hipGetErrorString(e), grid);
#else
#ifdef EXP_MASK
    (void)hipMemsetAsync(d_out, 0, (size_t)out_size * 4, stream);
#endif
    launch_phase<0x001>(a, 0, 0, grid, stream);
    launch_phase<0x002>(a, 0, 0, grid, stream);
#ifdef EXP_MASK
    const int NL = 1;
#else
    const int NL = 2;
#endif
    for (int l = 0; l < NL; ++l) {
        launch_phase<0x004>(a, l, l + 1, grid, stream);
        launch_phase<0x008>(a, l, l + 1, grid, stream);
        launch_phase<0x010>(a, l, l + 1, grid, stream);
        launch_phase<0x020>(a, l, l + 1, grid, stream);
        launch_phase<0x040>(a, l, l + 1, grid, stream);
        launch_phase<0x080>(a, l, l + 1, grid, stream);
        launch_phase<0x100>(a, l, l + 1, grid, stream);
        launch_phase<0x200>(a, l, l + 1, grid, stream);
        launch_phase<0x400>(a, l, l + 1, grid, stream);
    }
#ifdef EXP_MASK
    hipLaunchKernelGGL(dbg_checksum, dim3(1024), dim3(256), 0, stream, (const unsigned char*)d_ws, (float*)d_out);
#endif
#endif
}
```

```cpp
#include <hip/hip_runtime.h>
#include <hip/hip_cooperative_groups.h>
#include <cstdio>
#include <cstdint>
namespace cg = cooperative_groups;
namespace pg8 {
#define PG8_LAS __attribute__((address_space(3)))
typedef unsigned short bf16_t;
typedef short bf16x8 __attribute__((ext_vector_type(8)));
typedef float f32x4 __attribute__((ext_vector_type(4)));
typedef unsigned u32x4 __attribute__((ext_vector_type(4)));
constexpr int BM = 256, BK = 64, HALF = 128, HTB = HALF * BK * 2  , STAGE_BYTES = 8 * HTB, NXCD = 8, WGM = 8;

__host__ __device__ __forceinline__ int lds_byte(int r, int c) { const int st = (r >> 4) * 2 + (c >> 5), rr = r & 15, cc = c & 31, ob = rr * 64 + cc * 2; return st * 1024 + (ob ^ (((ob >> 9) & 1) << 5)); }
__host__ __device__ __forceinline__ void stage_rc(int b, int& R, int& C) { const int st = b / 1024, sb = b % 1024, swz = sb ^ (((sb >> 9) & 1) << 5); R = (st >> 1) * 16 + swz / 64; C = (st & 1) * 32 + (swz % 64) / 2; }
__host__ __device__ __forceinline__ int perm32(int rho) { const int n = rho >> 4, i = rho & 15; return 8 * (i >> 2) + 4 * n + (i & 3); }

struct Unit { int pm, pn; };
struct Gemm { const bf16_t* A; const bf16_t* Bt; int M, N, K; };

struct StaticOrder {
    int nM, nN, nwg, G, c;
    __host__ __device__ void init(int M, int N, int G_, int c_) { nM = M / BM; nN = N / BM; nwg = nM * nN; G = G_; c = c_; }
    __host__ __device__ bool next(int i, Unit& u) const {
        const long L = (long)i * G + c; if (L >= nwg) return false;
        int wgid = (int)L; { const int q = nwg / NXCD, r = nwg % NXCD, xcd = wgid % NXCD, off = wgid / NXCD; wgid = (xcd < r ? xcd * (q + 1) : r * (q + 1) + (xcd - r) * q) + off; }
        const int nig = WGM * nN, gid = wgid / nig, fm = gid * WGM, gsz = (nM - fm) < WGM ? (nM - fm) : WGM;
        u.pm = fm + ((wgid % nig) % gsz); u.pn = (wgid % nig) / gsz; return true;
    }
    __device__ __forceinline__ void a_ready(const Unit&) const {}
    __device__ __forceinline__ void done(const Unit&) const {}
};

typedef __bf16 bf16x2_hw __attribute__((ext_vector_type(2)));
typedef float f32x2_hw __attribute__((ext_vector_type(2)));
__device__ __forceinline__ unsigned cvt_pk_bf16(float lo, float hi) { const f32x2_hw v = {lo, hi}; return __builtin_bit_cast(unsigned, __builtin_convertvector(v, bf16x2_hw)); }
typedef float f32x2 __attribute__((ext_vector_type(2)));
__device__ __forceinline__ f32x2 gelu_pk(f32x2 v) {
    const f32x2 av = __builtin_elementwise_abs(v), d = av * 0.2316418882f + 1.0f;
    f32x2 t; t.x = __builtin_amdgcn_rcpf(d.x); t.y = __builtin_amdgcn_rcpf(d.y);
    f32x2 q = t * 0.5307027145f + (-0.7265760135f); q = q * t + 0.7107068705f; q = q * t + (-0.142248368f); q = q * t + 0.127414796f; q = q * t;
    const f32x2 s = (v * v) * (-0.72134752044f);
    f32x2 e; e.x = __builtin_amdgcn_exp2f(s.x); e.y = __builtin_amdgcn_exp2f(s.y);
    const f32x2 m = v * (q * e), r = v - m;
    f32x2 o; o.x = v.x < 0.f ? m.x : r.x; o.y = v.y < 0.f ? m.y : r.y; return o;
}

template <int ACT  > struct EpiBf16 {
    static constexpr bool PERM = true, AFTER_DRAIN = false; static_assert(ACT == 0 || ACT == 1, "EpiBf16: ACT is 0 (none) or 1 (gelu_pk)");
    bf16_t* O; int ldc; const float* bias; int split_cols; size_t split_stride; float scale0;
    __device__ __forceinline__ void operator()(const f32x4 (&acc)[2][2][4][2], const Unit& u, int wr, int wc, int fr, int fq) const {
        const int row0 = u.pm * BM + wr * 64 + fr; int colt = u.pn * BM; bf16_t* base = O;
        float sc = 1.f; if (split_cols) { const int t = colt / split_cols; base += (size_t)t * split_stride; colt -= t * split_cols; if (t == 0) sc = scale0; }
        const int col0 = colt + wc * 32 + 8 * fq, bcol0 = u.pn * BM + wc * 32 + 8 * fq;
        f32x4 bv[2][2];
#pragma unroll
        for (int bj = 0; bj < 2; ++bj)
#pragma unroll
            for (int n = 0; n < 2; ++n) bv[bj][n] = bias ? *(const f32x4*)(bias + bcol0 + bj * HALF + 4 * n) : (f32x4){0.f, 0.f, 0.f, 0.f};
#pragma unroll
        for (int ai = 0; ai < 2; ++ai)
#pragma unroll
            for (int m = 0; m < 4; ++m) { bf16_t* rowp = base + (size_t)(row0 + ai * HALF + m * 16) * ldc + col0;
#pragma unroll
                for (int bj = 0; bj < 2; ++bj) { f32x4 v0 = acc[ai][bj][m][0] + bv[bj][0], v1 = acc[ai][bj][m][1] + bv[bj][1];
                    if (ACT == 1) { f32x2 a = gelu_pk((f32x2){v0[0], v0[1]}), b = gelu_pk((f32x2){v0[2], v0[3]}), c = gelu_pk((f32x2){v1[0], v1[1]}), d = gelu_pk((f32x2){v1[2], v1[3]});
                        v0 = (f32x4){a.x, a.y, b.x, b.y}; v1 = (f32x4){c.x, c.y, d.x, d.y}; }
                    v0 = v0 * sc; v1 = v1 * sc; u32x4 w; w.x = cvt_pk_bf16(v0[0], v0[1]); w.y = cvt_pk_bf16(v0[2], v0[3]); w.z = cvt_pk_bf16(v1[0], v1[1]); w.w = cvt_pk_bf16(v1[2], v1[3]);
                    *(u32x4*)(rowp + bj * HALF) = w; } }
    }
};

struct PanelStats {
    unsigned* xbuf;
    unsigned* cnt;
    unsigned* tmo;
    int ntn; float eps;
    unsigned code;
    __device__ __forceinline__ bool run(const f32x4 (&v)[2][2][4][2], const Unit& u, int wr, int wc, int fr, int fq, PG8_LAS unsigned char* lds, int wid, int lane) const {
        typedef float f32x2v __attribute__((ext_vector_type(2)));
        PG8_LAS f32x2v* P = (PG8_LAS f32x2v*)lds;
        PG8_LAS f32x2v* S = (PG8_LAS f32x2v*)(lds + 8192);
        PG8_LAS unsigned* flag = (PG8_LAS unsigned*)(lds + 8192 + 2048);
#pragma unroll
        for (int ai = 0; ai < 2; ++ai)
#pragma unroll
            for (int m = 0; m < 4; ++m) {
                float s = 0.f;
#pragma unroll
                for (int bj = 0; bj < 2; ++bj)
#pragma unroll
                    for (int n = 0; n < 2; ++n) { const f32x4 x = v[ai][bj][m][n]; s += (x[0] + x[1]) + (x[2] + x[3]); }
                s += __shfl_xor(s, 16); s += __shfl_xor(s, 32);
                const float mw = s * (1.0f / 64.0f); float q = 0.f;
#pragma unroll
                for (int bj = 0; bj < 2; ++bj)
#pragma unroll
                    for (int n = 0; n < 2; ++n) { const f32x4 d = v[ai][bj][m][n] - mw; q += (d[0] * d[0] + d[1] * d[1]) + (d[2] * d[2] + d[3] * d[3]); }
                q += __shfl_xor(q, 16); q += __shfl_xor(q, 32);
                if (fq == 0) P[(ai * HALF + wr * 64 + m * 16 + fr) * 4 + wc] = (f32x2v){mw, q};
            }
        asm volatile("s_waitcnt lgkmcnt(0)" ::: "memory"); __builtin_amdgcn_s_barrier(); asm volatile("" ::: "memory");
#if defined(BROKEN_EXCHANGE_NO_WAIT)
#warning BROKEN CONTROL BUILD: the row-statistics exchange does not wait; results are wrong by design
        if (blockIdx.x >= 64) { const long long t0_ = clock64(); while (clock64() - t0_ < 60000) __builtin_amdgcn_s_sleep(8); }
#endif
        const int row = wid * 32 + (lane & 31);
        if (lane < 32) {
            const f32x2v a = P[row * 4 + 0], b = P[row * 4 + 1], c = P[row * 4 + 2], d = P[row * 4 + 3];
            const float mt = (a.x + b.x + c.x + d.x) * 0.25f;
            const float da = a.x - mt, db = b.x - mt, dc = c.x - mt, dd = d.x - mt;
            const float m2 = (a.y + b.y) + (c.y + d.y) + 64.0f * ((da * da + db * db) + (dc * dc + dd * dd));
            unsigned long long* slot = (unsigned long long*)xbuf + ((size_t)(u.pm * BM + row) * 4 + u.pn);
            __hip_atomic_store(slot, ((unsigned long long)__float_as_uint(m2) << 32) | __float_as_uint(mt), __ATOMIC_RELAXED, __HIP_MEMORY_SCOPE_AGENT);
        }
        asm volatile("s_waitcnt vmcnt(0)" ::: "memory");
        if (lane == 0) __hip_atomic_fetch_add(cnt + 64 * u.pm, 1u, __ATOMIC_RELAXED, __HIP_MEMORY_SCOPE_AGENT);
        if (wid == 0) {
            bool dead = false; const unsigned long long t0 = __builtin_amdgcn_s_memrealtime(); const unsigned want = 8u * (unsigned)ntn;
            for (;;) {
#if defined(BROKEN_EXCHANGE_NO_WAIT)
                break;
#endif
                if ((unsigned)__builtin_amdgcn_readfirstlane(__hip_atomic_load(cnt + 64 * u.pm, __ATOMIC_RELAXED, __HIP_MEMORY_SCOPE_AGENT)) >= want) break;
                if (__builtin_amdgcn_s_memrealtime() - t0 > 2000000ull) {
                    if (lane == 0) { unsigned expect = 0u; __hip_atomic_compare_exchange_strong(tmo + 1, &expect, code | (unsigned)(u.pm & 0xff), __ATOMIC_RELAXED, __ATOMIC_RELAXED, __HIP_MEMORY_SCOPE_AGENT);
                                     __hip_atomic_store(tmo, 1u, __ATOMIC_RELAXED, __HIP_MEMORY_SCOPE_AGENT); }
                    dead = true; break; }
                __builtin_amdgcn_s_sleep(2);
            }
            __builtin_amdgcn_fence(__ATOMIC_ACQUIRE, "agent");
            if (lane == 0) flag[0] = dead ? 1u : 0u;
        }
        asm volatile("s_waitcnt vmcnt(0) lgkmcnt(0)" ::: "memory"); __builtin_amdgcn_s_barrier(); asm volatile("" ::: "memory");
        const bool bad = flag[0] != 0u;
        if (lane < 32) {
            const unsigned long long* slot = (const unsigned long long*)xbuf + (size_t)(u.pm * BM + row) * 4; float mt[4], m2[4]; float ms = 0.f;
#pragma unroll
            for (int t = 0; t < 4; ++t) { if (t < ntn) { const unsigned long long w = __hip_atomic_load(slot + t, __ATOMIC_RELAXED, __HIP_MEMORY_SCOPE_AGENT); mt[t] = __uint_as_float((unsigned)w); m2[t] = __uint_as_float((unsigned)(w >> 32)); } else { mt[t] = 0.f; m2[t] = 0.f; } ms += mt[t]; }
            const float mean = ms / (float)ntn; float q = 0.f;
#pragma unroll
            for (int t = 0; t < 4; ++t) if (t < ntn) { const float dm = mt[t] - mean; q += m2[t] + 256.0f * dm * dm; }
            S[row] = (f32x2v){mean, 1.0f / sqrtf(q / (256.0f * (float)ntn) + eps)};
        }
        asm volatile("s_waitcnt lgkmcnt(0)" ::: "memory"); __builtin_amdgcn_s_barrier(); asm volatile("" ::: "memory");
        return bad;
    }
};
struct EpiLnRes {
    static constexpr bool PERM = false, AFTER_DRAIN = true;
    const float* base; float* out; int ldc; const float* bias; PanelStats st; unsigned poison;
    __device__ __forceinline__ void fused(f32x4 (&acc)[2][2][4][2], const Unit& u, int wr, int wc, int fr, int fq, PG8_LAS unsigned char* lds, int wid, int lane) const {
        typedef float f32x2v __attribute__((ext_vector_type(2)));
        const PG8_LAS f32x2v* S = (const PG8_LAS f32x2v*)(lds + 8192);
        const int col0 = u.pn * BM + wc * 32 + 4 * fq;
#pragma unroll
        for (int bj = 0; bj < 2; ++bj)
#pragma unroll
            for (int n = 0; n < 2; ++n) { const f32x4 bv = bias ? *(const f32x4*)(bias + col0 + bj * HALF + n * 16) : (f32x4){0.f, 0.f, 0.f, 0.f};
#pragma unroll
                for (int ai = 0; ai < 2; ++ai)
#pragma unroll
                    for (int m = 0; m < 4; ++m) acc[ai][bj][m][n] += bv; }
        f32x4 pre[4][2][2];
#pragma unroll
        for (int m = 0; m < 4; ++m) { const size_t off = (size_t)(u.pm * BM + wr * 64 + m * 16 + fr) * ldc + col0;
#pragma unroll
            for (int bj = 0; bj < 2; ++bj)
#pragma unroll
                for (int n = 0; n < 2; ++n) pre[m][bj][n] = *(const f32x4*)(base + off + bj * HALF + n * 16); }
        const bool bad = st.run(acc, u, wr, wc, fr, fq, lds, wid, lane) || poison != 0u;
        const float qnan = __builtin_nanf("");
#pragma unroll
        for (int ai = 0; ai < 2; ++ai)
#pragma unroll
            for (int m = 0; m < 4; ++m) { const int r = ai * HALF + wr * 64 + m * 16 + fr; const f32x2v sr = S[r]; const size_t off = (size_t)(u.pm * BM + r) * ldc + col0;
#pragma unroll
                for (int bj = 0; bj < 2; ++bj)
#pragma unroll
                    for (int n = 0; n < 2; ++n) { const f32x4 bs = ai == 0 ? pre[m][bj][n] : *(const f32x4*)(base + off + bj * HALF + n * 16); f32x4 o = bs + (acc[ai][bj][m][n] - sr.x) * sr.y;
                        if (bad) o = (f32x4){qnan, qnan, qnan, qnan}; *(f32x4*)(out + off + bj * HALF + n * 16) = o; }
                if (m & 1) asm volatile("" ::: "memory"); }
    }
};
struct EpiLnResLn {
    static constexpr bool PERM = false, AFTER_DRAIN = true;
    const float* base; float* out; bf16_t* xn; int ldc; const float* bias; PanelStats st1, st2; unsigned poison;
    __device__ __forceinline__ void fused(f32x4 (&acc)[2][2][4][2], const Unit& u, int wr, int wc, int fr, int fq, PG8_LAS unsigned char* lds, int wid, int lane) const {
        typedef float f32x2v __attribute__((ext_vector_type(2))); typedef unsigned u32x2v __attribute__((ext_vector_type(2)));
        const PG8_LAS f32x2v* S = (const PG8_LAS f32x2v*)(lds + 8192);
        const int col0 = u.pn * BM + wc * 32 + 4 * fq;
#pragma unroll
        for (int bj = 0; bj < 2; ++bj)
#pragma unroll
            for (int n = 0; n < 2; ++n) { const f32x4 bv = bias ? *(const f32x4*)(bias + col0 + bj * HALF + n * 16) : (f32x4){0.f, 0.f, 0.f, 0.f};
#pragma unroll
                for (int ai = 0; ai < 2; ++ai)
#pragma unroll
                    for (int m = 0; m < 4; ++m) acc[ai][bj][m][n] += bv; }
        bool bad = st1.run(acc, u, wr, wc, fr, fq, lds, wid, lane) || poison != 0u;
        const float qnan = __builtin_nanf("");
#pragma unroll
        for (int ai = 0; ai < 2; ++ai)
#pragma unroll
            for (int m = 0; m < 4; ++m) { const int r = ai * HALF + wr * 64 + m * 16 + fr; const f32x2v sr = S[r]; const size_t off = (size_t)(u.pm * BM + r) * ldc + col0;
#pragma unroll
                for (int bj = 0; bj < 2; ++bj)
#pragma unroll
                    for (int n = 0; n < 2; ++n) { const f32x4 bs = *(const f32x4*)(base + off + bj * HALF + n * 16); acc[ai][bj][m][n] = bs + (acc[ai][bj][m][n] - sr.x) * sr.y; }
                asm volatile("" : "+v"(acc[ai][0][m][0]), "+v"(acc[ai][0][m][1]), "+v"(acc[ai][1][m][0]), "+v"(acc[ai][1][m][1]));
                if (m & 1) asm volatile("" ::: "memory"); }
        const bool bad1 = bad;
        bad = st2.run(acc, u, wr, wc, fr, fq, lds, wid, lane) || bad;
#pragma unroll
        for (int ai = 0; ai < 2; ++ai)
#pragma unroll
            for (int m = 0; m < 4; ++m) { const int r = ai * HALF + wr * 64 + m * 16 + fr; const f32x2v sr = S[r]; const size_t off = (size_t)(u.pm * BM + r) * ldc + col0;
#pragma unroll
                for (int bj = 0; bj < 2; ++bj)
#pragma unroll
                    for (int n = 0; n < 2; ++n) { const f32x4 x1 = acc[ai][bj][m][n]; *(f32x4*)(out + off + bj * HALF + n * 16) = bad1 ? (f32x4){qnan, qnan, qnan, qnan} : x1;
                        const f32x4 o = (x1 - sr.x) * sr.y; u32x2v w; w.x = cvt_pk_bf16(o[0], o[1]); w.y = cvt_pk_bf16(o[2], o[3]);
                        if (bad) { w.x = 0x7fc07fc0u; w.y = 0x7fc07fc0u; } *(u32x2v*)(xn + off + bj * HALF + n * 16) = w; }
                asm volatile("" ::: "memory"); }
    }
};

template <class Epi, class Sched, bool ALIGN_EPI = false, bool SP2 = false>
__device__ __forceinline__ void gemm_phase(PG8_LAS unsigned char* lds, const Gemm g, const Sched& S, const Epi& E) {
    int tid_ = threadIdx.x; asm volatile("" : "+v"(tid_));
    const int tid = tid_, wid = __builtin_amdgcn_readfirstlane(tid >> 6), lane = tid & 63, wr = wid >> 2, wc = wid & 3, fr = lane & 15, fq = lane >> 4;
    const int K = g.K, nt = K / BK;
    unsigned voffA[2], voffB[2];
#pragma unroll
    for (int i = 0; i < 2; ++i) { int R, C; stage_rc(tid * 16 + i * 8192, R, C); const int Rb = Epi::PERM ? ((R & ~31) + perm32(R & 31)) : R;
        voffA[i] = (unsigned)(R * K + C) * 2u; voffB[i] = (unsigned)(Rb * K + C) * 2u; }
    const size_t kstep = (size_t)(BK * 2);
    const size_t hstep = (size_t)HALF * K * 2;
    const size_t tstep = 2 * hstep;
    const unsigned ldsw = (unsigned)wid * 1024u;
    const int aoff = lds_byte(wr * 64 + fr, fq * 8), boff = lds_byte(wc * 32 + fr, fq * 8);
#define PG8_SA(b, h) (((b) * 2 + (h)) * HTB)
#define PG8_SB(b, h) ((4 + (b) * 2 + (h)) * HTB)
#define PG8_STAGE(bufoff, gbase, voff) do { _Pragma("unroll") for (int _i = 0; _i < 2; ++_i) \
        __builtin_amdgcn_global_load_lds((const unsigned*)((const char*)(gbase) + (voff)[_i]), (PG8_LAS unsigned*)(lds + (bufoff) + ldsw + _i * 8192), 16, 0, 0); } while (0)
#define PG8_LDA(dst, b, h) do { _Pragma("unroll") for (int m = 0; m < 4; ++m) _Pragma("unroll") for (int k = 0; k < 2; ++k) dst[m][k] = *(const PG8_LAS bf16x8*)(lds + PG8_SA(b, h) + aoff + m * 2048 + k * 1024); } while (0)
#define PG8_LDB(dst, b, h) do { _Pragma("unroll") for (int n = 0; n < 2; ++n) _Pragma("unroll") for (int k = 0; k < 2; ++k) dst[n][k] = *(const PG8_LAS bf16x8*)(lds + PG8_SB(b, h) + boff + n * 2048 + k * 1024); } while (0)
#define PG8_MMA(ai, bj, At, Bt) do { __builtin_amdgcn_s_setprio(1); _Pragma("unroll") for (int m = 0; m < 4; ++m) _Pragma("unroll") for (int n = 0; n < 2; ++n) _Pragma("unroll") for (int k = 0; k < 2; ++k) \
        acc[ai][bj][m][n] = __builtin_amdgcn_mfma_f32_16x16x32_bf16(Bt[n][k], At[m][k], acc[ai][bj][m][n], 0, 0, 0); __builtin_amdgcn_s_setprio(0); } while (0)
#define PG8_WAIT_V(n) asm volatile("s_waitcnt vmcnt(" #n ")" ::: "memory")
#define PG8_WAIT_L(n) asm volatile("s_waitcnt lgkmcnt(" #n ")" ::: "memory")
#define PG8_BAR __builtin_amdgcn_s_barrier()
#define PG8_SCHED __builtin_amdgcn_sched_barrier(0)
    Unit cur, nxt; int ui = 0;
    if (!S.next(0, cur)) return;
    f32x4 acc[2][2][4][2];
#pragma unroll
    for (int a = 0; a < 2; ++a)
#pragma unroll
        for (int b = 0; b < 2; ++b)
#pragma unroll
            for (int m = 0; m < 4; ++m)
#pragma unroll
                for (int n = 0; n < 2; ++n) acc[a][b][m][n] = (f32x4){0.f, 0.f, 0.f, 0.f};
    bf16x8 At[4][2], B0[2][2], B1[2][2];
    const char* cA = (const char*)g.A + (size_t)cur.pm * tstep; const char* cB = (const char*)g.Bt + (size_t)cur.pn * tstep;
    S.a_ready(cur);
    if constexpr (SP2) {
        PG8_STAGE(PG8_SB(0, 0), cB, voffB); PG8_STAGE(PG8_SB(0, 1), cB + hstep, voffB); PG8_STAGE(PG8_SA(0, 0), cA, voffA); PG8_STAGE(PG8_SA(0, 1), cA + hstep, voffA);
        if (wr == 1) PG8_BAR;
        PG8_WAIT_V(2); PG8_BAR;
        PG8_STAGE(PG8_SB(1, 0), cB + kstep, voffB); PG8_STAGE(PG8_SA(1, 0), cA + kstep, voffA); PG8_STAGE(PG8_SB(1, 1), cB + hstep + kstep, voffB);
        PG8_WAIT_V(6); PG8_BAR;
    } else {
        PG8_STAGE(PG8_SB(0, 0), cB, voffB); PG8_STAGE(PG8_SA(0, 0), cA, voffA); PG8_STAGE(PG8_SB(0, 1), cB + hstep, voffB); PG8_STAGE(PG8_SA(0, 1), cA + hstep, voffA);
        if (wr == 1) PG8_BAR;
        PG8_WAIT_V(4); PG8_BAR;
        PG8_STAGE(PG8_SB(1, 0), cB + kstep, voffB); PG8_STAGE(PG8_SA(1, 0), cA + kstep, voffA); PG8_STAGE(PG8_SB(1, 1), cB + hstep + kstep, voffB);
        PG8_WAIT_V(6); PG8_BAR;
    }
    for (;;) {
        const bool has_next = S.next(ui + 1, nxt);
        const char* nA = has_next ? (const char*)g.A + (size_t)nxt.pm * tstep : cA; const char* nB = has_next ? (const char*)g.Bt + (size_t)nxt.pn * tstep : cB;
        for (int t = 0; t < nt; t += 2) {
            const bool last = (t == nt - 2);
            const char* a1 = cA + (size_t)(t + 1) * kstep;
            const char* a2 = last ? nA : cA + (size_t)(t + 2) * kstep; const char* b2 = last ? nB : cB + (size_t)(t + 2) * kstep;
            const char* a3 = a2 + kstep; const char* b3 = b2 + kstep;
            if (last && has_next) S.a_ready(nxt);
            if constexpr (SP2) {
            PG8_LDB(B0, 0, 0); PG8_LDB(B1, 0, 1); PG8_SCHED; PG8_LDA(At, 0, 0); PG8_STAGE(PG8_SA(1, 1), a1 + hstep, voffA);
            PG8_WAIT_V(8); PG8_WAIT_L(0); PG8_BAR; PG8_MMA(0, 0, At, B0); PG8_MMA(0, 1, At, B1); PG8_BAR; PG8_SCHED;
            PG8_LDA(At, 0, 1); PG8_STAGE(PG8_SB(0, 0), b2, voffB); PG8_STAGE(PG8_SB(0, 1), b2 + hstep, voffB); PG8_STAGE(PG8_SA(0, 0), a2, voffA);
            PG8_WAIT_V(8); PG8_WAIT_L(0); PG8_BAR; PG8_MMA(1, 0, At, B0); PG8_MMA(1, 1, At, B1); PG8_BAR; PG8_SCHED;
            PG8_LDB(B0, 1, 0); PG8_LDB(B1, 1, 1); PG8_SCHED; PG8_LDA(At, 1, 0); PG8_STAGE(PG8_SA(0, 1), a2 + hstep, voffA);
            PG8_WAIT_V(8); PG8_WAIT_L(0); PG8_BAR; PG8_MMA(0, 0, At, B0); PG8_MMA(0, 1, At, B1); PG8_BAR; PG8_SCHED;
            PG8_LDA(At, 1, 1); PG8_STAGE(PG8_SB(1, 0), b3, voffB); PG8_STAGE(PG8_SB(1, 1), b3 + hstep, voffB); PG8_STAGE(PG8_SA(1, 0), a3, voffA);
            PG8_WAIT_V(8); PG8_WAIT_L(0); PG8_BAR; PG8_MMA(1, 0, At, B0); PG8_MMA(1, 1, At, B1); PG8_BAR; PG8_SCHED;
            } else {
            PG8_LDB(B0, 0, 0); PG8_SCHED; PG8_LDA(At, 0, 0); PG8_STAGE(PG8_SA(1, 1), a1 + hstep, voffA);
            PG8_WAIT_L(8); PG8_BAR; PG8_WAIT_L(0); PG8_MMA(0, 0, At, B0); PG8_BAR; PG8_SCHED;
            PG8_LDB(B1, 0, 1); PG8_STAGE(PG8_SB(0, 0), b2, voffB);
            PG8_BAR; PG8_WAIT_L(0); PG8_MMA(0, 1, At, B1); PG8_BAR;
            PG8_LDA(At, 0, 1); PG8_STAGE(PG8_SA(0, 0), a2, voffA);
            PG8_BAR; PG8_WAIT_L(0); PG8_MMA(1, 0, At, B0); PG8_BAR; PG8_SCHED;
            PG8_STAGE(PG8_SB(0, 1), b2 + hstep, voffB);
            PG8_WAIT_V(6); PG8_BAR; PG8_MMA(1, 1, At, B1); PG8_BAR;
            PG8_LDB(B0, 1, 0); PG8_SCHED; PG8_LDA(At, 1, 0); PG8_STAGE(PG8_SA(0, 1), a2 + hstep, voffA);
            PG8_WAIT_L(8); PG8_BAR; PG8_WAIT_L(0); PG8_MMA(0, 0, At, B0); PG8_BAR; PG8_SCHED;
            PG8_LDB(B1, 1, 1); PG8_STAGE(PG8_SB(1, 0), b3, voffB);
            PG8_BAR; PG8_WAIT_L(0); PG8_MMA(0, 1, At, B1); PG8_BAR;
            PG8_LDA(At, 1, 1); PG8_STAGE(PG8_SA(1, 0), a3, voffA);
            PG8_BAR; PG8_WAIT_L(0); PG8_MMA(1, 0, At, B0); PG8_BAR; PG8_SCHED;
            PG8_STAGE(PG8_SB(1, 1), b3 + hstep, voffB);
            PG8_WAIT_V(6); PG8_BAR; PG8_MMA(1, 1, At, B1); PG8_BAR;
            }
        }
        if constexpr (ALIGN_EPI) { if (wr == 0) PG8_BAR; }
        if constexpr (!Epi::AFTER_DRAIN) { E(acc, cur, wr, wc, fr, fq); S.done(cur); }
        if (!has_next) break;
#pragma unroll
        for (int a = 0; a < 2; ++a)
#pragma unroll
            for (int b = 0; b < 2; ++b)
#pragma unroll
                for (int m = 0; m < 4; ++m)
#pragma unroll
                    for (int n = 0; n < 2; ++n) acc[a][b][m][n] = (f32x4){0.f, 0.f, 0.f, 0.f};
        cur = nxt; cA = nA; cB = nB; ++ui;
        if constexpr (ALIGN_EPI) { if (wr == 1) PG8_BAR; }
    }
    PG8_WAIT_V(0);
    if constexpr (!ALIGN_EPI) { if (wr == 0) PG8_BAR; }
    PG8_BAR;
    if constexpr (Epi::AFTER_DRAIN) { E.fused(acc, cur, wr, wc, fr, fq, lds, wid, lane); S.done(cur); }
#undef PG8_SA
#undef PG8_SB
#undef PG8_STAGE
#undef PG8_LDA
#undef PG8_LDB
#undef PG8_MMA
#undef PG8_WAIT_V
#undef PG8_WAIT_L
#undef PG8_BAR
#undef PG8_SCHED
}
}

#define LAS __attribute__((address_space(3)))
typedef unsigned short bf16;
typedef float f32x4 __attribute__((ext_vector_type(4)));
typedef float f32x2 __attribute__((ext_vector_type(2)));
typedef short bf16x8 __attribute__((ext_vector_type(8)));
typedef short s16x4 __attribute__((ext_vector_type(4)));
typedef short v4i16_t __attribute__((ext_vector_type(4)));
typedef unsigned u32x4 __attribute__((ext_vector_type(4)));
typedef unsigned u32x2 __attribute__((ext_vector_type(2)));

constexpr int NWAVES = 8, NTHREADS = 512;
constexpr int DM = 1024, SEQ = 4096, NBATCH = 4, MP = NBATCH * SEQ, NSMP = 32, MV = MP + NSMP, MT = 16640;
constexpr int DIN = 7680, QKV = 1536, DFF = 2816, NADA = 6144;
constexpr size_t O_YP = 0, O_YS = 16777216, O_KV0P = 16809984, O_KV1P = 17858560, O_KV2P = 22052864,
                 O_KV0S = 38830080, O_KV1S = 38895616, O_KV2S = 38961152, O_SV = 39026688, O_END = 39059456;
constexpr float LOG2E = 1.4426950408889634f;
constexpr float QSCALE = 0.08838834764831845f * LOG2E;

constexpr size_t MiB = 1u << 20;
constexpr size_t alm(size_t x) { return (x + MiB - 1) / MiB * MiB; }
constexpr size_t WS_WADA = 1 * MiB;
constexpr size_t WS_WL0 = WS_WADA + alm(2ull * NADA * DM * 2);
constexpr size_t WL_WIN = 0;
constexpr size_t WL_WPA = WL_WIN + alm((size_t)DIN * DM * 2);
constexpr size_t WL_WPS = WL_WPA + alm(1024ull * 512 * 2);
constexpr size_t WL_WOUT = WL_WPS + alm(1024ull * 512 * 2);
constexpr size_t WL_WFI = WL_WOUT + alm(1024ull * 1024 * 2);
constexpr size_t WL_WFO = WL_WFI + alm(5632ull * 1024 * 2);
constexpr size_t WL_WSP = WL_WFO + alm(1024ull * DFF * 2);
constexpr size_t WL_SIZE = WL_WSP + alm(8ull * 128 * 128 * 2);
constexpr size_t WS_MOD = WS_WL0 + 2 * WL_SIZE;
constexpr size_t WS_SC = WS_MOD + alm(2ull * 36 * NADA * 4);
constexpr size_t WS_XN = WS_SC + alm(256ull * DM * 2);
constexpr size_t WS_Q = WS_XN + alm((size_t)MT * DM * 2);
constexpr size_t WS_K = WS_Q + alm((size_t)MT * QKV * 2);
constexpr size_t WS_V = WS_K + alm((size_t)MT * QKV * 2);
constexpr size_t WS_U = WS_V + alm((size_t)MT * QKV * 2);
constexpr size_t WS_VS = WS_U + alm((size_t)MT * 512 * 2);
constexpr size_t WS_G = WS_VS + alm((size_t)MT * 512 * 2);
constexpr size_t WS_OG = WS_G + alm((size_t)MT * 2048 * 2);
constexpr size_t WS_DG = WS_OG + alm((size_t)MT * QKV * 2);
constexpr size_t WS_YA = WS_DG + alm((size_t)MT * 12 * 4);
constexpr size_t WS_YS = WS_YA + alm((size_t)MT * 512 * 2);
constexpr size_t WS_T1 = WS_YS + alm((size_t)MT * 512 * 2);
constexpr size_t WS_MG = WS_T1 + alm((size_t)MT * DM * 4);
constexpr size_t WS_X1 = WS_MG + alm((size_t)MT * DM * 2);
constexpr size_t WS_X2 = WS_X1 + alm((size_t)MT * DM * 4);
constexpr size_t WS_H = WS_X2 + alm((size_t)MT * DM * 4);
constexpr size_t WS_END = WS_H + alm((size_t)MT * DFF * 2);

constexpr int LDS_RING = 0, LDS_EXCH = 131072, LDS_BYTES = 155648;

__device__ __forceinline__ float bf2f(unsigned short h) { return __uint_as_float((unsigned)h << 16); }
__device__ __forceinline__ unsigned pk2(float lo, float hi) { return pg8::cvt_pk_bf16(lo, hi); }
__device__ __forceinline__ float fast_exp2(float x) { return __builtin_amdgcn_exp2f(x); }
__device__ __forceinline__ float sigmoidf_(float x) { return __builtin_amdgcn_rcpf(1.0f + fast_exp2(-x * LOG2E)); }
__device__ __forceinline__ float wave_sum(float v) {
#pragma unroll
    for (int o = 1; o < 64; o <<= 1) v += __shfl_xor(v, o);
    return v;
}
__device__ __forceinline__ float wave_max(float v) {
#pragma unroll
    for (int o = 1; o < 64; o <<= 1) v = fmaxf(v, __shfl_xor(v, o));
    return v;
}
__device__ __forceinline__ s16x4 vtr(const LAS unsigned char* p) { return __builtin_bit_cast(s16x4, __builtin_amdgcn_ds_read_tr16_b64_v4i16((LAS v4i16_t*)p)); }
#define LDS_WAIT() asm volatile("s_waitcnt lgkmcnt(0)" ::: "memory")

__device__ __forceinline__ int mod_row(int row) { return row < MP ? (row >> 12) : 4 + (row - MP); }

__device__ __forceinline__ __attribute__((address_space(1))) float* kv_out_ptr(__attribute__((address_space(1))) float* out, int layer, int g, int row, int kvi, int hh) {
    if (row < MP) {
        const int b = row >> 12, t = row & 4095, lw = 128 << (2 * g), tt = t - (SEQ - lw);
        if (tt < 0) return nullptr;
        const size_t base = g == 0 ? O_KV0P : (g == 1 ? O_KV1P : O_KV2P);
        return out + base + ((((size_t)(layer * NBATCH + b) * lw + tt) * 2 + kvi) * 4 + hh) * 128;
    } else if (row < MV) {
        const int b = row - MP;
        const size_t base = g == 0 ? O_KV0S : (g == 1 ? O_KV1S : O_KV2S);
        return out + base + (((size_t)(layer * NSMP + b) * 2 + kvi) * 4 + hh) * 128;
    }
    return nullptr;
}

using pg8::Unit;
typedef pg8::f32x4 (AccT)[2][2][4][2];

__device__ __forceinline__ void st8_bf16g(__attribute__((address_space(1))) bf16* p, f32x4 v0, f32x4 v1) {
    u32x4 w; w.x = pk2(v0[0], v0[1]); w.y = pk2(v0[2], v0[3]); w.z = pk2(v1[0], v1[1]); w.w = pk2(v1[2], v1[3]);
    *(__attribute__((address_space(1))) u32x4*)p = w;
}
__device__ __forceinline__ void st8_bf16(bf16* p, f32x4 v0, f32x4 v1) {
    u32x4 w; w.x = pk2(v0[0], v0[1]); w.y = pk2(v0[2], v0[3]); w.z = pk2(v1[0], v1[1]); w.w = pk2(v1[2], v1[3]);
    *(u32x4*)p = w;
}

#define LAUNDER_S(x) asm volatile("" : "+s"(x))
#define GP(T, p) ((T*)(__attribute__((address_space(1))) T*)(p))
struct EpiAda {
    static constexpr bool PERM = true, AFTER_DRAIN = false;
    float* MOD; const float* b_ada;
    __device__ __forceinline__ void operator()(const pg8::f32x4 (&acc)[2][2][4][2], const Unit& u, int wr, int wc, int fr_, int fq_) const {
        int fr = fr_, fq = fq_; asm volatile("" : "+v"(fr), "+v"(fq));
        if (u.pm != 0 || wr != 0) return;
#pragma unroll
        for (int m = 0; m < 3; ++m) {
            const int row = m * 16 + fr;
            if (row >= 36) continue;
#pragma unroll
            for (int bj = 0; bj < 2; ++bj) {
                const int col = u.pn * 256 + bj * 128 + wc * 32 + 8 * fq;
                const int layer = col / NADA, c = col - layer * NADA;
                const float* bp = b_ada + (size_t)layer * NADA + c;
                float* op = MOD + ((size_t)layer * 36 + row) * NADA + c;
                *(f32x4*)op = acc[0][bj][m][0] + *(const f32x4*)bp;
                *(f32x4*)(op + 4) = acc[0][bj][m][1] + *(const f32x4*)(bp + 4);
            }
        }
    }
};

struct EpiIn {
    static constexpr bool PERM = true, AFTER_DRAIN = false;
    unsigned char* wsb; const float* qw; const float* kw; float* out; int layer; LAS float* P;
    __device__ __forceinline__ void operator()(const pg8::f32x4 (&acc)[2][2][4][2], const Unit& u, int wr, int wc, int fr_, int fq_) const {
        int fr = fr_, fq = fq_; asm volatile("" : "+v"(fr), "+v"(fq));
        unsigned char* wsl = wsb; const float* qwl = qw; const float* kwl = kw; float* outl = out; LAUNDER_S(wsl); LAUNDER_S(qwl); LAUNDER_S(kwl); LAUNDER_S(outl);
        typedef __attribute__((address_space(1))) bf16 gbf; typedef __attribute__((address_space(1))) float gfl;
        gbf *Q = (gbf*)(wsl + WS_Q), *K = (gbf*)(wsl + WS_K), *V = (gbf*)(wsl + WS_V), *U = (gbf*)(wsl + WS_U), *VS = (gbf*)(wsl + WS_VS), *G = (gbf*)(wsl + WS_G);
        gfl* outg = (gfl*)outl;
        const int pn = u.pn;
        const int cw = wc * 32 + 8 * fq;
        const int rowb = u.pm * 256 + wr * 64 + fr;
        if (pn < 12) {
            const bool isk = pn >= 6;
#pragma unroll
            for (int ai = 0; ai < 2; ++ai)
#pragma unroll
                for (int m = 0; m < 4; ++m)
#pragma unroll
                    for (int bj = 0; bj < 2; ++bj) {
                        const pg8::f32x4 a = acc[ai][bj][m][0], b = acc[ai][bj][m][1];
                        float s = (a[0] * a[0] + a[1] * a[1]) + (a[2] * a[2] + a[3] * a[3]) + (b[0] * b[0] + b[1] * b[1]) + (b[2] * b[2] + b[3] * b[3]);
                        s += __shfl_xor(s, 16); s += __shfl_xor(s, 32);
                        if (fq == 0) P[(ai * 128 + wr * 64 + m * 16 + fr) * 8 + bj * 4 + wc] = s;
                    }
            asm volatile("s_waitcnt lgkmcnt(0)" ::: "memory"); __builtin_amdgcn_s_barrier(); asm volatile("" ::: "memory");
#pragma unroll
            for (int bj = 0; bj < 2; ++bj) {
                const int head = 2 * (isk ? pn - 6 : pn) + bj, g = head >> 2, hh = head & 3;
                const __attribute__((address_space(1))) float* wv = (const __attribute__((address_space(1))) float*)(isk ? kwl : qwl) + g * 128 + cw;
                pg8::f32x4 w0 = *(const __attribute__((address_space(1))) f32x4*)wv, w1 = *(const __attribute__((address_space(1))) f32x4*)(wv + 4);
                if (!isk) { w0 = w0 * QSCALE; w1 = w1 * QSCALE; }
                gbf* dst = (isk ? K : Q) + head * 128 + cw;
#pragma unroll
                for (int ai = 0; ai < 2; ++ai)
#pragma unroll
                    for (int m = 0; m < 4; ++m) {
                        const int rl = ai * 128 + wr * 64 + m * 16 + fr, row = u.pm * 256 + rl;
                        const f32x4 pv = *(const LAS f32x4*)(P + rl * 8 + bj * 4);
                        const float rstd = 1.0f / sqrtf(((pv[0] + pv[1]) + (pv[2] + pv[3])) * (1.0f / 128.0f) + 1e-6f);
                        const pg8::f32x4 v0 = acc[ai][bj][m][0] * rstd * w0, v1 = acc[ai][bj][m][1] * rstd * w1;
                        st8_bf16g(dst + (size_t)row * QKV, v0, v1);
                        if (isk) { gfl* o = kv_out_ptr(outg, layer, g, row, 0, hh); if (o) { *(__attribute__((address_space(1))) f32x4*)(o + cw) = v0; *(__attribute__((address_space(1))) f32x4*)(o + cw + 4) = v1; } }
                    }
            }
        } else if (pn < 18) {
#pragma unroll
            for (int bj = 0; bj < 2; ++bj) {
                const int head = 2 * (pn - 12) + bj, g = head >> 2, hh = head & 3;
                gbf* dst = V + head * 128 + cw;
#pragma unroll
                for (int ai = 0; ai < 2; ++ai)
#pragma unroll
                    for (int m = 0; m < 4; ++m) {
                        const int row = rowb + ai * 128 + m * 16;
                        const pg8::f32x4 v0 = acc[ai][bj][m][0], v1 = acc[ai][bj][m][1];
                        st8_bf16g(dst + (size_t)row * QKV, v0, v1);
                        gfl* o = kv_out_ptr(outg, layer, g, row, 1, hh); if (o) { *(__attribute__((address_space(1))) f32x4*)(o + cw) = v0; *(__attribute__((address_space(1))) f32x4*)(o + cw + 4) = v1; }
                    }
            }
        } else if (pn < 22) {
            gbf* base = (pn < 20 ? U : VS) + ((pn - 18) & 1) * 256 + cw;
#pragma unroll
            for (int bj = 0; bj < 2; ++bj)
#pragma unroll
                for (int ai = 0; ai < 2; ++ai)
#pragma unroll
                    for (int m = 0; m < 4; ++m) {
                        const int row = rowb + ai * 128 + m * 16;
                        const pg8::f32x4 v0 = acc[ai][bj][m][0], v1 = acc[ai][bj][m][1];
                        const pg8::f32x2 a = pg8::gelu_pk((pg8::f32x2){v0[0], v0[1]}), b = pg8::gelu_pk((pg8::f32x2){v0[2], v0[3]}),
                                         c = pg8::gelu_pk((pg8::f32x2){v1[0], v1[1]}), d = pg8::gelu_pk((pg8::f32x2){v1[2], v1[3]});
                        st8_bf16g(base + (size_t)row * 512 + bj * 128, (f32x4){a.x, a.y, b.x, b.y}, (f32x4){c.x, c.y, d.x, d.y});
                    }
        } else {
            gbf* base = G + (pn - 22) * 256 + cw;
#pragma unroll
            for (int bj = 0; bj < 2; ++bj)
#pragma unroll
                for (int ai = 0; ai < 2; ++ai)
#pragma unroll
                    for (int m = 0; m < 4; ++m) {
                        const int row = rowb + ai * 128 + m * 16;
                        const pg8::f32x4 v0 = acc[ai][bj][m][0], v1 = acc[ai][bj][m][1];
                        st8_bf16g(base + (size_t)row * 2048 + bj * 128,
                                 (f32x4){sigmoidf_(v0[0]), sigmoidf_(v0[1]), sigmoidf_(v0[2]), sigmoidf_(v0[3])},
                                 (f32x4){sigmoidf_(v1[0]), sigmoidf_(v1[1]), sigmoidf_(v1[2]), sigmoidf_(v1[3])});
                    }
        }
    }
};

struct EpiGate1 {
    static constexpr bool PERM = true, AFTER_DRAIN = false;
    const bf16* G; float* T1;
    __device__ __forceinline__ void operator()(const pg8::f32x4 (&acc)[2][2][4][2], const Unit& u, int wr, int wc, int fr_, int fq_) const {
        int fr = fr_, fq = fq_; asm volatile("" : "+v"(fr), "+v"(fq));
        const int col0 = u.pn * 256 + wc * 32 + 8 * fq, rowb = u.pm * 256 + wr * 64 + fr;
#pragma unroll
        for (int ai = 0; ai < 2; ++ai)
#pragma unroll
            for (int m = 0; m < 4; ++m) {
                const int row = rowb + ai * 128 + m * 16;
#pragma unroll
                for (int bj = 0; bj < 2; ++bj) {
                    const int col = col0 + bj * 128;
                    const u32x4 gv = *(const u32x4*)(G + (size_t)row * 2048 + col);
                    const f32x4 g0 = {__uint_as_float(gv.x << 16), __uint_as_float(gv.x & 0xffff0000u), __uint_as_float(gv.y << 16), __uint_as_float(gv.y & 0xffff0000u)};
                    const f32x4 g1 = {__uint_as_float(gv.z << 16), __uint_as_float(gv.z & 0xffff0000u), __uint_as_float(gv.w << 16), __uint_as_float(gv.w & 0xffff0000u)};
                    float* o = T1 + (size_t)row * DM + col;
                    *(f32x4*)o = g0 * acc[ai][bj][m][0]; *(f32x4*)(o + 4) = g1 * acc[ai][bj][m][1];
                }
            }
    }
};
struct EpiGate2 {
    static constexpr bool PERM = true, AFTER_DRAIN = false;
    const bf16* G; const float* T1; bf16* MG;
    __device__ __forceinline__ void operator()(const pg8::f32x4 (&acc)[2][2][4][2], const Unit& u, int wr, int wc, int fr_, int fq_) const {
        int fr = fr_, fq = fq_; asm volatile("" : "+v"(fr), "+v"(fq));
        const int col0 = u.pn * 256 + wc * 32 + 8 * fq, rowb = u.pm * 256 + wr * 64 + fr;
#pragma unroll
        for (int ai = 0; ai < 2; ++ai)
#pragma unroll
            for (int m = 0; m < 4; ++m) {
                const int row = rowb + ai * 128 + m * 16;
#pragma unroll
                for (int bj = 0; bj < 2; ++bj) {
                    const int col = col0 + bj * 128;
                    const u32x4 gv = *(const u32x4*)(G + (size_t)row * 2048 + 1024 + col);
                    const f32x4 g0 = {__uint_as_float(gv.x << 16), __uint_as_float(gv.x & 0xffff0000u), __uint_as_float(gv.y << 16), __uint_as_float(gv.y & 0xffff0000u)};
                    const f32x4 g1 = {__uint_as_float(gv.z << 16), __uint_as_float(gv.z & 0xffff0000u), __uint_as_float(gv.w << 16), __uint_as_float(gv.w & 0xffff0000u)};
                    const float* t = T1 + (size_t)row * DM + col;
                    const f32x4 t0 = *(const f32x4*)t, t1 = *(const f32x4*)(t + 4);
                    st8_bf16(MG + (size_t)row * DM + col, t0 + g0 * acc[ai][bj][m][0], t1 + g1 * acc[ai][bj][m][1]);
                }
            }
    }
};
struct EpiRes {
    static constexpr bool PERM = true, AFTER_DRAIN = false;
    const float* bp; const float* bs; float* op; float* os; const float* gate;
    __device__ __forceinline__ void operator()(const pg8::f32x4 (&acc)[2][2][4][2], const Unit& u, int wr, int wc, int fr_, int fq_) const {
        int fr = fr_, fq = fq_; asm volatile("" : "+v"(fr), "+v"(fq));
        const int col0 = u.pn * 256 + wc * 32 + 8 * fq, rowb = u.pm * 256 + wr * 64 + fr;
#pragma unroll
        for (int ai = 0; ai < 2; ++ai)
#pragma unroll
            for (int m = 0; m < 4; ++m) {
                const int row = rowb + ai * 128 + m * 16;
                if (row < MV) {
                    const float* b = row < MP ? bp + (size_t)row * DM : bs + (size_t)(row - MP) * DM;
                    float* o = row < MP ? op + (size_t)row * DM : os + (size_t)(row - MP) * DM;
                    const float* gt = gate + (size_t)mod_row(row) * NADA;
#pragma unroll
                    for (int bj = 0; bj < 2; ++bj) {
                        const int col = col0 + bj * 128;
                        const f32x4 b0 = *(const f32x4*)(b + col), b1 = *(const f32x4*)(b + col + 4);
                        const f32x4 g0 = *(const f32x4*)(gt + col), g1 = *(const f32x4*)(gt + col + 4);
                        *(f32x4*)(o + col) = b0 + g0 * acc[ai][bj][m][0]; *(f32x4*)(o + col + 4) = b1 + g1 * acc[ai][bj][m][1];
                    }
                }
            }
    }
};
struct EpiSwiglu {
    static constexpr bool PERM = true, AFTER_DRAIN = false;
    bf16* H;
    __device__ __forceinline__ void operator()(const pg8::f32x4 (&acc)[2][2][4][2], const Unit& u, int wr, int wc, int fr_, int fq_) const {
        int fr = fr_, fq = fq_; asm volatile("" : "+v"(fr), "+v"(fq));
        const int col = u.pn * 128 + wc * 32 + 8 * fq, rowb = u.pm * 256 + wr * 64 + fr;
#pragma unroll
        for (int ai = 0; ai < 2; ++ai)
#pragma unroll
            for (int m = 0; m < 4; ++m) {
                const int row = rowb + ai * 128 + m * 16;
                f32x4 r0, r1;
#pragma unroll
                for (int e = 0; e < 4; ++e) {
                    const float a0 = acc[ai][0][m][0][e], a1 = acc[ai][0][m][1][e];
                    r0[e] = a0 * sigmoidf_(a0) * acc[ai][1][m][0][e];
                    r1[e] = a1 * sigmoidf_(a1) * acc[ai][1][m][1][e];
                }
                st8_bf16(H + (size_t)row * DFF + col, r0, r1);
            }
    }
};

__device__ __forceinline__ void transpose_item(const float* W, int K, int N, bf16* WT, int mode, LAS float* scr, int item, int lane) {
    const int nblk = N / 32, kb = item / nblk, nb = item % nblk, k0 = 64 * kb, n0 = 32 * nb;
#pragma unroll 8
    for (int i = 0; i < 32; ++i) { const int kk = 2 * i + (lane >> 5); scr[kk * 33 + (lane & 31)] = W[(size_t)(k0 + kk) * N + n0 + (lane & 31)]; }
    LDS_WAIT(); asm volatile("" ::: "memory");
    int drow0 = n0;
    if (mode == 1) { const int bj = n0 >= DFF ? 1 : 0; const int j0 = n0 - bj * DFF; drow0 = (j0 >> 7) * 256 + bj * 128 + (j0 & 127); }
    const int c = lane & 7;
#pragma unroll
    for (int j = 0; j < 4; ++j) { const int n = (lane >> 3) + 8 * j; const LAS float* s = scr + (8 * c) * 33 + n;
        u32x4 o; o.x = pk2(s[0 * 33], s[1 * 33]); o.y = pk2(s[2 * 33], s[3 * 33]); o.z = pk2(s[4 * 33], s[5 * 33]); o.w = pk2(s[6 * 33], s[7 * 33]);
        *(u32x4*)(WT + (size_t)(drow0 + n) * K + k0 + 8 * c) = o; }
    LDS_WAIT(); asm volatile("" ::: "memory");
}

__device__ __forceinline__ void norm_mod_phase(const float* xp, const float* xs, const float* nw, const float* modl, int sh_off, bf16* XN, int gw, int NGW, int lane) {
    for (int row = gw; row < MT; row += NGW) {
        unsigned long long* o8 = (unsigned long long*)(XN + (size_t)row * DM) + lane;
        if (row >= MV) {
#pragma unroll
            for (int j = 0; j < 4; ++j) o8[64 * j] = 0ull;
            continue;
        }
        const float* xrow = row < MP ? xp + (size_t)row * DM : xs + (size_t)(row - MP) * DM;
        const f32x4* xr = (const f32x4*)xrow + lane;
        f32x4 v[4]; float s = 0.f;
#pragma unroll
        for (int j = 0; j < 4; ++j) { v[j] = xr[64 * j]; s += (v[j].x * v[j].x + v[j].y * v[j].y) + (v[j].z * v[j].z + v[j].w * v[j].w); }
        const float rstd = 1.0f / sqrtf(wave_sum(s) * (1.0f / DM) + 1e-6f);
        const float* mr = modl + (size_t)mod_row(row) * NADA + sh_off;
#pragma unroll
        for (int j = 0; j < 4; ++j) {
            const int col = 4 * lane + 256 * j;
            const f32x4 w = *(const f32x4*)(nw + col), shv = *(const f32x4*)(mr + col), scv = *(const f32x4*)(mr + 1024 + col);
            const f32x4 y = v[j] * rstd * w * (scv + 1.0f) + shv;
            o8[64 * j] = (unsigned long long)pk2(y.x, y.y) | ((unsigned long long)pk2(y.z, y.w) << 32);
        }
    }
}

constexpr int KV_STRIDE = 272;
constexpr int ATT_K_OFF = 0, ATT_V_OFF = 256 * KV_STRIDE;
__device__ __forceinline__ float alibi_slope(int head12) { return exp2f(-8.0f * (float)(head12 + 1) / 12.0f); }

__device__ __forceinline__ void attn_unit(LAS unsigned char* lds, const bf16* Q, const bf16* K, const bf16* V, bf16* OG, float* DG, int unit, float cshift, int wid, int lane, int tid) {
    const int g = unit >> 9, r9 = unit & 511, sh = 2 * g, d = 1 << sh, nb = 32 >> sh;
    const int qb = r9 % nb; int t2 = r9 / nb; const int r = t2 % d; t2 /= d; const int h = t2 & 3, b = t2 >> 2;
    const int hc = (g * 4 + h) * 128;
    {
        const int ch = tid & 15, r0 = tid >> 4;
        u32x4 kv[8], vv[8];
#pragma unroll
        for (int it = 0; it < 8; ++it) {
            const int j = r0 + 32 * it, mk = 128 * qb - 128 + j;
            if (qb > 0 || it >= 4) {
                const size_t off = ((size_t)b * SEQ + (size_t)mk * d + r) * QKV + hc + ch * 8;
                kv[it] = *(const u32x4*)(K + off); vv[it] = *(const u32x4*)(V + off);
            } else { kv[it] = (u32x4){0u, 0u, 0u, 0u}; vv[it] = (u32x4){0u, 0u, 0u, 0u}; }
        }
#pragma unroll
        for (int it = 0; it < 8; ++it) {
            const int j = r0 + 32 * it;
            *(LAS u32x4*)(lds + ATT_K_OFF + j * KV_STRIDE + ch * 16) = kv[it];
            *(LAS u32x4*)(lds + ATT_V_OFF + j * KV_STRIDE + ch * 16) = vv[it];
        }
    }
    const int ql = lane & 15, gq = lane >> 4;
    const int qi = 16 * wid + ql;
    const size_t qrow = (size_t)b * SEQ + (size_t)(128 * qb + qi) * d + r;
    bf16x8 qf[4];
#pragma unroll
    for (int kk = 0; kk < 4; ++kk) qf[kk] = *(const bf16x8*)(Q + qrow * QKV + hc + 32 * kk + 8 * gq);
    const float slope2 = alibi_slope(g * 4 + h) * LOG2E * (float)d;
    __syncthreads();
    f32x4 accO[8];
#pragma unroll
    for (int dt = 0; dt < 8; ++dt) accO[dt] = (f32x4){0.f, 0.f, 0.f, 0.f};
    float dsum = 0.f;
    const LAS unsigned char* kbase = lds + ATT_K_OFF + (16 * wid + ql) * KV_STRIDE + gq * 16;
    const LAS unsigned char* vbase = lds + ATT_V_OFF + (16 * wid + 4 * gq + (ql >> 2)) * KV_STRIDE + (ql & 3) * 8;
#pragma unroll
    for (int kt2 = 0; kt2 < 5; ++kt2) {
        const int ja = 16 * wid + 32 * kt2;
        f32x4 sa = {0.f, 0.f, 0.f, 0.f}, sb = {0.f, 0.f, 0.f, 0.f};
#pragma unroll
        for (int kk = 0; kk < 4; ++kk) {
            const bf16x8 ka = *(const LAS bf16x8*)(kbase + (32 * kt2) * KV_STRIDE + kk * 64);
            sa = __builtin_amdgcn_mfma_f32_16x16x32_bf16(ka, qf[kk], sa, 0, 0, 0);
        }
        if (kt2 < 4) {
#pragma unroll
            for (int kk = 0; kk < 4; ++kk) {
                const bf16x8 kb = *(const LAS bf16x8*)(kbase + (32 * kt2 + 16) * KV_STRIDE + kk * 64);
                sb = __builtin_amdgcn_mfma_f32_16x16x32_bf16(kb, qf[kk], sb, 0, 0, 0);
            }
        }
        float pa[4], pb[4];
#pragma unroll
        for (int jj = 0; jj < 4; ++jj) {
            const int j = ja + 4 * gq + jj, dist = 128 + qi - j;
            const bool ok = dist >= 0 && dist <= 128 && (128 * qb - 128 + j) >= 0;
            pa[jj] = ok ? fast_exp2(sa[jj] - slope2 * (float)dist - cshift) : 0.f;
            const int j2 = j + 16, dist2 = dist - 16;
            const bool ok2 = (kt2 < 4) && dist2 >= 0 && dist2 <= 128 && (128 * qb - 128 + j2) >= 0;
            pb[jj] = ok2 ? fast_exp2(sb[jj] - slope2 * (float)dist2 - cshift) : 0.f;
            dsum += pa[jj] + pb[jj];
        }
        u32x4 pw; pw.x = pk2(pa[0], pa[1]); pw.y = pk2(pa[2], pa[3]); pw.z = pk2(pb[0], pb[1]); pw.w = pk2(pb[2], pb[3]);
        const bf16x8 pfrag = __builtin_bit_cast(bf16x8, pw);
        const int rb = (kt2 < 4) ? (32 * kt2 + 16) : (32 * kt2);
#pragma unroll
        for (int dt = 0; dt < 8; ++dt) {
            const s16x4 lo = vtr(vbase + (32 * kt2) * KV_STRIDE + dt * 32);
            const s16x4 hi = vtr(vbase + rb * KV_STRIDE + dt * 32);
            const bf16x8 vf = {lo[0], lo[1], lo[2], lo[3], hi[0], hi[1], hi[2], hi[3]};
            accO[dt] = __builtin_amdgcn_mfma_f32_16x16x32_bf16(vf, pfrag, accO[dt], 0, 0, 0);
        }
    }
    dsum += __shfl_xor(dsum, 16); dsum += __shfl_xor(dsum, 32);
    const float inv = 1.0f / dsum;
    bf16* op = OG + qrow * QKV + g * 512 + h * 128 + 4 * gq;
#pragma unroll
    for (int dt = 0; dt < 8; ++dt) {
        u32x2 w; w.x = pk2(accO[dt][0] * inv, accO[dt][1] * inv); w.y = pk2(accO[dt][2] * inv, accO[dt][3] * inv);
        *(u32x2*)(op + dt * 16) = w;
    }
    if (gq == 0) DG[qrow * 12 + g * 4 + h] = dsum;
    __syncthreads();
}

__device__ __forceinline__ void attn_sample_item(LAS unsigned char* lds, const bf16* Q, const bf16* K, const bf16* V, const float* c0, const float* c1, const float* c2, int layer, bf16* YA, int item, int wid, int lane, int tid) {
    const int b = item >> 2, h = item & 3;
    LAS float* sc = (LAS float*)lds;
    LAS float* qs = (LAS float*)(lds + 2048);
    LAS float* part = (LAS float*)(lds + 4096);
    LAS float* pself = (LAS float*)(lds + 8192);
    const size_t row = (size_t)MP + b;
    if (tid < 384) { const int g = tid >> 7, dd = tid & 127; qs[tid] = bf2f(Q[row * QKV + (g * 4 + h) * 128 + dd]); }
    LDS_WAIT(); __syncthreads();
    const int k = lane >> 2, qd = lane & 3;
    {
        f32x4 kv[3][8];
#pragma unroll
        for (int i = 0; i < 3; ++i) {
            const int jj = 16 * (wid + 8 * i) + k, g = (wid + 8 * i) >> 3  , step = (jj & 127) + 1, d = 1 << (2 * g), lc = 128 << (2 * g);
            const float* cp = (g == 0 ? c0 : (g == 1 ? c1 : c2)) + ((((size_t)(layer * NSMP + b) * lc + (lc - d * step)) * 2 + 0) * 4 + h) * 128 + qd * 32;
#pragma unroll
            for (int e = 0; e < 8; ++e) kv[i][e] = *(const f32x4*)(cp + 4 * e);
        }
#pragma unroll
        for (int i = 0; i < 3; ++i) {
            const int jj = 16 * (wid + 8 * i) + k, g = i, step = (jj & 127) + 1, d = 1 << (2 * g);
            float s = 0.f;
#pragma unroll
            for (int e = 0; e < 8; ++e) { const f32x4 qv = *(const LAS f32x4*)(qs + g * 128 + qd * 32 + 4 * e); s += (kv[i][e].x * qv.x + kv[i][e].y * qv.y) + (kv[i][e].z * qv.z + kv[i][e].w * qv.w); }
            s += __shfl_xor(s, 1); s += __shfl_xor(s, 2);
            s -= alibi_slope(g * 4 + h) * LOG2E * (float)(d * step);
            if (qd == 0) sc[g * 132 + step] = s;
        }
        if (wid < 3) {
            const unsigned kk = *(const unsigned*)(K + row * QKV + (wid * 4 + h) * 128 + 2 * lane);
            float s = __uint_as_float(kk << 16) * qs[wid * 128 + 2 * lane] + __uint_as_float(kk & 0xffff0000u) * qs[wid * 128 + 2 * lane + 1];
            s = wave_sum(s);
            if (lane == 0) sc[wid * 132] = s;
        }
    }
    LDS_WAIT(); __syncthreads();
    float mx = -3.0e38f;
    for (int j = lane; j < 387; j += 64) { const int g = j / 129; mx = fmaxf(mx, sc[g * 132 + (j - g * 129)]); }
    mx = wave_max(mx);
    float den = 0.f;
    for (int j = lane; j < 387; j += 64) { const int g = j / 129; den += fast_exp2(sc[g * 132 + (j - g * 129)] - mx); }
    den = wave_sum(den);
    {
        f32x4 vv[3][8];
#pragma unroll
        for (int i = 0; i < 3; ++i) {
            const int jj = 16 * (wid + 8 * i) + k, g = i, step = (jj & 127) + 1, d = 1 << (2 * g), lc = 128 << (2 * g);
            const float* cp = (g == 0 ? c0 : (g == 1 ? c1 : c2)) + ((((size_t)(layer * NSMP + b) * lc + (lc - d * step)) * 2 + 1) * 4 + h) * 128 + qd * 32;
#pragma unroll
            for (int e = 0; e < 8; ++e) vv[i][e] = *(const f32x4*)(cp + 4 * e);
        }
        f32x4 acc[8];
#pragma unroll
        for (int e = 0; e < 8; ++e) acc[e] = (f32x4){0.f, 0.f, 0.f, 0.f};
#pragma unroll
        for (int i = 0; i < 3; ++i) {
            const int jj = 16 * (wid + 8 * i) + k, step = (jj & 127) + 1;
            const float p = fast_exp2(sc[i * 132 + step] - mx);
#pragma unroll
            for (int e = 0; e < 8; ++e) acc[e] += vv[i][e] * p;
        }
#pragma unroll
        for (int e = 0; e < 8; ++e)
#pragma unroll
            for (int c = 0; c < 4; ++c) { float v = acc[e][c]; v += __shfl_xor(v, 4); v += __shfl_xor(v, 8); v += __shfl_xor(v, 16); v += __shfl_xor(v, 32); acc[e][c] = v; }
        if (k == 0) {
#pragma unroll
            for (int e = 0; e < 8; ++e) *(LAS f32x4*)(part + wid * 128 + qd * 32 + 4 * e) = acc[e];
        }
        if (tid < 3) pself[tid] = fast_exp2(sc[tid * 132] - mx);
    }
    LDS_WAIT(); __syncthreads();
    if (tid < 128) {
        float a = 0.f;
#pragma unroll
        for (int w = 0; w < 8; ++w) a += part[w * 128 + tid];
#pragma unroll
        for (int g = 0; g < 3; ++g) a += pself[g] * bf2f(V[row * QKV + (g * 4 + h) * 128 + tid]);
        YA[row * 512 + h * 128 + tid] = (bf16)(pk2(a / den, 0.f) & 0xffffu);
    }
    LDS_WAIT(); __syncthreads();
}

constexpr int SG_STRIDE = 144;
constexpr int SG_SLAB = 128 * SG_STRIDE;
constexpr int SG_STATS = 4 * SG_SLAB;
__device__ __forceinline__ void sgu_unit(LAS unsigned char* lds, const bf16* U, const bf16* VS, const float* lnw, const float* lnb, const bf16* WSP, const float* bsp, bf16* YS, int unit, int wid, int lane) {
    const int half = unit & 1, bn = unit >> 1;
    const size_t R0 = (size_t)bn * 128;
    LAS f32x2* stats = (LAS f32x2*)(lds + SG_STATS);
    for (int i = 0; i < 16; ++i) {
        const int rl = 16 * wid + i;
        const u32x4 x = *(const u32x4*)(VS + (R0 + rl) * 512 + 8 * lane);
        const float f[8] = {__uint_as_float(x.x << 16), __uint_as_float(x.x & 0xffff0000u), __uint_as_float(x.y << 16), __uint_as_float(x.y & 0xffff0000u),
                            __uint_as_float(x.z << 16), __uint_as_float(x.z & 0xffff0000u), __uint_as_float(x.w << 16), __uint_as_float(x.w & 0xffff0000u)};
        float s = 0.f, s2 = 0.f;
#pragma unroll
        for (int e = 0; e < 8; ++e) { s += f[e]; s2 += f[e] * f[e]; }
        s = wave_sum(s); s2 = wave_sum(s2);
        const float mean = s * (1.0f / 512.0f), var = fmaxf(s2 * (1.0f / 512.0f) - mean * mean, 0.f);
        if (lane == 0) stats[rl] = (f32x2){mean, 1.0f / sqrtf(var + 1e-6f)};
    }
    LDS_WAIT(); __syncthreads();
    const int gl = wid & 3, th = wid >> 2, grp = half * 4 + gl, c0 = grp * 64;
    LAS unsigned char* slab = lds + gl * SG_SLAB;
    {
        const int cc = (lane & 7) * 8;
        const f32x4 w0 = *(const f32x4*)(lnw + c0 + cc), w1 = *(const f32x4*)(lnw + c0 + cc + 4), b0 = *(const f32x4*)(lnb + c0 + cc), b1 = *(const f32x4*)(lnb + c0 + cc + 4);
#pragma unroll
        for (int it = 0; it < 8; ++it) {
            const int rl = th * 64 + it * 8 + (lane >> 3);
            const u32x4 x = *(const u32x4*)(VS + (R0 + rl) * 512 + c0 + cc);
            const f32x2 st = stats[rl];
            f32x4 a = {__uint_as_float(x.x << 16), __uint_as_float(x.x & 0xffff0000u), __uint_as_float(x.y << 16), __uint_as_float(x.y & 0xffff0000u)};
            f32x4 c = {__uint_as_float(x.z << 16), __uint_as_float(x.z & 0xffff0000u), __uint_as_float(x.w << 16), __uint_as_float(x.w & 0xffff0000u)};
            a = (a - st.x) * st.y * w0 + b0; c = (c - st.x) * st.y * w1 + b1;
            u32x4 o; o.x = pk2(a[0], a[1]); o.y = pk2(a[2], a[3]); o.z = pk2(c[0], c[1]); o.w = pk2(c[2], c[3]);
            *(LAS u32x4*)(slab + rl * SG_STRIDE + cc * 2) = o;
        }
    }
    LDS_WAIT(); __syncthreads();
    const int ql = lane & 15, gq = lane >> 4;
    const LAS unsigned char* abase = slab + (8 * gq + (ql >> 2)) * SG_STRIDE + (ql & 3) * 8;
    const bf16* wg = WSP + (size_t)grp * 128 * 128;
#pragma unroll
    for (int ti = 0; ti < 4; ++ti) {
        const int tt = th == 0 ? (ti == 0 ? 0 : (ti == 1 ? 3 : (ti == 2 ? 4 : 7))) : (ti == 0 ? 1 : (ti == 1 ? 2 : (ti == 2 ? 5 : 6)));
        const int t = 16 * tt + ql;
        f32x4 acc[4];
#pragma unroll
        for (int ct = 0; ct < 4; ++ct) acc[ct] = (f32x4){0.f, 0.f, 0.f, 0.f};
        for (int kk = 0; kk <= (tt >> 1); ++kk) {
            const bf16x8 wf = *(const bf16x8*)(wg + (size_t)t * 128 + 32 * kk + 8 * gq);
#pragma unroll
            for (int ct = 0; ct < 4; ++ct) {
                const s16x4 lo = vtr(abase + (32 * kk) * SG_STRIDE + ct * 32);
                const s16x4 hi = vtr(abase + (32 * kk + 4) * SG_STRIDE + ct * 32);
                const bf16x8 af = {lo[0], lo[1], lo[2], lo[3], hi[0], hi[1], hi[2], hi[3]};
                acc[ct] = __builtin_amdgcn_mfma_f32_16x16x32_bf16(af, wf, acc[ct], 0, 0, 0);
            }
        }
        const float bias = bsp[grp * 128 + t];
#pragma unroll
        for (int ct = 0; ct < 4; ++ct) {
            const size_t off = (R0 + t) * 512 + c0 + ct * 16 + 4 * gq;
            const u32x2 uu = *(const u32x2*)(U + off);
            const float u0 = __uint_as_float(uu.x << 16), u1 = __uint_as_float(uu.x & 0xffff0000u), u2 = __uint_as_float(uu.y << 16), u3 = __uint_as_float(uu.y & 0xffff0000u);
            u32x2 o; o.x = pk2(u0 * (acc[ct][0] + bias), u1 * (acc[ct][1] + bias)); o.y = pk2(u2 * (acc[ct][2] + bias), u3 * (acc[ct][3] + bias));
            *(u32x2*)(YS + off) = o;
        }
    }
    LDS_WAIT(); __syncthreads();
}

__device__ __forceinline__ void sgu_sample_row(const bf16* U, const bf16* VS, const float* lnw, const float* lnb, const float* wsp_f32, const float* bsp, bf16* YS, float* out_sv, int b, int lane) {
    const size_t row = (size_t)MP + b;
    const u32x4 x = *(const u32x4*)(VS + row * 512 + 8 * lane);
    float f[8] = {__uint_as_float(x.x << 16), __uint_as_float(x.x & 0xffff0000u), __uint_as_float(x.y << 16), __uint_as_float(x.y & 0xffff0000u),
                  __uint_as_float(x.z << 16), __uint_as_float(x.z & 0xffff0000u), __uint_as_float(x.w << 16), __uint_as_float(x.w & 0xffff0000u)};
    float s = 0.f, s2 = 0.f;
#pragma unroll
    for (int e = 0; e < 8; ++e) { s += f[e]; s2 += f[e] * f[e]; }
    s = wave_sum(s); s2 = wave_sum(s2);
    const float mean = s * (1.0f / 512.0f), var = fmaxf(s2 * (1.0f / 512.0f) - mean * mean, 0.f), rstd = 1.0f / sqrtf(var + 1e-6f);
    const int c = 8 * lane, grp = c >> 6;
    const float w00 = wsp_f32[(size_t)grp * 128 * 128], b0 = bsp[grp * 128];
    const u32x4 uu = *(const u32x4*)(U + row * 512 + c);
    const float uf[8] = {__uint_as_float(uu.x << 16), __uint_as_float(uu.x & 0xffff0000u), __uint_as_float(uu.y << 16), __uint_as_float(uu.y & 0xffff0000u),
                         __uint_as_float(uu.z << 16), __uint_as_float(uu.z & 0xffff0000u), __uint_as_float(uu.w << 16), __uint_as_float(uu.w & 0xffff0000u)};
    float y[8];
#pragma unroll
    for (int e = 0; e < 8; ++e) { const float vn = (f[e] - mean) * rstd * lnw[c + e] + lnb[c + e]; out_sv[c + e] = vn; y[e] = uf[e] * (w00 * vn + b0); }
    u32x4 o; o.x = pk2(y[0], y[1]); o.y = pk2(y[2], y[3]); o.z = pk2(y[4], y[5]); o.w = pk2(y[6], y[7]);
    *(u32x4*)(YS + row * 512 + c) = o;
}

__device__ __forceinline__ void merge_row(const bf16* OG, const float* DG, bf16* YA, int row, int lane) {
    const int h = lane >> 4;
    const float d0 = DG[(size_t)row * 12 + h], d1 = DG[(size_t)row * 12 + 4 + h], d2 = DG[(size_t)row * 12 + 8 + h];
    const float inv = 1.0f / (d0 + d1 + d2);
    const float a0 = d0 * inv, a1 = d1 * inv, a2 = d2 * inv;
    const bf16* p = OG + (size_t)row * QKV + 8 * lane;
    const u32x4 x0 = *(const u32x4*)p, x1 = *(const u32x4*)(p + 512), x2 = *(const u32x4*)(p + 1024);
    u32x4 o;
#define MRG(c) pk2(a0 * __uint_as_float(x0.c << 16) + a1 * __uint_as_float(x1.c << 16) + a2 * __uint_as_float(x2.c << 16), \
                   a0 * __uint_as_float(x0.c & 0xffff0000u) + a1 * __uint_as_float(x1.c & 0xffff0000u) + a2 * __uint_as_float(x2.c & 0xffff0000u))
    o.x = MRG(x); o.y = MRG(y); o.z = MRG(z); o.w = MRG(w);
#undef MRG
    *(u32x4*)(YA + (size_t)row * 512 + 8 * lane) = o;
}


typedef float f32x16 __attribute__((ext_vector_type(16)));
template <class EpiS>
__device__ __forceinline__ void skinny_gemm(LAS unsigned char* lds, const bf16* A, const bf16* Bt, int K, int j, const EpiS& e, int wid, int lane, int tid) {
    const int r = lane & 31, hi = lane >> 5, ks = K >> 3;
    const bf16* ap = A + (size_t)r * K + wid * ks + 8 * hi;
    const bf16* bp = Bt + (size_t)(32 * j + r) * K + wid * ks + 8 * hi;
    f32x16 acc;
#pragma unroll
    for (int i = 0; i < 16; ++i) acc[i] = 0.f;
#pragma unroll 4
    for (int k = 0; k < ks; k += 16) {
        const bf16x8 a = *(const bf16x8*)(ap + k), b = *(const bf16x8*)(bp + k);
        acc = __builtin_amdgcn_mfma_f32_32x32x16_bf16(a, b, acc, 0, 0, 0);
    }
    LAS float* red = (LAS float*)lds;
#pragma unroll
    for (int i = 0; i < 16; ++i) red[wid * 1056 + ((i & 3) + 8 * (i >> 2) + 4 * hi) * 33 + r] = acc[i];
    LDS_WAIT(); __syncthreads();
    for (int e2 = tid; e2 < 1024; e2 += NTHREADS) {
        const int row = e2 >> 5, col = e2 & 31;
        float sum = 0.f;
#pragma unroll
        for (int w = 0; w < 8; ++w) sum += red[w * 1056 + row * 33 + col];
        e(row, 32 * j + col, sum);
    }
    LDS_WAIT(); __syncthreads();
}
struct SkGate1 { const bf16* G; float* T1; __device__ __forceinline__ void operator()(int sr, int col, float v) const { const size_t row = (size_t)MP + sr; T1[row * DM + col] = bf2f(G[row * 2048 + col]) * v; } };
struct SkGate2 { const bf16* G; const float* T1; bf16* MG; __device__ __forceinline__ void operator()(int sr, int col, float v) const { const size_t row = (size_t)MP + sr; MG[row * DM + col] = (bf16)(pk2(T1[row * DM + col] + bf2f(G[row * 2048 + 1024 + col]) * v, 0.f) & 0xffffu); } };
struct SkRes { const float* bs; float* os; const float* gate; __device__ __forceinline__ void operator()(int sr, int col, float v) const { os[(size_t)sr * DM + col] = bs[(size_t)sr * DM + col] + gate[(size_t)(4 + sr) * NADA + col] * v; } };


#define RLX_AGENT __ATOMIC_RELAXED, __HIP_MEMORY_SCOPE_AGENT
#define XB_TMO      128
#define XB_XCNT(j)  (256  + 64 * (j))
#define XB_XSUB(j)  (1280 + 64 * (j))
#define XB_XGEN(j)  (2304 + 64 * (j))
#define XB_TOP      3328
#define XB_TOPGEN   3392
#define XCD_BAR_WORDS 3456
#define XB_SPIN_CAP (1u << 18)

__device__ __forceinline__ unsigned xb_ld(unsigned* p)              { return __hip_atomic_load(p, __ATOMIC_RELAXED, __HIP_MEMORY_SCOPE_AGENT); }
__device__ __forceinline__ unsigned xb_add(unsigned* p, unsigned v) { return __hip_atomic_fetch_add(p, v, __ATOMIC_RELAXED, __HIP_MEMORY_SCOPE_AGENT); }
__device__ __forceinline__ unsigned xb_xcc_id() { return (unsigned)__builtin_amdgcn_s_getreg((3 << 11) | 20) & 0xFu; }
#define XB_SPIN(cond, bar) do { unsigned _sp = 0; while (cond) { __builtin_amdgcn_s_sleep(1); \
    if ((++_sp & 255u) == 0u) { if (xb_ld(&(bar)[XB_TMO])) break; if (_sp > XB_SPIN_CAP) { atomicAdd(&(bar)[XB_TMO], 1u); break; } } } } while (0)

struct XcdBarrier {
    unsigned* bar; unsigned x;
    volatile LAS unsigned* st;
};

__device__ __forceinline__ XcdBarrier xcd_barrier_post(unsigned* bar, volatile LAS unsigned* st) {
    XcdBarrier b; b.bar = bar; b.x = xb_xcc_id(); b.st = st;
    if (threadIdx.x == 0) (void)xb_add(&bar[XB_XCNT(b.x)], 1u);
    return b;
}
__device__ __forceinline__ void xcd_barrier_complete(unsigned* bar, unsigned x, unsigned& nloc, unsigned& nx) {
    const unsigned G = gridDim.x * gridDim.y * gridDim.z;
    unsigned sum, cnt, mine, sp = 0u;
    for (;;) {
        sum = 0u; cnt = 0u; mine = 0u;
#pragma unroll
        for (unsigned j = 0; j < 16; ++j) { const unsigned c = xb_ld(&bar[XB_XCNT(j)]); sum += c; cnt += (c > 0u) ? 1u : 0u; mine = (j == x) ? c : mine; }
        if (sum == G) break;
        __builtin_amdgcn_s_sleep(1);
        if ((++sp & 255u) == 0u) { if (xb_ld(&bar[XB_TMO])) break; if (sp > XB_SPIN_CAP) { atomicAdd(&bar[XB_TMO], 1u); break; } }
    }
    nloc = mine > 0u ? mine : 1u; nx = cnt > 0u ? cnt : 1u;
}

__device__ __forceinline__ void xcd_barrier(const XcdBarrier& b) {
    asm volatile("s_waitcnt vmcnt(0)" ::: "memory");
    __syncthreads();
    if (threadIdx.x == 0) {
        unsigned* bar = b.bar;
        __builtin_amdgcn_s_waitcnt(0);
        unsigned nloc = b.st[0], nx = b.st[1];
        if (nloc == 0u) { xcd_barrier_complete(bar, b.x, nloc, nx); b.st[0] = nloc; b.st[1] = nx; }
        const unsigned old = xb_add(&bar[XB_XSUB(b.x)], 1u);
        const unsigned gen = old / nloc;
        if (old + 1u == (gen + 1u) * nloc) {
            __builtin_amdgcn_fence(__ATOMIC_RELEASE, "agent");
            asm volatile("s_waitcnt vmcnt(0)" ::: "memory");
            const unsigned og = xb_add(&bar[XB_TOP], 1u);
            const unsigned tg = og / nx;
            if (og + 1u == (tg + 1u) * nx) xb_add(&bar[XB_TOPGEN], 1u);
            else XB_SPIN(xb_ld(&bar[XB_TOPGEN]) == tg, bar);
            __builtin_amdgcn_fence(__ATOMIC_ACQUIRE, "agent");
            xb_add(&bar[XB_XGEN(b.x)], 1u);
            asm volatile("s_waitcnt vmcnt(0)" ::: "memory");
        } else {
            XB_SPIN(xb_ld(&bar[XB_XGEN(b.x)]) == gen, bar);
            __builtin_amdgcn_fence(__ATOMIC_ACQUIRE, "agent");
            asm volatile("s_waitcnt vmcnt(0)" ::: "memory");
        }
    }
    __syncthreads();
}

constexpr int LDS_MISC = LDS_EXCH + 8192;
constexpr size_t WS_CTL = 0, CTL_ZERO_BYTES = 65536;
#ifndef PROBE_REP_MASK
#define PROBE_REP_MASK 0
#endif
#define PHON(k) for (int rep_ = 0; rep_ <= (((PROBE_REP_MASK) >> (k)) & 1); ++rep_) if constexpr (((PHM) >> (k)) & 1)
#define GSYNC() do { if constexpr (COOP) { CAS const Args* ap_ = (CAS const Args*)__builtin_amdgcn_kernarg_segment_ptr(); asm volatile("" : "+s"(ap_)); \
    XcdBarrier xb_; xb_.bar = (unsigned*)((unsigned char*)ap_->ws + WS_CTL); xb_.x = xb_xcc_id(); xb_.st = (volatile LAS unsigned*)(lds + LDS_MISC); xcd_barrier(xb_); } } while (0)
#define GSYNC_CG() do { if constexpr (COOP) cg::this_grid().sync(); } while (0)
#define GAS __attribute__((address_space(1)))
#define CAS __attribute__((address_space(4)))
struct Args { GAS const float* in[23]; GAS float* out; GAS unsigned char* ws; };

#define PHASE_ENV() \
    CAS const Args* ap = (CAS const Args*)__builtin_amdgcn_kernarg_segment_ptr(); asm volatile("" : "+s"(ap)); \
    int tid = threadIdx.x; asm volatile("" : "+v"(tid)); \
    const int lane = tid & 63, wid = __builtin_amdgcn_readfirstlane(tid >> 6); \
    int G_ = gridDim.x, bx_ = blockIdx.x; asm volatile("" : "+s"(G_), "+s"(bx_)); const int G = G_, bx = bx_; const int gw = bx * NWAVES + wid, NGW = G * NWAVES; \
    unsigned char* const ws = (unsigned char*)ap->ws; (void)lane; (void)wid; (void)gw; (void)NGW; (void)ws; (void)G; (void)bx
#define WL(l) (ws + WS_WL0 + (size_t)(l) * WL_SIZE)

template <int PHM, bool COOP>
__global__ void __launch_bounds__(NTHREADS, 2) fwd_megakernel(Args args_unused, int l_lo, int l_hi) {
    extern __shared__ __attribute__((aligned(16))) unsigned char lds_raw[];
    LAS unsigned char* lds = (LAS unsigned char*)lds_raw;
    if constexpr (COOP) {
        PHASE_ENV();
        if (tid < 32) ((LAS unsigned*)(lds + LDS_MISC))[tid] = 0u;
        __syncthreads();
        (void)xcd_barrier_post((unsigned*)(ws + WS_CTL), (volatile LAS unsigned*)(lds + LDS_MISC));
    }

    PHON(0) {
        PHASE_ENV();
        bf16* WADA = (bf16*)(ws + WS_WADA); bf16* SC = (bf16*)(ws + WS_SC);
        LAS float* scr = (LAS float*)(lds + wid * 16384);
        constexpr int I_ADA = 16 * 192, I_IN = 16 * 240, I_PA = 8 * 32, I_OUT = 16 * 32, I_FI = 16 * 176, I_FO = 44 * 32;
        constexpr int I_LAYER = I_ADA + I_IN + 2 * I_PA + I_OUT + I_FI + I_FO;
        for (int it = gw; it < 2 * I_LAYER; it += NGW) {
            const int l = it / I_LAYER; int r = it - l * I_LAYER;
            unsigned char* wl = WL(l);
            if (r < I_ADA) { transpose_item(((const float*)ap->in[7]) + (size_t)l * DM * NADA, DM, NADA, WADA + (size_t)l * NADA * DM, 0, scr, r, lane); continue; } r -= I_ADA;
            if (r < I_IN) { transpose_item(((const float*)ap->in[10]) + (size_t)l * DM * DIN, DM, DIN, (bf16*)(wl + WL_WIN), 0, scr, r, lane); continue; } r -= I_IN;
            if (r < I_PA) { transpose_item(((const float*)ap->in[17]) + (size_t)l * 512 * DM, 512, DM, (bf16*)(wl + WL_WPA), 0, scr, r, lane); continue; } r -= I_PA;
            if (r < I_PA) { transpose_item(((const float*)ap->in[18]) + (size_t)l * 512 * DM, 512, DM, (bf16*)(wl + WL_WPS), 0, scr, r, lane); continue; } r -= I_PA;
            if (r < I_OUT) { transpose_item(((const float*)ap->in[19]) + (size_t)l * DM * DM, DM, DM, (bf16*)(wl + WL_WOUT), 0, scr, r, lane); continue; } r -= I_OUT;
            if (r < I_FI) { transpose_item(((const float*)ap->in[21]) + (size_t)l * DM * 2 * DFF, DM, 2 * DFF, (bf16*)(wl + WL_WFI), 1, scr, r, lane); continue; } r -= I_FI;
            transpose_item(((const float*)ap->in[22]) + (size_t)l * DFF * DM, DFF, DM, (bf16*)(wl + WL_WFO), 0, scr, r, lane);
        }
        const int gt = bx * NTHREADS + tid, NGT = G * NTHREADS;
        const float* wsp = ((const float*)ap->in[15]);
        for (int i = gt; i < 2 * 8 * 128 * 128; i += NGT) {
            const int l = i >> 17, r = i & 131071, t = (r >> 7) & 127, s = r & 127;
            const float w = wsp[i];
            ((bf16*)(WL(l) + WL_WSP))[r] = (bf16)(s <= t ? (pk2(w, 0.f) & 0xffffu) : 0u);
        }
        const float* cpr = ((const float*)ap->in[5]); const float* csm = ((const float*)ap->in[6]);
        for (int i = gt; i < 256 * DM; i += NGT) {
            const int r = i >> 10, k = i & 1023;
            float v = 0.f;
            if (r < 4) v = cpr[r * DM + k]; else if (r < 36) v = csm[(r - 4) * DM + k];
            SC[i] = (bf16)(pk2(v * sigmoidf_(v), 0.f) & 0xffffu);
        }
    }
    GSYNC_CG();
    PHON(1) {
        PHASE_ENV();
        pg8::Gemm g{(const bf16*)(ws + WS_SC), (const bf16*)(ws + WS_WADA), 256, 2 * NADA, DM}; pg8::StaticOrder S; S.init(256, 2 * NADA, G, bx);
        EpiAda E{(float*)(ws + WS_MOD), ((const float*)ap->in[8])};
        pg8::gemm_phase<EpiAda, pg8::StaticOrder, true, true>(lds + LDS_RING, g, S, E);
    }
    GSYNC();

    for (int l = l_lo; l < l_hi; ++l) {
        PHON(2) {
            PHASE_ENV();
            const float* X2 = (const float*)(ws + WS_X2);
            const float* xin_p = l == 0 ? ((const float*)ap->in[0]) : X2;
            const float* xin_s = l == 0 ? ((const float*)ap->in[1]) : X2 + (size_t)MP * DM;
            norm_mod_phase(xin_p, xin_s, ((const float*)ap->in[9]) + l * DM, (const float*)(ws + WS_MOD) + (size_t)l * 36 * NADA, 0, (bf16*)(ws + WS_XN), gw, NGW, lane);
        }
        GSYNC();
        PHON(3) {
            PHASE_ENV();
            pg8::Gemm g{(const bf16*)(ws + WS_XN), (const bf16*)(WL(l) + WL_WIN), MT, DIN, DM}; pg8::StaticOrder S; S.init(MT, DIN, G, bx);
            EpiIn E{ws, ((const float*)ap->in[11]) + l * 384, ((const float*)ap->in[12]) + l * 384, ((float*)ap->out), l, (LAS float*)(lds + LDS_EXCH)};
            pg8::gemm_phase<EpiIn, pg8::StaticOrder, true, true>(lds + LDS_RING, g, S, E);
        }
        GSYNC();
        PHON(4) {
            PHASE_ENV();
            const bf16 *Qb = (const bf16*)(ws + WS_Q), *Kb = (const bf16*)(ws + WS_K), *Vb = (const bf16*)(ws + WS_V);
            float mq = 0.f, mk = 0.f;
            for (int i = lane; i < 384; i += 64) { mq = fmaxf(mq, fabsf(((const float*)ap->in[11])[l * 384 + i])); mk = fmaxf(mk, fabsf(((const float*)ap->in[12])[l * 384 + i])); }
            mq = wave_max(mq); mk = wave_max(mk);
            const float cshift = 11.3137085f * LOG2E * mq * mk;
            if (G == 256) { const int u0 = bx < 128 ? bx * 7 : 896 + (bx - 128) * 5, nu = bx < 128 ? 7 : 5;
                for (int u = u0; u < u0 + nu; ++u) attn_unit(lds, Qb, Kb, Vb, (bf16*)(ws + WS_OG), (float*)(ws + WS_DG), u, cshift, wid, lane, tid); }
            else for (int u = bx; u < 1536; u += G) attn_unit(lds, Qb, Kb, Vb, (bf16*)(ws + WS_OG), (float*)(ws + WS_DG), u, cshift, wid, lane, tid);
        }
        PHON(4) {
            PHASE_ENV();
            if (bx >= G / 2) {
                for (int it = bx - G / 2; it < NSMP * 4; it += G - G / 2)
                    attn_sample_item(lds, (const bf16*)(ws + WS_Q), (const bf16*)(ws + WS_K), (const bf16*)(ws + WS_V), ((const float*)ap->in[2]), ((const float*)ap->in[3]), ((const float*)ap->in[4]), l, (bf16*)(ws + WS_YA), it, wid, lane, tid);
            }
        }
        GSYNC();
        PHON(5) {
            PHASE_ENV();
            const bf16 *Ub = (const bf16*)(ws + WS_U), *VSb = (const bf16*)(ws + WS_VS); bf16 *YS = (bf16*)(ws + WS_YS);
            const bf16* WSP = (const bf16*)(WL(l) + WL_WSP);
            const float* lnw = ((const float*)ap->in[13]) + l * 512; const float* lnb = ((const float*)ap->in[14]) + l * 512; const float* bsp = ((const float*)ap->in[16]) + l * 8 * 128;
            for (int u = bx; u < 256; u += G) sgu_unit(lds, Ub, VSb, lnw, lnb, WSP, bsp, YS, u, wid, lane);
            for (int b = gw; b < NSMP; b += NGW) sgu_sample_row(Ub, VSb, lnw, lnb, ((const float*)ap->in[15]) + (size_t)l * 8 * 128 * 128, bsp, YS, ((float*)ap->out) + O_SV + (size_t)(l * NSMP + b) * 512, b, lane);
            for (int row = gw; row < MP; row += NGW) merge_row((const bf16*)(ws + WS_OG), (const float*)(ws + WS_DG), (bf16*)(ws + WS_YA), row, lane);
        }
        GSYNC();
        PHON(6) {
            PHASE_ENV();
            pg8::StaticOrder S; S.init(MP, DM, G, bx);
            pg8::Gemm g{(const bf16*)(ws + WS_YA), (const bf16*)(WL(l) + WL_WPA), MP, DM, 512}; EpiGate1 E{(const bf16*)(ws + WS_G), (float*)(ws + WS_T1)};
            pg8::gemm_phase<EpiGate1, pg8::StaticOrder, true, true>(lds + LDS_RING, g, S, E);
        }
        PHON(6) {
            PHASE_ENV();
            if (bx < 32) { SkGate1 e{(const bf16*)(ws + WS_G), (float*)(ws + WS_T1)};
                skinny_gemm(lds, (const bf16*)(ws + WS_YA) + (size_t)MP * 512, (const bf16*)(WL(l) + WL_WPA), 512, bx, e, wid, lane, tid); }
        }
        PHON(6) {
            PHASE_ENV();
            pg8::StaticOrder S; S.init(MP, DM, G, bx);
            pg8::Gemm g{(const bf16*)(ws + WS_YS), (const bf16*)(WL(l) + WL_WPS), MP, DM, 512}; EpiGate2 E{(const bf16*)(ws + WS_G), (const float*)(ws + WS_T1), (bf16*)(ws + WS_MG)};
            pg8::gemm_phase<EpiGate2, pg8::StaticOrder, true, true>(lds + LDS_RING, g, S, E);
        }
        PHON(6) {
            PHASE_ENV();
            if (bx < 32) { SkGate2 e{(const bf16*)(ws + WS_G), (const float*)(ws + WS_T1), (bf16*)(ws + WS_MG)};
                skinny_gemm(lds, (const bf16*)(ws + WS_YS) + (size_t)MP * 512, (const bf16*)(WL(l) + WL_WPS), 512, bx, e, wid, lane, tid); }
        }
        GSYNC();
        PHON(7) {
            PHASE_ENV();
            const float* X2 = (const float*)(ws + WS_X2); float* X1 = (float*)(ws + WS_X1);
            const float* xin_p = l == 0 ? ((const float*)ap->in[0]) : X2;
            const float* xin_s = l == 0 ? ((const float*)ap->in[1]) : X2 + (size_t)MP * DM;
            pg8::Gemm g{(const bf16*)(ws + WS_MG), (const bf16*)(WL(l) + WL_WOUT), MP, DM, DM}; pg8::StaticOrder S; S.init(MP, DM, G, bx);
            EpiRes E{xin_p, xin_s, X1, X1 + (size_t)MP * DM, (const float*)(ws + WS_MOD) + (size_t)l * 36 * NADA + 2048};
            pg8::gemm_phase<EpiRes, pg8::StaticOrder, true, true>(lds + LDS_RING, g, S, E);
        }
        PHON(7) {
            PHASE_ENV();
            if (bx < 32) { const float* X2 = (const float*)(ws + WS_X2);
                SkRes e{l == 0 ? ((const float*)ap->in[1]) : X2 + (size_t)MP * DM, (float*)(ws + WS_X1) + (size_t)MP * DM, (const float*)(ws + WS_MOD) + (size_t)l * 36 * NADA + 2048};
                skinny_gemm(lds, (const bf16*)(ws + WS_MG) + (size_t)MP * DM, (const bf16*)(WL(l) + WL_WOUT), DM, bx, e, wid, lane, tid); }
        }
        GSYNC();
        PHON(8) {
            PHASE_ENV();
            const float* X1 = (const float*)(ws + WS_X1);
            norm_mod_phase(X1, X1 + (size_t)MP * DM, ((const float*)ap->in[20]) + l * DM, (const float*)(ws + WS_MOD) + (size_t)l * 36 * NADA, 3072, (bf16*)(ws + WS_XN), gw, NGW, lane);
        }
        GSYNC();
        PHON(9) {
            PHASE_ENV();
            pg8::Gemm g{(const bf16*)(ws + WS_XN), (const bf16*)(WL(l) + WL_WFI), MT, 2 * DFF, DM}; pg8::StaticOrder S; S.init(MT, 2 * DFF, G, bx);
            EpiSwiglu E{(bf16*)(ws + WS_H)};
            pg8::gemm_phase<EpiSwiglu, pg8::StaticOrder, true, true>(lds + LDS_RING, g, S, E);
        }
        GSYNC();
        PHON(10) {
            PHASE_ENV();
            const float* X1 = (const float*)(ws + WS_X1); float* X2 = (float*)(ws + WS_X2);
            float* xout_p = l == 0 ? X2 : ((float*)ap->out) + O_YP;
            float* xout_s = l == 0 ? X2 + (size_t)MP * DM : ((float*)ap->out) + O_YS;
            pg8::Gemm g{(const bf16*)(ws + WS_H), (const bf16*)(WL(l) + WL_WFO), MP, DM, DFF}; pg8::StaticOrder S; S.init(MP, DM, G, bx);
            EpiRes E{X1, X1 + (size_t)MP * DM, xout_p, xout_s, (const float*)(ws + WS_MOD) + (size_t)l * 36 * NADA + 5120};
            pg8::gemm_phase<EpiRes, pg8::StaticOrder, true, true>(lds + LDS_RING, g, S, E);
        }
        PHON(10) {
            PHASE_ENV();
            if (bx < 32) { float* X2 = (float*)(ws + WS_X2);
                SkRes e{(const float*)(ws + WS_X1) + (size_t)MP * DM, l == 0 ? X2 + (size_t)MP * DM : ((float*)ap->out) + O_YS, (const float*)(ws + WS_MOD) + (size_t)l * 36 * NADA + 5120};
                skinny_gemm(lds, (const bf16*)(ws + WS_H) + (size_t)MP * DFF, (const bf16*)(WL(l) + WL_WFO), DFF, bx, e, wid, lane, tid); }
        }
        if (l + 1 < l_hi) GSYNC();
    }
}


#ifdef EXP_MASK
__global__ void __launch_bounds__(256) dbg_checksum(const unsigned char* ws, float* out) {
    const int lane = threadIdx.x & 63, gw = (blockIdx.x * 256 + threadIdx.x) >> 6, ngw = gridDim.x * 4;
    struct B { size_t off; int cols; int isf; };
    const B bufs[16] = {{WS_XN, 1024, 0}, {WS_Q, 1536, 0}, {WS_K, 1536, 0}, {WS_V, 1536, 0}, {WS_U, 512, 0}, {WS_VS, 512, 0}, {WS_G, 2048, 0}, {WS_OG, 1536, 0},
                        {WS_DG, 12, 1}, {WS_YA, 512, 0}, {WS_YS, 512, 0}, {WS_T1, 1024, 1}, {WS_MG, 1024, 0}, {WS_X1, 1024, 1}, {WS_H, 2816, 0}, {WS_X2, 1024, 1}};
    for (int b = 0; b < 16; ++b) {
        if (!((EXP_MASK >> b) & 1)) continue;
        for (int row = gw; row < MV; row += ngw) {
            float s = 0.f;
            for (int c = lane; c < bufs[b].cols; c += 64) {
                const float v = bufs[b].isf ? ((const float*)(ws + bufs[b].off))[(size_t)row * bufs[b].cols + c] : bf2f(((const bf16*)(ws + bufs[b].off))[(size_t)row * bufs[b].cols + c]);
                s += v * (float)(1 + (c % 7));
            }
            s = wave_sum(s);
            if (lane == 0) out[(size_t)b * MT + row] = s;
        }
    }
    if ((EXP_MASK >> 16) & 1) for (int i = blockIdx.x * 256 + threadIdx.x; i < 72 * NADA; i += gridDim.x * 256) out[16 * MT + i] = ((const float*)(ws + WS_MOD))[i];
}
#endif
#ifndef N_LAUNCH_MODE
#define N_LAUNCH_MODE 1
#endif
template <int PHM> static void launch_phase(const Args& a, int l_lo, int l_hi, int grid, hipStream_t stream) {
    static bool attr = false;
    if (!attr) { (void)hipFuncSetAttribute((const void*)fwd_megakernel<PHM, false>, hipFuncAttributeMaxDynamicSharedMemorySize, LDS_BYTES); attr = true; }
    hipLaunchKernelGGL((fwd_megakernel<PHM, false>), dim3(grid), dim3(NTHREADS), LDS_BYTES, stream, a, l_lo, l_hi);
}
extern "C" void kernel_launch(void* const* d_in, const int* in_sizes, int n_in, void* d_out, int out_size, void* d_ws, size_t ws_size, hipStream_t stream) {
    static int grid = 0;
    if (grid == 0) {
        if (n_in != 23 || (size_t)out_size != O_END || ws_size < WS_END) { fprintf(stderr, "kernel_launch: unexpected shapes (n_in %d out %d ws %zu need %zu)\n", n_in, out_size, ws_size, (size_t)WS_END); grid = -1; return; }
        int dev = 0, cus = 0, per_cu = 0;
        (void)hipGetDevice(&dev);
        (void)hipDeviceGetAttribute(&cus, hipDeviceAttributeMultiprocessorCount, dev);
#if N_LAUNCH_MODE == 1
        if (hipFuncSetAttribute((const void*)fwd_megakernel<0x7FF, true>, hipFuncAttributeMaxDynamicSharedMemorySize, LDS_BYTES) != hipSuccess) { fprintf(stderr, "kernel_launch: hipFuncSetAttribute failed\n"); grid = -1; return; }
        (void)hipOccupancyMaxActiveBlocksPerMultiprocessor(&per_cu, (const void*)fwd_megakernel<0x7FF, true>, NTHREADS, LDS_BYTES);
        (void)hipGetLastError();
        if (per_cu < 1) fprintf(stderr, "kernel_launch: occupancy query says %d blocks per CU\n", per_cu);
#endif
        grid = cus;
    }
    if (grid < 0) return;
    Args a{};
    for (int i = 0; i < 23; ++i) a.in[i] = (GAS const float*)d_in[i];
    a.out = (GAS float*)d_out; a.ws = (GAS unsigned char*)d_ws;
#if N_LAUNCH_MODE == 1
    (void)hipMemsetAsync((unsigned char*)d_ws + WS_CTL, 0, CTL_ZERO_BYTES, stream);
    int l_lo = 0, l_hi = 2;
    void* kargs[] = {&a, &l_lo, &l_hi};
    hipError_t e = hipLaunchCooperativeKernel((const void*)fwd_megakernel<0x7FF, true>, dim3(grid), dim3(NTHREADS), kargs, LDS_BYTES, stream);
    if (e != hipSuccess) fprintf(stderr, "cooperative launch failed: %s (grid %d)\n", hipGetErrorString(e), grid);
#else
#ifdef EXP_MASK
    (void)hipMemsetAsync(d_out, 0, (size_t)out_size * 4, stream);
#endif
    launch_phase<0x001>(a, 0, 0, grid, stream);
    launch_phase<0x002>(a, 0, 0, grid, stream);
#ifdef EXP_MASK
    const int NL = 1;
#else
    const int NL = 2;
#endif
    for (int l = 0; l < NL; ++l) {
        launch_phase<0x004>(a, l, l + 1, grid, stream);
        launch_phase<0x008>(a, l, l + 1, grid, stream);
        launch_phase<0x010>(a, l, l + 1, grid, stream);
        launch_phase<0x020>(a, l, l + 1, grid, stream);
        launch_phase<0x040>(a, l, l + 1, grid, stream);
        launch_phase<0x080>(a, l, l + 1, grid, stream);
        launch_phase<0x100>(a, l, l + 1, grid, stream);
        launch_phase<0x200>(a, l, l + 1, grid, stream);
        launch_phase<0x400>(a, l, l + 1, grid, stream);
    }
#ifdef EXP_MASK
    hipLaunchKernelGGL(dbg_checksum, dim3(1024), dim3(256), 0, stream, (const unsigned char*)d_ws, (float*)d_out);
#endif
#endif
}
```

```cpp
#include <hip/hip_runtime.h>
#include <hip/hip_cooperative_groups.h>
#include <cstdio>
#include <cstdint>
namespace cg = cooperative_groups;
namespace pg8 {
#define PG8_LAS __attribute__((address_space(3)))
typedef unsigned short bf16_t;
typedef short bf16x8 __attribute__((ext_vector_type(8)));
typedef float f32x4 __attribute__((ext_vector_type(4)));
typedef unsigned u32x4 __attribute__((ext_vector_type(4)));
constexpr int BM = 256, BK = 64, HALF = 128, HTB = HALF * BK * 2  , STAGE_BYTES = 8 * HTB, NXCD = 8, WGM = 8;

__host__ __device__ __forceinline__ int lds_byte(int r, int c) { const int st = (r >> 4) * 2 + (c >> 5), rr = r & 15, cc = c & 31, ob = rr * 64 + cc * 2; return st * 1024 + (ob ^ (((ob >> 9) & 1) << 5)); }
__host__ __device__ __forceinline__ void stage_rc(int b, int& R, int& C) { const int st = b / 1024, sb = b % 1024, swz = sb ^ (((sb >> 9) & 1) << 5); R = (st >> 1) * 16 + swz / 64; C = (st & 1) * 32 + (swz % 64) / 2; }
__host__ __device__ __forceinline__ int perm32(int rho) { const int n = rho >> 4, i = rho & 15; return 8 * (i >> 2) + 4 * n + (i & 3); }

struct Unit { int pm, pn; };
struct Gemm { const bf16_t* A; const bf16_t* Bt; int M, N, K; };

struct StaticOrder {
    int nM, nN, nwg, G, c;
    __host__ __device__ void init(int M, int N, int G_, int c_) { nM = M / BM; nN = N / BM; nwg = nM * nN; G = G_; c = c_; }
    __host__ __device__ bool next(int i, Unit& u) const {
        const long L = (long)i * G + c; if (L >= nwg) return false;
        int wgid = (int)L; { const int q = nwg / NXCD, r = nwg % NXCD, xcd = wgid % NXCD, off = wgid / NXCD; wgid = (xcd < r ? xcd * (q + 1) : r * (q + 1) + (xcd - r) * q) + off; }
        const int nig = WGM * nN, gid = wgid / nig, fm = gid * WGM, gsz = (nM - fm) < WGM ? (nM - fm) : WGM;
        u.pm = fm + ((wgid % nig) % gsz); u.pn = (wgid % nig) / gsz; return true;
    }
    __device__ __forceinline__ void a_ready(const Unit&) const {}
    __device__ __forceinline__ void done(const Unit&) const {}
};

typedef __bf16 bf16x2_hw __attribute__((ext_vector_type(2)));
typedef float f32x2_hw __attribute__((ext_vector_type(2)));
__device__ __forceinline__ unsigned cvt_pk_bf16(float lo, float hi) { const f32x2_hw v = {lo, hi}; return __builtin_bit_cast(unsigned, __builtin_convertvector(v, bf16x2_hw)); }
typedef float f32x2 __attribute__((ext_vector_type(2)));
__device__ __forceinline__ f32x2 gelu_pk(f32x2 v) {
    const f32x2 av = __builtin_elementwise_abs(v), d = av * 0.2316418882f + 1.0f;
    f32x2 t; t.x = __builtin_amdgcn_rcpf(d.x); t.y = __builtin_amdgcn_rcpf(d.y);
    f32x2 q = t * 0.5307027145f + (-0.7265760135f); q = q * t + 0.7107068705f; q = q * t + (-0.142248368f); q = q * t + 0.127414796f; q = q * t;
    const f32x2 s = (v * v) * (-0.72134752044f);
    f32x2 e; e.x = __builtin_amdgcn_exp2f(s.x); e.y = __builtin_amdgcn_exp2f(s.y);
    const f32x2 m = v * (q * e), r = v - m;
    f32x2 o; o.x = v.x < 0.f ? m.x : r.x; o.y = v.y < 0.f ? m.y : r.y; return o;
}

template <int ACT  > struct EpiBf16 {
    static constexpr bool PERM = true, AFTER_DRAIN = false; static_assert(ACT == 0 || ACT == 1, "EpiBf16: ACT is 0 (none) or 1 (gelu_pk)");
    bf16_t* O; int ldc; const float* bias; int split_cols; size_t split_stride; float scale0;
    __device__ __forceinline__ void operator()(const f32x4 (&acc)[2][2][4][2], const Unit& u, int wr, int wc, int fr, int fq) const {
        const int row0 = u.pm * BM + wr * 64 + fr; int colt = u.pn * BM; bf16_t* base = O;
        float sc = 1.f; if (split_cols) { const int t = colt / split_cols; base += (size_t)t * split_stride; colt -= t * split_cols; if (t == 0) sc = scale0; }
        const int col0 = colt + wc * 32 + 8 * fq, bcol0 = u.pn * BM + wc * 32 + 8 * fq;
        f32x4 bv[2][2];
#pragma unroll
        for (int bj = 0; bj < 2; ++bj)
#pragma unroll
            for (int n = 0; n < 2; ++n) bv[bj][n] = bias ? *(const f32x4*)(bias + bcol0 + bj * HALF + 4 * n) : (f32x4){0.f, 0.f, 0.f, 0.f};
#pragma unroll
        for (int ai = 0; ai < 2; ++ai)
#pragma unroll
            for (int m = 0; m < 4; ++m) { bf16_t* rowp = base + (size_t)(row0 + ai * HALF + m * 16) * ldc + col0;
#pragma unroll
                for (int bj = 0; bj < 2; ++bj) { f32x4 v0 = acc[ai][bj][m][0] + bv[bj][0], v1 = acc[ai][bj][m][1] + bv[bj][1];
                    if (ACT == 1) { f32x2 a = gelu_pk((f32x2){v0[0], v0[1]}), b = gelu_pk((f32x2){v0[2], v0[3]}), c = gelu_pk((f32x2){v1[0], v1[1]}), d = gelu_pk((f32x2){v1[2], v1[3]});
                        v0 = (f32x4){a.x, a.y, b.x, b.y}; v1 = (f32x4){c.x, c.y, d.x, d.y}; }
                    v0 = v0 * sc; v1 = v1 * sc; u32x4 w; w.x = cvt_pk_bf16(v0[0], v0[1]); w.y = cvt_pk_bf16(v0[2], v0[3]); w.z = cvt_pk_bf16(v1[0], v1[1]); w.w = cvt_pk_bf16(v1[2], v1[3]);
                    *(u32x4*)(rowp + bj * HALF) = w; } }
    }
};

struct PanelStats {
    unsigned* xbuf;
    unsigned* cnt;
    unsigned* tmo;
    int ntn; float eps;
    unsigned code;
    __device__ __forceinline__ bool run(const f32x4 (&v)[2][2][4][2], const Unit& u, int wr, int wc, int fr, int fq, PG8_LAS unsigned char* lds, int wid, int lane) const {
        typedef float f32x2v __attribute__((ext_vector_type(2)));
        PG8_LAS f32x2v* P = (PG8_LAS f32x2v*)lds;
        PG8_LAS f32x2v* S = (PG8_LAS f32x2v*)(lds + 8192);
        PG8_LAS unsigned* flag = (PG8_LAS unsigned*)(lds + 8192 + 2048);
#pragma unroll
        for (int ai = 0; ai < 2; ++ai)
#pragma unroll
            for (int m = 0; m < 4; ++m) {
                float s = 0.f;
#pragma unroll
                for (int bj = 0; bj < 2; ++bj)
#pragma unroll
                    for (int n = 0; n < 2; ++n) { const f32x4 x = v[ai][bj][m][n]; s += (x[0] + x[1]) + (x[2] + x[3]); }
                s += __shfl_xor(s, 16); s += __shfl_xor(s, 32);
                const float mw = s * (1.0f / 64.0f); float q = 0.f;
#pragma unroll
                for (int bj = 0; bj < 2; ++bj)
#pragma unroll
                    for (int n = 0; n < 2; ++n) { const f32x4 d = v[ai][bj][m][n] - mw; q += (d[0] * d[0] + d[1] * d[1]) + (d[2] * d[2] + d[3] * d[3]); }
                q += __shfl_xor(q, 16); q += __shfl_xor(q, 32);
                if (fq == 0) P[(ai * HALF + wr * 64 + m * 16 + fr) * 4 + wc] = (f32x2v){mw, q};
            }
        asm volatile("s_waitcnt lgkmcnt(0)" ::: "memory"); __builtin_amdgcn_s_barrier(); asm volatile("" ::: "memory");
#if defined(BROKEN_EXCHANGE_NO_WAIT)
#warning BROKEN CONTROL BUILD: the row-statistics exchange does not wait; results are wrong by design
        if (blockIdx.x >= 64) { const long long t0_ = clock64(); while (clock64() - t0_ < 60000) __builtin_amdgcn_s_sleep(8); }
#endif
        const int row = wid * 32 + (lane & 31);
        if (lane < 32) {
            const f32x2v a = P[row * 4 + 0], b = P[row * 4 + 1], c = P[row * 4 + 2], d = P[row * 4 + 3];
            const float mt = (a.x + b.x + c.x + d.x) * 0.25f;
            const float da = a.x - mt, db = b.x - mt, dc = c.x - mt, dd = d.x - mt;
            const float m2 = (a.y + b.y) + (c.y + d.y) + 64.0f * ((da * da + db * db) + (dc * dc + dd * dd));
            unsigned long long* slot = (unsigned long long*)xbuf + ((size_t)(u.pm * BM + row) * 4 + u.pn);
            __hip_atomic_store(slot, ((unsigned long long)__float_as_uint(m2) << 32) | __float_as_uint(mt), __ATOMIC_RELAXED, __HIP_MEMORY_SCOPE_AGENT);
        }
        asm volatile("s_waitcnt vmcnt(0)" ::: "memory");
        if (lane == 0) __hip_atomic_fetch_add(cnt + 64 * u.pm, 1u, __ATOMIC_RELAXED, __HIP_MEMORY_SCOPE_AGENT);
        if (wid == 0) {
            bool dead = false; const unsigned long long t0 = __builtin_amdgcn_s_memrealtime(); const unsigned want = 8u * (unsigned)ntn;
            for (;;) {
#if defined(BROKEN_EXCHANGE_NO_WAIT)
                break;
#endif
                if ((unsigned)__builtin_amdgcn_readfirstlane(__hip_atomic_load(cnt + 64 * u.pm, __ATOMIC_RELAXED, __HIP_MEMORY_SCOPE_AGENT)) >= want) break;
                if (__builtin_amdgcn_s_memrealtime() - t0 > 2000000ull) {
                    if (lane == 0) { unsigned expect = 0u; __hip_atomic_compare_exchange_strong(tmo + 1, &expect, code | (unsigned)(u.pm & 0xff), __ATOMIC_RELAXED, __ATOMIC_RELAXED, __HIP_MEMORY_SCOPE_AGENT);
                                     __hip_atomic_store(tmo, 1u, __ATOMIC_RELAXED, __HIP_MEMORY_SCOPE_AGENT); }
                    dead = true; break; }
                __builtin_amdgcn_s_sleep(2);
            }
            __builtin_amdgcn_fence(__ATOMIC_ACQUIRE, "agent");
            if (lane == 0) flag[0] = dead ? 1u : 0u;
        }
        asm volatile("s_waitcnt vmcnt(0) lgkmcnt(0)" ::: "memory"); __builtin_amdgcn_s_barrier(); asm volatile("" ::: "memory");
        const bool bad = flag[0] != 0u;
        if (lane < 32) {
            const unsigned long long* slot = (const unsigned long long*)xbuf + (size_t)(u.pm * BM + row) * 4; float mt[4], m2[4]; float ms = 0.f;
#pragma unroll
            for (int t = 0; t < 4; ++t) { if (t < ntn) { const unsigned long long w = __hip_atomic_load(slot + t, __ATOMIC_RELAXED, __HIP_MEMORY_SCOPE_AGENT); mt[t] = __uint_as_float((unsigned)w); m2[t] = __uint_as_float((unsigned)(w >> 32)); } else { mt[t] = 0.f; m2[t] = 0.f; } ms += mt[t]; }
            const float mean = ms / (float)ntn; float q = 0.f;
#pragma unroll
            for (int t = 0; t < 4; ++t) if (t < ntn) { const float dm = mt[t] - mean; q += m2[t] + 256.0f * dm * dm; }
            S[row] = (f32x2v){mean, 1.0f / sqrtf(q / (256.0f * (float)ntn) + eps)};
        }
        asm volatile("s_waitcnt lgkmcnt(0)" ::: "memory"); __builtin_amdgcn_s_barrier(); asm volatile("" ::: "memory");
        return bad;
    }
};
struct EpiLnRes {
    static constexpr bool PERM = false, AFTER_DRAIN = true;
    const float* base; float* out; int ldc; const float* bias; PanelStats st; unsigned poison;
    __device__ __forceinline__ void fused(f32x4 (&acc)[2][2][4][2], const Unit& u, int wr, int wc, int fr, int fq, PG8_LAS unsigned char* lds, int wid, int lane) const {
        typedef float f32x2v __attribute__((ext_vector_type(2)));
        const PG8_LAS f32x2v* S = (const PG8_LAS f32x2v*)(lds + 8192);
        const int col0 = u.pn * BM + wc * 32 + 4 * fq;
#pragma unroll
        for (int bj = 0; bj < 2; ++bj)
#pragma unroll
            for (int n = 0; n < 2; ++n) { const f32x4 bv = bias ? *(const f32x4*)(bias + col0 + bj * HALF + n * 16) : (f32x4){0.f, 0.f, 0.f, 0.f};
#pragma unroll
                for (int ai = 0; ai < 2; ++ai)
#pragma unroll
                    for (int m = 0; m < 4; ++m) acc[ai][bj][m][n] += bv; }
        f32x4 pre[4][2][2];
#pragma unroll
        for (int m = 0; m < 4; ++m) { const size_t off = (size_t)(u.pm * BM + wr * 64 + m * 16 + fr) * ldc + col0;
#pragma unroll
            for (int bj = 0; bj < 2; ++bj)
#pragma unroll
                for (int n = 0; n < 2; ++n) pre[m][bj][n] = *(const f32x4*)(base + off + bj * HALF + n * 16); }
        const bool bad = st.run(acc, u, wr, wc, fr, fq, lds, wid, lane) || poison != 0u;
        const float qnan = __builtin_nanf("");
#pragma unroll
        for (int ai = 0; ai < 2; ++ai)
#pragma unroll
            for (int m = 0; m < 4; ++m) { const int r = ai * HALF + wr * 64 + m * 16 + fr; const f32x2v sr = S[r]; const size_t off = (size_t)(u.pm * BM + r) * ldc + col0;
#pragma unroll
                for (int bj = 0; bj < 2; ++bj)
#pragma unroll
                    for (int n = 0; n < 2; ++n) { const f32x4 bs = ai == 0 ? pre[m][bj][n] : *(const f32x4*)(base + off + bj * HALF + n * 16); f32x4 o = bs + (acc[ai][bj][m][n] - sr.x) * sr.y;
                        if (bad) o = (f32x4){qnan, qnan, qnan, qnan}; *(f32x4*)(out + off + bj * HALF + n * 16) = o; }
                if (m & 1) asm volatile("" ::: "memory"); }
    }
};
struct EpiLnResLn {
    static constexpr bool PERM = false, AFTER_DRAIN = true;
    const float* base; float* out; bf16_t* xn; int ldc; const float* bias; PanelStats st1, st2; unsigned poison;
    __device__ __forceinline__ void fused(f32x4 (&acc)[2][2][4][2], const Unit& u, int wr, int wc, int fr, int fq, PG8_LAS unsigned char* lds, int wid, int lane) const {
        typedef float f32x2v __attribute__((ext_vector_type(2))); typedef unsigned u32x2v __attribute__((ext_vector_type(2)));
        const PG8_LAS f32x2v* S = (const PG8_LAS f32x2v*)(lds + 8192);
        const int col0 = u.pn * BM + wc * 32 + 4 * fq;
#pragma unroll
        for (int bj = 0; bj < 2; ++bj)
#pragma unroll
            for (int n = 0; n < 2; ++n) { const f32x4 bv = bias ? *(const f32x4*)(bias + col0 + bj * HALF + n * 16) : (f32x4){0.f, 0.f, 0.f, 0.f};
#pragma unroll
                for (int ai = 0; ai < 2; ++ai)
#pragma unroll
                    for (int m = 0; m < 4; ++m) acc[ai][bj][m][n] += bv; }
        bool bad = st1.run(acc, u, wr, wc, fr, fq, lds, wid, lane) || poison != 0u;
        const float qnan = __builtin_nanf("");
#pragma unroll
        for (int ai = 0; ai < 2; ++ai)
#pragma unroll
            for (int m = 0; m < 4; ++m) { const int r = ai * HALF + wr * 64 + m * 16 + fr; const f32x2v sr = S[r]; const size_t off = (size_t)(u.pm * BM + r) * ldc + col0;
#pragma unroll
                for (int bj = 0; bj < 2; ++bj)
#pragma unroll
                    for (int n = 0; n < 2; ++n) { const f32x4 bs = *(const f32x4*)(base + off + bj * HALF + n * 16); acc[ai][bj][m][n] = bs + (acc[ai][bj][m][n] - sr.x) * sr.y; }
                asm volatile("" : "+v"(acc[ai][0][m][0]), "+v"(acc[ai][0][m][1]), "+v"(acc[ai][1][m][0]), "+v"(acc[ai][1][m][1]));
                if (m & 1) asm volatile("" ::: "memory"); }
        const bool bad1 = bad;
        bad = st2.run(acc, u, wr, wc, fr, fq, lds, wid, lane) || bad;
#pragma unroll
        for (int ai = 0; ai < 2; ++ai)
#pragma unroll
            for (int m = 0; m < 4; ++m) { const int r = ai * HALF + wr * 64 + m * 16 + fr; const f32x2v sr = S[r]; const size_t off = (size_t)(u.pm * BM + r) * ldc + col0;
#pragma unroll
                for (int bj = 0; bj < 2; ++bj)
#pragma unroll
                    for (int n = 0; n < 2; ++n) { const f32x4 x1 = acc[ai][bj][m][n]; *(f32x4*)(out + off + bj * HALF + n * 16) = bad1 ? (f32x4){qnan, qnan, qnan, qnan} : x1;
                        const f32x4 o = (x1 - sr.x) * sr.y; u32x2v w; w.x = cvt_pk_bf16(o[0], o[1]); w.y = cvt_pk_bf16(o[2], o[3]);
                        if (bad) { w.x = 0x7fc07fc0u; w.y = 0x7fc07fc0u; } *(u32x2v*)(xn + off + bj * HALF + n * 16) = w; }
                asm volatile("" ::: "memory"); }
    }
};

template <class Epi, class Sched, bool ALIGN_EPI = false, bool SP2 = false>
__device__ __forceinline__ void gemm_phase(PG8_LAS unsigned char* lds, const Gemm g, const Sched& S, const Epi& E) {
    int tid_ = threadIdx.x; asm volatile("" : "+v"(tid_));
    const int tid = tid_, wid = __builtin_amdgcn_readfirstlane(tid >> 6), lane = tid & 63, wr = wid >> 2, wc = wid & 3, fr = lane & 15, fq = lane >> 4;
    const int K = g.K, nt = K / BK;
    unsigned voffA[2], voffB[2];
#pragma unroll
    for (int i = 0; i < 2; ++i) { int R, C; stage_rc(tid * 16 + i * 8192, R, C); const int Rb = Epi::PERM ? ((R & ~31) + perm32(R & 31)) : R;
        voffA[i] = (unsigned)(R * K + C) * 2u; voffB[i] = (unsigned)(Rb * K + C) * 2u; }
    const size_t kstep = (size_t)(BK * 2);
    const size_t hstep = (size_t)HALF * K * 2;
    const size_t tstep = 2 * hstep;
    const unsigned ldsw = (unsigned)wid * 1024u;
    const int aoff = lds_byte(wr * 64 + fr, fq * 8), boff = lds_byte(wc * 32 + fr, fq * 8);
#define PG8_SA(b, h) (((b) * 2 + (h)) * HTB)
#define PG8_SB(b, h) ((4 + (b) * 2 + (h)) * HTB)
#define PG8_STAGE(bufoff, gbase, voff) do { _Pragma("unroll") for (int _i = 0; _i < 2; ++_i) \
        __builtin_amdgcn_global_load_lds((const unsigned*)((const char*)(gbase) + (voff)[_i]), (PG8_LAS unsigned*)(lds + (bufoff) + ldsw + _i * 8192), 16, 0, 0); } while (0)
#define PG8_LDA(dst, b, h) do { _Pragma("unroll") for (int m = 0; m < 4; ++m) _Pragma("unroll") for (int k = 0; k < 2; ++k) dst[m][k] = *(const PG8_LAS bf16x8*)(lds + PG8_SA(b, h) + aoff + m * 2048 + k * 1024); } while (0)
#define PG8_LDB(dst, b, h) do { _Pragma("unroll") for (int n = 0; n < 2; ++n) _Pragma("unroll") for (int k = 0; k < 2; ++k) dst[n][k] = *(const PG8_LAS bf16x8*)(lds + PG8_SB(b, h) + boff + n * 2048 + k * 1024); } while (0)
#define PG8_MMA(ai, bj, At, Bt) do { __builtin_amdgcn_s_setprio(1); _Pragma("unroll") for (int m = 0; m < 4; ++m) _Pragma("unroll") for (int n = 0; n < 2; ++n) _Pragma("unroll") for (int k = 0; k < 2; ++k) \
        acc[ai][bj][m][n] = __builtin_amdgcn_mfma_f32_16x16x32_bf16(Bt[n][k], At[m][k], acc[ai][bj][m][n], 0, 0, 0); __builtin_amdgcn_s_setprio(0); } while (0)
#define PG8_WAIT_V(n) asm volatile("s_waitcnt vmcnt(" #n ")" ::: "memory")
#define PG8_WAIT_L(n) asm volatile("s_waitcnt lgkmcnt(" #n ")" ::: "memory")
#define PG8_BAR __builtin_amdgcn_s_barrier()
#define PG8_SCHED __builtin_amdgcn_sched_barrier(0)
    Unit cur, nxt; int ui = 0;
    if (!S.next(0, cur)) return;
    f32x4 acc[2][2][4][2];
#pragma unroll
    for (int a = 0; a < 2; ++a)
#pragma unroll
        for (int b = 0; b < 2; ++b)
#pragma unroll
            for (int m = 0; m < 4; ++m)
#pragma unroll
                for (int n = 0; n < 2; ++n) acc[a][b][m][n] = (f32x4){0.f, 0.f, 0.f, 0.f};
    bf16x8 At[4][2], B0[2][2], B1[2][2];
    const char* cA = (const char*)g.A + (size_t)cur.pm * tstep; const char* cB = (const char*)g.Bt + (size_t)cur.pn * tstep;
    S.a_ready(cur);
    if constexpr (SP2) {
        PG8_STAGE(PG8_SB(0, 0), cB, voffB); PG8_STAGE(PG8_SB(0, 1), cB + hstep, voffB); PG8_STAGE(PG8_SA(0, 0), cA, voffA); PG8_STAGE(PG8_SA(0, 1), cA + hstep, voffA);
        if (wr == 1) PG8_BAR;
        PG8_WAIT_V(2); PG8_BAR;
        PG8_STAGE(PG8_SB(1, 0), cB + kstep, voffB); PG8_STAGE(PG8_SA(1, 0), cA + kstep, voffA); PG8_STAGE(PG8_SB(1, 1), cB + hstep + kstep, voffB);
        PG8_WAIT_V(6); PG8_BAR;
    } else {
        PG8_STAGE(PG8_SB(0, 0), cB, voffB); PG8_STAGE(PG8_SA(0, 0), cA, voffA); PG8_STAGE(PG8_SB(0, 1), cB + hstep, voffB); PG8_STAGE(PG8_SA(0, 1), cA + hstep, voffA);
        if (wr == 1) PG8_BAR;
        PG8_WAIT_V(4); PG8_BAR;
        PG8_STAGE(PG8_SB(1, 0), cB + kstep, voffB); PG8_STAGE(PG8_SA(1, 0), cA + kstep, voffA); PG8_STAGE(PG8_SB(1, 1), cB + hstep + kstep, voffB);
        PG8_WAIT_V(6); PG8_BAR;
    }
    for (;;) {
        const bool has_next = S.next(ui + 1, nxt);
        const char* nA = has_next ? (const char*)g.A + (size_t)nxt.pm * tstep : cA; const char* nB = has_next ? (const char*)g.Bt + (size_t)nxt.pn * tstep : cB;
        for (int t = 0; t < nt; t += 2) {
            const bool last = (t == nt - 2);
            const char* a1 = cA + (size_t)(t + 1) * kstep;
            const char* a2 = last ? nA : cA + (size_t)(t + 2) * kstep; const char* b2 = last ? nB : cB + (size_t)(t + 2) * kstep;
            const char* a3 = a2 + kstep; const char* b3 = b2 + kstep;
            if (last && has_next) S.a_ready(nxt);
            if constexpr (SP2) {
            PG8_LDB(B0, 0, 0); PG8_LDB(B1, 0, 1); PG8_SCHED; PG8_LDA(At, 0, 0); PG8_STAGE(PG8_SA(1, 1), a1 + hstep, voffA);
            PG8_WAIT_V(8); PG8_WAIT_L(0); PG8_BAR; PG8_MMA(0, 0, At, B0); PG8_MMA(0, 1, At, B1); PG8_BAR; PG8_SCHED;
            PG8_LDA(At, 0, 1); PG8_STAGE(PG8_SB(0, 0), b2, voffB); PG8_STAGE(PG8_SB(0, 1), b2 + hstep, voffB); PG8_STAGE(PG8_SA(0, 0), a2, voffA);
            PG8_WAIT_V(8); PG8_WAIT_L(0); PG8_BAR; PG8_MMA(1, 0, At, B0); PG8_MMA(1, 1, At, B1); PG8_BAR; PG8_SCHED;
            PG8_LDB(B0, 1, 0); PG8_LDB(B1, 1, 1); PG8_SCHED; PG8_LDA(At, 1, 0); PG8_STAGE(PG8_SA(0, 1), a2 + hstep, voffA);
            PG8_WAIT_V(8); PG8_WAIT_L(0); PG8_BAR; PG8_MMA(0, 0, At, B0); PG8_MMA(0, 1, At, B1); PG8_BAR; PG8_SCHED;
            PG8_LDA(At, 1, 1); PG8_STAGE(PG8_SB(1, 0), b3, voffB); PG8_STAGE(PG8_SB(1, 1), b3 + hstep, voffB); PG8_STAGE(PG8_SA(1, 0), a3, voffA);
            PG8_WAIT_V(8); PG8_WAIT_L(0); PG8_BAR; PG8_MMA(1, 0, At, B0); PG8_MMA(1, 1, At, B1); PG8_BAR; PG8_SCHED;
            } else {
            PG8_LDB(B0, 0, 0); PG8_SCHED; PG8_LDA(At, 0, 0); PG8_STAGE(PG8_SA(1, 1), a1 + hstep, voffA);
            PG8_WAIT_L(8); PG8_BAR; PG8_WAIT_L(0); PG8_MMA(0, 0, At, B0); PG8_BAR; PG8_SCHED;
            PG8_LDB(B1, 0, 1); PG8_STAGE(PG8_SB(0, 0), b2, voffB);
            PG8_BAR; PG8_WAIT_L(0); PG8_MMA(0, 1, At, B1); PG8_BAR;
            PG8_LDA(At, 0, 1); PG8_STAGE(PG8_SA(0, 0), a2, voffA);
            PG8_BAR; PG8_WAIT_L(0); PG8_MMA(1, 0, At, B0); PG8_BAR; PG8_SCHED;
            PG8_STAGE(PG8_SB(0, 1), b2 + hstep, voffB);
            PG8_WAIT_V(6); PG8_BAR; PG8_MMA(1, 1, At, B1); PG8_BAR;
            PG8_LDB(B0, 1, 0); PG8_SCHED; PG8_LDA(At, 1, 0); PG8_STAGE(PG8_SA(0, 1), a2 + hstep, voffA);
            PG8_WAIT_L(8); PG8_BAR; PG8_WAIT_L(0); PG8_MMA(0, 0, At, B0); PG8_BAR; PG8_SCHED;
            PG8_LDB(B1, 1, 1); PG8_STAGE(PG8_SB(1, 0), b3, voffB);
            PG8_BAR; PG8_WAIT_L(0); PG8_MMA(0, 1, At, B1); PG8_BAR;
            PG8_LDA(At, 1, 1); PG8_STAGE(PG8_SA(1, 0), a3, voffA);
            PG8_BAR; PG8_WAIT_L(0); PG8_MMA(1, 0, At, B0); PG8_BAR; PG8_SCHED;
            PG8_STAGE(PG8_SB(1, 1), b3 + hstep, voffB);
            PG8_WAIT_V(6); PG8_BAR; PG8_MMA(1, 1, At, B1); PG8_BAR;
            }
        }
        if constexpr (ALIGN_EPI) { if (wr == 0) PG8_BAR; }
        if constexpr (!Epi::AFTER_DRAIN) { E(acc, cur, wr, wc, fr, fq); S.done(cur); }
        if (!has_next) break;
#pragma unroll
        for (int a = 0; a < 2; ++a)
#pragma unroll
            for (int b = 0; b < 2; ++b)
#pragma unroll
                for (int m = 0; m < 4; ++m)
#pragma unroll
                    for (int n = 0; n < 2; ++n) acc[a][b][m][n] = (f32x4){0.f, 0.f, 0.f, 0.f};
        cur = nxt; cA = nA; cB = nB; ++ui;
        if constexpr (ALIGN_EPI) { if (wr == 1) PG8_BAR; }
    }
    PG8_WAIT_V(0);
    if constexpr (!ALIGN_EPI) { if (wr == 0) PG8_BAR; }
    PG8_BAR;
    if constexpr (Epi::AFTER_DRAIN) { E.fused(acc, cur, wr, wc, fr, fq, lds, wid, lane); S.done(cur); }
#undef PG8_SA
#undef PG8_SB
#undef PG8_STAGE
#undef PG8_LDA
#undef PG8_LDB
#undef PG8_MMA
#undef PG8_WAIT_V
#undef PG8_WAIT_L
#undef PG8_BAR
#undef PG8_SCHED
}
}

#define LAS __attribute__((address_space(3)))
typedef unsigned short bf16;
typedef float f32x4 __attribute__((ext_vector_type(4)));
typedef float f32x2 __attribute__((ext_vector_type(2)));
typedef short bf16x8 __attribute__((ext_vector_type(8)));
typedef short s16x4 __attribute__((ext_vector_type(4)));
typedef short v4i16_t __attribute__((ext_vector_type(4)));
typedef unsigned u32x4 __attribute__((ext_vector_type(4)));
typedef unsigned u32x2 __attribute__((ext_vector_type(2)));

constexpr int NWAVES = 8, NTHREADS = 512;
constexpr int DM = 1024, SEQ = 4096, NBATCH = 4, MP = NBATCH * SEQ, NSMP = 32, MV = MP + NSMP, MT = 16640;
constexpr int DIN = 7680, QKV = 1536, DFF = 2816, NADA = 6144;
constexpr size_t O_YP = 0, O_YS = 16777216, O_KV0P = 16809984, O_KV1P = 17858560, O_KV2P = 22052864,
                 O_KV0S = 38830080, O_KV1S = 38895616, O_KV2S = 38961152, O_SV = 39026688, O_END = 39059456;
constexpr float LOG2E = 1.4426950408889634f;
constexpr float QSCALE = 0.08838834764831845f * LOG2E;

constexpr size_t MiB = 1u << 20;
constexpr size_t alm(size_t x) { return (x + MiB - 1) / MiB * MiB; }
constexpr size_t WS_WADA = 1 * MiB;
constexpr size_t WS_WL0 = WS_WADA + alm(2ull * NADA * DM * 2);
constexpr size_t WL_WIN = 0;
constexpr size_t WL_WPA = WL_WIN + alm((size_t)DIN * DM * 2);
constexpr size_t WL_WPS = WL_WPA + alm(1024ull * 512 * 2);
constexpr size_t WL_WOUT = WL_WPS + alm(1024ull * 512 * 2);
constexpr size_t WL_WFI = WL_WOUT + alm(1024ull * 1024 * 2);
constexpr size_t WL_WFO = WL_WFI + alm(5632ull * 1024 * 2);
constexpr size_t WL_WSP = WL_WFO + alm(1024ull * DFF * 2);
constexpr size_t WL_SIZE = WL_WSP + alm(8ull * 128 * 128 * 2);
constexpr size_t WS_MOD = WS_WL0 + 2 * WL_SIZE;
constexpr size_t WS_SC = WS_MOD + alm(2ull * 36 * NADA * 4);
constexpr size_t WS_XN = WS_SC + alm(256ull * DM * 2);
constexpr size_t WS_Q = WS_XN + alm((size_t)MT * DM * 2);
constexpr size_t WS_K = WS_Q + alm((size_t)MT * QKV * 2);
constexpr size_t WS_V = WS_K + alm((size_t)MT * QKV * 2);
constexpr size_t WS_U = WS_V + alm((size_t)MT * QKV * 2);
constexpr size_t WS_VS = WS_U + alm((size_t)MT * 512 * 2);
constexpr size_t WS_G = WS_VS + alm((size_t)MT * 512 * 2);
constexpr size_t WS_OG = WS_G + alm((size_t)MT * 2048 * 2);
constexpr size_t WS_DG = WS_OG + alm((size_t)MT * QKV * 2);
constexpr size_t WS_YA = WS_DG + alm((size_t)MT * 12 * 4);
constexpr size_t WS_YS = WS_YA + alm((size_t)MT * 512 * 2);
constexpr size_t WS_T1 = WS_YS + alm((size_t)MT * 512 * 2);
constexpr size_t WS_MG = WS_T1 + alm((size_t)MT * DM * 4);
constexpr size_t WS_X1 = WS_MG + alm((size_t)MT * DM * 2);
constexpr size_t WS_X2 = WS_X1 + alm((size_t)MT * DM * 4);
constexpr size_t WS_H = WS_X2 + alm((size_t)MT * DM * 4);
constexpr size_t WS_END = WS_H + alm((size_t)MT * DFF * 2);

constexpr int LDS_RING = 0, LDS_EXCH = 131072, LDS_BYTES = 155648;

__device__ __forceinline__ float bf2f(unsigned short h) { return __uint_as_float((unsigned)h << 16); }
__device__ __forceinline__ unsigned pk2(float lo, float hi) { return pg8::cvt_pk_bf16(lo, hi); }
__device__ __forceinline__ float fast_exp2(float x) { return __builtin_amdgcn_exp2f(x); }
__device__ __forceinline__ float sigmoidf_(float x) { return __builtin_amdgcn_rcpf(1.0f + fast_exp2(-x * LOG2E)); }
__device__ __forceinline__ float wave_sum(float v) {
#pragma unroll
    for (int o = 1; o < 64; o <<= 1) v += __shfl_xor(v, o);
    return v;
}
__device__ __forceinline__ float wave_max(float v) {
#pragma unroll
    for (int o = 1; o < 64; o <<= 1) v = fmaxf(v, __shfl_xor(v, o));
    return v;
}
__device__ __forceinline__ s16x4 vtr(const LAS unsigned char* p) { return __builtin_bit_cast(s16x4, __builtin_amdgcn_ds_read_tr16_b64_v4i16((LAS v4i16_t*)p)); }
#define LDS_WAIT() asm volatile("s_waitcnt lgkmcnt(0)" ::: "memory")

__device__ __forceinline__ int mod_row(int row) { return row < MP ? (row >> 12) : 4 + (row - MP); }

__device__ __forceinline__ __attribute__((address_space(1))) float* kv_out_ptr(__attribute__((address_space(1))) float* out, int layer, int g, int row, int kvi, int hh) {
    if (row < MP) {
        const int b = row >> 12, t = row & 4095, lw = 128 << (2 * g), tt = t - (SEQ - lw);
        if (tt < 0) return nullptr;
        const size_t base = g == 0 ? O_KV0P : (g == 1 ? O_KV1P : O_KV2P);
        return out + base + ((((size_t)(layer * NBATCH + b) * lw + tt) * 2 + kvi) * 4 + hh) * 128;
    } else if (row < MV) {
        const int b = row - MP;
        const size_t base = g == 0 ? O_KV0S : (g == 1 ? O_KV1S : O_KV2S);
        return out + base + (((size_t)(layer * NSMP + b) * 2 + kvi) * 4 + hh) * 128;
    }
    return nullptr;
}

using pg8::Unit;
typedef pg8::f32x4 (AccT)[2][2][4][2];

__device__ __forceinline__ void st8_bf16g(__attribute__((address_space(1))) bf16* p, f32x4 v0, f32x4 v1) {
    u32x4 w; w.x = pk2(v0[0], v0[1]); w.y = pk2(v0[2], v0[3]); w.z = pk2(v1[0], v1[1]); w.w = pk2(v1[2], v1[3]);
    *(__attribute__((address_space(1))) u32x4*)p = w;
}
__device__ __forceinline__ void st8_bf16(bf16* p, f32x4 v0, f32x4 v1) {
    u32x4 w; w.x = pk2(v0[0], v0[1]); w.y = pk2(v0[2], v0[3]); w.z = pk2(v1[0], v1[1]); w.w = pk2(v1[2], v1[3]);
    *(u32x4*)p = w;
}

#define LAUNDER_S(x) asm volatile("" : "+s"(x))
#define GP(T, p) ((T*)(__attribute__((address_space(1))) T*)(p))
struct EpiAda {
    static constexpr bool PERM = true, AFTER_DRAIN = false;
    float* MOD; const float* b_ada;
    __device__ __forceinline__ void operator()(const pg8::f32x4 (&acc)[2][2][4][2], const Unit& u, int wr, int wc, int fr_, int fq_) const {
        int fr = fr_, fq = fq_; asm volatile("" : "+v"(fr), "+v"(fq));
        if (u.pm != 0 || wr != 0) return;
#pragma unroll
        for (int m = 0; m < 3; ++m) {
            const int row = m * 16 + fr;
            if (row >= 36) continue;
#pragma unroll
            for (int bj = 0; bj < 2; ++bj) {
                const int col = u.pn * 256 + bj * 128 + wc * 32 + 8 * fq;
                const int layer = col / NADA, c = col - layer * NADA;
                const float* bp = b_ada + (size_t)layer * NADA + c;
                float* op = MOD + ((size_t)layer * 36 + row) * NADA + c;
                *(f32x4*)op = acc[0][bj][m][0] + *(const f32x4*)bp;
                *(f32x4*)(op + 4) = acc[0][bj][m][1] + *(const f32x4*)(bp + 4);
            }
        }
    }
};

struct EpiIn {
    static constexpr bool PERM = true, AFTER_DRAIN = false;
    unsigned char* wsb; const float* qw; const float* kw; float* out; int layer; LAS float* P;
    __device__ __forceinline__ void operator()(const pg8::f32x4 (&acc)[2][2][4][2], const Unit& u, int wr, int wc, int fr_, int fq_) const {
        int fr = fr_, fq = fq_; asm volatile("" : "+v"(fr), "+v"(fq));
        unsigned char* wsl = wsb; const float* qwl = qw; const float* kwl = kw; float* outl = out; LAUNDER_S(wsl); LAUNDER_S(qwl); LAUNDER_S(kwl); LAUNDER_S(outl);
        typedef __attribute__((address_space(1))) bf16 gbf; typedef __attribute__((address_space(1))) float gfl;
        gbf *Q = (gbf*)(wsl + WS_Q), *K = (gbf*)(wsl + WS_K), *V = (gbf*)(wsl + WS_V), *U = (gbf*)(wsl + WS_U), *VS = (gbf*)(wsl + WS_VS), *G = (gbf*)(wsl + WS_G);
        gfl* outg = (gfl*)outl;
        const int pn = u.pn;
        const int cw = wc * 32 + 8 * fq;
        const int rowb = u.pm * 256 + wr * 64 + fr;
        if (pn < 12) {
            const bool isk = pn >= 6;
#pragma unroll
            for (int ai = 0; ai < 2; ++ai)
#pragma unroll
                for (int m = 0; m < 4; ++m)
#pragma unroll
                    for (int bj = 0; bj < 2; ++bj) {
                        const pg8::f32x4 a = acc[ai][bj][m][0], b = acc[ai][bj][m][1];
                        float s = (a[0] * a[0] + a[1] * a[1]) + (a[2] * a[2] + a[3] * a[3]) + (b[0] * b[0] + b[1] * b[1]) + (b[2] * b[2] + b[3] * b[3]);
                        s += __shfl_xor(s, 16); s += __shfl_xor(s, 32);
                        if (fq == 0) P[(ai * 128 + wr * 64 + m * 16 + fr) * 8 + bj * 4 + wc] = s;
                    }
            asm volatile("s_waitcnt lgkmcnt(0)" ::: "memory"); __builtin_amdgcn_s_barrier(); asm volatile("" ::: "memory");
#pragma unroll
            for (int bj = 0; bj < 2; ++bj) {
                const int head = 2 * (isk ? pn - 6 : pn) + bj, g = head >> 2, hh = head & 3;
                const __attribute__((address_space(1))) float* wv = (const __attribute__((address_space(1))) float*)(isk ? kwl : qwl) + g * 128 + cw;
                pg8::f32x4 w0 = *(const __attribute__((address_space(1))) f32x4*)wv, w1 = *(const __attribute__((address_space(1))) f32x4*)(wv + 4);
                if (!isk) { w0 = w0 * QSCALE; w1 = w1 * QSCALE; }
                gbf* dst = (isk ? K : Q) + head * 128 + cw;
#pragma unroll
                for (int ai = 0; ai < 2; ++ai)
#pragma unroll
                    for (int m = 0; m < 4; ++m) {
                        const int rl = ai * 128 + wr * 64 + m * 16 + fr, row = u.pm * 256 + rl;
                        const f32x4 pv = *(const LAS f32x4*)(P + rl * 8 + bj * 4);
                        const float rstd = 1.0f / sqrtf(((pv[0] + pv[1]) + (pv[2] + pv[3])) * (1.0f / 128.0f) + 1e-6f);
                        const pg8::f32x4 v0 = acc[ai][bj][m][0] * rstd * w0, v1 = acc[ai][bj][m][1] * rstd * w1;
                        st8_bf16g(dst + (size_t)row * QKV, v0, v1);
                        if (isk) { gfl* o = kv_out_ptr(outg, layer, g, row, 0, hh); if (o) { *(__attribute__((address_space(1))) f32x4*)(o + cw) = v0; *(__attribute__((address_space(1))) f32x4*)(o + cw + 4) = v1; } }
                    }
            }
        } else if (pn < 18) {
#pragma unroll
            for (int bj = 0; bj < 2; ++bj) {
                const int head = 2 * (pn - 12) + bj, g = head >> 2, hh = head & 3;
                gbf* dst = V + head * 128 + cw;
#pragma unroll
                for (int ai = 0; ai < 2; ++ai)
#pragma unroll
                    for (int m = 0; m < 4; ++m) {
                        const int row = rowb + ai * 128 + m * 16;
                        const pg8::f32x4 v0 = acc[ai][bj][m][0], v1 = acc[ai][bj][m][1];
                        st8_bf16g(dst + (size_t)row * QKV, v0, v1);
                        gfl* o = kv_out_ptr(outg, layer, g, row, 1, hh); if (o) { *(__attribute__((address_space(1))) f32x4*)(o + cw) = v0; *(__attribute__((address_space(1))) f32x4*)(o + cw + 4) = v1; }
                    }
            }
        } else if (pn < 22) {
            gbf* base = (pn < 20 ? U : VS) + ((pn - 18) & 1) * 256 + cw;
#pragma unroll
            for (int bj = 0; bj < 2; ++bj)
#pragma unroll
                for (int ai = 0; ai < 2; ++ai)
#pragma unroll
                    for (int m = 0; m < 4; ++m) {
                        const int row = rowb + ai * 128 + m * 16;
                        const pg8::f32x4 v0 = acc[ai][bj][m][0], v1 = acc[ai][bj][m][1];
                        const pg8::f32x2 a = pg8::gelu_pk((pg8::f32x2){v0[0], v0[1]}), b = pg8::gelu_pk((pg8::f32x2){v0[2], v0[3]}),
                                         c = pg8::gelu_pk((pg8::f32x2){v1[0], v1[1]}), d = pg8::gelu_pk((pg8::f32x2){v1[2], v1[3]});
                        st8_bf16g(base + (size_t)row * 512 + bj * 128, (f32x4){a.x, a.y, b.x, b.y}, (f32x4){c.x, c.y, d.x, d.y});
                    }
        } else {
            gbf* base = G + (pn - 22) * 256 + cw;
#pragma unroll
            for (int bj = 0; bj < 2; ++bj)
#pragma unroll
                for (int ai = 0; ai < 2; ++ai)
#pragma unroll
                    for (int m = 0; m < 4; ++m) {
                        const int row = rowb + ai * 128 + m * 16;
                        const pg8::f32x4 v0 = acc[ai][bj][m][0], v1 = acc[ai][bj][m][1];
                        st8_bf16g(base + (size_t)row * 2048 + bj * 128,
                                 (f32x4){sigmoidf_(v0[0]), sigmoidf_(v0[1]), sigmoidf_(v0[2]), sigmoidf_(v0[3])},
                                 (f32x4){sigmoidf_(v1[0]), sigmoidf_(v1[1]), sigmoidf_(v1[2]), sigmoidf_(v1[3])});
                    }
        }
    }
};

struct EpiGate1 {
    static constexpr bool PERM = true, AFTER_DRAIN = false;
    const bf16* G; float* T1;
    __device__ __forceinline__ void operator()(const pg8::f32x4 (&acc)[2][2][4][2], const Unit& u, int wr, int wc, int fr_, int fq_) const {
        int fr = fr_, fq = fq_; asm volatile("" : "+v"(fr), "+v"(fq));
        const int col0 = u.pn * 256 + wc * 32 + 8 * fq, rowb = u.pm * 256 + wr * 64 + fr;
#pragma unroll
        for (int ai = 0; ai < 2; ++ai)
#pragma unroll
            for (int m = 0; m < 4; ++m) {
                const int row = rowb + ai * 128 + m * 16;
#pragma unroll
                for (int bj = 0; bj < 2; ++bj) {
                    const int col = col0 + bj * 128;
                    const u32x4 gv = *(const u32x4*)(G + (size_t)row * 2048 + col);
                    const f32x4 g0 = {__uint_as_float(gv.x << 16), __uint_as_float(gv.x & 0xffff0000u), __uint_as_float(gv.y << 16), __uint_as_float(gv.y & 0xffff0000u)};
                    const f32x4 g1 = {__uint_as_float(gv.z << 16), __uint_as_float(gv.z & 0xffff0000u), __uint_as_float(gv.w << 16), __uint_as_float(gv.w & 0xffff0000u)};
                    float* o = T1 + (size_t)row * DM + col;
                    *(f32x4*)o = g0 * acc[ai][bj][m][0]; *(f32x4*)(o + 4) = g1 * acc[ai][bj][m][1];
                }
            }
    }
};
struct EpiGate2 {
    static constexpr bool PERM = true, AFTER_DRAIN = false;
    const bf16* G; const float* T1; bf16* MG;
    __device__ __forceinline__ void operator()(const pg8::f32x4 (&acc)[2][2][4][2], const Unit& u, int wr, int wc, int fr_, int fq_) const {
        int fr = fr_, fq = fq_; asm volatile("" : "+v"(fr), "+v"(fq));
        const int col0 = u.pn * 256 + wc * 32 + 8 * fq, rowb = u.pm * 256 + wr * 64 + fr;
#pragma unroll
        for (int ai = 0; ai < 2; ++ai)
#pragma unroll
            for (int m = 0; m < 4; ++m) {
                const int row = rowb + ai * 128 + m * 16;
#pragma unroll
                for (int bj = 0; bj < 2; ++bj) {
                    const int col = col0 + bj * 128;
                    const u32x4 gv = *(const u32x4*)(G + (size_t)row * 2048 + 1024 + col);
                    const f32x4 g0 = {__uint_as_float(gv.x << 16), __uint_as_float(gv.x & 0xffff0000u), __uint_as_float(gv.y << 16), __uint_as_float(gv.y & 0xffff0000u)};
                    const f32x4 g1 = {__uint_as_float(gv.z << 16), __uint_as_float(gv.z & 0xffff0000u), __uint_as_float(gv.w << 16), __uint_as_float(gv.w & 0xffff0000u)};
                    const float* t = T1 + (size_t)row * DM + col;
                    const f32x4 t0 = *(const f32x4*)t, t1 = *(const f32x4*)(t + 4);
                    st8_bf16(MG + (size_t)row * DM + col, t0 + g0 * acc[ai][bj][m][0], t1 + g1 * acc[ai][bj][m][1]);
                }
            }
    }
};
struct EpiRes {
    static constexpr bool PERM = true, AFTER_DRAIN = false;
    const float* bp; const float* bs; float* op; float* os; const float* gate;
    __device__ __forceinline__ void operator()(const pg8::f32x4 (&acc)[2][2][4][2], const Unit& u, int wr, int wc, int fr_, int fq_) const {
        int fr = fr_, fq = fq_; asm volatile("" : "+v"(fr), "+v"(fq));
        const int col0 = u.pn * 256 + wc * 32 + 8 * fq, rowb = u.pm * 256 + wr * 64 + fr;
#pragma unroll
        for (int ai = 0; ai < 2; ++ai)
#pragma unroll
            for (int m = 0; m < 4; ++m) {
                const int row = rowb + ai * 128 + m * 16;
                if (row < MV) {
                    const float* b = row < MP ? bp + (size_t)row * DM : bs + (size_t)(row - MP) * DM;
                    float* o = row < MP ? op + (size_t)row * DM : os + (size_t)(row - MP) * DM;
                    const float* gt = gate + (size_t)mod_row(row) * NADA;
#pragma unroll
                    for (int bj = 0; bj < 2; ++bj) {
                        const int col = col0 + bj * 128;
                        const f32x4 b0 = *(const f32x4*)(b + col), b1 = *(const f32x4*)(b + col + 4);
                        const f32x4 g0 = *(const f32x4*)(gt + col), g1 = *(const f32x4*)(gt + col + 4);
                        *(f32x4*)(o + col) = b0 + g0 * acc[ai][bj][m][0]; *(f32x4*)(o + col + 4) = b1 + g1 * acc[ai][bj][m][1];
                    }
                }
            }
    }
};
struct EpiSwiglu {
    static constexpr bool PERM = true, AFTER_DRAIN = false;
    bf16* H;
    __device__ __forceinline__ void operator()(const pg8::f32x4 (&acc)[2][2][4][2], const Unit& u, int wr, int wc, int fr_, int fq_) const {
        int fr = fr_, fq = fq_; asm volatile("" : "+v"(fr), "+v"(fq));
        const int col = u.pn * 128 + wc * 32 + 8 * fq, rowb = u.pm * 256 + wr * 64 + fr;
#pragma unroll
        for (int ai = 0; ai < 2; ++ai)
#pragma unroll
            for (int m = 0; m < 4; ++m) {
                const int row = rowb + ai * 128 + m * 16;
                f32x4 r0, r1;
#pragma unroll
                for (int e = 0; e < 4; ++e) {
                    const float a0 = acc[ai][0][m][0][e], a1 = acc[ai][0][m][1][e];
                    r0[e] = a0 * sigmoidf_(a0) * acc[ai][1][m][0][e];
                    r1[e] = a1 * sigmoidf_(a1) * acc[ai][1][m][1][e];
                }
                st8_bf16(H + (size_t)row * DFF + col, r0, r1);
            }
    }
};

__device__ __forceinline__ void transpose_item(const float* W, int K, int N, bf16* WT, int mode, LAS float* scr, int item, int lane) {
    const int nblk = N / 32, kb = item / nblk, nb = item % nblk, k0 = 64 * kb, n0 = 32 * nb;
    float wv[32];
#pragma unroll
    for (int i = 0; i < 32; ++i) wv[i] = W[(size_t)(k0 + 2 * i + (lane >> 5)) * N + n0 + (lane & 31)];
#pragma unroll
    for (int i = 0; i < 32; ++i) scr[(2 * i + (lane >> 5)) * 33 + (lane & 31)] = wv[i];
    LDS_WAIT(); asm volatile("" ::: "memory");
    int drow0 = n0;
    if (mode == 1) { const int bj = n0 >= DFF ? 1 : 0; const int j0 = n0 - bj * DFF; drow0 = (j0 >> 7) * 256 + bj * 128 + (j0 & 127); }
    const int c = lane & 7;
#pragma unroll
    for (int j = 0; j < 4; ++j) { const int n = (lane >> 3) + 8 * j; const LAS float* s = scr + (8 * c) * 33 + n;
        u32x4 o; o.x = pk2(s[0 * 33], s[1 * 33]); o.y = pk2(s[2 * 33], s[3 * 33]); o.z = pk2(s[4 * 33], s[5 * 33]); o.w = pk2(s[6 * 33], s[7 * 33]);
        *(u32x4*)(WT + (size_t)(drow0 + n) * K + k0 + 8 * c) = o; }
    LDS_WAIT(); asm volatile("" ::: "memory");
}

__device__ __forceinline__ void norm_mod_phase(const float* xp, const float* xs, const float* nw, const float* modl, int sh_off, bf16* XN, int gw, int NGW, int lane) {
    for (int row = gw; row < MT; row += NGW) {
        unsigned long long* o8 = (unsigned long long*)(XN + (size_t)row * DM) + lane;
        if (row >= MV) {
#pragma unroll
            for (int j = 0; j < 4; ++j) o8[64 * j] = 0ull;
            continue;
        }
        const float* xrow = row < MP ? xp + (size_t)row * DM : xs + (size_t)(row - MP) * DM;
        const f32x4* xr = (const f32x4*)xrow + lane;
        f32x4 v[4]; float s = 0.f;
#pragma unroll
        for (int j = 0; j < 4; ++j) { v[j] = xr[64 * j]; s += (v[j].x * v[j].x + v[j].y * v[j].y) + (v[j].z * v[j].z + v[j].w * v[j].w); }
        const float rstd = 1.0f / sqrtf(wave_sum(s) * (1.0f / DM) + 1e-6f);
        const float* mr = modl + (size_t)mod_row(row) * NADA + sh_off;
#pragma unroll
        for (int j = 0; j < 4; ++j) {
            const int col = 4 * lane + 256 * j;
            const f32x4 w = *(const f32x4*)(nw + col), shv = *(const f32x4*)(mr + col), scv = *(const f32x4*)(mr + 1024 + col);
            const f32x4 y = v[j] * rstd * w * (scv + 1.0f) + shv;
            o8[64 * j] = (unsigned long long)pk2(y.x, y.y) | ((unsigned long long)pk2(y.z, y.w) << 32);
        }
    }
}

constexpr int KV_STRIDE = 272;
constexpr int ATT_K_OFF = 0, ATT_V_OFF = 256 * KV_STRIDE;
__device__ __forceinline__ float alibi_slope(int head12) { return exp2f(-8.0f * (float)(head12 + 1) / 12.0f); }

__device__ __forceinline__ void attn_unit(LAS unsigned char* lds, const bf16* Q, const bf16* K, const bf16* V, bf16* OG, float* DG, int unit, float cshift, int wid, int lane, int tid) {
    const int g = unit >> 9, r9 = unit & 511, sh = 2 * g, d = 1 << sh, nb = 32 >> sh;
    const int qb = r9 % nb; int t2 = r9 / nb; const int r = t2 % d; t2 /= d; const int h = t2 & 3, b = t2 >> 2;
    const int hc = (g * 4 + h) * 128;
    {
        const int ch = tid & 15, r0 = tid >> 4;
        u32x4 kv[8], vv[8];
#pragma unroll
        for (int it = 0; it < 8; ++it) {
            const int j = r0 + 32 * it, mk = 128 * qb - 128 + j;
            if (qb > 0 || it >= 4) {
                const size_t off = ((size_t)b * SEQ + (size_t)mk * d + r) * QKV + hc + ch * 8;
                kv[it] = *(const u32x4*)(K + off); vv[it] = *(const u32x4*)(V + off);
            } else { kv[it] = (u32x4){0u, 0u, 0u, 0u}; vv[it] = (u32x4){0u, 0u, 0u, 0u}; }
        }
#pragma unroll
        for (int it = 0; it < 8; ++it) {
            const int j = r0 + 32 * it;
            *(LAS u32x4*)(lds + ATT_K_OFF + j * KV_STRIDE + ch * 16) = kv[it];
            *(LAS u32x4*)(lds + ATT_V_OFF + j * KV_STRIDE + ch * 16) = vv[it];
        }
    }
    const int ql = lane & 15, gq = lane >> 4;
    const int qi = 16 * wid + ql;
    const size_t qrow = (size_t)b * SEQ + (size_t)(128 * qb + qi) * d + r;
    bf16x8 qf[4];
#pragma unroll
    for (int kk = 0; kk < 4; ++kk) qf[kk] = *(const bf16x8*)(Q + qrow * QKV + hc + 32 * kk + 8 * gq);
    const float slope2 = alibi_slope(g * 4 + h) * LOG2E * (float)d;
    __syncthreads();
    f32x4 accO[8];
#pragma unroll
    for (int dt = 0; dt < 8; ++dt) accO[dt] = (f32x4){0.f, 0.f, 0.f, 0.f};
    float dsum = 0.f;
    const LAS unsigned char* kbase = lds + ATT_K_OFF + (16 * wid + ql) * KV_STRIDE + gq * 16;
    const LAS unsigned char* vbase = lds + ATT_V_OFF + (16 * wid + 4 * gq + (ql >> 2)) * KV_STRIDE + (ql & 3) * 8;
#pragma unroll
    for (int kt2 = 0; kt2 < 5; ++kt2) {
        const int ja = 16 * wid + 32 * kt2;
        f32x4 sa = {0.f, 0.f, 0.f, 0.f}, sb = {0.f, 0.f, 0.f, 0.f};
#pragma unroll
        for (int kk = 0; kk < 4; ++kk) {
            const bf16x8 ka = *(const LAS bf16x8*)(kbase + (32 * kt2) * KV_STRIDE + kk * 64);
            sa = __builtin_amdgcn_mfma_f32_16x16x32_bf16(ka, qf[kk], sa, 0, 0, 0);
        }
        if (kt2 < 4) {
#pragma unroll
            for (int kk = 0; kk < 4; ++kk) {
                const bf16x8 kb = *(const LAS bf16x8*)(kbase + (32 * kt2 + 16) * KV_STRIDE + kk * 64);
                sb = __builtin_amdgcn_mfma_f32_16x16x32_bf16(kb, qf[kk], sb, 0, 0, 0);
            }
        }
        float pa[4], pb[4];
#pragma unroll
        for (int jj = 0; jj < 4; ++jj) {
            const int j = ja + 4 * gq + jj, dist = 128 + qi - j;
            const bool ok = dist >= 0 && dist <= 128 && (128 * qb - 128 + j) >= 0;
            pa[jj] = ok ? fast_exp2(sa[jj] - slope2 * (float)dist - cshift) : 0.f;
            const int j2 = j + 16, dist2 = dist - 16;
            const bool ok2 = (kt2 < 4) && dist2 >= 0 && dist2 <= 128 && (128 * qb - 128 + j2) >= 0;
            pb[jj] = ok2 ? fast_exp2(sb[jj] - slope2 * (float)dist2 - cshift) : 0.f;
            dsum += pa[jj] + pb[jj];
        }
        u32x4 pw; pw.x = pk2(pa[0], pa[1]); pw.y = pk2(pa[2], pa[3]); pw.z = pk2(pb[0], pb[1]); pw.w = pk2(pb[2], pb[3]);
        const bf16x8 pfrag = __builtin_bit_cast(bf16x8, pw);
        const int rb = (kt2 < 4) ? (32 * kt2 + 16) : (32 * kt2);
#pragma unroll
        for (int dt = 0; dt < 8; ++dt) {
            const s16x4 lo = vtr(vbase + (32 * kt2) * KV_STRIDE + dt * 32);
            const s16x4 hi = vtr(vbase + rb * KV_STRIDE + dt * 32);
            const bf16x8 vf = {lo[0], lo[1], lo[2], lo[3], hi[0], hi[1], hi[2], hi[3]};
            accO[dt] = __builtin_amdgcn_mfma_f32_16x16x32_bf16(vf, pfrag, accO[dt], 0, 0, 0);
        }
    }
    dsum += __shfl_xor(dsum, 16); dsum += __shfl_xor(dsum, 32);
    const float inv = 1.0f / dsum;
    bf16* op = OG + qrow * QKV + g * 512 + h * 128 + 4 * gq;
#pragma unroll
    for (int dt = 0; dt < 8; ++dt) {
        u32x2 w; w.x = pk2(accO[dt][0] * inv, accO[dt][1] * inv); w.y = pk2(accO[dt][2] * inv, accO[dt][3] * inv);
        *(u32x2*)(op + dt * 16) = w;
    }
    if (gq == 0) DG[qrow * 12 + g * 4 + h] = dsum;
    __syncthreads();
}

__device__ __forceinline__ void attn_sample_item(LAS unsigned char* lds, const bf16* Q, const bf16* K, const bf16* V, const float* c0, const float* c1, const float* c2, int layer, bf16* YA, int item, int wid, int lane, int tid) {
    const int b = item >> 2, h = item & 3;
    LAS float* sc = (LAS float*)lds;
    LAS float* qs = (LAS float*)(lds + 2048);
    LAS float* part = (LAS float*)(lds + 4096);
    LAS float* pself = (LAS float*)(lds + 8192);
    const size_t row = (size_t)MP + b;
    if (tid < 384) { const int g = tid >> 7, dd = tid & 127; qs[tid] = bf2f(Q[row * QKV + (g * 4 + h) * 128 + dd]); }
    LDS_WAIT(); __syncthreads();
    const int k = lane >> 2, qd = lane & 3;
    {
        f32x4 kv[3][8];
#pragma unroll
        for (int i = 0; i < 3; ++i) {
            const int jj = 16 * (wid + 8 * i) + k, g = (wid + 8 * i) >> 3  , step = (jj & 127) + 1, d = 1 << (2 * g), lc = 128 << (2 * g);
            const float* cp = (g == 0 ? c0 : (g == 1 ? c1 : c2)) + ((((size_t)(layer * NSMP + b) * lc + (lc - d * step)) * 2 + 0) * 4 + h) * 128 + qd * 32;
#pragma unroll
            for (int e = 0; e < 8; ++e) kv[i][e] = *(const f32x4*)(cp + 4 * e);
        }
#pragma unroll
        for (int i = 0; i < 3; ++i) {
            const int jj = 16 * (wid + 8 * i) + k, g = i, step = (jj & 127) + 1, d = 1 << (2 * g);
            float s = 0.f;
#pragma unroll
            for (int e = 0; e < 8; ++e) { const f32x4 qv = *(const LAS f32x4*)(qs + g * 128 + qd * 32 + 4 * e); s += (kv[i][e].x * qv.x + kv[i][e].y * qv.y) + (kv[i][e].z * qv.z + kv[i][e].w * qv.w); }
            s += __shfl_xor(s, 1); s += __shfl_xor(s, 2);
            s -= alibi_slope(g * 4 + h) * LOG2E * (float)(d * step);
            if (qd == 0) sc[g * 132 + step] = s;
        }
        if (wid < 3) {
            const unsigned kk = *(const unsigned*)(K + row * QKV + (wid * 4 + h) * 128 + 2 * lane);
            float s = __uint_as_float(kk << 16) * qs[wid * 128 + 2 * lane] + __uint_as_float(kk & 0xffff0000u) * qs[wid * 128 + 2 * lane + 1];
            s = wave_sum(s);
            if (lane == 0) sc[wid * 132] = s;
        }
    }
    LDS_WAIT(); __syncthreads();
    float mx = -3.0e38f;
    for (int j = lane; j < 387; j += 64) { const int g = j / 129; mx = fmaxf(mx, sc[g * 132 + (j - g * 129)]); }
    mx = wave_max(mx);
    float den = 0.f;
    for (int j = lane; j < 387; j += 64) { const int g = j / 129; den += fast_exp2(sc[g * 132 + (j - g * 129)] - mx); }
    den = wave_sum(den);
    {
        f32x4 vv[3][8];
#pragma unroll
        for (int i = 0; i < 3; ++i) {
            const int jj = 16 * (wid + 8 * i) + k, g = i, step = (jj & 127) + 1, d = 1 << (2 * g), lc = 128 << (2 * g);
            const float* cp = (g == 0 ? c0 : (g == 1 ? c1 : c2)) + ((((size_t)(layer * NSMP + b) * lc + (lc - d * step)) * 2 + 1) * 4 + h) * 128 + qd * 32;
#pragma unroll
            for (int e = 0; e < 8; ++e) vv[i][e] = *(const f32x4*)(cp + 4 * e);
        }
        f32x4 acc[8];
#pragma unroll
        for (int e = 0; e < 8; ++e) acc[e] = (f32x4){0.f, 0.f, 0.f, 0.f};
#pragma unroll
        for (int i = 0; i < 3; ++i) {
            const int jj = 16 * (wid + 8 * i) + k, step = (jj & 127) + 1;
            const float p = fast_exp2(sc[i * 132 + step] - mx);
#pragma unroll
            for (int e = 0; e < 8; ++e) acc[e] += vv[i][e] * p;
        }
#pragma unroll
        for (int e = 0; e < 8; ++e)
#pragma unroll
            for (int c = 0; c < 4; ++c) { float v = acc[e][c]; v += __shfl_xor(v, 4); v += __shfl_xor(v, 8); v += __shfl_xor(v, 16); v += __shfl_xor(v, 32); acc[e][c] = v; }
        if (k == 0) {
#pragma unroll
            for (int e = 0; e < 8; ++e) *(LAS f32x4*)(part + wid * 128 + qd * 32 + 4 * e) = acc[e];
        }
        if (tid < 3) pself[tid] = fast_exp2(sc[tid * 132] - mx);
    }
    LDS_WAIT(); __syncthreads();
    if (tid < 128) {
        float a = 0.f;
#pragma unroll
        for (int w = 0; w < 8; ++w) a += part[w * 128 + tid];
#pragma unroll
        for (int g = 0; g < 3; ++g) a += pself[g] * bf2f(V[row * QKV + (g * 4 + h) * 128 + tid]);
        YA[row * 512 + h * 128 + tid] = (bf16)(pk2(a / den, 0.f) & 0xffffu);
    }
    LDS_WAIT(); __syncthreads();
}

constexpr int SG_STRIDE = 144;
constexpr int SG_SLAB = 128 * SG_STRIDE;
constexpr int SG_STATS = 4 * SG_SLAB;
__device__ __forceinline__ void sgu_unit(LAS unsigned char* lds, const bf16* U, const bf16* VS, const float* lnw, const float* lnb, const bf16* WSP, const float* bsp, bf16* YS, int unit, int wid, int lane) {
    const int half = unit & 1, bn = unit >> 1;
    const size_t R0 = (size_t)bn * 128;
    LAS f32x2* stats = (LAS f32x2*)(lds + SG_STATS);
    for (int i = 0; i < 16; ++i) {
        const int rl = 16 * wid + i;
        const u32x4 x = *(const u32x4*)(VS + (R0 + rl) * 512 + 8 * lane);
        const float f[8] = {__uint_as_float(x.x << 16), __uint_as_float(x.x & 0xffff0000u), __uint_as_float(x.y << 16), __uint_as_float(x.y & 0xffff0000u),
                            __uint_as_float(x.z << 16), __uint_as_float(x.z & 0xffff0000u), __uint_as_float(x.w << 16), __uint_as_float(x.w & 0xffff0000u)};
        float s = 0.f, s2 = 0.f;
#pragma unroll
        for (int e = 0; e < 8; ++e) { s += f[e]; s2 += f[e] * f[e]; }
        s = wave_sum(s); s2 = wave_sum(s2);
        const float mean = s * (1.0f / 512.0f), var = fmaxf(s2 * (1.0f / 512.0f) - mean * mean, 0.f);
        if (lane == 0) stats[rl] = (f32x2){mean, 1.0f / sqrtf(var + 1e-6f)};
    }
    LDS_WAIT(); __syncthreads();
    const int gl = wid & 3, th = wid >> 2, grp = half * 4 + gl, c0 = grp * 64;
    LAS unsigned char* slab = lds + gl * SG_SLAB;
    {
        const int cc = (lane & 7) * 8;
        const f32x4 w0 = *(const f32x4*)(lnw + c0 + cc), w1 = *(const f32x4*)(lnw + c0 + cc + 4), b0 = *(const f32x4*)(lnb + c0 + cc), b1 = *(const f32x4*)(lnb + c0 + cc + 4);
#pragma unroll
        for (int it = 0; it < 8; ++it) {
            const int rl = th * 64 + it * 8 + (lane >> 3);
            const u32x4 x = *(const u32x4*)(VS + (R0 + rl) * 512 + c0 + cc);
            const f32x2 st = stats[rl];
            f32x4 a = {__uint_as_float(x.x << 16), __uint_as_float(x.x & 0xffff0000u), __uint_as_float(x.y << 16), __uint_as_float(x.y & 0xffff0000u)};
            f32x4 c = {__uint_as_float(x.z << 16), __uint_as_float(x.z & 0xffff0000u), __uint_as_float(x.w << 16), __uint_as_float(x.w & 0xffff0000u)};
            a = (a - st.x) * st.y * w0 + b0; c = (c - st.x) * st.y * w1 + b1;
            u32x4 o; o.x = pk2(a[0], a[1]); o.y = pk2(a[2], a[3]); o.z = pk2(c[0], c[1]); o.w = pk2(c[2], c[3]);
            *(LAS u32x4*)(slab + rl * SG_STRIDE + cc * 2) = o;
        }
    }
    LDS_WAIT(); __syncthreads();
    const int ql = lane & 15, gq = lane >> 4;
    const LAS unsigned char* abase = slab + (8 * gq + (ql >> 2)) * SG_STRIDE + (ql & 3) * 8;
    const bf16* wg = WSP + (size_t)grp * 128 * 128;
#pragma unroll
    for (int ti = 0; ti < 4; ++ti) {
        const int tt = th == 0 ? (ti == 0 ? 0 : (ti == 1 ? 3 : (ti == 2 ? 4 : 7))) : (ti == 0 ? 1 : (ti == 1 ? 2 : (ti == 2 ? 5 : 6)));
        const int t = 16 * tt + ql;
        f32x4 acc[4];
#pragma unroll
        for (int ct = 0; ct < 4; ++ct) acc[ct] = (f32x4){0.f, 0.f, 0.f, 0.f};
        for (int kk = 0; kk <= (tt >> 1); ++kk) {
            const bf16x8 wf = *(const bf16x8*)(wg + (size_t)t * 128 + 32 * kk + 8 * gq);
#pragma unroll
            for (int ct = 0; ct < 4; ++ct) {
                const s16x4 lo = vtr(abase + (32 * kk) * SG_STRIDE + ct * 32);
                const s16x4 hi = vtr(abase + (32 * kk + 4) * SG_STRIDE + ct * 32);
                const bf16x8 af = {lo[0], lo[1], lo[2], lo[3], hi[0], hi[1], hi[2], hi[3]};
                acc[ct] = __builtin_amdgcn_mfma_f32_16x16x32_bf16(af, wf, acc[ct], 0, 0, 0);
            }
        }
        const float bias = bsp[grp * 128 + t];
#pragma unroll
        for (int ct = 0; ct < 4; ++ct) {
            const size_t off = (R0 + t) * 512 + c0 + ct * 16 + 4 * gq;
            const u32x2 uu = *(const u32x2*)(U + off);
            const float u0 = __uint_as_float(uu.x << 16), u1 = __uint_as_float(uu.x & 0xffff0000u), u2 = __uint_as_float(uu.y << 16), u3 = __uint_as_float(uu.y & 0xffff0000u);
            u32x2 o; o.x = pk2(u0 * (acc[ct][0] + bias), u1 * (acc[ct][1] + bias)); o.y = pk2(u2 * (acc[ct][2] + bias), u3 * (acc[ct][3] + bias));
            *(u32x2*)(YS + off) = o;
        }
    }
    LDS_WAIT(); __syncthreads();
}

__device__ __forceinline__ void sgu_sample_row(const bf16* U, const bf16* VS, const float* lnw, const float* lnb, const float* wsp_f32, const float* bsp, bf16* YS, float* out_sv, int b, int lane) {
    const size_t row = (size_t)MP + b;
    const u32x4 x = *(const u32x4*)(VS + row * 512 + 8 * lane);
    float f[8] = {__uint_as_float(x.x << 16), __uint_as_float(x.x & 0xffff0000u), __uint_as_float(x.y << 16), __uint_as_float(x.y & 0xffff0000u),
                  __uint_as_float(x.z << 16), __uint_as_float(x.z & 0xffff0000u), __uint_as_float(x.w << 16), __uint_as_float(x.w & 0xffff0000u)};
    float s = 0.f, s2 = 0.f;
#pragma unroll
    for (int e = 0; e < 8; ++e) { s += f[e]; s2 += f[e] * f[e]; }
    s = wave_sum(s); s2 = wave_sum(s2);
    const float mean = s * (1.0f / 512.0f), var = fmaxf(s2 * (1.0f / 512.0f) - mean * mean, 0.f), rstd = 1.0f / sqrtf(var + 1e-6f);
    const int c = 8 * lane, grp = c >> 6;
    const float w00 = wsp_f32[(size_t)grp * 128 * 128], b0 = bsp[grp * 128];
    const u32x4 uu = *(const u32x4*)(U + row * 512 + c);
    const float uf[8] = {__uint_as_float(uu.x << 16), __uint_as_float(uu.x & 0xffff0000u), __uint_as_float(uu.y << 16), __uint_as_float(uu.y & 0xffff0000u),
                         __uint_as_float(uu.z << 16), __uint_as_float(uu.z & 0xffff0000u), __uint_as_float(uu.w << 16), __uint_as_float(uu.w & 0xffff0000u)};
    float y[8];
#pragma unroll
    for (int e = 0; e < 8; ++e) { const float vn = (f[e] - mean) * rstd * lnw[c + e] + lnb[c + e]; out_sv[c + e] = vn; y[e] = uf[e] * (w00 * vn + b0); }
    u32x4 o; o.x = pk2(y[0], y[1]); o.y = pk2(y[2], y[3]); o.z = pk2(y[4], y[5]); o.w = pk2(y[6], y[7]);
    *(u32x4*)(YS + row * 512 + c) = o;
}

__device__ __forceinline__ void merge_row(const bf16* OG, const float* DG, bf16* YA, int row, int lane) {
    const int h = lane >> 4;
    const float d0 = DG[(size_t)row * 12 + h], d1 = DG[(size_t)row * 12 + 4 + h], d2 = DG[(size_t)row * 12 + 8 + h];
    const float inv = 1.0f / (d0 + d1 + d2);
    const float a0 = d0 * inv, a1 = d1 * inv, a2 = d2 * inv;
    const bf16* p = OG + (size_t)row * QKV + 8 * lane;
    const u32x4 x0 = *(const u32x4*)p, x1 = *(const u32x4*)(p + 512), x2 = *(const u32x4*)(p + 1024);
    u32x4 o;
#define MRG(c) pk2(a0 * __uint_as_float(x0.c << 16) + a1 * __uint_as_float(x1.c << 16) + a2 * __uint_as_float(x2.c << 16), \
                   a0 * __uint_as_float(x0.c & 0xffff0000u) + a1 * __uint_as_float(x1.c & 0xffff0000u) + a2 * __uint_as_float(x2.c & 0xffff0000u))
    o.x = MRG(x); o.y = MRG(y); o.z = MRG(z); o.w = MRG(w);
#undef MRG
    *(u32x4*)(YA + (size_t)row * 512 + 8 * lane) = o;
}


typedef float f32x16 __attribute__((ext_vector_type(16)));
template <class EpiS>
__device__ __forceinline__ void skinny_gemm(LAS unsigned char* lds, const bf16* A, const bf16* Bt, int K, int j, const EpiS& e, int wid, int lane, int tid) {
    const int r = lane & 31, hi = lane >> 5, ks = K >> 3;
    const bf16* ap = A + (size_t)r * K + wid * ks + 8 * hi;
    const bf16* bp = Bt + (size_t)(32 * j + r) * K + wid * ks + 8 * hi;
    f32x16 acc;
#pragma unroll
    for (int i = 0; i < 16; ++i) acc[i] = 0.f;
#pragma unroll 4
    for (int k = 0; k < ks; k += 16) {
        const bf16x8 a = *(const bf16x8*)(ap + k), b = *(const bf16x8*)(bp + k);
        acc = __builtin_amdgcn_mfma_f32_32x32x16_bf16(a, b, acc, 0, 0, 0);
    }
    LAS float* red = (LAS float*)lds;
#pragma unroll
    for (int i = 0; i < 16; ++i) red[wid * 1056 + ((i & 3) + 8 * (i >> 2) + 4 * hi) * 33 + r] = acc[i];
    LDS_WAIT(); __syncthreads();
    for (int e2 = tid; e2 < 1024; e2 += NTHREADS) {
        const int row = e2 >> 5, col = e2 & 31;
        float sum = 0.f;
#pragma unroll
        for (int w = 0; w < 8; ++w) sum += red[w * 1056 + row * 33 + col];
        e(row, 32 * j + col, sum);
    }
    LDS_WAIT(); __syncthreads();
}
struct SkGate1 { const bf16* G; float* T1; __device__ __forceinline__ void operator()(int sr, int col, float v) const { const size_t row = (size_t)MP + sr; T1[row * DM + col] = bf2f(G[row * 2048 + col]) * v; } };
struct SkGate2 { const bf16* G; const float* T1; bf16* MG; __device__ __forceinline__ void operator()(int sr, int col, float v) const { const size_t row = (size_t)MP + sr; MG[row * DM + col] = (bf16)(pk2(T1[row * DM + col] + bf2f(G[row * 2048 + 1024 + col]) * v, 0.f) & 0xffffu); } };
struct SkRes { const float* bs; float* os; const float* gate; __device__ __forceinline__ void operator()(int sr, int col, float v) const { os[(size_t)sr * DM + col] = bs[(size_t)sr * DM + col] + gate[(size_t)(4 + sr) * NADA + col] * v; } };


#define RLX_AGENT __ATOMIC_RELAXED, __HIP_MEMORY_SCOPE_AGENT
#define XB_TMO      128
#define XB_XCNT(j)  (256  + 64 * (j))
#define XB_XSUB(j)  (1280 + 64 * (j))
#define XB_XGEN(j)  (2304 + 64 * (j))
#define XB_TOP      3328
#define XB_TOPGEN   3392
#define XCD_BAR_WORDS 3456
#define XB_SPIN_CAP (1u << 18)

__device__ __forceinline__ unsigned xb_ld(unsigned* p)              { return __hip_atomic_load(p, __ATOMIC_RELAXED, __HIP_MEMORY_SCOPE_AGENT); }
__device__ __forceinline__ unsigned xb_add(unsigned* p, unsigned v) { return __hip_atomic_fetch_add(p, v, __ATOMIC_RELAXED, __HIP_MEMORY_SCOPE_AGENT); }
__device__ __forceinline__ unsigned xb_xcc_id() { return (unsigned)__builtin_amdgcn_s_getreg((3 << 11) | 20) & 0xFu; }
#define XB_SPIN(cond, bar) do { unsigned _sp = 0; while (cond) { __builtin_amdgcn_s_sleep(1); \
    if ((++_sp & 255u) == 0u) { if (xb_ld(&(bar)[XB_TMO])) break; if (_sp > XB_SPIN_CAP) { atomicAdd(&(bar)[XB_TMO], 1u); break; } } } } while (0)

struct XcdBarrier {
    unsigned* bar; unsigned x;
    volatile LAS unsigned* st;
};

__device__ __forceinline__ XcdBarrier xcd_barrier_post(unsigned* bar, volatile LAS unsigned* st) {
    XcdBarrier b; b.bar = bar; b.x = xb_xcc_id(); b.st = st;
    if (threadIdx.x == 0) (void)xb_add(&bar[XB_XCNT(b.x)], 1u);
    return b;
}
__device__ __forceinline__ void xcd_barrier_complete(unsigned* bar, unsigned x, unsigned& nloc, unsigned& nx) {
    const unsigned G = gridDim.x * gridDim.y * gridDim.z;
    unsigned sum, cnt, mine, sp = 0u;
    for (;;) {
        sum = 0u; cnt = 0u; mine = 0u;
#pragma unroll
        for (unsigned j = 0; j < 16; ++j) { const unsigned c = xb_ld(&bar[XB_XCNT(j)]); sum += c; cnt += (c > 0u) ? 1u : 0u; mine = (j == x) ? c : mine; }
        if (sum == G) break;
        __builtin_amdgcn_s_sleep(1);
        if ((++sp & 255u) == 0u) { if (xb_ld(&bar[XB_TMO])) break; if (sp > XB_SPIN_CAP) { atomicAdd(&bar[XB_TMO], 1u); break; } }
    }
    nloc = mine > 0u ? mine : 1u; nx = cnt > 0u ? cnt : 1u;
}

__device__ __forceinline__ void xcd_barrier(const XcdBarrier& b) {
    asm volatile("s_waitcnt vmcnt(0)" ::: "memory");
    __syncthreads();
    if (threadIdx.x == 0) {
        unsigned* bar = b.bar;
        __builtin_amdgcn_s_waitcnt(0);
        unsigned nloc = b.st[0], nx = b.st[1];
        if (nloc == 0u) { xcd_barrier_complete(bar, b.x, nloc, nx); b.st[0] = nloc; b.st[1] = nx; }
        const unsigned old = xb_add(&bar[XB_XSUB(b.x)], 1u);
        const unsigned gen = old / nloc;
        if (old + 1u == (gen + 1u) * nloc) {
            __builtin_amdgcn_fence(__ATOMIC_RELEASE, "agent");
            asm volatile("s_waitcnt vmcnt(0)" ::: "memory");
            const unsigned og = xb_add(&bar[XB_TOP], 1u);
            const unsigned tg = og / nx;
            if (og + 1u == (tg + 1u) * nx) xb_add(&bar[XB_TOPGEN], 1u);
            else XB_SPIN(xb_ld(&bar[XB_TOPGEN]) == tg, bar);
            __builtin_amdgcn_fence(__ATOMIC_ACQUIRE, "agent");
            xb_add(&bar[XB_XGEN(b.x)], 1u);
            asm volatile("s_waitcnt vmcnt(0)" ::: "memory");
        } else {
            XB_SPIN(xb_ld(&bar[XB_XGEN(b.x)]) == gen, bar);
            __builtin_amdgcn_fence(__ATOMIC_ACQUIRE, "agent");
            asm volatile("s_waitcnt vmcnt(0)" ::: "memory");
        }
    }
    __syncthreads();
}

constexpr int LDS_MISC = LDS_EXCH + 8192;
constexpr size_t WS_CTL = 0, CTL_ZERO_BYTES = 65536;
#ifndef PROBE_REP_MASK
#define PROBE_REP_MASK 0
#endif
#define PHON(k) for (int rep_ = 0; rep_ <= (((PROBE_REP_MASK) >> (k)) & 1); ++rep_) if constexpr (((PHM) >> (k)) & 1)
#define GSYNC() do { if constexpr (COOP) { CAS const Args* ap_ = (CAS const Args*)__builtin_amdgcn_kernarg_segment_ptr(); asm volatile("" : "+s"(ap_)); \
    XcdBarrier xb_; xb_.bar = (unsigned*)((unsigned char*)ap_->ws + WS_CTL); xb_.x = xb_xcc_id(); xb_.st = (volatile LAS unsigned*)(lds + LDS_MISC); xcd_barrier(xb_); } } while (0)
#define GSYNC_CG() do { if constexpr (COOP) cg::this_grid().sync(); } while (0)
#define GAS __attribute__((address_space(1)))
#define CAS __attribute__((address_space(4)))
struct Args { GAS const float* in[23]; GAS float* out; GAS unsigned char* ws; };

constexpr int I_ADA = 16 * 192, I_IN = 16 * 240, I_PA = 8 * 32, I_OUT = 16 * 32, I_FI = 16 * 176, I_FO = 44 * 32;
constexpr int I_LAYER = I_ADA + I_IN + 2 * I_PA + I_OUT + I_FI + I_FO;
__device__ __forceinline__ void weight_copy_item(CAS const Args* ap, unsigned char* ws, int l, int r, LAS float* scr, int lane) {
    unsigned char* wl = ws + WS_WL0 + (size_t)l * WL_SIZE;
    if (r < I_IN) { transpose_item(((const float*)ap->in[10]) + (size_t)l * DM * DIN, DM, DIN, (bf16*)(wl + WL_WIN), 0, scr, r, lane); return; } r -= I_IN;
    if (r < I_PA) { transpose_item(((const float*)ap->in[17]) + (size_t)l * 512 * DM, 512, DM, (bf16*)(wl + WL_WPA), 0, scr, r, lane); return; } r -= I_PA;
    if (r < I_PA) { transpose_item(((const float*)ap->in[18]) + (size_t)l * 512 * DM, 512, DM, (bf16*)(wl + WL_WPS), 0, scr, r, lane); return; } r -= I_PA;
    if (r < I_OUT) { transpose_item(((const float*)ap->in[19]) + (size_t)l * DM * DM, DM, DM, (bf16*)(wl + WL_WOUT), 0, scr, r, lane); return; } r -= I_OUT;
    if (r < I_FI) { transpose_item(((const float*)ap->in[21]) + (size_t)l * DM * 2 * DFF, DM, 2 * DFF, (bf16*)(wl + WL_WFI), 1, scr, r, lane); return; } r -= I_FI;
    transpose_item(((const float*)ap->in[22]) + (size_t)l * DFF * DM, DFF, DM, (bf16*)(wl + WL_WFO), 0, scr, r, lane);
}
#define PHASE_ENV() \
    CAS const Args* ap = (CAS const Args*)__builtin_amdgcn_kernarg_segment_ptr(); asm volatile("" : "+s"(ap)); \
    int tid = threadIdx.x; asm volatile("" : "+v"(tid)); \
    const int lane = tid & 63, wid = __builtin_amdgcn_readfirstlane(tid >> 6); \
    int G_ = gridDim.x, bx_ = blockIdx.x; asm volatile("" : "+s"(G_), "+s"(bx_)); const int G = G_, bx = bx_; const int gw = bx * NWAVES + wid, NGW = G * NWAVES; \
    unsigned char* const ws = (unsigned char*)ap->ws; (void)lane; (void)wid; (void)gw; (void)NGW; (void)ws; (void)G; (void)bx
#define WL(l) (ws + WS_WL0 + (size_t)(l) * WL_SIZE)

template <int PHM, bool COOP>
__global__ void __launch_bounds__(NTHREADS, 2) fwd_megakernel(Args args_unused, int l_lo, int l_hi) {
    extern __shared__ __attribute__((aligned(16))) unsigned char lds_raw[];
    LAS unsigned char* lds = (LAS unsigned char*)lds_raw;
    if constexpr (COOP) {
        PHASE_ENV();
        if (tid < 32) ((LAS unsigned*)(lds + LDS_MISC))[tid] = 0u;
        __syncthreads();
        (void)xcd_barrier_post((unsigned*)(ws + WS_CTL), (volatile LAS unsigned*)(lds + LDS_MISC));
    }

    PHON(0) {
        PHASE_ENV();
        bf16* WADA = (bf16*)(ws + WS_WADA); bf16* SC = (bf16*)(ws + WS_SC);
        LAS float* scr = (LAS float*)(lds + wid * 16384);
        for (int it = gw; it < 2 * I_ADA + (I_LAYER - I_ADA); it += NGW) {
            if (it < 2 * I_ADA) { const int l = it / I_ADA; transpose_item(((const float*)ap->in[7]) + (size_t)l * DM * NADA, DM, NADA, WADA + (size_t)l * NADA * DM, 0, scr, it - l * I_ADA, lane); }
            else weight_copy_item(ap, ws, 0, it - 2 * I_ADA, scr, lane);
        }
        const int gt = bx * NTHREADS + tid, NGT = G * NTHREADS;
        const float* wsp = ((const float*)ap->in[15]);
        for (int i = gt; i < 2 * 8 * 128 * 128; i += NGT) {
            const int l = i >> 17, r = i & 131071, t = (r >> 7) & 127, s = r & 127;
            const float w = wsp[i];
            ((bf16*)(WL(l) + WL_WSP))[r] = (bf16)(s <= t ? (pk2(w, 0.f) & 0xffffu) : 0u);
        }
        const float* cpr = ((const float*)ap->in[5]); const float* csm = ((const float*)ap->in[6]);
        for (int i = gt; i < 256 * DM; i += NGT) {
            const int r = i >> 10, k = i & 1023;
            float v = 0.f;
            if (r < 4) v = cpr[r * DM + k]; else if (r < 36) v = csm[(r - 4) * DM + k];
            SC[i] = (bf16)(pk2(v * sigmoidf_(v), 0.f) & 0xffffu);
        }
    }
    GSYNC_CG();
    PHON(1) {
        PHASE_ENV();
        pg8::Gemm g{(const bf16*)(ws + WS_SC), (const bf16*)(ws + WS_WADA), 256, 2 * NADA, DM}; pg8::StaticOrder S; S.init(256, 2 * NADA, G, bx);
        EpiAda E{(float*)(ws + WS_MOD), ((const float*)ap->in[8])};
        pg8::gemm_phase<EpiAda, pg8::StaticOrder, true, true>(lds + LDS_RING, g, S, E);
    }
    GSYNC();

    for (int l = l_lo; l < l_hi; ++l) {
        PHON(2) {
            PHASE_ENV();
            const float* X2 = (const float*)(ws + WS_X2);
            const float* xin_p = l == 0 ? ((const float*)ap->in[0]) : X2;
            const float* xin_s = l == 0 ? ((const float*)ap->in[1]) : X2 + (size_t)MP * DM;
            norm_mod_phase(xin_p, xin_s, ((const float*)ap->in[9]) + l * DM, (const float*)(ws + WS_MOD) + (size_t)l * 36 * NADA, 0, (bf16*)(ws + WS_XN), gw, NGW, lane);
        }
        GSYNC();
        PHON(3) {
            PHASE_ENV();
            pg8::Gemm g{(const bf16*)(ws + WS_XN), (const bf16*)(WL(l) + WL_WIN), MT, DIN, DM}; pg8::StaticOrder S; S.init(MT, DIN, G, bx);
            EpiIn E{ws, ((const float*)ap->in[11]) + l * 384, ((const float*)ap->in[12]) + l * 384, ((float*)ap->out), l, (LAS float*)(lds + LDS_EXCH)};
            pg8::gemm_phase<EpiIn, pg8::StaticOrder, true, true>(lds + LDS_RING, g, S, E);
        }
        PHON(3) {
            if (l == 0) {
                PHASE_ENV();
                constexpr int NU = (MT / 256) * (DIN / 256);
                const int nfull = NU % G;
                if (nfull > 0 && bx >= nfull) {
                    LAS float* scr = (LAS float*)(lds + wid * 16384);
                    const int nw = (G - nfull) * NWAVES, w0 = (bx - nfull) * NWAVES + wid;
                    for (int it = w0; it < I_LAYER - I_ADA; it += nw) weight_copy_item(ap, ws, 1, it, scr, lane);
                } else if (nfull == 0) {
                    LAS float* scr = (LAS float*)(lds + wid * 16384);
                    for (int it = gw; it < I_LAYER - I_ADA; it += NGW) weight_copy_item(ap, ws, 1, it, scr, lane);
                }
            }
        }
        GSYNC();
        PHON(4) {
            PHASE_ENV();
            const bf16 *Qb = (const bf16*)(ws + WS_Q), *Kb = (const bf16*)(ws + WS_K), *Vb = (const bf16*)(ws + WS_V);
            float mq = 0.f, mk = 0.f;
            for (int i = lane; i < 384; i += 64) { mq = fmaxf(mq, fabsf(((const float*)ap->in[11])[l * 384 + i])); mk = fmaxf(mk, fabsf(((const float*)ap->in[12])[l * 384 + i])); }
            mq = wave_max(mq); mk = wave_max(mk);
            const float cshift = 11.3137085f * LOG2E * mq * mk;
            if (G == 256) { const int u0 = bx < 128 ? bx * 7 : 896 + (bx - 128) * 5, nu = bx < 128 ? 7 : 5;
                for (int u = u0; u < u0 + nu; ++u) attn_unit(lds, Qb, Kb, Vb, (bf16*)(ws + WS_OG), (float*)(ws + WS_DG), u, cshift, wid, lane, tid); }
            else for (int u = bx; u < 1536; u += G) attn_unit(lds, Qb, Kb, Vb, (bf16*)(ws + WS_OG), (float*)(ws + WS_DG), u, cshift, wid, lane, tid);
        }
        PHON(4) {
            PHASE_ENV();
            if (bx >= G / 2) {
                for (int it = bx - G / 2; it < NSMP * 4; it += G - G / 2)
                    attn_sample_item(lds, (const bf16*)(ws + WS_Q), (const bf16*)(ws + WS_K), (const bf16*)(ws + WS_V), ((const float*)ap->in[2]), ((const float*)ap->in[3]), ((const float*)ap->in[4]), l, (bf16*)(ws + WS_YA), it, wid, lane, tid);
            }
        }
        GSYNC();
        PHON(5) {
            PHASE_ENV();
            const bf16 *Ub = (const bf16*)(ws + WS_U), *VSb = (const bf16*)(ws + WS_VS); bf16 *YS = (bf16*)(ws + WS_YS);
            const bf16* WSP = (const bf16*)(WL(l) + WL_WSP);
            const float* lnw = ((const float*)ap->in[13]) + l * 512; const float* lnb = ((const float*)ap->in[14]) + l * 512; const float* bsp = ((const float*)ap->in[16]) + l * 8 * 128;
            for (int u = bx; u < 256; u += G) sgu_unit(lds, Ub, VSb, lnw, lnb, WSP, bsp, YS, u, wid, lane);
            for (int b = gw; b < NSMP; b += NGW) sgu_sample_row(Ub, VSb, lnw, lnb, ((const float*)ap->in[15]) + (size_t)l * 8 * 128 * 128, bsp, YS, ((float*)ap->out) + O_SV + (size_t)(l * NSMP + b) * 512, b, lane);
            for (int row = gw; row < MP; row += NGW) merge_row((const bf16*)(ws + WS_OG), (const float*)(ws + WS_DG), (bf16*)(ws + WS_YA), row, lane);
        }
        GSYNC();
        PHON(6) {
            PHASE_ENV();
            pg8::StaticOrder S; S.init(MP, DM, G, bx);
            pg8::Gemm g{(const bf16*)(ws + WS_YA), (const bf16*)(WL(l) + WL_WPA), MP, DM, 512}; EpiGate1 E{(const bf16*)(ws + WS_G), (float*)(ws + WS_T1)};
            pg8::gemm_phase<EpiGate1, pg8::StaticOrder, true, true>(lds + LDS_RING, g, S, E);
        }
        PHON(6) {
            PHASE_ENV();
            if (bx < 32) { SkGate1 e{(const bf16*)(ws + WS_G), (float*)(ws + WS_T1)};
                skinny_gemm(lds, (const bf16*)(ws + WS_YA) + (size_t)MP * 512, (const bf16*)(WL(l) + WL_WPA), 512, bx, e, wid, lane, tid); }
        }
        PHON(6) {
            PHASE_ENV();
            pg8::StaticOrder S; S.init(MP, DM, G, bx);
            pg8::Gemm g{(const bf16*)(ws + WS_YS), (const bf16*)(WL(l) + WL_WPS), MP, DM, 512}; EpiGate2 E{(const bf16*)(ws + WS_G), (const float*)(ws + WS_T1), (bf16*)(ws + WS_MG)};
            pg8::gemm_phase<EpiGate2, pg8::StaticOrder, true, true>(lds + LDS_RING, g, S, E);
        }
        PHON(6) {
            PHASE_ENV();
            if (bx < 32) { SkGate2 e{(const bf16*)(ws + WS_G), (const float*)(ws + WS_T1), (bf16*)(ws + WS_MG)};
                skinny_gemm(lds, (const bf16*)(ws + WS_YS) + (size_t)MP * 512, (const bf16*)(WL(l) + WL_WPS), 512, bx, e, wid, lane, tid); }
        }
        GSYNC();
        PHON(7) {
            PHASE_ENV();
            const float* X2 = (const float*)(ws + WS_X2); float* X1 = (float*)(ws + WS_X1);
            const float* xin_p = l == 0 ? ((const float*)ap->in[0]) : X2;
            const float* xin_s = l == 0 ? ((const float*)ap->in[1]) : X2 + (size_t)MP * DM;
            pg8::Gemm g{(const bf16*)(ws + WS_MG), (const bf16*)(WL(l) + WL_WOUT), MP, DM, DM}; pg8::StaticOrder S; S.init(MP, DM, G, bx);
            EpiRes E{xin_p, xin_s, X1, X1 + (size_t)MP * DM, (const float*)(ws + WS_MOD) + (size_t)l * 36 * NADA + 2048};
            pg8::gemm_phase<EpiRes, pg8::StaticOrder, true, true>(lds + LDS_RING, g, S, E);
        }
        PHON(7) {
            PHASE_ENV();
            if (bx < 32) { const float* X2 = (const float*)(ws + WS_X2);
                SkRes e{l == 0 ? ((const float*)ap->in[1]) : X2 + (size_t)MP * DM, (float*)(ws + WS_X1) + (size_t)MP * DM, (const float*)(ws + WS_MOD) + (size_t)l * 36 * NADA + 2048};
                skinny_gemm(lds, (const bf16*)(ws + WS_MG) + (size_t)MP * DM, (const bf16*)(WL(l) + WL_WOUT), DM, bx, e, wid, lane, tid); }
        }
        GSYNC();
        PHON(8) {
            PHASE_ENV();
            const float* X1 = (const float*)(ws + WS_X1);
            norm_mod_phase(X1, X1 + (size_t)MP * DM, ((const float*)ap->in[20]) + l * DM, (const float*)(ws + WS_MOD) + (size_t)l * 36 * NADA, 3072, (bf16*)(ws + WS_XN), gw, NGW, lane);
        }
        GSYNC();
        PHON(9) {
            PHASE_ENV();
            pg8::Gemm g{(const bf16*)(ws + WS_XN), (const bf16*)(WL(l) + WL_WFI), MT, 2 * DFF, DM}; pg8::StaticOrder S; S.init(MT, 2 * DFF, G, bx);
            EpiSwiglu E{(bf16*)(ws + WS_H)};
            pg8::gemm_phase<EpiSwiglu, pg8::StaticOrder, true, true>(lds + LDS_RING, g, S, E);
        }
        GSYNC();
        PHON(10) {
            PHASE_ENV();
            const float* X1 = (const float*)(ws + WS_X1); float* X2 = (float*)(ws + WS_X2);
            float* xout_p = l == 0 ? X2 : ((float*)ap->out) + O_YP;
            float* xout_s = l == 0 ? X2 + (size_t)MP * DM : ((float*)ap->out) + O_YS;
            pg8::Gemm g{(const bf16*)(ws + WS_H), (const bf16*)(WL(l) + WL_WFO), MP, DM, DFF}; pg8::StaticOrder S; S.init(MP, DM, G, bx);
            EpiRes E{X1, X1 + (size_t)MP * DM, xout_p, xout_s, (const float*)(ws + WS_MOD) + (size_t)l * 36 * NADA + 5120};
            pg8::gemm_phase<EpiRes, pg8::StaticOrder, true, true>(lds + LDS_RING, g, S, E);
        }
        PHON(10) {
            PHASE_ENV();
            if (bx < 32) { float* X2 = (float*)(ws + WS_X2);
                SkRes e{(const float*)(ws + WS_X1) + (size_t)MP * DM, l == 0 ? X2 + (size_t)MP * DM : ((float*)ap->out) + O_YS, (const float*)(ws + WS_MOD) + (size_t)l * 36 * NADA + 5120};
                skinny_gemm(lds, (const bf16*)(ws + WS_H) + (size_t)MP * DFF, (const bf16*)(WL(l) + WL_WFO), DFF, bx, e, wid, lane, tid); }
        }
        if (l + 1 < l_hi) GSYNC();
    }
}


#ifdef EXP_MASK
__global__ void __launch_bounds__(256) dbg_checksum(const unsigned char* ws, float* out) {
    const int lane = threadIdx.x & 63, gw = (blockIdx.x * 256 + threadIdx.x) >> 6, ngw = gridDim.x * 4;
    struct B { size_t off; int cols; int isf; };
    const B bufs[16] = {{WS_XN, 1024, 0}, {WS_Q, 1536, 0}, {WS_K, 1536, 0}, {WS_V, 1536, 0}, {WS_U, 512, 0}, {WS_VS, 512, 0}, {WS_G, 2048, 0}, {WS_OG, 1536, 0},
                        {WS_DG, 12, 1}, {WS_YA, 512, 0}, {WS_YS, 512, 0}, {WS_T1, 1024, 1}, {WS_MG, 1024, 0}, {WS_X1, 1024, 1}, {WS_H, 2816, 0}, {WS_X2, 1024, 1}};
    for (int b = 0; b < 16; ++b) {
        if (!((EXP_MASK >> b) & 1)) continue;
        for (int row = gw; row < MV; row += ngw) {
            float s = 0.f;
            for (int c = lane; c < bufs[b].cols; c += 64) {
                const float v = bufs[b].isf ? ((const float*)(ws + bufs[b].off))[(size_t)row * bufs[b].cols + c] : bf2f(((const bf16*)(ws + bufs[b].off))[(size_t)row * bufs[b].cols + c]);
                s += v * (float)(1 + (c % 7));
            }
            s = wave_sum(s);
            if (lane == 0) out[(size_t)b * MT + row] = s;
        }
    }
    if ((EXP_MASK >> 16) & 1) for (int i = blockIdx.x * 256 + threadIdx.x; i < 72 * NADA; i += gridDim.x * 256) out[16 * MT + i] = ((const float*)(ws + WS_MOD))[i];
}
#endif
#ifndef N_LAUNCH_MODE
#define N_LAUNCH_MODE 1
#endif
template <int PHM> static void launch_phase(const Args& a, int l_lo, int l_hi, int grid, hipStream_t stream) {
    static bool attr = false;
    if (!attr) { (void)hipFuncSetAttribute((const void*)fwd_megakernel<PHM, false>, hipFuncAttributeMaxDynamicSharedMemorySize, LDS_BYTES); attr = true; }
    hipLaunchKernelGGL((fwd_megakernel<PHM, false>), dim3(grid), dim3(NTHREADS), LDS_BYTES, stream, a, l_lo, l_hi);
}
extern "C" void kernel_launch(void* const* d_in, const int* in_sizes, int n_in, void* d_out, int out_size, void* d_ws, size_t ws_size, hipStream_t stream) {
    static int grid = 0;
    if (grid == 0) {
        if (n_in != 23 || (size_t)out_size != O_END || ws_size < WS_END) { fprintf(stderr, "kernel_launch: unexpected shapes (n_in %d out %d ws %zu need %zu)\n", n_in, out_size, ws_size, (size_t)WS_END); grid = -1; return; }
        int dev = 0, cus = 0, per_cu = 0;
        (void)hipGetDevice(&dev);
        (void)hipDeviceGetAttribute(&cus, hipDeviceAttributeMultiprocessorCount, dev);
#if N_LAUNCH_MODE == 1
        if (hipFuncSetAttribute((const void*)fwd_megakernel<0x7FF, true>, hipFuncAttributeMaxDynamicSharedMemorySize, LDS_BYTES) != hipSuccess) { fprintf(stderr, "kernel_launch: hipFuncSetAttribute failed\n"); grid = -1; return; }
        (void)hipOccupancyMaxActiveBlocksPerMultiprocessor(&per_cu, (const void*)fwd_megakernel<0x7FF, true>, NTHREADS, LDS_BYTES);
        (void)hipGetLastError();
        if (per_cu < 1) fprintf(stderr, "kernel_launch: occupancy query says %d blocks per CU\n", per_cu);
#endif
        grid = cus;
    }
    if (grid < 0) return;
    Args a{};
    for (int i = 0; i < 23; ++i) a.in[i] = (GAS const float*)d_in[i];
    a.out = (GAS float*)d_out; a.ws = (GAS unsigned char*)d_ws;
#if N_LAUNCH_MODE == 1
    (void)hipMemsetAsync((unsigned char*)d_ws + WS_CTL, 0, CTL_ZERO_BYTES, stream);
    int l_lo = 0, l_hi = 2;
    void* kargs[] = {&a, &l_lo, &l_hi};
    hipError_t e = hipLaunchCooperativeKernel((const void*)fwd_megakernel<0x7FF, true>, dim3(grid), dim3(NTHREADS), kargs, LDS_BYTES, stream);
    if (e != hipSuccess) fprintf(stderr, "cooperative launch failed: %s (grid %d)\n", hipGetErrorString(e), grid);
#else
#ifdef EXP_MASK
    (void)hipMemsetAsync(d_out, 0, (size_t)out_size * 4, stream);
#endif
    launch_phase<0x001>(a, 0, 0, grid, stream);
    launch_phase<0x002>(a, 0, 0, grid, stream);
#ifdef EXP_MASK
    const int NL = 1;
#else
    const int NL = 2;
#endif
    for (int l = 0; l < NL; ++l) {
        launch_phase<0x004>(a, l, l + 1, grid, stream);
        launch_phase<0x008>(a, l, l + 1, grid, stream);
        launch_phase<0x010>(a, l, l + 1, grid, stream);
        launch_phase<0x020>(a, l, l + 1, grid, stream);
        launch_phase<0x040>(a, l, l + 1, grid, stream);
        launch_phase<0x080>(a, l, l + 1, grid, stream);
        launch_phase<0x100>(a, l, l + 1, grid, stream);
        launch_phase<0x200>(a, l, l + 1, grid, stream);
        launch_phase<0x400>(a, l, l + 1, grid, stream);
    }
#ifdef EXP_MASK
    hipLaunchKernelGGL(dbg_checksum, dim3(1024), dim3(256), 0, stream, (const unsigned char*)d_ws, (float*)d_out);
#endif
#endif
}
```

```cpp
#include <hip/hip_runtime.h>
#include <hip/hip_cooperative_groups.h>
#include <cstdio>
#include <cstdint>
namespace cg = cooperative_groups;
namespace pg8 {
#define PG8_LAS __attribute__((address_space(3)))
typedef unsigned short bf16_t;
typedef short bf16x8 __attribute__((ext_vector_type(8)));
typedef float f32x4 __attribute__((ext_vector_type(4)));
typedef unsigned u32x4 __attribute__((ext_vector_type(4)));
constexpr int BM = 256, BK = 64, HALF = 128, HTB = HALF * BK * 2  , STAGE_BYTES = 8 * HTB, NXCD = 8, WGM = 8;

__host__ __device__ __forceinline__ int lds_byte(int r, int c) { const int st = (r >> 4) * 2 + (c >> 5), rr = r & 15, cc = c & 31, ob = rr * 64 + cc * 2; return st * 1024 + (ob ^ (((ob >> 9) & 1) << 5)); }
__host__ __device__ __forceinline__ void stage_rc(int b, int& R, int& C) { const int st = b / 1024, sb = b % 1024, swz = sb ^ (((sb >> 9) & 1) << 5); R = (st >> 1) * 16 + swz / 64; C = (st & 1) * 32 + (swz % 64) / 2; }
__host__ __device__ __forceinline__ int perm32(int rho) { const int n = rho >> 4, i = rho & 15; return 8 * (i >> 2) + 4 * n + (i & 3); }

struct Unit { int pm, pn; };
struct Gemm { const bf16_t* A; const bf16_t* Bt; int M, N, K; };

struct StaticOrder {
    int nM, nN, nwg, G, c;
    __host__ __device__ void init(int M, int N, int G_, int c_) { nM = M / BM; nN = N / BM; nwg = nM * nN; G = G_; c = c_; }
    __host__ __device__ bool next(int i, Unit& u) const {
        const long L = (long)i * G + c; if (L >= nwg) return false;
        int wgid = (int)L; { const int q = nwg / NXCD, r = nwg % NXCD, xcd = wgid % NXCD, off = wgid / NXCD; wgid = (xcd < r ? xcd * (q + 1) : r * (q + 1) + (xcd - r) * q) + off; }
        const int nig = WGM * nN, gid = wgid / nig, fm = gid * WGM, gsz = (nM - fm) < WGM ? (nM - fm) : WGM;
        u.pm = fm + ((wgid % nig) % gsz); u.pn = (wgid % nig) / gsz; return true;
    }
    __device__ __forceinline__ void a_ready(const Unit&) const {}
    __device__ __forceinline__ void done(const Unit&) const {}
};

typedef __bf16 bf16x2_hw __attribute__((ext_vector_type(2)));
typedef float f32x2_hw __attribute__((ext_vector_type(2)));
__device__ __forceinline__ unsigned cvt_pk_bf16(float lo, float hi) { const f32x2_hw v = {lo, hi}; return __builtin_bit_cast(unsigned, __builtin_convertvector(v, bf16x2_hw)); }
typedef float f32x2 __attribute__((ext_vector_type(2)));
__device__ __forceinline__ f32x2 gelu_pk(f32x2 v) {
    const f32x2 av = __builtin_elementwise_abs(v), d = av * 0.2316418882f + 1.0f;
    f32x2 t; t.x = __builtin_amdgcn_rcpf(d.x); t.y = __builtin_amdgcn_rcpf(d.y);
    f32x2 q = t * 0.5307027145f + (-0.7265760135f); q = q * t + 0.7107068705f; q = q * t + (-0.142248368f); q = q * t + 0.127414796f; q = q * t;
    const f32x2 s = (v * v) * (-0.72134752044f);
    f32x2 e; e.x = __builtin_amdgcn_exp2f(s.x); e.y = __builtin_amdgcn_exp2f(s.y);
    const f32x2 m = v * (q * e), r = v - m;
    f32x2 o; o.x = v.x < 0.f ? m.x : r.x; o.y = v.y < 0.f ? m.y : r.y; return o;
}

template <int ACT  > struct EpiBf16 {
    static constexpr bool PERM = true, AFTER_DRAIN = false; static_assert(ACT == 0 || ACT == 1, "EpiBf16: ACT is 0 (none) or 1 (gelu_pk)");
    bf16_t* O; int ldc; const float* bias; int split_cols; size_t split_stride; float scale0;
    __device__ __forceinline__ void operator()(const f32x4 (&acc)[2][2][4][2], const Unit& u, int wr, int wc, int fr, int fq) const {
        const int row0 = u.pm * BM + wr * 64 + fr; int colt = u.pn * BM; bf16_t* base = O;
        float sc = 1.f; if (split_cols) { const int t = colt / split_cols; base += (size_t)t * split_stride; colt -= t * split_cols; if (t == 0) sc = scale0; }
        const int col0 = colt + wc * 32 + 8 * fq, bcol0 = u.pn * BM + wc * 32 + 8 * fq;
        f32x4 bv[2][2];
#pragma unroll
        for (int bj = 0; bj < 2; ++bj)
#pragma unroll
            for (int n = 0; n < 2; ++n) bv[bj][n] = bias ? *(const f32x4*)(bias + bcol0 + bj * HALF + 4 * n) : (f32x4){0.f, 0.f, 0.f, 0.f};
#pragma unroll
        for (int ai = 0; ai < 2; ++ai)
#pragma unroll
            for (int m = 0; m < 4; ++m) { bf16_t* rowp = base + (size_t)(row0 + ai * HALF + m * 16) * ldc + col0;
#pragma unroll
                for (int bj = 0; bj < 2; ++bj) { f32x4 v0 = acc[ai][bj][m][0] + bv[bj][0], v1 = acc[ai][bj][m][1] + bv[bj][1];
                    if (ACT == 1) { f32x2 a = gelu_pk((f32x2){v0[0], v0[1]}), b = gelu_pk((f32x2){v0[2], v0[3]}), c = gelu_pk((f32x2){v1[0], v1[1]}), d = gelu_pk((f32x2){v1[2], v1[3]});
                        v0 = (f32x4){a.x, a.y, b.x, b.y}; v1 = (f32x4){c.x, c.y, d.x, d.y}; }
                    v0 = v0 * sc; v1 = v1 * sc; u32x4 w; w.x = cvt_pk_bf16(v0[0], v0[1]); w.y = cvt_pk_bf16(v0[2], v0[3]); w.z = cvt_pk_bf16(v1[0], v1[1]); w.w = cvt_pk_bf16(v1[2], v1[3]);
                    *(u32x4*)(rowp + bj * HALF) = w; } }
    }
};

struct PanelStats {
    unsigned* xbuf;
    unsigned* cnt;
    unsigned* tmo;
    int ntn; float eps;
    unsigned code;
    __device__ __forceinline__ bool run(const f32x4 (&v)[2][2][4][2], const Unit& u, int wr, int wc, int fr, int fq, PG8_LAS unsigned char* lds, int wid, int lane) const {
        typedef float f32x2v __attribute__((ext_vector_type(2)));
        PG8_LAS f32x2v* P = (PG8_LAS f32x2v*)lds;
        PG8_LAS f32x2v* S = (PG8_LAS f32x2v*)(lds + 8192);
        PG8_LAS unsigned* flag = (PG8_LAS unsigned*)(lds + 8192 + 2048);
#pragma unroll
        for (int ai = 0; ai < 2; ++ai)
#pragma unroll
            for (int m = 0; m < 4; ++m) {
                float s = 0.f;
#pragma unroll
                for (int bj = 0; bj < 2; ++bj)
#pragma unroll
                    for (int n = 0; n < 2; ++n) { const f32x4 x = v[ai][bj][m][n]; s += (x[0] + x[1]) + (x[2] + x[3]); }
                s += __shfl_xor(s, 16); s += __shfl_xor(s, 32);
                const float mw = s * (1.0f / 64.0f); float q = 0.f;
#pragma unroll
                for (int bj = 0; bj < 2; ++bj)
#pragma unroll
                    for (int n = 0; n < 2; ++n) { const f32x4 d = v[ai][bj][m][n] - mw; q += (d[0] * d[0] + d[1] * d[1]) + (d[2] * d[2] + d[3] * d[3]); }
                q += __shfl_xor(q, 16); q += __shfl_xor(q, 32);
                if (fq == 0) P[(ai * HALF + wr * 64 + m * 16 + fr) * 4 + wc] = (f32x2v){mw, q};
            }
        asm volatile("s_waitcnt lgkmcnt(0)" ::: "memory"); __builtin_amdgcn_s_barrier(); asm volatile("" ::: "memory");
#if defined(BROKEN_EXCHANGE_NO_WAIT)
#warning BROKEN CONTROL BUILD: the row-statistics exchange does not wait; results are wrong by design
        if (blockIdx.x >= 64) { const long long t0_ = clock64(); while (clock64() - t0_ < 60000) __builtin_amdgcn_s_sleep(8); }
#endif
        const int row = wid * 32 + (lane & 31);
        if (lane < 32) {
            const f32x2v a = P[row * 4 + 0], b = P[row * 4 + 1], c = P[row * 4 + 2], d = P[row * 4 + 3];
            const float mt = (a.x + b.x + c.x + d.x) * 0.25f;
            const float da = a.x - mt, db = b.x - mt, dc = c.x - mt, dd = d.x - mt;
            const float m2 = (a.y + b.y) + (c.y + d.y) + 64.0f * ((da * da + db * db) + (dc * dc + dd * dd));
            unsigned long long* slot = (unsigned long long*)xbuf + ((size_t)(u.pm * BM + row) * 4 + u.pn);
            __hip_atomic_store(slot, ((unsigned long long)__float_as_uint(m2) << 32) | __float_as_uint(mt), __ATOMIC_RELAXED, __HIP_MEMORY_SCOPE_AGENT);
        }
        asm volatile("s_waitcnt vmcnt(0)" ::: "memory");
        if (lane == 0) __hip_atomic_fetch_add(cnt + 64 * u.pm, 1u, __ATOMIC_RELAXED, __HIP_MEMORY_SCOPE_AGENT);
        if (wid == 0) {
            bool dead = false; const unsigned long long t0 = __builtin_amdgcn_s_memrealtime(); const unsigned want = 8u * (unsigned)ntn;
            for (;;) {
#if defined(BROKEN_EXCHANGE_NO_WAIT)
                break;
#endif
                if ((unsigned)__builtin_amdgcn_readfirstlane(__hip_atomic_load(cnt + 64 * u.pm, __ATOMIC_RELAXED, __HIP_MEMORY_SCOPE_AGENT)) >= want) break;
                if (__builtin_amdgcn_s_memrealtime() - t0 > 2000000ull) {
                    if (lane == 0) { unsigned expect = 0u; __hip_atomic_compare_exchange_strong(tmo + 1, &expect, code | (unsigned)(u.pm & 0xff), __ATOMIC_RELAXED, __ATOMIC_RELAXED, __HIP_MEMORY_SCOPE_AGENT);
                                     __hip_atomic_store(tmo, 1u, __ATOMIC_RELAXED, __HIP_MEMORY_SCOPE_AGENT); }
                    dead = true; break; }
                __builtin_amdgcn_s_sleep(2);
            }
            __builtin_amdgcn_fence(__ATOMIC_ACQUIRE, "agent");
            if (lane == 0) flag[0] = dead ? 1u : 0u;
        }
        asm volatile("s_waitcnt vmcnt(0) lgkmcnt(0)" ::: "memory"); __builtin_amdgcn_s_barrier(); asm volatile("" ::: "memory");
        const bool bad = flag[0] != 0u;
        if (lane < 32) {
            const unsigned long long* slot = (const unsigned long long*)xbuf + (size_t)(u.pm * BM + row) * 4; float mt[4], m2[4]; float ms = 0.f;
#pragma unroll
            for (int t = 0; t < 4; ++t) { if (t < ntn) { const unsigned long long w = __hip_atomic_load(slot + t, __ATOMIC_RELAXED, __HIP_MEMORY_SCOPE_AGENT); mt[t] = __uint_as_float((unsigned)w); m2[t] = __uint_as_float((unsigned)(w >> 32)); } else { mt[t] = 0.f; m2[t] = 0.f; } ms += mt[t]; }
            const float mean = ms / (float)ntn; float q = 0.f;
#pragma unroll
            for (int t = 0; t < 4; ++t) if (t < ntn) { const float dm = mt[t] - mean; q += m2[t] + 256.0f * dm * dm; }
            S[row] = (f32x2v){mean, 1.0f / sqrtf(q / (256.0f * (float)ntn) + eps)};
        }
        asm volatile("s_waitcnt lgkmcnt(0)" ::: "memory"); __builtin_amdgcn_s_barrier(); asm volatile("" ::: "memory");
        return bad;
    }
};
struct EpiLnRes {
    static constexpr bool PERM = false, AFTER_DRAIN = true;
    const float* base; float* out; int ldc; const float* bias; PanelStats st; unsigned poison;
    __device__ __forceinline__ void fused(f32x4 (&acc)[2][2][4][2], const Unit& u, int wr, int wc, int fr, int fq, PG8_LAS unsigned char* lds, int wid, int lane) const {
        typedef float f32x2v __attribute__((ext_vector_type(2)));
        const PG8_LAS f32x2v* S = (const PG8_LAS f32x2v*)(lds + 8192);
        const int col0 = u.pn * BM + wc * 32 + 4 * fq;
#pragma unroll
        for (int bj = 0; bj < 2; ++bj)
#pragma unroll
            for (int n = 0; n < 2; ++n) { const f32x4 bv = bias ? *(const f32x4*)(bias + col0 + bj * HALF + n * 16) : (f32x4){0.f, 0.f, 0.f, 0.f};
#pragma unroll
                for (int ai = 0; ai < 2; ++ai)
#pragma unroll
                    for (int m = 0; m < 4; ++m) acc[ai][bj][m][n] += bv; }
        f32x4 pre[4][2][2];
#pragma unroll
        for (int m = 0; m < 4; ++m) { const size_t off = (size_t)(u.pm * BM + wr * 64 + m * 16 + fr) * ldc + col0;
#pragma unroll
            for (int bj = 0; bj < 2; ++bj)
#pragma unroll
                for (int n = 0; n < 2; ++n) pre[m][bj][n] = *(const f32x4*)(base + off + bj * HALF + n * 16); }
        const bool bad = st.run(acc, u, wr, wc, fr, fq, lds, wid, lane) || poison != 0u;
        const float qnan = __builtin_nanf("");
#pragma unroll
        for (int ai = 0; ai < 2; ++ai)
#pragma unroll
            for (int m = 0; m < 4; ++m) { const int r = ai * HALF + wr * 64 + m * 16 + fr; const f32x2v sr = S[r]; const size_t off = (size_t)(u.pm * BM + r) * ldc + col0;
#pragma unroll
                for (int bj = 0; bj < 2; ++bj)
#pragma unroll
                    for (int n = 0; n < 2; ++n) { const f32x4 bs = ai == 0 ? pre[m][bj][n] : *(const f32x4*)(base + off + bj * HALF + n * 16); f32x4 o = bs + (acc[ai][bj][m][n] - sr.x) * sr.y;
                        if (bad) o = (f32x4){qnan, qnan, qnan, qnan}; *(f32x4*)(out + off + bj * HALF + n * 16) = o; }
                if (m & 1) asm volatile("" ::: "memory"); }
    }
};
struct EpiLnResLn {
    static constexpr bool PERM = false, AFTER_DRAIN = true;
    const float* base; float* out; bf16_t* xn; int ldc; const float* bias; PanelStats st1, st2; unsigned poison;
    __device__ __forceinline__ void fused(f32x4 (&acc)[2][2][4][2], const Unit& u, int wr, int wc, int fr, int fq, PG8_LAS unsigned char* lds, int wid, int lane) const {
        typedef float f32x2v __attribute__((ext_vector_type(2))); typedef unsigned u32x2v __attribute__((ext_vector_type(2)));
        const PG8_LAS f32x2v* S = (const PG8_LAS f32x2v*)(lds + 8192);
        const int col0 = u.pn * BM + wc * 32 + 4 * fq;
#pragma unroll
        for (int bj = 0; bj < 2; ++bj)
#pragma unroll
            for (int n = 0; n < 2; ++n) { const f32x4 bv = bias ? *(const f32x4*)(bias + col0 + bj * HALF + n * 16) : (f32x4){0.f, 0.f, 0.f, 0.f};
#pragma unroll
                for (int ai = 0; ai < 2; ++ai)
#pragma unroll
                    for (int m = 0; m < 4; ++m) acc[ai][bj][m][n] += bv; }
        bool bad = st1.run(acc, u, wr, wc, fr, fq, lds, wid, lane) || poison != 0u;
        const float qnan = __builtin_nanf("");
#pragma unroll
        for (int ai = 0; ai < 2; ++ai)
#pragma unroll
            for (int m = 0; m < 4; ++m) { const int r = ai * HALF + wr * 64 + m * 16 + fr; const f32x2v sr = S[r]; const size_t off = (size_t)(u.pm * BM + r) * ldc + col0;
#pragma unroll
                for (int bj = 0; bj < 2; ++bj)
#pragma unroll
                    for (int n = 0; n < 2; ++n) { const f32x4 bs = *(const f32x4*)(base + off + bj * HALF + n * 16); acc[ai][bj][m][n] = bs + (acc[ai][bj][m][n] - sr.x) * sr.y; }
                asm volatile("" : "+v"(acc[ai][0][m][0]), "+v"(acc[ai][0][m][1]), "+v"(acc[ai][1][m][0]), "+v"(acc[ai][1][m][1]));
                if (m & 1) asm volatile("" ::: "memory"); }
        const bool bad1 = bad;
        bad = st2.run(acc, u, wr, wc, fr, fq, lds, wid, lane) || bad;
#pragma unroll
        for (int ai = 0; ai < 2; ++ai)
#pragma unroll
            for (int m = 0; m < 4; ++m) { const int r = ai * HALF + wr * 64 + m * 16 + fr; const f32x2v sr = S[r]; const size_t off = (size_t)(u.pm * BM + r) * ldc + col0;
#pragma unroll
                for (int bj = 0; bj < 2; ++bj)
#pragma unroll
                    for (int n = 0; n < 2; ++n) { const f32x4 x1 = acc[ai][bj][m][n]; *(f32x4*)(out + off + bj * HALF + n * 16) = bad1 ? (f32x4){qnan, qnan, qnan, qnan} : x1;
                        const f32x4 o = (x1 - sr.x) * sr.y; u32x2v w; w.x = cvt_pk_bf16(o[0], o[1]); w.y = cvt_pk_bf16(o[2], o[3]);
                        if (bad) { w.x = 0x7fc07fc0u; w.y = 0x7fc07fc0u; } *(u32x2v*)(xn + off + bj * HALF + n * 16) = w; }
                asm volatile("" ::: "memory"); }
    }
};

template <class Epi, class Sched, bool ALIGN_EPI = false, bool SP2 = false>
__device__ __forceinline__ void gemm_phase(PG8_LAS unsigned char* lds, const Gemm g, const Sched& S, const Epi& E) {
    int tid_ = threadIdx.x; asm volatile("" : "+v"(tid_));
    const int tid = tid_, wid = __builtin_amdgcn_readfirstlane(tid >> 6), lane = tid & 63, wr = wid >> 2, wc = wid & 3, fr = lane & 15, fq = lane >> 4;
    const int K = g.K, nt = K / BK;
    unsigned voffA[2], voffB[2];
#pragma unroll
    for (int i = 0; i < 2; ++i) { int R, C; stage_rc(tid * 16 + i * 8192, R, C); const int Rb = Epi::PERM ? ((R & ~31) + perm32(R & 31)) : R;
        voffA[i] = (unsigned)(R * K + C) * 2u; voffB[i] = (unsigned)(Rb * K + C) * 2u; }
    const size_t kstep = (size_t)(BK * 2);
    const size_t hstep = (size_t)HALF * K * 2;
    const size_t tstep = 2 * hstep;
    const unsigned ldsw = (unsigned)wid * 1024u;
    const int aoff = lds_byte(wr * 64 + fr, fq * 8), boff = lds_byte(wc * 32 + fr, fq * 8);
#define PG8_SA(b, h) (((b) * 2 + (h)) * HTB)
#define PG8_SB(b, h) ((4 + (b) * 2 + (h)) * HTB)
#define PG8_STAGE(bufoff, gbase, voff) do { _Pragma("unroll") for (int _i = 0; _i < 2; ++_i) \
        __builtin_amdgcn_global_load_lds((const unsigned*)((const char*)(gbase) + (voff)[_i]), (PG8_LAS unsigned*)(lds + (bufoff) + ldsw + _i * 8192), 16, 0, 0); } while (0)
#define PG8_LDA(dst, b, h) do { _Pragma("unroll") for (int m = 0; m < 4; ++m) _Pragma("unroll") for (int k = 0; k < 2; ++k) dst[m][k] = *(const PG8_LAS bf16x8*)(lds + PG8_SA(b, h) + aoff + m * 2048 + k * 1024); } while (0)
#define PG8_LDB(dst, b, h) do { _Pragma("unroll") for (int n = 0; n < 2; ++n) _Pragma("unroll") for (int k = 0; k < 2; ++k) dst[n][k] = *(const PG8_LAS bf16x8*)(lds + PG8_SB(b, h) + boff + n * 2048 + k * 1024); } while (0)
#define PG8_MMA(ai, bj, At, Bt) do { __builtin_amdgcn_s_setprio(1); _Pragma("unroll") for (int m = 0; m < 4; ++m) _Pragma("unroll") for (int n = 0; n < 2; ++n) _Pragma("unroll") for (int k = 0; k < 2; ++k) \
        acc[ai][bj][m][n] = __builtin_amdgcn_mfma_f32_16x16x32_bf16(Bt[n][k], At[m][k], acc[ai][bj][m][n], 0, 0, 0); __builtin_amdgcn_s_setprio(0); } while (0)
#define PG8_WAIT_V(n) asm volatile("s_waitcnt vmcnt(" #n ")" ::: "memory")
#define PG8_WAIT_L(n) asm volatile("s_waitcnt lgkmcnt(" #n ")" ::: "memory")
#define PG8_BAR __builtin_amdgcn_s_barrier()
#define PG8_SCHED __builtin_amdgcn_sched_barrier(0)
    Unit cur, nxt; int ui = 0;
    if (!S.next(0, cur)) return;
    f32x4 acc[2][2][4][2];
#pragma unroll
    for (int a = 0; a < 2; ++a)
#pragma unroll
        for (int b = 0; b < 2; ++b)
#pragma unroll
            for (int m = 0; m < 4; ++m)
#pragma unroll
                for (int n = 0; n < 2; ++n) acc[a][b][m][n] = (f32x4){0.f, 0.f, 0.f, 0.f};
    bf16x8 At[4][2], B0[2][2], B1[2][2];
    const char* cA = (const char*)g.A + (size_t)cur.pm * tstep; const char* cB = (const char*)g.Bt + (size_t)cur.pn * tstep;
    S.a_ready(cur);
    if constexpr (SP2) {
        PG8_STAGE(PG8_SB(0, 0), cB, voffB); PG8_STAGE(PG8_SB(0, 1), cB + hstep, voffB); PG8_STAGE(PG8_SA(0, 0), cA, voffA); PG8_STAGE(PG8_SA(0, 1), cA + hstep, voffA);
        if (wr == 1) PG8_BAR;
        PG8_WAIT_V(2); PG8_BAR;
        PG8_STAGE(PG8_SB(1, 0), cB + kstep, voffB); PG8_STAGE(PG8_SA(1, 0), cA + kstep, voffA); PG8_STAGE(PG8_SB(1, 1), cB + hstep + kstep, voffB);
        PG8_WAIT_V(6); PG8_BAR;
    } else {
        PG8_STAGE(PG8_SB(0, 0), cB, voffB); PG8_STAGE(PG8_SA(0, 0), cA, voffA); PG8_STAGE(PG8_SB(0, 1), cB + hstep, voffB); PG8_STAGE(PG8_SA(0, 1), cA + hstep, voffA);
        if (wr == 1) PG8_BAR;
        PG8_WAIT_V(4); PG8_BAR;
        PG8_STAGE(PG8_SB(1, 0), cB + kstep, voffB); PG8_STAGE(PG8_SA(1, 0), cA + kstep, voffA); PG8_STAGE(PG8_SB(1, 1), cB + hstep + kstep, voffB);
        PG8_WAIT_V(6); PG8_BAR;
    }
    for (;;) {
        const bool has_next = S.next(ui + 1, nxt);
        const char* nA = has_next ? (const char*)g.A + (size_t)nxt.pm * tstep : cA; const char* nB = has_next ? (const char*)g.Bt + (size_t)nxt.pn * tstep : cB;
        for (int t = 0; t < nt; t += 2) {
            const bool last = (t == nt - 2);
            const char* a1 = cA + (size_t)(t + 1) * kstep;
            const char* a2 = last ? nA : cA + (size_t)(t + 2) * kstep; const char* b2 = last ? nB : cB + (size_t)(t + 2) * kstep;
            const char* a3 = a2 + kstep; const char* b3 = b2 + kstep;
            if (last && has_next) S.a_ready(nxt);
            if constexpr (SP2) {
            PG8_LDB(B0, 0, 0); PG8_LDB(B1, 0, 1); PG8_SCHED; PG8_LDA(At, 0, 0); PG8_STAGE(PG8_SA(1, 1), a1 + hstep, voffA);
            PG8_WAIT_V(8); PG8_WAIT_L(0); PG8_BAR; PG8_MMA(0, 0, At, B0); PG8_MMA(0, 1, At, B1); PG8_BAR; PG8_SCHED;
            PG8_LDA(At, 0, 1); PG8_STAGE(PG8_SB(0, 0), b2, voffB); PG8_STAGE(PG8_SB(0, 1), b2 + hstep, voffB); PG8_STAGE(PG8_SA(0, 0), a2, voffA);
            PG8_WAIT_V(8); PG8_WAIT_L(0); PG8_BAR; PG8_MMA(1, 0, At, B0); PG8_MMA(1, 1, At, B1); PG8_BAR; PG8_SCHED;
            PG8_LDB(B0, 1, 0); PG8_LDB(B1, 1, 1); PG8_SCHED; PG8_LDA(At, 1, 0); PG8_STAGE(PG8_SA(0, 1), a2 + hstep, voffA);
            PG8_WAIT_V(8); PG8_WAIT_L(0); PG8_BAR; PG8_MMA(0, 0, At, B0); PG8_MMA(0, 1, At, B1); PG8_BAR; PG8_SCHED;
            PG8_LDA(At, 1, 1); PG8_STAGE(PG8_SB(1, 0), b3, voffB); PG8_STAGE(PG8_SB(1, 1), b3 + hstep, voffB); PG8_STAGE(PG8_SA(1, 0), a3, voffA);
            PG8_WAIT_V(8); PG8_WAIT_L(0); PG8_BAR; PG8_MMA(1, 0, At, B0); PG8_MMA(1, 1, At, B1); PG8_BAR; PG8_SCHED;
            } else {
            PG8_LDB(B0, 0, 0); PG8_SCHED; PG8_LDA(At, 0, 0); PG8_STAGE(PG8_SA(1, 1), a1 + hstep, voffA);
            PG8_WAIT_L(8); PG8_BAR; PG8_WAIT_L(0); PG8_MMA(0, 0, At, B0); PG8_BAR; PG8_SCHED;
            PG8_LDB(B1, 0, 1); PG8_STAGE(PG8_SB(0, 0), b2, voffB);
            PG8_BAR; PG8_WAIT_L(0); PG8_MMA(0, 1, At, B1); PG8_BAR;
            PG8_LDA(At, 0, 1); PG8_STAGE(PG8_SA(0, 0), a2, voffA);
            PG8_BAR; PG8_WAIT_L(0); PG8_MMA(1, 0, At, B0); PG8_BAR; PG8_SCHED;
            PG8_STAGE(PG8_SB(0, 1), b2 + hstep, voffB);
            PG8_WAIT_V(6); PG8_BAR; PG8_MMA(1, 1, At, B1); PG8_BAR;
            PG8_LDB(B0, 1, 0); PG8_SCHED; PG8_LDA(At, 1, 0); PG8_STAGE(PG8_SA(0, 1), a2 + hstep, voffA);
            PG8_WAIT_L(8); PG8_BAR; PG8_WAIT_L(0); PG8_MMA(0, 0, At, B0); PG8_BAR; PG8_SCHED;
            PG8_LDB(B1, 1, 1); PG8_STAGE(PG8_SB(1, 0), b3, voffB);
            PG8_BAR; PG8_WAIT_L(0); PG8_MMA(0, 1, At, B1); PG8_BAR;
            PG8_LDA(At, 1, 1); PG8_STAGE(PG8_SA(1, 0), a3, voffA);
            PG8_BAR; PG8_WAIT_L(0); PG8_MMA(1, 0, At, B0); PG8_BAR; PG8_SCHED;
            PG8_STAGE(PG8_SB(1, 1), b3 + hstep, voffB);
            PG8_WAIT_V(6); PG8_BAR; PG8_MMA(1, 1, At, B1); PG8_BAR;
            }
        }
        if constexpr (ALIGN_EPI) { if (wr == 0) PG8_BAR; }
        if constexpr (Epi::CHAIN) { if (has_next) E.mid(acc, cur, wr, wc, fr, fq); else E(acc, cur, wr, wc, fr, fq); }
        else if constexpr (!Epi::AFTER_DRAIN) { E(acc, cur, wr, wc, fr, fq); S.done(cur); }
        if (!has_next) break;
        if constexpr (!Epi::CHAIN) {
#pragma unroll
        for (int a = 0; a < 2; ++a)
#pragma unroll
            for (int b = 0; b < 2; ++b)
#pragma unroll
                for (int m = 0; m < 4; ++m)
#pragma unroll
                    for (int n = 0; n < 2; ++n) acc[a][b][m][n] = (f32x4){0.f, 0.f, 0.f, 0.f};
        }
        cur = nxt; cA = nA; cB = nB; ++ui;
        if constexpr (ALIGN_EPI) { if (wr == 1) PG8_BAR; }
    }
    PG8_WAIT_V(0);
    if constexpr (!ALIGN_EPI) { if (wr == 0) PG8_BAR; }
    PG8_BAR;
    if constexpr (Epi::AFTER_DRAIN) { E.fused(acc, cur, wr, wc, fr, fq, lds, wid, lane); S.done(cur); }
#undef PG8_SA
#undef PG8_SB
#undef PG8_STAGE
#undef PG8_LDA
#undef PG8_LDB
#undef PG8_MMA
#undef PG8_WAIT_V
#undef PG8_WAIT_L
#undef PG8_BAR
#undef PG8_SCHED
}
}

#define LAS __attribute__((address_space(3)))
typedef unsigned short bf16;
typedef float f32x4 __attribute__((ext_vector_type(4)));
typedef float f32x2 __attribute__((ext_vector_type(2)));
typedef short bf16x8 __attribute__((ext_vector_type(8)));
typedef short s16x4 __attribute__((ext_vector_type(4)));
typedef short v4i16_t __attribute__((ext_vector_type(4)));
typedef unsigned u32x4 __attribute__((ext_vector_type(4)));
typedef unsigned u32x2 __attribute__((ext_vector_type(2)));

constexpr int NWAVES = 8, NTHREADS = 512;
constexpr int DM = 1024, SEQ = 4096, NBATCH = 4, MP = NBATCH * SEQ, NSMP = 32, MV = MP + NSMP, MT = 16640;
constexpr int DIN = 7680, QKV = 1536, DFF = 2816, NADA = 6144;
constexpr size_t O_YP = 0, O_YS = 16777216, O_KV0P = 16809984, O_KV1P = 17858560, O_KV2P = 22052864,
                 O_KV0S = 38830080, O_KV1S = 38895616, O_KV2S = 38961152, O_SV = 39026688, O_END = 39059456;
constexpr float LOG2E = 1.4426950408889634f;
constexpr float QSCALE = 0.08838834764831845f * LOG2E;

constexpr size_t MiB = 1u << 20;
constexpr size_t alm(size_t x) { return (x + MiB - 1) / MiB * MiB; }
constexpr size_t WS_WADA = 1 * MiB;
constexpr size_t WS_WL0 = WS_WADA + alm(2ull * NADA * DM * 2);
constexpr size_t WL_WIN = 0;
constexpr size_t WL_WPA = WL_WIN + alm((size_t)DIN * DM * 2);
constexpr size_t WL_WPS = WL_WPA + alm(1024ull * 512 * 2);
constexpr size_t WL_WOUT = WL_WPS + alm(1024ull * 512 * 2);
constexpr size_t WL_WFI = WL_WOUT + alm(1024ull * 1024 * 2);
constexpr size_t WL_WFO = WL_WFI + alm(5632ull * 1024 * 2);
constexpr size_t WL_WSP = WL_WFO + alm(1024ull * DFF * 2);
constexpr size_t WL_SIZE = WL_WSP + alm(8ull * 128 * 128 * 2);
constexpr size_t WS_MOD = WS_WL0 + 2 * WL_SIZE;
constexpr size_t WS_SC = WS_MOD + alm(2ull * 36 * NADA * 4);
constexpr size_t WS_XN = WS_SC + alm(256ull * DM * 2);
constexpr size_t WS_Q = WS_XN + alm((size_t)MT * DM * 2);
constexpr size_t WS_K = WS_Q + alm((size_t)MT * QKV * 2);
constexpr size_t WS_V = WS_K + alm((size_t)MT * QKV * 2);
constexpr size_t WS_U = WS_V + alm((size_t)MT * QKV * 2);
constexpr size_t WS_VS = WS_U + alm((size_t)MT * 512 * 2);
constexpr size_t WS_G = WS_VS + alm((size_t)MT * 512 * 2);
constexpr size_t WS_OG = WS_G + alm((size_t)MT * 2048 * 2);
constexpr size_t WS_DG = WS_OG + alm((size_t)MT * QKV * 2);
constexpr size_t WS_YY = WS_DG + alm((size_t)MT * 12 * 4);
constexpr size_t WS_T1 = WS_YY + alm((size_t)(2 * MP + 64) * 512 * 2);
constexpr size_t WS_MG = WS_T1 + alm((size_t)MT * DM * 4);
constexpr size_t WS_X1 = WS_MG + alm((size_t)MT * DM * 2);
constexpr size_t WS_X2 = WS_X1 + alm((size_t)MT * DM * 4);
constexpr size_t WS_H = WS_X2 + alm((size_t)MT * DM * 4);
constexpr size_t WS_END = WS_H + alm((size_t)MT * DFF * 2);

constexpr int LDS_RING = 0, LDS_EXCH = 131072, LDS_BYTES = 155648;

__device__ __forceinline__ float bf2f(unsigned short h) { return __uint_as_float((unsigned)h << 16); }
__device__ __forceinline__ unsigned pk2(float lo, float hi) { return pg8::cvt_pk_bf16(lo, hi); }
__device__ __forceinline__ float fast_exp2(float x) { return __builtin_amdgcn_exp2f(x); }
__device__ __forceinline__ float sigmoidf_(float x) { return __builtin_amdgcn_rcpf(1.0f + fast_exp2(-x * LOG2E)); }
__device__ __forceinline__ float wave_sum(float v) {
#pragma unroll
    for (int o = 1; o < 64; o <<= 1) v += __shfl_xor(v, o);
    return v;
}
__device__ __forceinline__ float wave_max(float v) {
#pragma unroll
    for (int o = 1; o < 64; o <<= 1) v = fmaxf(v, __shfl_xor(v, o));
    return v;
}
__device__ __forceinline__ s16x4 vtr(const LAS unsigned char* p) { return __builtin_bit_cast(s16x4, __builtin_amdgcn_ds_read_tr16_b64_v4i16((LAS v4i16_t*)p)); }
#define LDS_WAIT() asm volatile("s_waitcnt lgkmcnt(0)" ::: "memory")

__device__ __forceinline__ int mod_row(int row) { return row < MP ? (row >> 12) : 4 + (row - MP); }

__device__ __forceinline__ __attribute__((address_space(1))) float* kv_out_ptr(__attribute__((address_space(1))) float* out, int layer, int g, int row, int kvi, int hh) {
    if (row < MP) {
        const int b = row >> 12, t = row & 4095, lw = 128 << (2 * g), tt = t - (SEQ - lw);
        if (tt < 0) return nullptr;
        const size_t base = g == 0 ? O_KV0P : (g == 1 ? O_KV1P : O_KV2P);
        return out + base + ((((size_t)(layer * NBATCH + b) * lw + tt) * 2 + kvi) * 4 + hh) * 128;
    } else if (row < MV) {
        const int b = row - MP;
        const size_t base = g == 0 ? O_KV0S : (g == 1 ? O_KV1S : O_KV2S);
        return out + base + (((size_t)(layer * NSMP + b) * 2 + kvi) * 4 + hh) * 128;
    }
    return nullptr;
}

using pg8::Unit;
typedef pg8::f32x4 (AccT)[2][2][4][2];

__device__ __forceinline__ void st8_bf16g(__attribute__((address_space(1))) bf16* p, f32x4 v0, f32x4 v1) {
    u32x4 w; w.x = pk2(v0[0], v0[1]); w.y = pk2(v0[2], v0[3]); w.z = pk2(v1[0], v1[1]); w.w = pk2(v1[2], v1[3]);
    *(__attribute__((address_space(1))) u32x4*)p = w;
}
__device__ __forceinline__ void st8_bf16(bf16* p, f32x4 v0, f32x4 v1) {
    u32x4 w; w.x = pk2(v0[0], v0[1]); w.y = pk2(v0[2], v0[3]); w.z = pk2(v1[0], v1[1]); w.w = pk2(v1[2], v1[3]);
    *(u32x4*)p = w;
}

#define LAUNDER_S(x) asm volatile("" : "+s"(x))
#define GP(T, p) ((T*)(__attribute__((address_space(1))) T*)(p))
struct EpiAda {
    static constexpr bool PERM = true, AFTER_DRAIN = false, CHAIN = false;
    float* MOD; const float* b_ada;
    __device__ __forceinline__ void operator()(const pg8::f32x4 (&acc)[2][2][4][2], const Unit& u, int wr, int wc, int fr_, int fq_) const {
        int fr = fr_, fq = fq_; asm volatile("" : "+v"(fr), "+v"(fq));
        if (u.pm != 0 || wr != 0) return;
#pragma unroll
        for (int m = 0; m < 3; ++m) {
            const int row = m * 16 + fr;
            if (row >= 36) continue;
#pragma unroll
            for (int bj = 0; bj < 2; ++bj) {
                const int col = u.pn * 256 + bj * 128 + wc * 32 + 8 * fq;
                const int layer = col / NADA, c = col - layer * NADA;
                const float* bp = b_ada + (size_t)layer * NADA + c;
                float* op = MOD + ((size_t)layer * 36 + row) * NADA + c;
                *(f32x4*)op = acc[0][bj][m][0] + *(const f32x4*)bp;
                *(f32x4*)(op + 4) = acc[0][bj][m][1] + *(const f32x4*)(bp + 4);
            }
        }
    }
};

struct EpiIn {
    static constexpr bool PERM = true, AFTER_DRAIN = false, CHAIN = false;
    unsigned char* wsb; const float* qw; const float* kw; float* out; int layer; LAS float* P;
    __device__ __forceinline__ void operator()(const pg8::f32x4 (&acc)[2][2][4][2], const Unit& u, int wr, int wc, int fr_, int fq_) const {
        int fr = fr_, fq = fq_; asm volatile("" : "+v"(fr), "+v"(fq));
        unsigned char* wsl = wsb; const float* qwl = qw; const float* kwl = kw; float* outl = out; LAUNDER_S(wsl); LAUNDER_S(qwl); LAUNDER_S(kwl); LAUNDER_S(outl);
        typedef __attribute__((address_space(1))) bf16 gbf; typedef __attribute__((address_space(1))) float gfl;
        gbf *Q = (gbf*)(wsl + WS_Q), *K = (gbf*)(wsl + WS_K), *V = (gbf*)(wsl + WS_V), *U = (gbf*)(wsl + WS_U), *VS = (gbf*)(wsl + WS_VS), *G = (gbf*)(wsl + WS_G);
        gfl* outg = (gfl*)outl;
        const int pn = u.pn;
        const int cw = wc * 32 + 8 * fq;
        const int rowb = u.pm * 256 + wr * 64 + fr;
        if (pn < 12) {
            const bool isk = pn >= 6;
#pragma unroll
            for (int ai = 0; ai < 2; ++ai)
#pragma unroll
                for (int m = 0; m < 4; ++m)
#pragma unroll
                    for (int bj = 0; bj < 2; ++bj) {
                        const pg8::f32x4 a = acc[ai][bj][m][0], b = acc[ai][bj][m][1];
                        float s = (a[0] * a[0] + a[1] * a[1]) + (a[2] * a[2] + a[3] * a[3]) + (b[0] * b[0] + b[1] * b[1]) + (b[2] * b[2] + b[3] * b[3]);
                        s += __shfl_xor(s, 16); s += __shfl_xor(s, 32);
                        if (fq == 0) P[(ai * 128 + wr * 64 + m * 16 + fr) * 8 + bj * 4 + wc] = s;
                    }
            asm volatile("s_waitcnt lgkmcnt(0)" ::: "memory"); __builtin_amdgcn_s_barrier(); asm volatile("" ::: "memory");
#pragma unroll
            for (int bj = 0; bj < 2; ++bj) {
                const int head = 2 * (isk ? pn - 6 : pn) + bj, g = head >> 2, hh = head & 3;
                const __attribute__((address_space(1))) float* wv = (const __attribute__((address_space(1))) float*)(isk ? kwl : qwl) + g * 128 + cw;
                pg8::f32x4 w0 = *(const __attribute__((address_space(1))) f32x4*)wv, w1 = *(const __attribute__((address_space(1))) f32x4*)(wv + 4);
                if (!isk) { w0 = w0 * QSCALE; w1 = w1 * QSCALE; }
                gbf* dst = (isk ? K : Q) + head * 128 + cw;
#pragma unroll
                for (int ai = 0; ai < 2; ++ai)
#pragma unroll
                    for (int m = 0; m < 4; ++m) {
                        const int rl = ai * 128 + wr * 64 + m * 16 + fr, row = u.pm * 256 + rl;
                        const f32x4 pv = *(const LAS f32x4*)(P + rl * 8 + bj * 4);
                        const float rstd = 1.0f / sqrtf(((pv[0] + pv[1]) + (pv[2] + pv[3])) * (1.0f / 128.0f) + 1e-6f);
                        const pg8::f32x4 v0 = acc[ai][bj][m][0] * rstd * w0, v1 = acc[ai][bj][m][1] * rstd * w1;
                        st8_bf16g(dst + (size_t)row * QKV, v0, v1);
                        if (isk) { gfl* o = kv_out_ptr(outg, layer, g, row, 0, hh); if (o) { *(__attribute__((address_space(1))) f32x4*)(o + cw) = v0; *(__attribute__((address_space(1))) f32x4*)(o + cw + 4) = v1; } }
                    }
            }
        } else if (pn < 18) {
#pragma unroll
            for (int bj = 0; bj < 2; ++bj) {
                const int head = 2 * (pn - 12) + bj, g = head >> 2, hh = head & 3;
                gbf* dst = V + head * 128 + cw;
#pragma unroll
                for (int ai = 0; ai < 2; ++ai)
#pragma unroll
                    for (int m = 0; m < 4; ++m) {
                        const int row = rowb + ai * 128 + m * 16;
                        const pg8::f32x4 v0 = acc[ai][bj][m][0], v1 = acc[ai][bj][m][1];
                        st8_bf16g(dst + (size_t)row * QKV, v0, v1);
                        gfl* o = kv_out_ptr(outg, layer, g, row, 1, hh); if (o) { *(__attribute__((address_space(1))) f32x4*)(o + cw) = v0; *(__attribute__((address_space(1))) f32x4*)(o + cw + 4) = v1; }
                    }
            }
        } else if (pn < 22) {
            gbf* base = (pn < 20 ? U : VS) + ((pn - 18) & 1) * 256 + cw;
#pragma unroll
            for (int bj = 0; bj < 2; ++bj)
#pragma unroll
                for (int ai = 0; ai < 2; ++ai)
#pragma unroll
                    for (int m = 0; m < 4; ++m) {
                        const int row = rowb + ai * 128 + m * 16;
                        const pg8::f32x4 v0 = acc[ai][bj][m][0], v1 = acc[ai][bj][m][1];
                        const pg8::f32x2 a = pg8::gelu_pk((pg8::f32x2){v0[0], v0[1]}), b = pg8::gelu_pk((pg8::f32x2){v0[2], v0[3]}),
                                         c = pg8::gelu_pk((pg8::f32x2){v1[0], v1[1]}), d = pg8::gelu_pk((pg8::f32x2){v1[2], v1[3]});
                        st8_bf16g(base + (size_t)row * 512 + bj * 128, (f32x4){a.x, a.y, b.x, b.y}, (f32x4){c.x, c.y, d.x, d.y});
                    }
        } else {
            gbf* base = G + (pn - 22) * 256 + cw;
#pragma unroll
            for (int bj = 0; bj < 2; ++bj)
#pragma unroll
                for (int ai = 0; ai < 2; ++ai)
#pragma unroll
                    for (int m = 0; m < 4; ++m) {
                        const int row = rowb + ai * 128 + m * 16;
                        const pg8::f32x4 v0 = acc[ai][bj][m][0], v1 = acc[ai][bj][m][1];
                        st8_bf16g(base + (size_t)row * 2048 + bj * 128,
                                 (f32x4){sigmoidf_(v0[0]), sigmoidf_(v0[1]), sigmoidf_(v0[2]), sigmoidf_(v0[3])},
                                 (f32x4){sigmoidf_(v1[0]), sigmoidf_(v1[1]), sigmoidf_(v1[2]), sigmoidf_(v1[3])});
                    }
        }
    }
};

struct EpiGate1 {
    static constexpr bool PERM = true, AFTER_DRAIN = false, CHAIN = false;
    const bf16* G; float* T1;
    __device__ __forceinline__ void operator()(const pg8::f32x4 (&acc)[2][2][4][2], const Unit& u, int wr, int wc, int fr_, int fq_) const {
        int fr = fr_, fq = fq_; asm volatile("" : "+v"(fr), "+v"(fq));
        const int col0 = u.pn * 256 + wc * 32 + 8 * fq, rowb = u.pm * 256 + wr * 64 + fr;
#pragma unroll
        for (int ai = 0; ai < 2; ++ai)
#pragma unroll
            for (int m = 0; m < 4; ++m) {
                const int row = rowb + ai * 128 + m * 16;
#pragma unroll
                for (int bj = 0; bj < 2; ++bj) {
                    const int col = col0 + bj * 128;
                    const u32x4 gv = *(const u32x4*)(G + (size_t)row * 2048 + col);
                    const f32x4 g0 = {__uint_as_float(gv.x << 16), __uint_as_float(gv.x & 0xffff0000u), __uint_as_float(gv.y << 16), __uint_as_float(gv.y & 0xffff0000u)};
                    const f32x4 g1 = {__uint_as_float(gv.z << 16), __uint_as_float(gv.z & 0xffff0000u), __uint_as_float(gv.w << 16), __uint_as_float(gv.w & 0xffff0000u)};
                    float* o = T1 + (size_t)row * DM + col;
                    *(f32x4*)o = g0 * acc[ai][bj][m][0]; *(f32x4*)(o + 4) = g1 * acc[ai][bj][m][1];
                }
            }
    }
};
struct EpiGate2 {
    static constexpr bool PERM = true, AFTER_DRAIN = false, CHAIN = false;
    const bf16* G; const float* T1; bf16* MG;
    __device__ __forceinline__ void operator()(const pg8::f32x4 (&acc)[2][2][4][2], const Unit& u, int wr, int wc, int fr_, int fq_) const {
        int fr = fr_, fq = fq_; asm volatile("" : "+v"(fr), "+v"(fq));
        const int col0 = u.pn * 256 + wc * 32 + 8 * fq, rowb = u.pm * 256 + wr * 64 + fr;
#pragma unroll
        for (int ai = 0; ai < 2; ++ai)
#pragma unroll
            for (int m = 0; m < 4; ++m) {
                const int row = rowb + ai * 128 + m * 16;
#pragma unroll
                for (int bj = 0; bj < 2; ++bj) {
                    const int col = col0 + bj * 128;
                    const u32x4 gv = *(const u32x4*)(G + (size_t)row * 2048 + 1024 + col);
                    const f32x4 g0 = {__uint_as_float(gv.x << 16), __uint_as_float(gv.x & 0xffff0000u), __uint_as_float(gv.y << 16), __uint_as_float(gv.y & 0xffff0000u)};
                    const f32x4 g1 = {__uint_as_float(gv.z << 16), __uint_as_float(gv.z & 0xffff0000u), __uint_as_float(gv.w << 16), __uint_as_float(gv.w & 0xffff0000u)};
                    const float* t = T1 + (size_t)row * DM + col;
                    const f32x4 t0 = *(const f32x4*)t, t1 = *(const f32x4*)(t + 4);
                    st8_bf16(MG + (size_t)row * DM + col, t0 + g0 * acc[ai][bj][m][0], t1 + g1 * acc[ai][bj][m][1]);
                }
            }
    }
};

struct PairOrder {
    pg8::StaticOrder S0;
    __device__ bool next(int i, Unit& u) const { if (i >= 2) return false; Unit b; if (!S0.next(0, b)) return false; u.pm = b.pm + (i ? MP / 256 : 0); u.pn = b.pn + (i ? 4 : 0); return true; }
    __device__ __forceinline__ void a_ready(const Unit&) const {}
    __device__ __forceinline__ void done(const Unit&) const {}
};
__device__ __forceinline__ void unpack8(const u32x4 gv, f32x4& g0, f32x4& g1) {
    g0 = (f32x4){__uint_as_float(gv.x << 16), __uint_as_float(gv.x & 0xffff0000u), __uint_as_float(gv.y << 16), __uint_as_float(gv.y & 0xffff0000u)};
    g1 = (f32x4){__uint_as_float(gv.z << 16), __uint_as_float(gv.z & 0xffff0000u), __uint_as_float(gv.w << 16), __uint_as_float(gv.w & 0xffff0000u)};
}
struct EpiMerged {
    static constexpr bool PERM = true, AFTER_DRAIN = false, CHAIN = true;
    const bf16* G; bf16* MG;
    __device__ __forceinline__ void mid(pg8::f32x4 (&acc)[2][2][4][2], const Unit& u, int wr, int wc, int fr_, int fq_) const {
        int fr = fr_, fq = fq_; asm volatile("" : "+v"(fr), "+v"(fq));
        const int col0 = u.pn * 256 + wc * 32 + 8 * fq, rowb = u.pm * 256 + wr * 64 + fr;
#pragma unroll
        for (int ai = 0; ai < 2; ++ai)
#pragma unroll
            for (int m = 0; m < 4; ++m) {
                const int row = rowb + ai * 128 + m * 16;
#pragma unroll
                for (int bj = 0; bj < 2; ++bj) {
                    const int col = col0 + bj * 128;
                    f32x4 a0, a1, b0, b1;
                    unpack8(*(const u32x4*)(G + (size_t)row * 2048 + col), a0, a1);
                    unpack8(*(const u32x4*)(G + (size_t)row * 2048 + 1024 + col), b0, b1);
#pragma unroll
                    for (int e = 0; e < 4; ++e) {
                        acc[ai][bj][m][0][e] *= a0[e] * __builtin_amdgcn_rcpf(fmaxf(b0[e], 1e-30f));
                        acc[ai][bj][m][1][e] *= a1[e] * __builtin_amdgcn_rcpf(fmaxf(b1[e], 1e-30f));
                    }
                }
            }
    }
    __device__ __forceinline__ void operator()(const pg8::f32x4 (&acc)[2][2][4][2], const Unit& u, int wr, int wc, int fr_, int fq_) const {
        int fr = fr_, fq = fq_; asm volatile("" : "+v"(fr), "+v"(fq));
        const int col0 = (u.pn - 4) * 256 + wc * 32 + 8 * fq, rowb = (u.pm - MP / 256) * 256 + wr * 64 + fr;
#pragma unroll
        for (int ai = 0; ai < 2; ++ai)
#pragma unroll
            for (int m = 0; m < 4; ++m) {
                const int row = rowb + ai * 128 + m * 16;
#pragma unroll
                for (int bj = 0; bj < 2; ++bj) {
                    const int col = col0 + bj * 128;
                    f32x4 b0, b1;
                    unpack8(*(const u32x4*)(G + (size_t)row * 2048 + 1024 + col), b0, b1);
                    st8_bf16(MG + (size_t)row * DM + col, b0 * acc[ai][bj][m][0], b1 * acc[ai][bj][m][1]);
                }
            }
    }
};
struct EpiRes {
    static constexpr bool PERM = true, AFTER_DRAIN = false, CHAIN = false;
    const float* bp; const float* bs; float* op; float* os; const float* gate;
    __device__ __forceinline__ void operator()(const pg8::f32x4 (&acc)[2][2][4][2], const Unit& u, int wr, int wc, int fr_, int fq_) const {
        int fr = fr_, fq = fq_; asm volatile("" : "+v"(fr), "+v"(fq));
        const int col0 = u.pn * 256 + wc * 32 + 8 * fq, rowb = u.pm * 256 + wr * 64 + fr;
#pragma unroll
        for (int ai = 0; ai < 2; ++ai)
#pragma unroll
            for (int m = 0; m < 4; ++m) {
                const int row = rowb + ai * 128 + m * 16;
                if (row < MV) {
                    const float* b = row < MP ? bp + (size_t)row * DM : bs + (size_t)(row - MP) * DM;
                    float* o = row < MP ? op + (size_t)row * DM : os + (size_t)(row - MP) * DM;
                    const float* gt = gate + (size_t)mod_row(row) * NADA;
#pragma unroll
                    for (int bj = 0; bj < 2; ++bj) {
                        const int col = col0 + bj * 128;
                        const f32x4 b0 = *(const f32x4*)(b + col), b1 = *(const f32x4*)(b + col + 4);
                        const f32x4 g0 = *(const f32x4*)(gt + col), g1 = *(const f32x4*)(gt + col + 4);
                        *(f32x4*)(o + col) = b0 + g0 * acc[ai][bj][m][0]; *(f32x4*)(o + col + 4) = b1 + g1 * acc[ai][bj][m][1];
                    }
                }
            }
    }
};
struct EpiSwiglu {
    static constexpr bool PERM = true, AFTER_DRAIN = false, CHAIN = false;
    bf16* H;
    __device__ __forceinline__ void operator()(const pg8::f32x4 (&acc)[2][2][4][2], const Unit& u, int wr, int wc, int fr_, int fq_) const {
        int fr = fr_, fq = fq_; asm volatile("" : "+v"(fr), "+v"(fq));
        const int col = u.pn * 128 + wc * 32 + 8 * fq, rowb = u.pm * 256 + wr * 64 + fr;
#pragma unroll
        for (int ai = 0; ai < 2; ++ai)
#pragma unroll
            for (int m = 0; m < 4; ++m) {
                const int row = rowb + ai * 128 + m * 16;
                f32x4 r0, r1;
#pragma unroll
                for (int e = 0; e < 4; ++e) {
                    const float a0 = acc[ai][0][m][0][e], a1 = acc[ai][0][m][1][e];
                    r0[e] = a0 * sigmoidf_(a0) * acc[ai][1][m][0][e];
                    r1[e] = a1 * sigmoidf_(a1) * acc[ai][1][m][1][e];
                }
                st8_bf16(H + (size_t)row * DFF + col, r0, r1);
            }
    }
};

__device__ __forceinline__ void transpose_item(const float* W, int K, int N, bf16* WT, int mode, LAS float* scr, int item, int lane) {
    const int nblk = N / 32, kb = item / nblk, nb = item % nblk, k0 = 64 * kb, n0 = 32 * nb;
    float wv[32];
#pragma unroll
    for (int i = 0; i < 32; ++i) wv[i] = W[(size_t)(k0 + 2 * i + (lane >> 5)) * N + n0 + (lane & 31)];
#pragma unroll
    for (int i = 0; i < 32; ++i) scr[(2 * i + (lane >> 5)) * 33 + (lane & 31)] = wv[i];
    LDS_WAIT(); asm volatile("" ::: "memory");
    int drow0 = n0;
    if (mode == 1) { const int bj = n0 >= DFF ? 1 : 0; const int j0 = n0 - bj * DFF; drow0 = (j0 >> 7) * 256 + bj * 128 + (j0 & 127); }
    const int c = lane & 7;
#pragma unroll
    for (int j = 0; j < 4; ++j) { const int n = (lane >> 3) + 8 * j; const LAS float* s = scr + (8 * c) * 33 + n;
        u32x4 o; o.x = pk2(s[0 * 33], s[1 * 33]); o.y = pk2(s[2 * 33], s[3 * 33]); o.z = pk2(s[4 * 33], s[5 * 33]); o.w = pk2(s[6 * 33], s[7 * 33]);
        *(u32x4*)(WT + (size_t)(drow0 + n) * K + k0 + 8 * c) = o; }
    LDS_WAIT(); asm volatile("" ::: "memory");
}

__device__ __forceinline__ void norm_mod_phase(const float* xp, const float* xs, const float* nw, const float* modl, int sh_off, bf16* XN, int gw, int NGW, int lane) {
    for (int row = gw; row < MT; row += NGW) {
        unsigned long long* o8 = (unsigned long long*)(XN + (size_t)row * DM) + lane;
        if (row >= MV) {
#pragma unroll
            for (int j = 0; j < 4; ++j) o8[64 * j] = 0ull;
            continue;
        }
        const float* xrow = row < MP ? xp + (size_t)row * DM : xs + (size_t)(row - MP) * DM;
        const f32x4* xr = (const f32x4*)xrow + lane;
        f32x4 v[4]; float s = 0.f;
#pragma unroll
        for (int j = 0; j < 4; ++j) { v[j] = xr[64 * j]; s += (v[j].x * v[j].x + v[j].y * v[j].y) + (v[j].z * v[j].z + v[j].w * v[j].w); }
        const float rstd = 1.0f / sqrtf(wave_sum(s) * (1.0f / DM) + 1e-6f);
        const float* mr = modl + (size_t)mod_row(row) * NADA + sh_off;
#pragma unroll
        for (int j = 0; j < 4; ++j) {
            const int col = 4 * lane + 256 * j;
            const f32x4 w = *(const f32x4*)(nw + col), shv = *(const f32x4*)(mr + col), scv = *(const f32x4*)(mr + 1024 + col);
            const f32x4 y = v[j] * rstd * w * (scv + 1.0f) + shv;
            o8[64 * j] = (unsigned long long)pk2(y.x, y.y) | ((unsigned long long)pk2(y.z, y.w) << 32);
        }
    }
}

constexpr int KV_STRIDE = 272;
constexpr int ATT_K_OFF = 0, ATT_V_OFF = 256 * KV_STRIDE;
__device__ __forceinline__ float alibi_slope(int head12) { return exp2f(-8.0f * (float)(head12 + 1) / 12.0f); }

__device__ __forceinline__ void attn_unit(LAS unsigned char* lds, const bf16* Q, const bf16* K, const bf16* V, bf16* OG, float* DG, int unit, float cshift, int wid, int lane, int tid) {
    const int g = unit >> 9, r9 = unit & 511, sh = 2 * g, d = 1 << sh, nb = 32 >> sh;
    const int qb = r9 % nb; int t2 = r9 / nb; const int r = t2 % d; t2 /= d; const int h = t2 & 3, b = t2 >> 2;
    const int hc = (g * 4 + h) * 128;
    {
        const int ch = tid & 15, r0 = tid >> 4;
        u32x4 kv[8], vv[8];
#pragma unroll
        for (int it = 0; it < 8; ++it) {
            const int j = r0 + 32 * it, mk = 128 * qb - 128 + j;
            if (qb > 0 || it >= 4) {
                const size_t off = ((size_t)b * SEQ + (size_t)mk * d + r) * QKV + hc + ch * 8;
                kv[it] = *(const u32x4*)(K + off); vv[it] = *(const u32x4*)(V + off);
            } else { kv[it] = (u32x4){0u, 0u, 0u, 0u}; vv[it] = (u32x4){0u, 0u, 0u, 0u}; }
        }
#pragma unroll
        for (int it = 0; it < 8; ++it) {
            const int j = r0 + 32 * it;
            *(LAS u32x4*)(lds + ATT_K_OFF + j * KV_STRIDE + ch * 16) = kv[it];
            *(LAS u32x4*)(lds + ATT_V_OFF + j * KV_STRIDE + ch * 16) = vv[it];
        }
    }
    const int ql = lane & 15, gq = lane >> 4;
    const int qi = 16 * wid + ql;
    const size_t qrow = (size_t)b * SEQ + (size_t)(128 * qb + qi) * d + r;
    bf16x8 qf[4];
#pragma unroll
    for (int kk = 0; kk < 4; ++kk) qf[kk] = *(const bf16x8*)(Q + qrow * QKV + hc + 32 * kk + 8 * gq);
    const float slope2 = alibi_slope(g * 4 + h) * LOG2E * (float)d;
    __syncthreads();
    f32x4 accO[8];
#pragma unroll
    for (int dt = 0; dt < 8; ++dt) accO[dt] = (f32x4){0.f, 0.f, 0.f, 0.f};
    float dsum = 0.f;
    const LAS unsigned char* kbase = lds + ATT_K_OFF + (16 * wid + ql) * KV_STRIDE + gq * 16;
    const LAS unsigned char* vbase = lds + ATT_V_OFF + (16 * wid + 4 * gq + (ql >> 2)) * KV_STRIDE + (ql & 3) * 8;
#pragma unroll
    for (int kt2 = 0; kt2 < 5; ++kt2) {
        const int ja = 16 * wid + 32 * kt2;
        f32x4 sa = {0.f, 0.f, 0.f, 0.f}, sb = {0.f, 0.f, 0.f, 0.f};
#pragma unroll
        for (int kk = 0; kk < 4; ++kk) {
            const bf16x8 ka = *(const LAS bf16x8*)(kbase + (32 * kt2) * KV_STRIDE + kk * 64);
            sa = __builtin_amdgcn_mfma_f32_16x16x32_bf16(ka, qf[kk], sa, 0, 0, 0);
        }
        if (kt2 < 4) {
#pragma unroll
            for (int kk = 0; kk < 4; ++kk) {
                const bf16x8 kb = *(const LAS bf16x8*)(kbase + (32 * kt2 + 16) * KV_STRIDE + kk * 64);
                sb = __builtin_amdgcn_mfma_f32_16x16x32_bf16(kb, qf[kk], sb, 0, 0, 0);
            }
        }
        float pa[4], pb[4];
#pragma unroll
        for (int jj = 0; jj < 4; ++jj) {
            const int j = ja + 4 * gq + jj, dist = 128 + qi - j;
            const bool ok = dist >= 0 && dist <= 128 && (128 * qb - 128 + j) >= 0;
            pa[jj] = ok ? fast_exp2(sa[jj] - slope2 * (float)dist - cshift) : 0.f;
            const int j2 = j + 16, dist2 = dist - 16;
            const bool ok2 = (kt2 < 4) && dist2 >= 0 && dist2 <= 128 && (128 * qb - 128 + j2) >= 0;
            pb[jj] = ok2 ? fast_exp2(sb[jj] - slope2 * (float)dist2 - cshift) : 0.f;
            dsum += pa[jj] + pb[jj];
        }
        u32x4 pw; pw.x = pk2(pa[0], pa[1]); pw.y = pk2(pa[2], pa[3]); pw.z = pk2(pb[0], pb[1]); pw.w = pk2(pb[2], pb[3]);
        const bf16x8 pfrag = __builtin_bit_cast(bf16x8, pw);
        const int rb = (kt2 < 4) ? (32 * kt2 + 16) : (32 * kt2);
#pragma unroll
        for (int dt = 0; dt < 8; ++dt) {
            const s16x4 lo = vtr(vbase + (32 * kt2) * KV_STRIDE + dt * 32);
            const s16x4 hi = vtr(vbase + rb * KV_STRIDE + dt * 32);
            const bf16x8 vf = {lo[0], lo[1], lo[2], lo[3], hi[0], hi[1], hi[2], hi[3]};
            accO[dt] = __builtin_amdgcn_mfma_f32_16x16x32_bf16(vf, pfrag, accO[dt], 0, 0, 0);
        }
    }
    dsum += __shfl_xor(dsum, 16); dsum += __shfl_xor(dsum, 32);
    const float inv = 1.0f / dsum;
    bf16* op = OG + qrow * QKV + g * 512 + h * 128 + 4 * gq;
#pragma unroll
    for (int dt = 0; dt < 8; ++dt) {
        u32x2 w; w.x = pk2(accO[dt][0] * inv, accO[dt][1] * inv); w.y = pk2(accO[dt][2] * inv, accO[dt][3] * inv);
        *(u32x2*)(op + dt * 16) = w;
    }
    if (gq == 0) DG[qrow * 12 + g * 4 + h] = dsum;
    __syncthreads();
}

__device__ __forceinline__ void attn_sample_item(LAS unsigned char* lds, const bf16* Q, const bf16* K, const bf16* V, const float* c0, const float* c1, const float* c2, int layer, bf16* YA, int item, int wid, int lane, int tid) {
    const int b = item >> 2, h = item & 3;
    LAS float* sc = (LAS float*)lds;
    LAS float* qs = (LAS float*)(lds + 2048);
    LAS float* part = (LAS float*)(lds + 4096);
    LAS float* pself = (LAS float*)(lds + 8192);
    const size_t row = (size_t)MP + b;
    if (tid < 384) { const int g = tid >> 7, dd = tid & 127; qs[tid] = bf2f(Q[row * QKV + (g * 4 + h) * 128 + dd]); }
    LDS_WAIT(); __syncthreads();
    const int k = lane >> 2, qd = lane & 3;
    {
        f32x4 kv[3][8];
#pragma unroll
        for (int i = 0; i < 3; ++i) {
            const int jj = 16 * (wid + 8 * i) + k, g = (wid + 8 * i) >> 3  , step = (jj & 127) + 1, d = 1 << (2 * g), lc = 128 << (2 * g);
            const float* cp = (g == 0 ? c0 : (g == 1 ? c1 : c2)) + ((((size_t)(layer * NSMP + b) * lc + (lc - d * step)) * 2 + 0) * 4 + h) * 128 + qd * 32;
#pragma unroll
            for (int e = 0; e < 8; ++e) kv[i][e] = *(const f32x4*)(cp + 4 * e);
        }
#pragma unroll
        for (int i = 0; i < 3; ++i) {
            const int jj = 16 * (wid + 8 * i) + k, g = i, step = (jj & 127) + 1, d = 1 << (2 * g);
            float s = 0.f;
#pragma unroll
            for (int e = 0; e < 8; ++e) { const f32x4 qv = *(const LAS f32x4*)(qs + g * 128 + qd * 32 + 4 * e); s += (kv[i][e].x * qv.x + kv[i][e].y * qv.y) + (kv[i][e].z * qv.z + kv[i][e].w * qv.w); }
            s += __shfl_xor(s, 1); s += __shfl_xor(s, 2);
            s -= alibi_slope(g * 4 + h) * LOG2E * (float)(d * step);
            if (qd == 0) sc[g * 132 + step] = s;
        }
        if (wid < 3) {
            const unsigned kk = *(const unsigned*)(K + row * QKV + (wid * 4 + h) * 128 + 2 * lane);
            float s = __uint_as_float(kk << 16) * qs[wid * 128 + 2 * lane] + __uint_as_float(kk & 0xffff0000u) * qs[wid * 128 + 2 * lane + 1];
            s = wave_sum(s);
            if (lane == 0) sc[wid * 132] = s;
        }
    }
    LDS_WAIT(); __syncthreads();
    float mx = -3.0e38f;
    for (int j = lane; j < 387; j += 64) { const int g = j / 129; mx = fmaxf(mx, sc[g * 132 + (j - g * 129)]); }
    mx = wave_max(mx);
    float den = 0.f;
    for (int j = lane; j < 387; j += 64) { const int g = j / 129; den += fast_exp2(sc[g * 132 + (j - g * 129)] - mx); }
    den = wave_sum(den);
    {
        f32x4 vv[3][8];
#pragma unroll
        for (int i = 0; i < 3; ++i) {
            const int jj = 16 * (wid + 8 * i) + k, g = i, step = (jj & 127) + 1, d = 1 << (2 * g), lc = 128 << (2 * g);
            const float* cp = (g == 0 ? c0 : (g == 1 ? c1 : c2)) + ((((size_t)(layer * NSMP + b) * lc + (lc - d * step)) * 2 + 1) * 4 + h) * 128 + qd * 32;
#pragma unroll
            for (int e = 0; e < 8; ++e) vv[i][e] = *(const f32x4*)(cp + 4 * e);
        }
        f32x4 acc[8];
#pragma unroll
        for (int e = 0; e < 8; ++e) acc[e] = (f32x4){0.f, 0.f, 0.f, 0.f};
#pragma unroll
        for (int i = 0; i < 3; ++i) {
            const int jj = 16 * (wid + 8 * i) + k, step = (jj & 127) + 1;
            const float p = fast_exp2(sc[i * 132 + step] - mx);
#pragma unroll
            for (int e = 0; e < 8; ++e) acc[e] += vv[i][e] * p;
        }
#pragma unroll
        for (int e = 0; e < 8; ++e)
#pragma unroll
            for (int c = 0; c < 4; ++c) { float v = acc[e][c]; v += __shfl_xor(v, 4); v += __shfl_xor(v, 8); v += __shfl_xor(v, 16); v += __shfl_xor(v, 32); acc[e][c] = v; }
        if (k == 0) {
#pragma unroll
            for (int e = 0; e < 8; ++e) *(LAS f32x4*)(part + wid * 128 + qd * 32 + 4 * e) = acc[e];
        }
        if (tid < 3) pself[tid] = fast_exp2(sc[tid * 132] - mx);
    }
    LDS_WAIT(); __syncthreads();
    if (tid < 128) {
        float a = 0.f;
#pragma unroll
        for (int w = 0; w < 8; ++w) a += part[w * 128 + tid];
#pragma unroll
        for (int g = 0; g < 3; ++g) a += pself[g] * bf2f(V[row * QKV + (g * 4 + h) * 128 + tid]);
        YA[row * 512 + h * 128 + tid] = (bf16)(pk2(a / den, 0.f) & 0xffffu);
    }
    LDS_WAIT(); __syncthreads();
}

constexpr int SG_STRIDE = 144;
constexpr int SG_SLAB = 128 * SG_STRIDE;
constexpr int SG_STATS = 4 * SG_SLAB;
__device__ __forceinline__ void sgu_unit(LAS unsigned char* lds, const bf16* U, const bf16* VS, const float* lnw, const float* lnb, const bf16* WSP, const float* bsp, bf16* YS, int unit, int wid, int lane) {
    const int half = unit & 1, bn = unit >> 1;
    const size_t R0 = (size_t)bn * 128;
    LAS f32x2* stats = (LAS f32x2*)(lds + SG_STATS);
    for (int i = 0; i < 16; ++i) {
        const int rl = 16 * wid + i;
        const u32x4 x = *(const u32x4*)(VS + (R0 + rl) * 512 + 8 * lane);
        const float f[8] = {__uint_as_float(x.x << 16), __uint_as_float(x.x & 0xffff0000u), __uint_as_float(x.y << 16), __uint_as_float(x.y & 0xffff0000u),
                            __uint_as_float(x.z << 16), __uint_as_float(x.z & 0xffff0000u), __uint_as_float(x.w << 16), __uint_as_float(x.w & 0xffff0000u)};
        float s = 0.f, s2 = 0.f;
#pragma unroll
        for (int e = 0; e < 8; ++e) { s += f[e]; s2 += f[e] * f[e]; }
        s = wave_sum(s); s2 = wave_sum(s2);
        const float mean = s * (1.0f / 512.0f), var = fmaxf(s2 * (1.0f / 512.0f) - mean * mean, 0.f);
        if (lane == 0) stats[rl] = (f32x2){mean, 1.0f / sqrtf(var + 1e-6f)};
    }
    LDS_WAIT(); __syncthreads();
    const int gl = wid & 3, th = wid >> 2, grp = half * 4 + gl, c0 = grp * 64;
    LAS unsigned char* slab = lds + gl * SG_SLAB;
    {
        const int cc = (lane & 7) * 8;
        const f32x4 w0 = *(const f32x4*)(lnw + c0 + cc), w1 = *(const f32x4*)(lnw + c0 + cc + 4), b0 = *(const f32x4*)(lnb + c0 + cc), b1 = *(const f32x4*)(lnb + c0 + cc + 4);
#pragma unroll
        for (int it = 0; it < 8; ++it) {
            const int rl = th * 64 + it * 8 + (lane >> 3);
            const u32x4 x = *(const u32x4*)(VS + (R0 + rl) * 512 + c0 + cc);
            const f32x2 st = stats[rl];
            f32x4 a = {__uint_as_float(x.x << 16), __uint_as_float(x.x & 0xffff0000u), __uint_as_float(x.y << 16), __uint_as_float(x.y & 0xffff0000u)};
            f32x4 c = {__uint_as_float(x.z << 16), __uint_as_float(x.z & 0xffff0000u), __uint_as_float(x.w << 16), __uint_as_float(x.w & 0xffff0000u)};
            a = (a - st.x) * st.y * w0 + b0; c = (c - st.x) * st.y * w1 + b1;
            u32x4 o; o.x = pk2(a[0], a[1]); o.y = pk2(a[2], a[3]); o.z = pk2(c[0], c[1]); o.w = pk2(c[2], c[3]);
            *(LAS u32x4*)(slab + rl * SG_STRIDE + cc * 2) = o;
        }
    }
    LDS_WAIT(); __syncthreads();
    const int ql = lane & 15, gq = lane >> 4;
    const LAS unsigned char* abase = slab + (8 * gq + (ql >> 2)) * SG_STRIDE + (ql & 3) * 8;
    const bf16* wg = WSP + (size_t)grp * 128 * 128;
#pragma unroll
    for (int ti = 0; ti < 4; ++ti) {
        const int tt = th == 0 ? (ti == 0 ? 0 : (ti == 1 ? 3 : (ti == 2 ? 4 : 7))) : (ti == 0 ? 1 : (ti == 1 ? 2 : (ti == 2 ? 5 : 6)));
        const int t = 16 * tt + ql;
        f32x4 acc[4];
#pragma unroll
        for (int ct = 0; ct < 4; ++ct) acc[ct] = (f32x4){0.f, 0.f, 0.f, 0.f};
        for (int kk = 0; kk <= (tt >> 1); ++kk) {
            const bf16x8 wf = *(const bf16x8*)(wg + (size_t)t * 128 + 32 * kk + 8 * gq);
#pragma unroll
            for (int ct = 0; ct < 4; ++ct) {
                const s16x4 lo = vtr(abase + (32 * kk) * SG_STRIDE + ct * 32);
                const s16x4 hi = vtr(abase + (32 * kk + 4) * SG_STRIDE + ct * 32);
                const bf16x8 af = {lo[0], lo[1], lo[2], lo[3], hi[0], hi[1], hi[2], hi[3]};
                acc[ct] = __builtin_amdgcn_mfma_f32_16x16x32_bf16(af, wf, acc[ct], 0, 0, 0);
            }
        }
        const float bias = bsp[grp * 128 + t];
#pragma unroll
        for (int ct = 0; ct < 4; ++ct) {
            const size_t off = (R0 + t) * 512 + c0 + ct * 16 + 4 * gq;
            const u32x2 uu = *(const u32x2*)(U + off);
            const float u0 = __uint_as_float(uu.x << 16), u1 = __uint_as_float(uu.x & 0xffff0000u), u2 = __uint_as_float(uu.y << 16), u3 = __uint_as_float(uu.y & 0xffff0000u);
            u32x2 o; o.x = pk2(u0 * (acc[ct][0] + bias), u1 * (acc[ct][1] + bias)); o.y = pk2(u2 * (acc[ct][2] + bias), u3 * (acc[ct][3] + bias));
            *(u32x2*)(YS + off) = o;
        }
    }
    LDS_WAIT(); __syncthreads();
}

__device__ __forceinline__ void sgu_sample_row(const bf16* U, const bf16* VS, const float* lnw, const float* lnb, const float* wsp_f32, const float* bsp, bf16* YS, float* out_sv, int b, int lane) {
    const size_t row = (size_t)MP + b;
    const u32x4 x = *(const u32x4*)(VS + row * 512 + 8 * lane);
    float f[8] = {__uint_as_float(x.x << 16), __uint_as_float(x.x & 0xffff0000u), __uint_as_float(x.y << 16), __uint_as_float(x.y & 0xffff0000u),
                  __uint_as_float(x.z << 16), __uint_as_float(x.z & 0xffff0000u), __uint_as_float(x.w << 16), __uint_as_float(x.w & 0xffff0000u)};
    float s = 0.f, s2 = 0.f;
#pragma unroll
    for (int e = 0; e < 8; ++e) { s += f[e]; s2 += f[e] * f[e]; }
    s = wave_sum(s); s2 = wave_sum(s2);
    const float mean = s * (1.0f / 512.0f), var = fmaxf(s2 * (1.0f / 512.0f) - mean * mean, 0.f), rstd = 1.0f / sqrtf(var + 1e-6f);
    const int c = 8 * lane, grp = c >> 6;
    const float w00 = wsp_f32[(size_t)grp * 128 * 128], b0 = bsp[grp * 128];
    const u32x4 uu = *(const u32x4*)(U + row * 512 + c);
    const float uf[8] = {__uint_as_float(uu.x << 16), __uint_as_float(uu.x & 0xffff0000u), __uint_as_float(uu.y << 16), __uint_as_float(uu.y & 0xffff0000u),
                         __uint_as_float(uu.z << 16), __uint_as_float(uu.z & 0xffff0000u), __uint_as_float(uu.w << 16), __uint_as_float(uu.w & 0xffff0000u)};
    float y[8];
#pragma unroll
    for (int e = 0; e < 8; ++e) { const float vn = (f[e] - mean) * rstd * lnw[c + e] + lnb[c + e]; out_sv[c + e] = vn; y[e] = uf[e] * (w00 * vn + b0); }
    u32x4 o; o.x = pk2(y[0], y[1]); o.y = pk2(y[2], y[3]); o.z = pk2(y[4], y[5]); o.w = pk2(y[6], y[7]);
    *(u32x4*)(YS + row * 512 + c) = o;
}

__device__ __forceinline__ void merge_row(const bf16* OG, const float* DG, bf16* YA, int row, int lane) {
    const int h = lane >> 4;
    const float d0 = DG[(size_t)row * 12 + h], d1 = DG[(size_t)row * 12 + 4 + h], d2 = DG[(size_t)row * 12 + 8 + h];
    const float inv = 1.0f / (d0 + d1 + d2);
    const float a0 = d0 * inv, a1 = d1 * inv, a2 = d2 * inv;
    const bf16* p = OG + (size_t)row * QKV + 8 * lane;
    const u32x4 x0 = *(const u32x4*)p, x1 = *(const u32x4*)(p + 512), x2 = *(const u32x4*)(p + 1024);
    u32x4 o;
#define MRG(c) pk2(a0 * __uint_as_float(x0.c << 16) + a1 * __uint_as_float(x1.c << 16) + a2 * __uint_as_float(x2.c << 16), \
                   a0 * __uint_as_float(x0.c & 0xffff0000u) + a1 * __uint_as_float(x1.c & 0xffff0000u) + a2 * __uint_as_float(x2.c & 0xffff0000u))
    o.x = MRG(x); o.y = MRG(y); o.z = MRG(z); o.w = MRG(w);
#undef MRG
    *(u32x4*)(YA + (size_t)row * 512 + 8 * lane) = o;
}


typedef float f32x16 __attribute__((ext_vector_type(16)));
template <class EpiS>
__device__ __forceinline__ void skinny_gemm(LAS unsigned char* lds, const bf16* A, const bf16* Bt, int K, int j, const EpiS& e, int wid, int lane, int tid) {
    const int r = lane & 31, hi = lane >> 5, ks = K >> 3;
    const bf16* ap = A + (size_t)r * K + wid * ks + 8 * hi;
    const bf16* bp = Bt + (size_t)(32 * j + r) * K + wid * ks + 8 * hi;
    f32x16 acc;
#pragma unroll
    for (int i = 0; i < 16; ++i) acc[i] = 0.f;
#pragma unroll 4
    for (int k = 0; k < ks; k += 16) {
        const bf16x8 a = *(const bf16x8*)(ap + k), b = *(const bf16x8*)(bp + k);
        acc = __builtin_amdgcn_mfma_f32_32x32x16_bf16(a, b, acc, 0, 0, 0);
    }
    LAS float* red = (LAS float*)lds;
#pragma unroll
    for (int i = 0; i < 16; ++i) red[wid * 1056 + ((i & 3) + 8 * (i >> 2) + 4 * hi) * 33 + r] = acc[i];
    LDS_WAIT(); __syncthreads();
    for (int e2 = tid; e2 < 1024; e2 += NTHREADS) {
        const int row = e2 >> 5, col = e2 & 31;
        float sum = 0.f;
#pragma unroll
        for (int w = 0; w < 8; ++w) sum += red[w * 1056 + row * 33 + col];
        e(row, 32 * j + col, sum);
    }
    LDS_WAIT(); __syncthreads();
}
struct SkGate1 { const bf16* G; float* T1; __device__ __forceinline__ void operator()(int sr, int col, float v) const { const size_t row = (size_t)MP + sr; T1[row * DM + col] = bf2f(G[row * 2048 + col]) * v; } };
struct SkGate2 { const bf16* G; const float* T1; bf16* MG; __device__ __forceinline__ void operator()(int sr, int col, float v) const { const size_t row = (size_t)MP + sr; MG[row * DM + col] = (bf16)(pk2(T1[row * DM + col] + bf2f(G[row * 2048 + 1024 + col]) * v, 0.f) & 0xffffu); } };
struct SkRes { const float* bs; float* os; const float* gate; __device__ __forceinline__ void operator()(int sr, int col, float v) const { os[(size_t)sr * DM + col] = bs[(size_t)sr * DM + col] + gate[(size_t)(4 + sr) * NADA + col] * v; } };


#define RLX_AGENT __ATOMIC_RELAXED, __HIP_MEMORY_SCOPE_AGENT
#define XB_TMO      128
#define XB_XCNT(j)  (256  + 64 * (j))
#define XB_XSUB(j)  (1280 + 64 * (j))
#define XB_XGEN(j)  (2304 + 64 * (j))
#define XB_TOP      3328
#define XB_TOPGEN   3392
#define XCD_BAR_WORDS 3456
#define XB_SPIN_CAP (1u << 18)

__device__ __forceinline__ unsigned xb_ld(unsigned* p)              { return __hip_atomic_load(p, __ATOMIC_RELAXED, __HIP_MEMORY_SCOPE_AGENT); }
__device__ __forceinline__ unsigned xb_add(unsigned* p, unsigned v) { return __hip_atomic_fetch_add(p, v, __ATOMIC_RELAXED, __HIP_MEMORY_SCOPE_AGENT); }
__device__ __forceinline__ unsigned xb_xcc_id() { return (unsigned)__builtin_amdgcn_s_getreg((3 << 11) | 20) & 0xFu; }
#define XB_SPIN(cond, bar) do { unsigned _sp = 0; while (cond) { __builtin_amdgcn_s_sleep(1); \
    if ((++_sp & 255u) == 0u) { if (xb_ld(&(bar)[XB_TMO])) break; if (_sp > XB_SPIN_CAP) { atomicAdd(&(bar)[XB_TMO], 1u); break; } } } } while (0)

struct XcdBarrier {
    unsigned* bar; unsigned x;
    volatile LAS unsigned* st;
};

__device__ __forceinline__ XcdBarrier xcd_barrier_post(unsigned* bar, volatile LAS unsigned* st) {
    XcdBarrier b; b.bar = bar; b.x = xb_xcc_id(); b.st = st;
    if (threadIdx.x == 0) (void)xb_add(&bar[XB_XCNT(b.x)], 1u);
    return b;
}
__device__ __forceinline__ void xcd_barrier_complete(unsigned* bar, unsigned x, unsigned& nloc, unsigned& nx) {
    const unsigned G = gridDim.x * gridDim.y * gridDim.z;
    unsigned sum, cnt, mine, sp = 0u;
    for (;;) {
        sum = 0u; cnt = 0u; mine = 0u;
#pragma unroll
        for (unsigned j = 0; j < 16; ++j) { const unsigned c = xb_ld(&bar[XB_XCNT(j)]); sum += c; cnt += (c > 0u) ? 1u : 0u; mine = (j == x) ? c : mine; }
        if (sum == G) break;
        __builtin_amdgcn_s_sleep(1);
        if ((++sp & 255u) == 0u) { if (xb_ld(&bar[XB_TMO])) break; if (sp > XB_SPIN_CAP) { atomicAdd(&bar[XB_TMO], 1u); break; } }
    }
    nloc = mine > 0u ? mine : 1u; nx = cnt > 0u ? cnt : 1u;
}

__device__ __forceinline__ void xcd_barrier(const XcdBarrier& b) {
    asm volatile("s_waitcnt vmcnt(0)" ::: "memory");
    __syncthreads();
    if (threadIdx.x == 0) {
        unsigned* bar = b.bar;
        __builtin_amdgcn_s_waitcnt(0);
        unsigned nloc = b.st[0], nx = b.st[1];
        if (nloc == 0u) { xcd_barrier_complete(bar, b.x, nloc, nx); b.st[0] = nloc; b.st[1] = nx; }
        const unsigned old = xb_add(&bar[XB_XSUB(b.x)], 1u);
        const unsigned gen = old / nloc;
        if (old + 1u == (gen + 1u) * nloc) {
            __builtin_amdgcn_fence(__ATOMIC_RELEASE, "agent");
            asm volatile("s_waitcnt vmcnt(0)" ::: "memory");
            const unsigned og = xb_add(&bar[XB_TOP], 1u);
            const unsigned tg = og / nx;
            if (og + 1u == (tg + 1u) * nx) xb_add(&bar[XB_TOPGEN], 1u);
            else XB_SPIN(xb_ld(&bar[XB_TOPGEN]) == tg, bar);
            __builtin_amdgcn_fence(__ATOMIC_ACQUIRE, "agent");
            xb_add(&bar[XB_XGEN(b.x)], 1u);
            asm volatile("s_waitcnt vmcnt(0)" ::: "memory");
        } else {
            XB_SPIN(xb_ld(&bar[XB_XGEN(b.x)]) == gen, bar);
            __builtin_amdgcn_fence(__ATOMIC_ACQUIRE, "agent");
            asm volatile("s_waitcnt vmcnt(0)" ::: "memory");
        }
    }
    __syncthreads();
}

constexpr int LDS_MISC = LDS_EXCH + 8192;
constexpr size_t WS_CTL = 0, CTL_ZERO_BYTES = 65536;
#ifndef PROBE_REP_MASK
#define PROBE_REP_MASK 0
#endif
#define PHON(k) for (int rep_ = 0; rep_ <= (((PROBE_REP_MASK) >> (k)) & 1); ++rep_) if constexpr (((PHM) >> (k)) & 1)
#define GSYNC() do { if constexpr (COOP) { CAS const Args* ap_ = (CAS const Args*)__builtin_amdgcn_kernarg_segment_ptr(); asm volatile("" : "+s"(ap_)); \
    XcdBarrier xb_; xb_.bar = (unsigned*)((unsigned char*)ap_->ws + WS_CTL); xb_.x = xb_xcc_id(); xb_.st = (volatile LAS unsigned*)(lds + LDS_MISC); xcd_barrier(xb_); } } while (0)
#define GSYNC_CG() do { if constexpr (COOP) cg::this_grid().sync(); } while (0)
#define GAS __attribute__((address_space(1)))
#define CAS __attribute__((address_space(4)))
struct Args { GAS const float* in[23]; GAS float* out; GAS unsigned char* ws; };

constexpr int I_ADA = 16 * 192, I_IN = 16 * 240, I_PA = 8 * 32, I_OUT = 16 * 32, I_FI = 16 * 176, I_FO = 44 * 32;
constexpr int I_LAYER = I_ADA + I_IN + 2 * I_PA + I_OUT + I_FI + I_FO;
__device__ __forceinline__ void weight_copy_item(CAS const Args* ap, unsigned char* ws, int l, int r, LAS float* scr, int lane) {
    unsigned char* wl = ws + WS_WL0 + (size_t)l * WL_SIZE;
    if (r < I_IN) { transpose_item(((const float*)ap->in[10]) + (size_t)l * DM * DIN, DM, DIN, (bf16*)(wl + WL_WIN), 0, scr, r, lane); return; } r -= I_IN;
    if (r < I_PA) { transpose_item(((const float*)ap->in[17]) + (size_t)l * 512 * DM, 512, DM, (bf16*)(wl + WL_WPA), 0, scr, r, lane); return; } r -= I_PA;
    if (r < I_PA) { transpose_item(((const float*)ap->in[18]) + (size_t)l * 512 * DM, 512, DM, (bf16*)(wl + WL_WPS), 0, scr, r, lane); return; } r -= I_PA;
    if (r < I_OUT) { transpose_item(((const float*)ap->in[19]) + (size_t)l * DM * DM, DM, DM, (bf16*)(wl + WL_WOUT), 0, scr, r, lane); return; } r -= I_OUT;
    if (r < I_FI) { transpose_item(((const float*)ap->in[21]) + (size_t)l * DM * 2 * DFF, DM, 2 * DFF, (bf16*)(wl + WL_WFI), 1, scr, r, lane); return; } r -= I_FI;
    transpose_item(((const float*)ap->in[22]) + (size_t)l * DFF * DM, DFF, DM, (bf16*)(wl + WL_WFO), 0, scr, r, lane);
}
#define PHASE_ENV() \
    CAS const Args* ap = (CAS const Args*)__builtin_amdgcn_kernarg_segment_ptr(); asm volatile("" : "+s"(ap)); \
    int tid = threadIdx.x; asm volatile("" : "+v"(tid)); \
    const int lane = tid & 63, wid = __builtin_amdgcn_readfirstlane(tid >> 6); \
    int G_ = gridDim.x, bx_ = blockIdx.x; asm volatile("" : "+s"(G_), "+s"(bx_)); const int G = G_, bx = bx_; const int gw = bx * NWAVES + wid, NGW = G * NWAVES; \
    unsigned char* const ws = (unsigned char*)ap->ws; (void)lane; (void)wid; (void)gw; (void)NGW; (void)ws; (void)G; (void)bx
#define WL(l) (ws + WS_WL0 + (size_t)(l) * WL_SIZE)

template <int PHM, bool COOP>
__global__ void __launch_bounds__(NTHREADS, 2) fwd_megakernel(Args args_unused, int l_lo, int l_hi) {
    extern __shared__ __attribute__((aligned(16))) unsigned char lds_raw[];
    LAS unsigned char* lds = (LAS unsigned char*)lds_raw;
    if constexpr (COOP) {
        PHASE_ENV();
        if (tid < 32) ((LAS unsigned*)(lds + LDS_MISC))[tid] = 0u;
        __syncthreads();
        (void)xcd_barrier_post((unsigned*)(ws + WS_CTL), (volatile LAS unsigned*)(lds + LDS_MISC));
    }

    PHON(0) {
        PHASE_ENV();
        bf16* WADA = (bf16*)(ws + WS_WADA); bf16* SC = (bf16*)(ws + WS_SC);
        LAS float* scr = (LAS float*)(lds + wid * 16384);
        for (int it = gw; it < 2 * I_ADA + (I_LAYER - I_ADA); it += NGW) {
            if (it < 2 * I_ADA) { const int l = it / I_ADA; transpose_item(((const float*)ap->in[7]) + (size_t)l * DM * NADA, DM, NADA, WADA + (size_t)l * NADA * DM, 0, scr, it - l * I_ADA, lane); }
            else weight_copy_item(ap, ws, 0, it - 2 * I_ADA, scr, lane);
        }
        const int gt = bx * NTHREADS + tid, NGT = G * NTHREADS;
        const float* wsp = ((const float*)ap->in[15]);
        for (int i = gt; i < 2 * 8 * 128 * 128; i += NGT) {
            const int l = i >> 17, r = i & 131071, t = (r >> 7) & 127, s = r & 127;
            const float w = wsp[i];
            ((bf16*)(WL(l) + WL_WSP))[r] = (bf16)(s <= t ? (pk2(w, 0.f) & 0xffffu) : 0u);
        }
        const float* cpr = ((const float*)ap->in[5]); const float* csm = ((const float*)ap->in[6]);
        for (int i = gt; i < 256 * DM; i += NGT) {
            const int r = i >> 10, k = i & 1023;
            float v = 0.f;
            if (r < 4) v = cpr[r * DM + k]; else if (r < 36) v = csm[(r - 4) * DM + k];
            SC[i] = (bf16)(pk2(v * sigmoidf_(v), 0.f) & 0xffffu);
        }
    }
    GSYNC_CG();
    PHON(1) {
        PHASE_ENV();
        pg8::Gemm g{(const bf16*)(ws + WS_SC), (const bf16*)(ws + WS_WADA), 256, 2 * NADA, DM}; pg8::StaticOrder S; S.init(256, 2 * NADA, G, bx);
        EpiAda E{(float*)(ws + WS_MOD), ((const float*)ap->in[8])};
        pg8::gemm_phase<EpiAda, pg8::StaticOrder, true, true>(lds + LDS_RING, g, S, E);
    }
    GSYNC();

    for (int l = l_lo; l < l_hi; ++l) {
        PHON(2) {
            PHASE_ENV();
            const float* X2 = (const float*)(ws + WS_X2);
            const float* xin_p = l == 0 ? ((const float*)ap->in[0]) : X2;
            const float* xin_s = l == 0 ? ((const float*)ap->in[1]) : X2 + (size_t)MP * DM;
            norm_mod_phase(xin_p, xin_s, ((const float*)ap->in[9]) + l * DM, (const float*)(ws + WS_MOD) + (size_t)l * 36 * NADA, 0, (bf16*)(ws + WS_XN), gw, NGW, lane);
        }
        GSYNC();
        PHON(3) {
            PHASE_ENV();
            pg8::Gemm g{(const bf16*)(ws + WS_XN), (const bf16*)(WL(l) + WL_WIN), MT, DIN, DM}; pg8::StaticOrder S; S.init(MT, DIN, G, bx);
            EpiIn E{ws, ((const float*)ap->in[11]) + l * 384, ((const float*)ap->in[12]) + l * 384, ((float*)ap->out), l, (LAS float*)(lds + LDS_EXCH)};
            pg8::gemm_phase<EpiIn, pg8::StaticOrder, true, true>(lds + LDS_RING, g, S, E);
        }
        PHON(3) {
            if (l == 0) {
                PHASE_ENV();
                constexpr int NU = (MT / 256) * (DIN / 256);
                const int nfull = NU % G;
                if (nfull > 0 && bx >= nfull) {
                    LAS float* scr = (LAS float*)(lds + wid * 16384);
                    const int nw = (G - nfull) * NWAVES, w0 = (bx - nfull) * NWAVES + wid;
                    for (int it = w0; it < I_LAYER - I_ADA; it += nw) weight_copy_item(ap, ws, 1, it, scr, lane);
                } else if (nfull == 0) {
                    LAS float* scr = (LAS float*)(lds + wid * 16384);
                    for (int it = gw; it < I_LAYER - I_ADA; it += NGW) weight_copy_item(ap, ws, 1, it, scr, lane);
                }
            }
        }
        GSYNC();
        PHON(4) {
            PHASE_ENV();
            const bf16 *Qb = (const bf16*)(ws + WS_Q), *Kb = (const bf16*)(ws + WS_K), *Vb = (const bf16*)(ws + WS_V);
            float mq = 0.f, mk = 0.f;
            for (int i = lane; i < 384; i += 64) { mq = fmaxf(mq, fabsf(((const float*)ap->in[11])[l * 384 + i])); mk = fmaxf(mk, fabsf(((const float*)ap->in[12])[l * 384 + i])); }
            mq = wave_max(mq); mk = wave_max(mk);
            const float cshift = 11.3137085f * LOG2E * mq * mk;
            if (G == 256) { const int u0 = bx < 128 ? bx * 7 : 896 + (bx - 128) * 5, nu = bx < 128 ? 7 : 5;
                for (int u = u0; u < u0 + nu; ++u) attn_unit(lds, Qb, Kb, Vb, (bf16*)(ws + WS_OG), (float*)(ws + WS_DG), u, cshift, wid, lane, tid); }
            else for (int u = bx; u < 1536; u += G) attn_unit(lds, Qb, Kb, Vb, (bf16*)(ws + WS_OG), (float*)(ws + WS_DG), u, cshift, wid, lane, tid);
        }
        PHON(4) {
            PHASE_ENV();
            if (bx >= G / 2) {
                for (int it = bx - G / 2; it < NSMP * 4; it += G - G / 2)
                    attn_sample_item(lds, (const bf16*)(ws + WS_Q), (const bf16*)(ws + WS_K), (const bf16*)(ws + WS_V), ((const float*)ap->in[2]), ((const float*)ap->in[3]), ((const float*)ap->in[4]), l, (bf16*)(ws + WS_YY) + (size_t)MP * 512  , it, wid, lane, tid);
            }
        }
        GSYNC();
        PHON(5) {
            PHASE_ENV();
            const bf16 *Ub = (const bf16*)(ws + WS_U), *VSb = (const bf16*)(ws + WS_VS); bf16 *YS = (bf16*)(ws + WS_YY) + (size_t)MP * 512;
            const bf16* WSP = (const bf16*)(WL(l) + WL_WSP);
            const float* lnw = ((const float*)ap->in[13]) + l * 512; const float* lnb = ((const float*)ap->in[14]) + l * 512; const float* bsp = ((const float*)ap->in[16]) + l * 8 * 128;
            for (int u = bx; u < 256; u += G) sgu_unit(lds, Ub, VSb, lnw, lnb, WSP, bsp, YS, u, wid, lane);
            for (int b = gw; b < NSMP; b += NGW) sgu_sample_row(Ub, VSb, lnw, lnb, ((const float*)ap->in[15]) + (size_t)l * 8 * 128 * 128, bsp, YS + (size_t)32 * 512  , ((float*)ap->out) + O_SV + (size_t)(l * NSMP + b) * 512, b, lane);
            for (int row = gw; row < MP; row += NGW) merge_row((const bf16*)(ws + WS_OG), (const float*)(ws + WS_DG), (bf16*)(ws + WS_YY), row, lane);
        }
        GSYNC();
        PHON(6) {
            PHASE_ENV();
            if (bx < 32) { SkGate1 e{(const bf16*)(ws + WS_G), (float*)(ws + WS_T1)};
                skinny_gemm(lds, (const bf16*)(ws + WS_YY) + (size_t)(2 * MP) * 512, (const bf16*)(WL(l) + WL_WPA), 512, bx, e, wid, lane, tid); }
        }
        PHON(6) {
            PHASE_ENV();
            PairOrder S; S.S0.init(MP, DM, G, bx);
            pg8::Gemm g{(const bf16*)(ws + WS_YY), (const bf16*)(WL(l) + WL_WPA), 2 * MP, 2 * DM, 512}; EpiMerged E{(const bf16*)(ws + WS_G), (bf16*)(ws + WS_MG)};
            pg8::gemm_phase<EpiMerged, PairOrder, true, true>(lds + LDS_RING, g, S, E);
        }
        PHON(6) {
            PHASE_ENV();
            if (bx < 32) { SkGate2 e{(const bf16*)(ws + WS_G), (const float*)(ws + WS_T1), (bf16*)(ws + WS_MG)};
                skinny_gemm(lds, (const bf16*)(ws + WS_YY) + (size_t)(2 * MP + 32) * 512, (const bf16*)(WL(l) + WL_WPS), 512, bx, e, wid, lane, tid); }
        }
        GSYNC();
        PHON(7) {
            PHASE_ENV();
            const float* X2 = (const float*)(ws + WS_X2); float* X1 = (float*)(ws + WS_X1);
            const float* xin_p = l == 0 ? ((const float*)ap->in[0]) : X2;
            const float* xin_s = l == 0 ? ((const float*)ap->in[1]) : X2 + (size_t)MP * DM;
            pg8::Gemm g{(const bf16*)(ws + WS_MG), (const bf16*)(WL(l) + WL_WOUT), MP, DM, DM}; pg8::StaticOrder S; S.init(MP, DM, G, bx);
            EpiRes E{xin_p, xin_s, X1, X1 + (size_t)MP * DM, (const float*)(ws + WS_MOD) + (size_t)l * 36 * NADA + 2048};
            pg8::gemm_phase<EpiRes, pg8::StaticOrder, true, true>(lds + LDS_RING, g, S, E);
        }
        PHON(7) {
            PHASE_ENV();
            if (bx < 32) { const float* X2 = (const float*)(ws + WS_X2);
                SkRes e{l == 0 ? ((const float*)ap->in[1]) : X2 + (size_t)MP * DM, (float*)(ws + WS_X1) + (size_t)MP * DM, (const float*)(ws + WS_MOD) + (size_t)l * 36 * NADA + 2048};
                skinny_gemm(lds, (const bf16*)(ws + WS_MG) + (size_t)MP * DM, (const bf16*)(WL(l) + WL_WOUT), DM, bx, e, wid, lane, tid); }
        }
        GSYNC();
        PHON(8) {
            PHASE_ENV();
            const float* X1 = (const float*)(ws + WS_X1);
            norm_mod_phase(X1, X1 + (size_t)MP * DM, ((const float*)ap->in[20]) + l * DM, (const float*)(ws + WS_MOD) + (size_t)l * 36 * NADA, 3072, (bf16*)(ws + WS_XN), gw, NGW, lane);
        }
        GSYNC();
        PHON(9) {
            PHASE_ENV();
            pg8::Gemm g{(const bf16*)(ws + WS_XN), (const bf16*)(WL(l) + WL_WFI), MT, 2 * DFF, DM}; pg8::StaticOrder S; S.init(MT, 2 * DFF, G, bx);
            EpiSwiglu E{(bf16*)(ws + WS_H)};
            pg8::gemm_phase<EpiSwiglu, pg8::StaticOrder, true, true>(lds + LDS_RING, g, S, E);
        }
        GSYNC();
        PHON(10) {
            PHASE_ENV();
            const float* X1 = (const float*)(ws + WS_X1); float* X2 = (float*)(ws + WS_X2);
            float* xout_p = l == 0 ? X2 : ((float*)ap->out) + O_YP;
            float* xout_s = l == 0 ? X2 + (size_t)MP * DM : ((float*)ap->out) + O_YS;
            pg8::Gemm g{(const bf16*)(ws + WS_H), (const bf16*)(WL(l) + WL_WFO), MP, DM, DFF}; pg8::StaticOrder S; S.init(MP, DM, G, bx);
            EpiRes E{X1, X1 + (size_t)MP * DM, xout_p, xout_s, (const float*)(ws + WS_MOD) + (size_t)l * 36 * NADA + 5120};
            pg8::gemm_phase<EpiRes, pg8::StaticOrder, true, true>(lds + LDS_RING, g, S, E);
        }
        PHON(10) {
            PHASE_ENV();
            if (bx < 32) { float* X2 = (float*)(ws + WS_X2);
                SkRes e{(const float*)(ws + WS_X1) + (size_t)MP * DM, l == 0 ? X2 + (size_t)MP * DM : ((float*)ap->out) + O_YS, (const float*)(ws + WS_MOD) + (size_t)l * 36 * NADA + 5120};
                skinny_gemm(lds, (const bf16*)(ws + WS_H) + (size_t)MP * DFF, (const bf16*)(WL(l) + WL_WFO), DFF, bx, e, wid, lane, tid); }
        }
        if (l + 1 < l_hi) GSYNC();
    }
}


#ifdef EXP_MASK
__global__ void __launch_bounds__(256) dbg_checksum(const unsigned char* ws, float* out) {
    const int lane = threadIdx.x & 63, gw = (blockIdx.x * 256 + threadIdx.x) >> 6, ngw = gridDim.x * 4;
    struct B { size_t off; int cols; int isf; };
    const B bufs[16] = {{WS_XN, 1024, 0}, {WS_Q, 1536, 0}, {WS_K, 1536, 0}, {WS_V, 1536, 0}, {WS_U, 512, 0}, {WS_VS, 512, 0}, {WS_G, 2048, 0}, {WS_OG, 1536, 0},
                        {WS_DG, 12, 1}, {WS_YY, 512, 0}, {WS_YY + (size_t)MP * 1024, 512, 0}, {WS_T1, 1024, 1}, {WS_MG, 1024, 0}, {WS_X1, 1024, 1}, {WS_H, 2816, 0}, {WS_X2, 1024, 1}};
    for (int b = 0; b < 16; ++b) {
        if (!((EXP_MASK >> b) & 1)) continue;
        for (int row = gw; row < MV; row += ngw) {
            float s = 0.f;
            for (int c = lane; c < bufs[b].cols; c += 64) {
                const float v = bufs[b].isf ? ((const float*)(ws + bufs[b].off))[(size_t)row * bufs[b].cols + c] : bf2f(((const bf16*)(ws + bufs[b].off))[(size_t)row * bufs[b].cols + c]);
                s += v * (float)(1 + (c % 7));
            }
            s = wave_sum(s);
            if (lane == 0) out[(size_t)b * MT + row] = s;
        }
    }
    if ((EXP_MASK >> 16) & 1) for (int i = blockIdx.x * 256 + threadIdx.x; i < 72 * NADA; i += gridDim.x * 256) out[16 * MT + i] = ((const float*)(ws + WS_MOD))[i];
}
#endif
#ifndef N_LAUNCH_MODE
#define N_LAUNCH_MODE 1
#endif
template <int PHM> static void launch_phase(const Args& a, int l_lo, int l_hi, int grid, hipStream_t stream) {
    static bool attr = false;
    if (!attr) { (void)hipFuncSetAttribute((const void*)fwd_megakernel<PHM, false>, hipFuncAttributeMaxDynamicSharedMemorySize, LDS_BYTES); attr = true; }
    hipLaunchKernelGGL((fwd_megakernel<PHM, false>), dim3(grid), dim3(NTHREADS), LDS_BYTES, stream, a, l_lo, l_hi);
}
extern "C" void kernel_launch(void* const* d_in, const int* in_sizes, int n_in, void* d_out, int out_size, void* d_ws, size_t ws_size, hipStream_t stream) {
    static int grid = 0;
    if (grid == 0) {
        if (n_in != 23 || (size_t)out_size != O_END || ws_size < WS_END) { fprintf(stderr, "kernel_launch: unexpected shapes (n_in %d out %d ws %zu need %zu)\n", n_in, out_size, ws_size, (size_t)WS_END); grid = -1; return; }
        int dev = 0, cus = 0, per_cu = 0;
        (void)hipGetDevice(&dev);
        (void)hipDeviceGetAttribute(&cus, hipDeviceAttributeMultiprocessorCount, dev);
#if N_LAUNCH_MODE == 1
        if (hipFuncSetAttribute((const void*)fwd_megakernel<0x7FF, true>, hipFuncAttributeMaxDynamicSharedMemorySize, LDS_BYTES) != hipSuccess) { fprintf(stderr, "kernel_launch: hipFuncSetAttribute failed\n"); grid = -1; return; }
        (void)hipOccupancyMaxActiveBlocksPerMultiprocessor(&per_cu, (const void*)fwd_megakernel<0x7FF, true>, NTHREADS, LDS_BYTES);
        (void)hipGetLastError();
        if (per_cu < 1) fprintf(stderr, "kernel_launch: occupancy query says %d blocks per CU\n", per_cu);
#endif
        grid = cus;
    }
    if (grid < 0) return;
    Args a{};
    for (int i = 0; i < 23; ++i) a.in[i] = (GAS const float*)d_in[i];
    a.out = (GAS float*)d_out; a.ws = (GAS unsigned char*)d_ws;
#if N_LAUNCH_MODE == 1
    (void)hipMemsetAsync((unsigned char*)d_ws + WS_CTL, 0, CTL_ZERO_BYTES, stream);
    int l_lo = 0, l_hi = 2;
    void* kargs[] = {&a, &l_lo, &l_hi};
    hipError_t e = hipLaunchCooperativeKernel((const void*)fwd_megakernel<0x7FF, true>, dim3(grid), dim3(NTHREADS), kargs, LDS_BYTES, stream);
    if (e != hipSuccess) fprintf(stderr, "cooperative launch failed: %s (grid %d)\n", hipGetErrorString(e), grid);
#else
#ifdef EXP_MASK
    (void)hipMemsetAsync(d_out, 0, (size_t)out_size * 4, stream);
#endif
    launch_phase<0x001>(a, 0, 0, grid, stream);
    launch_phase<0x002>(a, 0, 0, grid, stream);
#ifdef EXP_MASK
    const int NL = 1;
#else
    const int NL = 2;
#endif
    for (int l = 0; l < NL; ++l) {
        launch_phase<0x004>(a, l, l + 1, grid, stream);
        launch_phase<0x008>(a, l, l + 1, grid, stream);
        launch_phase<0x010>(a, l, l + 1, grid, stream);
        launch_phase<0x020>(a, l, l + 1, grid, stream);
        launch_phase<0x040>(a, l, l + 1, grid, stream);
        launch_phase<0x080>(a, l, l + 1, grid, stream);
        launch_phase<0x100>(a, l, l + 1, grid, stream);
        launch_phase<0x200>(a, l, l + 1, grid, stream);
        launch_phase<0x400>(a, l, l + 1, grid, stream);
    }
#ifdef EXP_MASK
    hipLaunchKernelGGL(dbg_checksum, dim3(1024), dim3(256), 0, stream, (const unsigned char*)d_ws, (float*)d_out);
#endif
#endif
}
```

```cpp
#include <hip/hip_runtime.h>
#include <hip/hip_cooperative_groups.h>
#include <cstdio>
#include <cstdint>
namespace cg = cooperative_groups;
namespace pg8 {
#define PG8_LAS __attribute__((address_space(3)))
typedef unsigned short bf16_t;
typedef short bf16x8 __attribute__((ext_vector_type(8)));
typedef float f32x4 __attribute__((ext_vector_type(4)));
typedef unsigned u32x4 __attribute__((ext_vector_type(4)));
constexpr int BM = 256, BK = 64, HALF = 128, HTB = HALF * BK * 2  , STAGE_BYTES = 8 * HTB, NXCD = 8, WGM = 8;

__host__ __device__ __forceinline__ int lds_byte(int r, int c) { const int st = (r >> 4) * 2 + (c >> 5), rr = r & 15, cc = c & 31, ob = rr * 64 + cc * 2; return st * 1024 + (ob ^ (((ob >> 9) & 1) << 5)); }
__host__ __device__ __forceinline__ void stage_rc(int b, int& R, int& C) { const int st = b / 1024, sb = b % 1024, swz = sb ^ (((sb >> 9) & 1) << 5); R = (st >> 1) * 16 + swz / 64; C = (st & 1) * 32 + (swz % 64) / 2; }
__host__ __device__ __forceinline__ int perm32(int rho) { const int n = rho >> 4, i = rho & 15; return 8 * (i >> 2) + 4 * n + (i & 3); }

struct Unit { int pm, pn; };
struct Gemm { const bf16_t* A; const bf16_t* Bt; int M, N, K; };

struct StaticOrder {
    int nM, nN, nwg, G, c;
    __host__ __device__ void init(int M, int N, int G_, int c_) { nM = M / BM; nN = N / BM; nwg = nM * nN; G = G_; c = c_; }
    __host__ __device__ bool next(int i, Unit& u) const {
        const long L = (long)i * G + c; if (L >= nwg) return false;
        int wgid = (int)L; { const int q = nwg / NXCD, r = nwg % NXCD, xcd = wgid % NXCD, off = wgid / NXCD; wgid = (xcd < r ? xcd * (q + 1) : r * (q + 1) + (xcd - r) * q) + off; }
        const int nig = WGM * nN, gid = wgid / nig, fm = gid * WGM, gsz = (nM - fm) < WGM ? (nM - fm) : WGM;
        u.pm = fm + ((wgid % nig) % gsz); u.pn = (wgid % nig) / gsz; return true;
    }
    __device__ __forceinline__ void a_ready(const Unit&) const {}
    __device__ __forceinline__ void done(const Unit&) const {}
};

typedef __bf16 bf16x2_hw __attribute__((ext_vector_type(2)));
typedef float f32x2_hw __attribute__((ext_vector_type(2)));
__device__ __forceinline__ unsigned cvt_pk_bf16(float lo, float hi) { const f32x2_hw v = {lo, hi}; return __builtin_bit_cast(unsigned, __builtin_convertvector(v, bf16x2_hw)); }
typedef float f32x2 __attribute__((ext_vector_type(2)));
__device__ __forceinline__ f32x2 gelu_pk(f32x2 v) {
    const f32x2 av = __builtin_elementwise_abs(v), d = av * 0.2316418882f + 1.0f;
    f32x2 t; t.x = __builtin_amdgcn_rcpf(d.x); t.y = __builtin_amdgcn_rcpf(d.y);
    f32x2 q = t * 0.5307027145f + (-0.7265760135f); q = q * t + 0.7107068705f; q = q * t + (-0.142248368f); q = q * t + 0.127414796f; q = q * t;
    const f32x2 s = (v * v) * (-0.72134752044f);
    f32x2 e; e.x = __builtin_amdgcn_exp2f(s.x); e.y = __builtin_amdgcn_exp2f(s.y);
    const f32x2 m = v * (q * e), r = v - m;
    f32x2 o; o.x = v.x < 0.f ? m.x : r.x; o.y = v.y < 0.f ? m.y : r.y; return o;
}

template <int ACT  > struct EpiBf16 {
    static constexpr bool PERM = true, AFTER_DRAIN = false; static_assert(ACT == 0 || ACT == 1, "EpiBf16: ACT is 0 (none) or 1 (gelu_pk)");
    bf16_t* O; int ldc; const float* bias; int split_cols; size_t split_stride; float scale0;
    __device__ __forceinline__ void operator()(const f32x4 (&acc)[2][2][4][2], const Unit& u, int wr, int wc, int fr, int fq) const {
        const int row0 = u.pm * BM + wr * 64 + fr; int colt = u.pn * BM; bf16_t* base = O;
        float sc = 1.f; if (split_cols) { const int t = colt / split_cols; base += (size_t)t * split_stride; colt -= t * split_cols; if (t == 0) sc = scale0; }
        const int col0 = colt + wc * 32 + 8 * fq, bcol0 = u.pn * BM + wc * 32 + 8 * fq;
        f32x4 bv[2][2];
#pragma unroll
        for (int bj = 0; bj < 2; ++bj)
#pragma unroll
            for (int n = 0; n < 2; ++n) bv[bj][n] = bias ? *(const f32x4*)(bias + bcol0 + bj * HALF + 4 * n) : (f32x4){0.f, 0.f, 0.f, 0.f};
#pragma unroll
        for (int ai = 0; ai < 2; ++ai)
#pragma unroll
            for (int m = 0; m < 4; ++m) { bf16_t* rowp = base + (size_t)(row0 + ai * HALF + m * 16) * ldc + col0;
#pragma unroll
                for (int bj = 0; bj < 2; ++bj) { f32x4 v0 = acc[ai][bj][m][0] + bv[bj][0], v1 = acc[ai][bj][m][1] + bv[bj][1];
                    if (ACT == 1) { f32x2 a = gelu_pk((f32x2){v0[0], v0[1]}), b = gelu_pk((f32x2){v0[2], v0[3]}), c = gelu_pk((f32x2){v1[0], v1[1]}), d = gelu_pk((f32x2){v1[2], v1[3]});
                        v0 = (f32x4){a.x, a.y, b.x, b.y}; v1 = (f32x4){c.x, c.y, d.x, d.y}; }
                    v0 = v0 * sc; v1 = v1 * sc; u32x4 w; w.x = cvt_pk_bf16(v0[0], v0[1]); w.y = cvt_pk_bf16(v0[2], v0[3]); w.z = cvt_pk_bf16(v1[0], v1[1]); w.w = cvt_pk_bf16(v1[2], v1[3]);
                    *(u32x4*)(rowp + bj * HALF) = w; } }
    }
};

struct PanelStats {
    unsigned* xbuf;
    unsigned* cnt;
    unsigned* tmo;
    int ntn; float eps;
    unsigned code;
    __device__ __forceinline__ bool run(const f32x4 (&v)[2][2][4][2], const Unit& u, int wr, int wc, int fr, int fq, PG8_LAS unsigned char* lds, int wid, int lane) const {
        typedef float f32x2v __attribute__((ext_vector_type(2)));
        PG8_LAS f32x2v* P = (PG8_LAS f32x2v*)lds;
        PG8_LAS f32x2v* S = (PG8_LAS f32x2v*)(lds + 8192);
        PG8_LAS unsigned* flag = (PG8_LAS unsigned*)(lds + 8192 + 2048);
#pragma unroll
        for (int ai = 0; ai < 2; ++ai)
#pragma unroll
            for (int m = 0; m < 4; ++m) {
                float s = 0.f;
#pragma unroll
                for (int bj = 0; bj < 2; ++bj)
#pragma unroll
                    for (int n = 0; n < 2; ++n) { const f32x4 x = v[ai][bj][m][n]; s += (x[0] + x[1]) + (x[2] + x[3]); }
                s += __shfl_xor(s, 16); s += __shfl_xor(s, 32);
                const float mw = s * (1.0f / 64.0f); float q = 0.f;
#pragma unroll
                for (int bj = 0; bj < 2; ++bj)
#pragma unroll
                    for (int n = 0; n < 2; ++n) { const f32x4 d = v[ai][bj][m][n] - mw; q += (d[0] * d[0] + d[1] * d[1]) + (d[2] * d[2] + d[3] * d[3]); }
                q += __shfl_xor(q, 16); q += __shfl_xor(q, 32);
                if (fq == 0) P[(ai * HALF + wr * 64 + m * 16 + fr) * 4 + wc] = (f32x2v){mw, q};
            }
        asm volatile("s_waitcnt lgkmcnt(0)" ::: "memory"); __builtin_amdgcn_s_barrier(); asm volatile("" ::: "memory");
#if defined(BROKEN_EXCHANGE_NO_WAIT)
#warning BROKEN CONTROL BUILD: the row-statistics exchange does not wait; results are wrong by design
        if (blockIdx.x >= 64) { const long long t0_ = clock64(); while (clock64() - t0_ < 60000) __builtin_amdgcn_s_sleep(8); }
#endif
        const int row = wid * 32 + (lane & 31);
        if (lane < 32) {
            const f32x2v a = P[row * 4 + 0], b = P[row * 4 + 1], c = P[row * 4 + 2], d = P[row * 4 + 3];
            const float mt = (a.x + b.x + c.x + d.x) * 0.25f;
            const float da = a.x - mt, db = b.x - mt, dc = c.x - mt, dd = d.x - mt;
            const float m2 = (a.y + b.y) + (c.y + d.y) + 64.0f * ((da * da + db * db) + (dc * dc + dd * dd));
            unsigned long long* slot = (unsigned long long*)xbuf + ((size_t)(u.pm * BM + row) * 4 + u.pn);
            __hip_atomic_store(slot, ((unsigned long long)__float_as_uint(m2) << 32) | __float_as_uint(mt), __ATOMIC_RELAXED, __HIP_MEMORY_SCOPE_AGENT);
        }
        asm volatile("s_waitcnt vmcnt(0)" ::: "memory");
        if (lane == 0) __hip_atomic_fetch_add(cnt + 64 * u.pm, 1u, __ATOMIC_RELAXED, __HIP_MEMORY_SCOPE_AGENT);
        if (wid == 0) {
            bool dead = false; const unsigned long long t0 = __builtin_amdgcn_s_memrealtime(); const unsigned want = 8u * (unsigned)ntn;
            for (;;) {
#if defined(BROKEN_EXCHANGE_NO_WAIT)
                break;
#endif
                if ((unsigned)__builtin_amdgcn_readfirstlane(__hip_atomic_load(cnt + 64 * u.pm, __ATOMIC_RELAXED, __HIP_MEMORY_SCOPE_AGENT)) >= want) break;
                if (__builtin_amdgcn_s_memrealtime() - t0 > 2000000ull) {
                    if (lane == 0) { unsigned expect = 0u; __hip_atomic_compare_exchange_strong(tmo + 1, &expect, code | (unsigned)(u.pm & 0xff), __ATOMIC_RELAXED, __ATOMIC_RELAXED, __HIP_MEMORY_SCOPE_AGENT);
                                     __hip_atomic_store(tmo, 1u, __ATOMIC_RELAXED, __HIP_MEMORY_SCOPE_AGENT); }
                    dead = true; break; }
                __builtin_amdgcn_s_sleep(2);
            }
            __builtin_amdgcn_fence(__ATOMIC_ACQUIRE, "agent");
            if (lane == 0) flag[0] = dead ? 1u : 0u;
        }
        asm volatile("s_waitcnt vmcnt(0) lgkmcnt(0)" ::: "memory"); __builtin_amdgcn_s_barrier(); asm volatile("" ::: "memory");
        const bool bad = flag[0] != 0u;
        if (lane < 32) {
            const unsigned long long* slot = (const unsigned long long*)xbuf + (size_t)(u.pm * BM + row) * 4; float mt[4], m2[4]; float ms = 0.f;
#pragma unroll
            for (int t = 0; t < 4; ++t) { if (t < ntn) { const unsigned long long w = __hip_atomic_load(slot + t, __ATOMIC_RELAXED, __HIP_MEMORY_SCOPE_AGENT); mt[t] = __uint_as_float((unsigned)w); m2[t] = __uint_as_float((unsigned)(w >> 32)); } else { mt[t] = 0.f; m2[t] = 0.f; } ms += mt[t]; }
            const float mean = ms / (float)ntn; float q = 0.f;
#pragma unroll
            for (int t = 0; t < 4; ++t) if (t < ntn) { const float dm = mt[t] - mean; q += m2[t] + 256.0f * dm * dm; }
            S[row] = (f32x2v){mean, 1.0f / sqrtf(q / (256.0f * (float)ntn) + eps)};
        }
        asm volatile("s_waitcnt lgkmcnt(0)" ::: "memory"); __builtin_amdgcn_s_barrier(); asm volatile("" ::: "memory");
        return bad;
    }
};
struct EpiLnRes {
    static constexpr bool PERM = false, AFTER_DRAIN = true;
    const float* base; float* out; int ldc; const float* bias; PanelStats st; unsigned poison;
    __device__ __forceinline__ void fused(f32x4 (&acc)[2][2][4][2], const Unit& u, int wr, int wc, int fr, int fq, PG8_LAS unsigned char* lds, int wid, int lane) const {
        typedef float f32x2v __attribute__((ext_vector_type(2)));
        const PG8_LAS f32x2v* S = (const PG8_LAS f32x2v*)(lds + 8192);
        const int col0 = u.pn * BM + wc * 32 + 4 * fq;
#pragma unroll
        for (int bj = 0; bj < 2; ++bj)
#pragma unroll
            for (int n = 0; n < 2; ++n) { const f32x4 bv = bias ? *(const f32x4*)(bias + col0 + bj * HALF + n * 16) : (f32x4){0.f, 0.f, 0.f, 0.f};
#pragma unroll
                for (int ai = 0; ai < 2; ++ai)
#pragma unroll
                    for (int m = 0; m < 4; ++m) acc[ai][bj][m][n] += bv; }
        f32x4 pre[4][2][2];
#pragma unroll
        for (int m = 0; m < 4; ++m) { const size_t off = (size_t)(u.pm * BM + wr * 64 + m * 16 + fr) * ldc + col0;
#pragma unroll
            for (int bj = 0; bj < 2; ++bj)
#pragma unroll
                for (int n = 0; n < 2; ++n) pre[m][bj][n] = *(const f32x4*)(base + off + bj * HALF + n * 16); }
        const bool bad = st.run(acc, u, wr, wc, fr, fq, lds, wid, lane) || poison != 0u;
        const float qnan = __builtin_nanf("");
#pragma unroll
        for (int ai = 0; ai < 2; ++ai)
#pragma unroll
            for (int m = 0; m < 4; ++m) { const int r = ai * HALF + wr * 64 + m * 16 + fr; const f32x2v sr = S[r]; const size_t off = (size_t)(u.pm * BM + r) * ldc + col0;
#pragma unroll
                for (int bj = 0; bj < 2; ++bj)
#pragma unroll
                    for (int n = 0; n < 2; ++n) { const f32x4 bs = ai == 0 ? pre[m][bj][n] : *(const f32x4*)(base + off + bj * HALF + n * 16); f32x4 o = bs + (acc[ai][bj][m][n] - sr.x) * sr.y;
                        if (bad) o = (f32x4){qnan, qnan, qnan, qnan}; *(f32x4*)(out + off + bj * HALF + n * 16) = o; }
                if (m & 1) asm volatile("" ::: "memory"); }
    }
};
struct EpiLnResLn {
    static constexpr bool PERM = false, AFTER_DRAIN = true;
    const float* base; float* out; bf16_t* xn; int ldc; const float* bias; PanelStats st1, st2; unsigned poison;
    __device__ __forceinline__ void fused(f32x4 (&acc)[2][2][4][2], const Unit& u, int wr, int wc, int fr, int fq, PG8_LAS unsigned char* lds, int wid, int lane) const {
        typedef float f32x2v __attribute__((ext_vector_type(2))); typedef unsigned u32x2v __attribute__((ext_vector_type(2)));
        const PG8_LAS f32x2v* S = (const PG8_LAS f32x2v*)(lds + 8192);
        const int col0 = u.pn * BM + wc * 32 + 4 * fq;
#pragma unroll
        for (int bj = 0; bj < 2; ++bj)
#pragma unroll
            for (int n = 0; n < 2; ++n) { const f32x4 bv = bias ? *(const f32x4*)(bias + col0 + bj * HALF + n * 16) : (f32x4){0.f, 0.f, 0.f, 0.f};
#pragma unroll
                for (int ai = 0; ai < 2; ++ai)
#pragma unroll
                    for (int m = 0; m < 4; ++m) acc[ai][bj][m][n] += bv; }
        bool bad = st1.run(acc, u, wr, wc, fr, fq, lds, wid, lane) || poison != 0u;
        const float qnan = __builtin_nanf("");
#pragma unroll
        for (int ai = 0; ai < 2; ++ai)
#pragma unroll
            for (int m = 0; m < 4; ++m) { const int r = ai * HALF + wr * 64 + m * 16 + fr; const f32x2v sr = S[r]; const size_t off = (size_t)(u.pm * BM + r) * ldc + col0;
#pragma unroll
                for (int bj = 0; bj < 2; ++bj)
#pragma unroll
                    for (int n = 0; n < 2; ++n) { const f32x4 bs = *(const f32x4*)(base + off + bj * HALF + n * 16); acc[ai][bj][m][n] = bs + (acc[ai][bj][m][n] - sr.x) * sr.y; }
                asm volatile("" : "+v"(acc[ai][0][m][0]), "+v"(acc[ai][0][m][1]), "+v"(acc[ai][1][m][0]), "+v"(acc[ai][1][m][1]));
                if (m & 1) asm volatile("" ::: "memory"); }
        const bool bad1 = bad;
        bad = st2.run(acc, u, wr, wc, fr, fq, lds, wid, lane) || bad;
#pragma unroll
        for (int ai = 0; ai < 2; ++ai)
#pragma unroll
            for (int m = 0; m < 4; ++m) { const int r = ai * HALF + wr * 64 + m * 16 + fr; const f32x2v sr = S[r]; const size_t off = (size_t)(u.pm * BM + r) * ldc + col0;
#pragma unroll
                for (int bj = 0; bj < 2; ++bj)
#pragma unroll
                    for (int n = 0; n < 2; ++n) { const f32x4 x1 = acc[ai][bj][m][n]; *(f32x4*)(out + off + bj * HALF + n * 16) = bad1 ? (f32x4){qnan, qnan, qnan, qnan} : x1;
                        const f32x4 o = (x1 - sr.x) * sr.y; u32x2v w; w.x = cvt_pk_bf16(o[0], o[1]); w.y = cvt_pk_bf16(o[2], o[3]);
                        if (bad) { w.x = 0x7fc07fc0u; w.y = 0x7fc07fc0u; } *(u32x2v*)(xn + off + bj * HALF + n * 16) = w; }
                asm volatile("" ::: "memory"); }
    }
};

template <class Epi, class Sched, bool ALIGN_EPI = false, bool SP2 = false>
__device__ __forceinline__ void gemm_phase(PG8_LAS unsigned char* lds, const Gemm g, const Sched& S, const Epi& E) {
    int tid_ = threadIdx.x; asm volatile("" : "+v"(tid_));
    const int tid = tid_, wid = __builtin_amdgcn_readfirstlane(tid >> 6), lane = tid & 63, wr = wid >> 2, wc = wid & 3, fr = lane & 15, fq = lane >> 4;
    const int K = g.K, nt = K / BK;
    unsigned voffA[2], voffB[2];
#pragma unroll
    for (int i = 0; i < 2; ++i) { int R, C; stage_rc(tid * 16 + i * 8192, R, C); const int Rb = Epi::PERM ? ((R & ~31) + perm32(R & 31)) : R;
        voffA[i] = (unsigned)(R * K + C) * 2u; voffB[i] = (unsigned)(Rb * K + C) * 2u; }
    const size_t kstep = (size_t)(BK * 2);
    const size_t hstep = (size_t)HALF * K * 2;
    const size_t tstep = 2 * hstep;
    const unsigned ldsw = (unsigned)wid * 1024u;
    const int aoff = lds_byte(wr * 64 + fr, fq * 8), boff = lds_byte(wc * 32 + fr, fq * 8);
#define PG8_SA(b, h) (((b) * 2 + (h)) * HTB)
#define PG8_SB(b, h) ((4 + (b) * 2 + (h)) * HTB)
#define PG8_STAGE(bufoff, gbase, voff) do { _Pragma("unroll") for (int _i = 0; _i < 2; ++_i) \
        __builtin_amdgcn_global_load_lds((const unsigned*)((const char*)(gbase) + (voff)[_i]), (PG8_LAS unsigned*)(lds + (bufoff) + ldsw + _i * 8192), 16, 0, 0); } while (0)
#define PG8_LDA(dst, b, h) do { _Pragma("unroll") for (int m = 0; m < 4; ++m) _Pragma("unroll") for (int k = 0; k < 2; ++k) dst[m][k] = *(const PG8_LAS bf16x8*)(lds + PG8_SA(b, h) + aoff + m * 2048 + k * 1024); } while (0)
#define PG8_LDB(dst, b, h) do { _Pragma("unroll") for (int n = 0; n < 2; ++n) _Pragma("unroll") for (int k = 0; k < 2; ++k) dst[n][k] = *(const PG8_LAS bf16x8*)(lds + PG8_SB(b, h) + boff + n * 2048 + k * 1024); } while (0)
#define PG8_MMA(ai, bj, At, Bt) do { __builtin_amdgcn_s_setprio(1); _Pragma("unroll") for (int m = 0; m < 4; ++m) _Pragma("unroll") for (int n = 0; n < 2; ++n) _Pragma("unroll") for (int k = 0; k < 2; ++k) \
        acc[ai][bj][m][n] = __builtin_amdgcn_mfma_f32_16x16x32_bf16(Bt[n][k], At[m][k], acc[ai][bj][m][n], 0, 0, 0); __builtin_amdgcn_s_setprio(0); } while (0)
#define PG8_WAIT_V(n) asm volatile("s_waitcnt vmcnt(" #n ")" ::: "memory")
#define PG8_WAIT_L(n) asm volatile("s_waitcnt lgkmcnt(" #n ")" ::: "memory")
#define PG8_BAR __builtin_amdgcn_s_barrier()
#define PG8_SCHED __builtin_amdgcn_sched_barrier(0)
    Unit cur, nxt; int ui = 0;
    if (!S.next(0, cur)) return;
    f32x4 acc[2][2][4][2];
#pragma unroll
    for (int a = 0; a < 2; ++a)
#pragma unroll
        for (int b = 0; b < 2; ++b)
#pragma unroll
            for (int m = 0; m < 4; ++m)
#pragma unroll
                for (int n = 0; n < 2; ++n) acc[a][b][m][n] = (f32x4){0.f, 0.f, 0.f, 0.f};
    bf16x8 At[4][2], B0[2][2], B1[2][2];
    const char* cA = (const char*)g.A + (size_t)cur.pm * tstep; const char* cB = (const char*)g.Bt + (size_t)cur.pn * tstep;
    S.a_ready(cur);
    if constexpr (SP2) {
        PG8_STAGE(PG8_SB(0, 0), cB, voffB); PG8_STAGE(PG8_SB(0, 1), cB + hstep, voffB); PG8_STAGE(PG8_SA(0, 0), cA, voffA); PG8_STAGE(PG8_SA(0, 1), cA + hstep, voffA);
        if (wr == 1) PG8_BAR;
        PG8_WAIT_V(2); PG8_BAR;
        PG8_STAGE(PG8_SB(1, 0), cB + kstep, voffB); PG8_STAGE(PG8_SA(1, 0), cA + kstep, voffA); PG8_STAGE(PG8_SB(1, 1), cB + hstep + kstep, voffB);
        PG8_WAIT_V(6); PG8_BAR;
    } else {
        PG8_STAGE(PG8_SB(0, 0), cB, voffB); PG8_STAGE(PG8_SA(0, 0), cA, voffA); PG8_STAGE(PG8_SB(0, 1), cB + hstep, voffB); PG8_STAGE(PG8_SA(0, 1), cA + hstep, voffA);
        if (wr == 1) PG8_BAR;
        PG8_WAIT_V(4); PG8_BAR;
        PG8_STAGE(PG8_SB(1, 0), cB + kstep, voffB); PG8_STAGE(PG8_SA(1, 0), cA + kstep, voffA); PG8_STAGE(PG8_SB(1, 1), cB + hstep + kstep, voffB);
        PG8_WAIT_V(6); PG8_BAR;
    }
    for (;;) {
        const bool has_next = S.next(ui + 1, nxt);
        const char* nA = has_next ? (const char*)g.A + (size_t)nxt.pm * tstep : cA; const char* nB = has_next ? (const char*)g.Bt + (size_t)nxt.pn * tstep : cB;
        for (int t = 0; t < nt; t += 2) {
            const bool last = (t == nt - 2);
            const char* a1 = cA + (size_t)(t + 1) * kstep;
            const char* a2 = last ? nA : cA + (size_t)(t + 2) * kstep; const char* b2 = last ? nB : cB + (size_t)(t + 2) * kstep;
            const char* a3 = a2 + kstep; const char* b3 = b2 + kstep;
            if (last && has_next) S.a_ready(nxt);
            if constexpr (SP2) {
            PG8_LDB(B0, 0, 0); PG8_LDB(B1, 0, 1); PG8_SCHED; PG8_LDA(At, 0, 0); PG8_STAGE(PG8_SA(1, 1), a1 + hstep, voffA);
            PG8_WAIT_V(8); PG8_WAIT_L(0); PG8_BAR; PG8_MMA(0, 0, At, B0); PG8_MMA(0, 1, At, B1); PG8_BAR; PG8_SCHED;
            PG8_LDA(At, 0, 1); PG8_STAGE(PG8_SB(0, 0), b2, voffB); PG8_STAGE(PG8_SB(0, 1), b2 + hstep, voffB); PG8_STAGE(PG8_SA(0, 0), a2, voffA);
            PG8_WAIT_V(8); PG8_WAIT_L(0); PG8_BAR; PG8_MMA(1, 0, At, B0); PG8_MMA(1, 1, At, B1); PG8_BAR; PG8_SCHED;
            PG8_LDB(B0, 1, 0); PG8_LDB(B1, 1, 1); PG8_SCHED; PG8_LDA(At, 1, 0); PG8_STAGE(PG8_SA(0, 1), a2 + hstep, voffA);
            PG8_WAIT_V(8); PG8_WAIT_L(0); PG8_BAR; PG8_MMA(0, 0, At, B0); PG8_MMA(0, 1, At, B1); PG8_BAR; PG8_SCHED;
            PG8_LDA(At, 1, 1); PG8_STAGE(PG8_SB(1, 0), b3, voffB); PG8_STAGE(PG8_SB(1, 1), b3 + hstep, voffB); PG8_STAGE(PG8_SA(1, 0), a3, voffA);
            PG8_WAIT_V(8); PG8_WAIT_L(0); PG8_BAR; PG8_MMA(1, 0, At, B0); PG8_MMA(1, 1, At, B1); PG8_BAR; PG8_SCHED;
            } else {
            PG8_LDB(B0, 0, 0); PG8_SCHED; PG8_LDA(At, 0, 0); PG8_STAGE(PG8_SA(1, 1), a1 + hstep, voffA);
            PG8_WAIT_L(8); PG8_BAR; PG8_WAIT_L(0); PG8_MMA(0, 0, At, B0); PG8_BAR; PG8_SCHED;
            PG8_LDB(B1, 0, 1); PG8_STAGE(PG8_SB(0, 0), b2, voffB);
            PG8_BAR; PG8_WAIT_L(0); PG8_MMA(0, 1, At, B1); PG8_BAR;
            PG8_LDA(At, 0, 1); PG8_STAGE(PG8_SA(0, 0), a2, voffA);
            PG8_BAR; PG8_WAIT_L(0); PG8_MMA(1, 0, At, B0); PG8_BAR; PG8_SCHED;
            PG8_STAGE(PG8_SB(0, 1), b2 + hstep, voffB);
            PG8_WAIT_V(6); PG8_BAR; PG8_MMA(1, 1, At, B1); PG8_BAR;
            PG8_LDB(B0, 1, 0); PG8_SCHED; PG8_LDA(At, 1, 0); PG8_STAGE(PG8_SA(0, 1), a2 + hstep, voffA);
            PG8_WAIT_L(8); PG8_BAR; PG8_WAIT_L(0); PG8_MMA(0, 0, At, B0); PG8_BAR; PG8_SCHED;
            PG8_LDB(B1, 1, 1); PG8_STAGE(PG8_SB(1, 0), b3, voffB);
            PG8_BAR; PG8_WAIT_L(0); PG8_MMA(0, 1, At, B1); PG8_BAR;
            PG8_LDA(At, 1, 1); PG8_STAGE(PG8_SA(1, 0), a3, voffA);
            PG8_BAR; PG8_WAIT_L(0); PG8_MMA(1, 0, At, B0); PG8_BAR; PG8_SCHED;
            PG8_STAGE(PG8_SB(1, 1), b3 + hstep, voffB);
            PG8_WAIT_V(6); PG8_BAR; PG8_MMA(1, 1, At, B1); PG8_BAR;
            }
        }
        if constexpr (ALIGN_EPI) { if (wr == 0) PG8_BAR; }
        if constexpr (Epi::CHAIN) { if (has_next) E.mid(acc, cur, wr, wc, fr, fq); else E(acc, cur, wr, wc, fr, fq); }
        else if constexpr (!Epi::AFTER_DRAIN) { E(acc, cur, wr, wc, fr, fq); S.done(cur); }
        if (!has_next) break;
        if constexpr (!Epi::CHAIN) {
#pragma unroll
        for (int a = 0; a < 2; ++a)
#pragma unroll
            for (int b = 0; b < 2; ++b)
#pragma unroll
                for (int m = 0; m < 4; ++m)
#pragma unroll
                    for (int n = 0; n < 2; ++n) acc[a][b][m][n] = (f32x4){0.f, 0.f, 0.f, 0.f};
        }
        cur = nxt; cA = nA; cB = nB; ++ui;
        if constexpr (ALIGN_EPI) { if (wr == 1) PG8_BAR; }
    }
    PG8_WAIT_V(0);
    if constexpr (!ALIGN_EPI) { if (wr == 0) PG8_BAR; }
    PG8_BAR;
    if constexpr (Epi::AFTER_DRAIN) { E.fused(acc, cur, wr, wc, fr, fq, lds, wid, lane); S.done(cur); }
#undef PG8_SA
#undef PG8_SB
#undef PG8_STAGE
#undef PG8_LDA
#undef PG8_LDB
#undef PG8_MMA
#undef PG8_WAIT_V
#undef PG8_WAIT_L
#undef PG8_BAR
#undef PG8_SCHED
}
}

#define LAS __attribute__((address_space(3)))
typedef unsigned short bf16;
typedef float f32x4 __attribute__((ext_vector_type(4)));
typedef float f32x2 __attribute__((ext_vector_type(2)));
typedef short bf16x8 __attribute__((ext_vector_type(8)));
typedef short s16x4 __attribute__((ext_vector_type(4)));
typedef short v4i16_t __attribute__((ext_vector_type(4)));
typedef unsigned u32x4 __attribute__((ext_vector_type(4)));
typedef unsigned u32x2 __attribute__((ext_vector_type(2)));

constexpr int NWAVES = 8, NTHREADS = 512;
constexpr int DM = 1024, SEQ = 4096, NBATCH = 4, MP = NBATCH * SEQ, NSMP = 32, MV = MP + NSMP, MT = 16640;
constexpr int DIN = 7680, QKV = 1536, DFF = 2816, NADA = 6144;
constexpr size_t O_YP = 0, O_YS = 16777216, O_KV0P = 16809984, O_KV1P = 17858560, O_KV2P = 22052864,
                 O_KV0S = 38830080, O_KV1S = 38895616, O_KV2S = 38961152, O_SV = 39026688, O_END = 39059456;
constexpr float LOG2E = 1.4426950408889634f;
constexpr float QSCALE = 0.08838834764831845f * LOG2E;

constexpr size_t MiB = 1u << 20;
constexpr size_t alm(size_t x) { return (x + MiB - 1) / MiB * MiB; }
constexpr size_t WS_WADA = 1 * MiB;
constexpr size_t WS_WL0 = WS_WADA + alm(2ull * NADA * DM * 2);
constexpr size_t WL_WIN = 0;
constexpr size_t WL_WPA = WL_WIN + alm((size_t)DIN * DM * 2);
constexpr size_t WL_WPS = WL_WPA + alm(1024ull * 512 * 2);
constexpr size_t WL_WOUT = WL_WPS + alm(1024ull * 512 * 2);
constexpr size_t WL_WFI = WL_WOUT + alm(1024ull * 1024 * 2);
constexpr size_t WL_WFO = WL_WFI + alm(5632ull * 1024 * 2);
constexpr size_t WL_WSP = WL_WFO + alm(1024ull * DFF * 2);
constexpr size_t WL_SIZE = WL_WSP + alm(8ull * 128 * 128 * 2);
constexpr size_t WS_MOD = WS_WL0 + 2 * WL_SIZE;
constexpr size_t WS_SC = WS_MOD + alm(2ull * 36 * NADA * 4);
constexpr size_t WS_XN = WS_SC + alm(256ull * DM * 2);
constexpr size_t WS_Q = WS_XN + alm((size_t)MT * DM * 2);
constexpr size_t WS_K = WS_Q + alm((size_t)MT * QKV * 2);
constexpr size_t WS_V = WS_K + alm((size_t)MT * QKV * 2);
constexpr size_t WS_U = WS_V + alm((size_t)MT * QKV * 2);
constexpr size_t WS_VS = WS_U + alm((size_t)MT * 512 * 2);
constexpr size_t WS_G = WS_VS + alm((size_t)MT * 512 * 2);
constexpr size_t WS_OG = WS_G + alm((size_t)MT * 2048 * 2);
constexpr size_t WS_DG = WS_OG + alm((size_t)MT * QKV * 2);
constexpr size_t WS_YY = WS_DG + alm((size_t)MT * 12 * 4);
constexpr size_t WS_T1 = WS_YY + alm((size_t)(2 * MP + 64) * 512 * 2);
constexpr size_t WS_MG = WS_T1 + alm((size_t)MT * DM * 4);
constexpr size_t WS_X1 = WS_MG + alm((size_t)MT * DM * 2);
constexpr size_t WS_X2 = WS_X1 + alm((size_t)MT * DM * 4);
constexpr size_t WS_H = WS_X2 + alm((size_t)MT * DM * 4);
constexpr size_t WS_END = WS_H + alm((size_t)MT * DFF * 2);

constexpr int LDS_RING = 0, LDS_EXCH = 131072, LDS_BYTES = 155648;

__device__ __forceinline__ float bf2f(unsigned short h) { return __uint_as_float((unsigned)h << 16); }
__device__ __forceinline__ unsigned pk2(float lo, float hi) { return pg8::cvt_pk_bf16(lo, hi); }
__device__ __forceinline__ float fast_exp2(float x) { return __builtin_amdgcn_exp2f(x); }
__device__ __forceinline__ float sigmoidf_(float x) { return __builtin_amdgcn_rcpf(1.0f + fast_exp2(-x * LOG2E)); }
__device__ __forceinline__ float wave_sum(float v) {
#pragma unroll
    for (int o = 1; o < 64; o <<= 1) v += __shfl_xor(v, o);
    return v;
}
__device__ __forceinline__ float wave_max(float v) {
#pragma unroll
    for (int o = 1; o < 64; o <<= 1) v = fmaxf(v, __shfl_xor(v, o));
    return v;
}
__device__ __forceinline__ s16x4 vtr(const LAS unsigned char* p) { return __builtin_bit_cast(s16x4, __builtin_amdgcn_ds_read_tr16_b64_v4i16((LAS v4i16_t*)p)); }
#define LDS_WAIT() asm volatile("s_waitcnt lgkmcnt(0)" ::: "memory")

__device__ __forceinline__ int mod_row(int row) { return row < MP ? (row >> 12) : 4 + (row - MP); }

__device__ __forceinline__ __attribute__((address_space(1))) float* kv_out_ptr(__attribute__((address_space(1))) float* out, int layer, int g, int row, int kvi, int hh) {
    if (row < MP) {
        const int b = row >> 12, t = row & 4095, lw = 128 << (2 * g), tt = t - (SEQ - lw);
        if (tt < 0) return nullptr;
        const size_t base = g == 0 ? O_KV0P : (g == 1 ? O_KV1P : O_KV2P);
        return out + base + ((((size_t)(layer * NBATCH + b) * lw + tt) * 2 + kvi) * 4 + hh) * 128;
    } else if (row < MV) {
        const int b = row - MP;
        const size_t base = g == 0 ? O_KV0S : (g == 1 ? O_KV1S : O_KV2S);
        return out + base + (((size_t)(layer * NSMP + b) * 2 + kvi) * 4 + hh) * 128;
    }
    return nullptr;
}

using pg8::Unit;
typedef pg8::f32x4 (AccT)[2][2][4][2];

__device__ __forceinline__ void st8_bf16g(__attribute__((address_space(1))) bf16* p, f32x4 v0, f32x4 v1) {
    u32x4 w; w.x = pk2(v0[0], v0[1]); w.y = pk2(v0[2], v0[3]); w.z = pk2(v1[0], v1[1]); w.w = pk2(v1[2], v1[3]);
    *(__attribute__((address_space(1))) u32x4*)p = w;
}
__device__ __forceinline__ void st8_bf16(bf16* p, f32x4 v0, f32x4 v1) {
    u32x4 w; w.x = pk2(v0[0], v0[1]); w.y = pk2(v0[2], v0[3]); w.z = pk2(v1[0], v1[1]); w.w = pk2(v1[2], v1[3]);
    *(u32x4*)p = w;
}

#define LAUNDER_S(x) asm volatile("" : "+s"(x))
#define GP(T, p) ((T*)(__attribute__((address_space(1))) T*)(p))
struct EpiAda {
    static constexpr bool PERM = true, AFTER_DRAIN = false, CHAIN = false;
    float* MOD; const float* b_ada;
    __device__ __forceinline__ void operator()(const pg8::f32x4 (&acc)[2][2][4][2], const Unit& u, int wr, int wc, int fr_, int fq_) const {
        int fr = fr_, fq = fq_; asm volatile("" : "+v"(fr), "+v"(fq));
        if (u.pm != 0 || wr != 0) return;
#pragma unroll
        for (int m = 0; m < 3; ++m) {
            const int row = m * 16 + fr;
            if (row >= 36) continue;
#pragma unroll
            for (int bj = 0; bj < 2; ++bj) {
                const int col = u.pn * 256 + bj * 128 + wc * 32 + 8 * fq;
                const int layer = col / NADA, c = col - layer * NADA;
                const float* bp = b_ada + (size_t)layer * NADA + c;
                float* op = MOD + ((size_t)layer * 36 + row) * NADA + c;
                *(f32x4*)op = acc[0][bj][m][0] + *(const f32x4*)bp;
                *(f32x4*)(op + 4) = acc[0][bj][m][1] + *(const f32x4*)(bp + 4);
            }
        }
    }
};

struct EpiIn {
    static constexpr bool PERM = true, AFTER_DRAIN = false, CHAIN = false;
    unsigned char* wsb; const float* qw; const float* kw; float* out; int layer; LAS float* P;
    __device__ __forceinline__ void operator()(const pg8::f32x4 (&acc)[2][2][4][2], const Unit& u, int wr, int wc, int fr_, int fq_) const {
        int fr = fr_, fq = fq_; asm volatile("" : "+v"(fr), "+v"(fq));
        unsigned char* wsl = wsb; const float* qwl = qw; const float* kwl = kw; float* outl = out; LAUNDER_S(wsl); LAUNDER_S(qwl); LAUNDER_S(kwl); LAUNDER_S(outl);
        typedef __attribute__((address_space(1))) bf16 gbf; typedef __attribute__((address_space(1))) float gfl;
        gbf *Q = (gbf*)(wsl + WS_Q), *K = (gbf*)(wsl + WS_K), *V = (gbf*)(wsl + WS_V), *U = (gbf*)(wsl + WS_U), *VS = (gbf*)(wsl + WS_VS), *G = (gbf*)(wsl + WS_G);
        gfl* outg = (gfl*)outl;
        const int pn = u.pn;
        const int cw = wc * 32 + 8 * fq;
        const int rowb = u.pm * 256 + wr * 64 + fr;
        if (pn < 12) {
            const bool isk = pn >= 6;
#pragma unroll
            for (int ai = 0; ai < 2; ++ai)
#pragma unroll
                for (int m = 0; m < 4; ++m)
#pragma unroll
                    for (int bj = 0; bj < 2; ++bj) {
                        const pg8::f32x4 a = acc[ai][bj][m][0], b = acc[ai][bj][m][1];
                        float s = (a[0] * a[0] + a[1] * a[1]) + (a[2] * a[2] + a[3] * a[3]) + (b[0] * b[0] + b[1] * b[1]) + (b[2] * b[2] + b[3] * b[3]);
                        s += __shfl_xor(s, 16); s += __shfl_xor(s, 32);
                        if (fq == 0) P[(ai * 128 + wr * 64 + m * 16 + fr) * 8 + bj * 4 + wc] = s;
                    }
            asm volatile("s_waitcnt lgkmcnt(0)" ::: "memory"); __builtin_amdgcn_s_barrier(); asm volatile("" ::: "memory");
#pragma unroll
            for (int bj = 0; bj < 2; ++bj) {
                const int head = 2 * (isk ? pn - 6 : pn) + bj, g = head >> 2, hh = head & 3;
                const __attribute__((address_space(1))) float* wv = (const __attribute__((address_space(1))) float*)(isk ? kwl : qwl) + g * 128 + cw;
                pg8::f32x4 w0 = *(const __attribute__((address_space(1))) f32x4*)wv, w1 = *(const __attribute__((address_space(1))) f32x4*)(wv + 4);
                if (!isk) { w0 = w0 * QSCALE; w1 = w1 * QSCALE; }
                gbf* dst = (isk ? K : Q) + head * 128 + cw;
#pragma unroll
                for (int ai = 0; ai < 2; ++ai)
#pragma unroll
                    for (int m = 0; m < 4; ++m) {
                        const int rl = ai * 128 + wr * 64 + m * 16 + fr, row = u.pm * 256 + rl;
                        const f32x4 pv = *(const LAS f32x4*)(P + rl * 8 + bj * 4);
                        const float rstd = 1.0f / sqrtf(((pv[0] + pv[1]) + (pv[2] + pv[3])) * (1.0f / 128.0f) + 1e-6f);
                        const pg8::f32x4 v0 = acc[ai][bj][m][0] * rstd * w0, v1 = acc[ai][bj][m][1] * rstd * w1;
                        st8_bf16g(dst + (size_t)row * QKV, v0, v1);
                        if (isk) { gfl* o = kv_out_ptr(outg, layer, g, row, 0, hh); if (o) { *(__attribute__((address_space(1))) f32x4*)(o + cw) = v0; *(__attribute__((address_space(1))) f32x4*)(o + cw + 4) = v1; } }
                    }
            }
        } else if (pn < 18) {
#pragma unroll
            for (int bj = 0; bj < 2; ++bj) {
                const int head = 2 * (pn - 12) + bj, g = head >> 2, hh = head & 3;
                gbf* dst = V + head * 128 + cw;
#pragma unroll
                for (int ai = 0; ai < 2; ++ai)
#pragma unroll
                    for (int m = 0; m < 4; ++m) {
                        const int row = rowb + ai * 128 + m * 16;
                        const pg8::f32x4 v0 = acc[ai][bj][m][0], v1 = acc[ai][bj][m][1];
                        st8_bf16g(dst + (size_t)row * QKV, v0, v1);
                        gfl* o = kv_out_ptr(outg, layer, g, row, 1, hh); if (o) { *(__attribute__((address_space(1))) f32x4*)(o + cw) = v0; *(__attribute__((address_space(1))) f32x4*)(o + cw + 4) = v1; }
                    }
            }
        } else if (pn < 22) {
            gbf* base = (pn < 20 ? U : VS) + ((pn - 18) & 1) * 256 + cw;
#pragma unroll
            for (int bj = 0; bj < 2; ++bj)
#pragma unroll
                for (int ai = 0; ai < 2; ++ai)
#pragma unroll
                    for (int m = 0; m < 4; ++m) {
                        const int row = rowb + ai * 128 + m * 16;
                        const pg8::f32x4 v0 = acc[ai][bj][m][0], v1 = acc[ai][bj][m][1];
                        const pg8::f32x2 a = pg8::gelu_pk((pg8::f32x2){v0[0], v0[1]}), b = pg8::gelu_pk((pg8::f32x2){v0[2], v0[3]}),
                                         c = pg8::gelu_pk((pg8::f32x2){v1[0], v1[1]}), d = pg8::gelu_pk((pg8::f32x2){v1[2], v1[3]});
                        st8_bf16g(base + (size_t)row * 512 + bj * 128, (f32x4){a.x, a.y, b.x, b.y}, (f32x4){c.x, c.y, d.x, d.y});
                    }
        } else {
            gbf* base = G + (pn - 22) * 256 + cw;
#pragma unroll
            for (int bj = 0; bj < 2; ++bj)
#pragma unroll
                for (int ai = 0; ai < 2; ++ai)
#pragma unroll
                    for (int m = 0; m < 4; ++m) {
                        const int row = rowb + ai * 128 + m * 16;
                        const pg8::f32x4 v0 = acc[ai][bj][m][0], v1 = acc[ai][bj][m][1];
                        st8_bf16g(base + (size_t)row * 2048 + bj * 128,
                                 (f32x4){sigmoidf_(v0[0]), sigmoidf_(v0[1]), sigmoidf_(v0[2]), sigmoidf_(v0[3])},
                                 (f32x4){sigmoidf_(v1[0]), sigmoidf_(v1[1]), sigmoidf_(v1[2]), sigmoidf_(v1[3])});
                    }
        }
    }
};

struct EpiGate1 {
    static constexpr bool PERM = true, AFTER_DRAIN = false, CHAIN = false;
    const bf16* G; float* T1;
    __device__ __forceinline__ void operator()(const pg8::f32x4 (&acc)[2][2][4][2], const Unit& u, int wr, int wc, int fr_, int fq_) const {
        int fr = fr_, fq = fq_; asm volatile("" : "+v"(fr), "+v"(fq));
        const int col0 = u.pn * 256 + wc * 32 + 8 * fq, rowb = u.pm * 256 + wr * 64 + fr;
#pragma unroll
        for (int ai = 0; ai < 2; ++ai)
#pragma unroll
            for (int m = 0; m < 4; ++m) {
                const int row = rowb + ai * 128 + m * 16;
#pragma unroll
                for (int bj = 0; bj < 2; ++bj) {
                    const int col = col0 + bj * 128;
                    const u32x4 gv = *(const u32x4*)(G + (size_t)row * 2048 + col);
                    const f32x4 g0 = {__uint_as_float(gv.x << 16), __uint_as_float(gv.x & 0xffff0000u), __uint_as_float(gv.y << 16), __uint_as_float(gv.y & 0xffff0000u)};
                    const f32x4 g1 = {__uint_as_float(gv.z << 16), __uint_as_float(gv.z & 0xffff0000u), __uint_as_float(gv.w << 16), __uint_as_float(gv.w & 0xffff0000u)};
                    float* o = T1 + (size_t)row * DM + col;
                    *(f32x4*)o = g0 * acc[ai][bj][m][0]; *(f32x4*)(o + 4) = g1 * acc[ai][bj][m][1];
                }
            }
    }
};
struct EpiGate2 {
    static constexpr bool PERM = true, AFTER_DRAIN = false, CHAIN = false;
    const bf16* G; const float* T1; bf16* MG;
    __device__ __forceinline__ void operator()(const pg8::f32x4 (&acc)[2][2][4][2], const Unit& u, int wr, int wc, int fr_, int fq_) const {
        int fr = fr_, fq = fq_; asm volatile("" : "+v"(fr), "+v"(fq));
        const int col0 = u.pn * 256 + wc * 32 + 8 * fq, rowb = u.pm * 256 + wr * 64 + fr;
#pragma unroll
        for (int ai = 0; ai < 2; ++ai)
#pragma unroll
            for (int m = 0; m < 4; ++m) {
                const int row = rowb + ai * 128 + m * 16;
#pragma unroll
                for (int bj = 0; bj < 2; ++bj) {
                    const int col = col0 + bj * 128;
                    const u32x4 gv = *(const u32x4*)(G + (size_t)row * 2048 + 1024 + col);
                    const f32x4 g0 = {__uint_as_float(gv.x << 16), __uint_as_float(gv.x & 0xffff0000u), __uint_as_float(gv.y << 16), __uint_as_float(gv.y & 0xffff0000u)};
                    const f32x4 g1 = {__uint_as_float(gv.z << 16), __uint_as_float(gv.z & 0xffff0000u), __uint_as_float(gv.w << 16), __uint_as_float(gv.w & 0xffff0000u)};
                    const float* t = T1 + (size_t)row * DM + col;
                    const f32x4 t0 = *(const f32x4*)t, t1 = *(const f32x4*)(t + 4);
                    st8_bf16(MG + (size_t)row * DM + col, t0 + g0 * acc[ai][bj][m][0], t1 + g1 * acc[ai][bj][m][1]);
                }
            }
    }
};

struct PairOrder {
    pg8::StaticOrder S0;
    __device__ bool next(int i, Unit& u) const { if (i >= 2) return false; Unit b; if (!S0.next(0, b)) return false; u.pm = b.pm + (i ? MP / 256 : 0); u.pn = b.pn + (i ? 4 : 0); return true; }
    __device__ __forceinline__ void a_ready(const Unit&) const {}
    __device__ __forceinline__ void done(const Unit&) const {}
};
__device__ __forceinline__ void unpack8(const u32x4 gv, f32x4& g0, f32x4& g1) {
    g0 = (f32x4){__uint_as_float(gv.x << 16), __uint_as_float(gv.x & 0xffff0000u), __uint_as_float(gv.y << 16), __uint_as_float(gv.y & 0xffff0000u)};
    g1 = (f32x4){__uint_as_float(gv.z << 16), __uint_as_float(gv.z & 0xffff0000u), __uint_as_float(gv.w << 16), __uint_as_float(gv.w & 0xffff0000u)};
}
struct EpiMerged {
    static constexpr bool PERM = true, AFTER_DRAIN = false, CHAIN = true;
    const bf16* G; bf16* MG;
    __device__ __forceinline__ void mid(pg8::f32x4 (&acc)[2][2][4][2], const Unit& u, int wr, int wc, int fr_, int fq_) const {
        int fr = fr_, fq = fq_; asm volatile("" : "+v"(fr), "+v"(fq));
        const int col0 = u.pn * 256 + wc * 32 + 8 * fq, rowb = u.pm * 256 + wr * 64 + fr;
#pragma unroll
        for (int ai = 0; ai < 2; ++ai)
#pragma unroll
            for (int m = 0; m < 4; ++m) {
                const int row = rowb + ai * 128 + m * 16;
#pragma unroll
                for (int bj = 0; bj < 2; ++bj) {
                    const int col = col0 + bj * 128;
                    f32x4 a0, a1, b0, b1;
                    unpack8(*(const u32x4*)(G + (size_t)row * 2048 + col), a0, a1);
                    unpack8(*(const u32x4*)(G + (size_t)row * 2048 + 1024 + col), b0, b1);
#pragma unroll
                    for (int e = 0; e < 4; ++e) {
                        acc[ai][bj][m][0][e] *= a0[e] * __builtin_amdgcn_rcpf(fmaxf(b0[e], 1e-30f));
                        acc[ai][bj][m][1][e] *= a1[e] * __builtin_amdgcn_rcpf(fmaxf(b1[e], 1e-30f));
                    }
                }
            }
    }
    __device__ __forceinline__ void operator()(const pg8::f32x4 (&acc)[2][2][4][2], const Unit& u, int wr, int wc, int fr_, int fq_) const {
        int fr = fr_, fq = fq_; asm volatile("" : "+v"(fr), "+v"(fq));
        const int col0 = (u.pn - 4) * 256 + wc * 32 + 8 * fq, rowb = (u.pm - MP / 256) * 256 + wr * 64 + fr;
#pragma unroll
        for (int ai = 0; ai < 2; ++ai)
#pragma unroll
            for (int m = 0; m < 4; ++m) {
                const int row = rowb + ai * 128 + m * 16;
#pragma unroll
                for (int bj = 0; bj < 2; ++bj) {
                    const int col = col0 + bj * 128;
                    f32x4 b0, b1;
                    unpack8(*(const u32x4*)(G + (size_t)row * 2048 + 1024 + col), b0, b1);
                    st8_bf16(MG + (size_t)row * DM + col, b0 * acc[ai][bj][m][0], b1 * acc[ai][bj][m][1]);
                }
            }
    }
};
struct EpiRes {
    static constexpr bool PERM = true, AFTER_DRAIN = false, CHAIN = false;
    const float* bp; const float* bs; float* op; float* os; const float* gate;
    __device__ __forceinline__ void operator()(const pg8::f32x4 (&acc)[2][2][4][2], const Unit& u, int wr, int wc, int fr_, int fq_) const {
        int fr = fr_, fq = fq_; asm volatile("" : "+v"(fr), "+v"(fq));
        const int col0 = u.pn * 256 + wc * 32 + 8 * fq, rowb = u.pm * 256 + wr * 64 + fr;
#pragma unroll
        for (int ai = 0; ai < 2; ++ai)
#pragma unroll
            for (int m = 0; m < 4; ++m) {
                const int row = rowb + ai * 128 + m * 16;
                if (row < MV) {
                    const float* b = row < MP ? bp + (size_t)row * DM : bs + (size_t)(row - MP) * DM;
                    float* o = row < MP ? op + (size_t)row * DM : os + (size_t)(row - MP) * DM;
                    const float* gt = gate + (size_t)mod_row(row) * NADA;
#pragma unroll
                    for (int bj = 0; bj < 2; ++bj) {
                        const int col = col0 + bj * 128;
                        const f32x4 b0 = *(const f32x4*)(b + col), b1 = *(const f32x4*)(b + col + 4);
                        const f32x4 g0 = *(const f32x4*)(gt + col), g1 = *(const f32x4*)(gt + col + 4);
                        *(f32x4*)(o + col) = b0 + g0 * acc[ai][bj][m][0]; *(f32x4*)(o + col + 4) = b1 + g1 * acc[ai][bj][m][1];
                    }
                }
            }
    }
};
struct EpiSwiglu {
    static constexpr bool PERM = true, AFTER_DRAIN = false, CHAIN = false;
    bf16* H;
    __device__ __forceinline__ void operator()(const pg8::f32x4 (&acc)[2][2][4][2], const Unit& u, int wr, int wc, int fr_, int fq_) const {
        int fr = fr_, fq = fq_; asm volatile("" : "+v"(fr), "+v"(fq));
        const int col = u.pn * 128 + wc * 32 + 8 * fq, rowb = u.pm * 256 + wr * 64 + fr;
#pragma unroll
        for (int ai = 0; ai < 2; ++ai)
#pragma unroll
            for (int m = 0; m < 4; ++m) {
                const int row = rowb + ai * 128 + m * 16;
                f32x4 r0, r1;
#pragma unroll
                for (int e = 0; e < 4; ++e) {
                    const float a0 = acc[ai][0][m][0][e], a1 = acc[ai][0][m][1][e];
                    r0[e] = a0 * sigmoidf_(a0) * acc[ai][1][m][0][e];
                    r1[e] = a1 * sigmoidf_(a1) * acc[ai][1][m][1][e];
                }
                st8_bf16(H + (size_t)row * DFF + col, r0, r1);
            }
    }
};

__device__ __forceinline__ void transpose_item(const float* W, int K, int N, bf16* WT, int mode, LAS float* scr, int item, int lane) {
    const int nblk = N / 32, kb = item / nblk, nb = item % nblk, k0 = 64 * kb, n0 = 32 * nb;
    float wv[32];
#pragma unroll
    for (int i = 0; i < 32; ++i) wv[i] = W[(size_t)(k0 + 2 * i + (lane >> 5)) * N + n0 + (lane & 31)];
#pragma unroll
    for (int i = 0; i < 32; ++i) scr[(2 * i + (lane >> 5)) * 33 + (lane & 31)] = wv[i];
    LDS_WAIT(); asm volatile("" ::: "memory");
    int drow0 = n0;
    if (mode == 1) { const int bj = n0 >= DFF ? 1 : 0; const int j0 = n0 - bj * DFF; drow0 = (j0 >> 7) * 256 + bj * 128 + (j0 & 127); }
    const int c = lane & 7;
#pragma unroll
    for (int j = 0; j < 4; ++j) { const int n = (lane >> 3) + 8 * j; const LAS float* s = scr + (8 * c) * 33 + n;
        u32x4 o; o.x = pk2(s[0 * 33], s[1 * 33]); o.y = pk2(s[2 * 33], s[3 * 33]); o.z = pk2(s[4 * 33], s[5 * 33]); o.w = pk2(s[6 * 33], s[7 * 33]);
        *(u32x4*)(WT + (size_t)(drow0 + n) * K + k0 + 8 * c) = o; }
    LDS_WAIT(); asm volatile("" ::: "memory");
}

__device__ __forceinline__ void norm_mod_phase(const float* xp, const float* xs, const float* nw, const float* modl, int sh_off, bf16* XN, int gw, int NGW, int lane) {
    for (int row = gw; row < MT; row += NGW) {
        unsigned long long* o8 = (unsigned long long*)(XN + (size_t)row * DM) + lane;
        if (row >= MV) {
#pragma unroll
            for (int j = 0; j < 4; ++j) o8[64 * j] = 0ull;
            continue;
        }
        const float* xrow = row < MP ? xp + (size_t)row * DM : xs + (size_t)(row - MP) * DM;
        const f32x4* xr = (const f32x4*)xrow + lane;
        f32x4 v[4]; float s = 0.f;
#pragma unroll
        for (int j = 0; j < 4; ++j) { v[j] = xr[64 * j]; s += (v[j].x * v[j].x + v[j].y * v[j].y) + (v[j].z * v[j].z + v[j].w * v[j].w); }
        const float rstd = 1.0f / sqrtf(wave_sum(s) * (1.0f / DM) + 1e-6f);
        const float* mr = modl + (size_t)mod_row(row) * NADA + sh_off;
#pragma unroll
        for (int j = 0; j < 4; ++j) {
            const int col = 4 * lane + 256 * j;
            const f32x4 w = *(const f32x4*)(nw + col), shv = *(const f32x4*)(mr + col), scv = *(const f32x4*)(mr + 1024 + col);
            const f32x4 y = v[j] * rstd * w * (scv + 1.0f) + shv;
            o8[64 * j] = (unsigned long long)pk2(y.x, y.y) | ((unsigned long long)pk2(y.z, y.w) << 32);
        }
    }
}

constexpr int KV_STRIDE = 272;
constexpr int ATT_K_OFF = 0, ATT_V_OFF = 256 * KV_STRIDE;
__device__ __forceinline__ float alibi_slope(int head12) { return exp2f(-8.0f * (float)(head12 + 1) / 12.0f); }

__device__ __forceinline__ void attn_unit(LAS unsigned char* lds, const bf16* Q, const bf16* K, const bf16* V, bf16* OG, float* DG, int unit, float cshift, int wid, int lane, int tid) {
    const int g = unit >> 9, r9 = unit & 511, sh = 2 * g, d = 1 << sh, nb = 32 >> sh;
    const int qb = r9 % nb; int t2 = r9 / nb; const int r = t2 % d; t2 /= d; const int h = t2 & 3, b = t2 >> 2;
    const int hc = (g * 4 + h) * 128;
    {
        const int ch = tid & 15, r0 = tid >> 4;
        u32x4 kv[8], vv[8];
#pragma unroll
        for (int it = 0; it < 8; ++it) {
            const int j = r0 + 32 * it, mk = 128 * qb - 128 + j;
            if (qb > 0 || it >= 4) {
                const size_t off = ((size_t)b * SEQ + (size_t)mk * d + r) * QKV + hc + ch * 8;
                kv[it] = *(const u32x4*)(K + off); vv[it] = *(const u32x4*)(V + off);
            } else { kv[it] = (u32x4){0u, 0u, 0u, 0u}; vv[it] = (u32x4){0u, 0u, 0u, 0u}; }
        }
#pragma unroll
        for (int it = 0; it < 8; ++it) {
            const int j = r0 + 32 * it;
            *(LAS u32x4*)(lds + ATT_K_OFF + j * KV_STRIDE + ch * 16) = kv[it];
            *(LAS u32x4*)(lds + ATT_V_OFF + j * KV_STRIDE + ch * 16) = vv[it];
        }
    }
    const int ql = lane & 15, gq = lane >> 4;
    const int qi = 16 * wid + ql;
    const size_t qrow = (size_t)b * SEQ + (size_t)(128 * qb + qi) * d + r;
    bf16x8 qf[4];
#pragma unroll
    for (int kk = 0; kk < 4; ++kk) qf[kk] = *(const bf16x8*)(Q + qrow * QKV + hc + 32 * kk + 8 * gq);
    const float slope2 = alibi_slope(g * 4 + h) * LOG2E * (float)d;
    __syncthreads();
    f32x4 accO[8];
#pragma unroll
    for (int dt = 0; dt < 8; ++dt) accO[dt] = (f32x4){0.f, 0.f, 0.f, 0.f};
    float dsum = 0.f;
    const LAS unsigned char* kbase = lds + ATT_K_OFF + (16 * wid + ql) * KV_STRIDE + gq * 16;
    const LAS unsigned char* vbase = lds + ATT_V_OFF + (16 * wid + 4 * gq + (ql >> 2)) * KV_STRIDE + (ql & 3) * 8;
#pragma unroll
    for (int kt2 = 0; kt2 < 5; ++kt2) {
        const int ja = 16 * wid + 32 * kt2;
        f32x4 sa = {0.f, 0.f, 0.f, 0.f}, sb = {0.f, 0.f, 0.f, 0.f};
#pragma unroll
        for (int kk = 0; kk < 4; ++kk) {
            const bf16x8 ka = *(const LAS bf16x8*)(kbase + (32 * kt2) * KV_STRIDE + kk * 64);
            sa = __builtin_amdgcn_mfma_f32_16x16x32_bf16(ka, qf[kk], sa, 0, 0, 0);
        }
        if (kt2 < 4) {
#pragma unroll
            for (int kk = 0; kk < 4; ++kk) {
                const bf16x8 kb = *(const LAS bf16x8*)(kbase + (32 * kt2 + 16) * KV_STRIDE + kk * 64);
                sb = __builtin_amdgcn_mfma_f32_16x16x32_bf16(kb, qf[kk], sb, 0, 0, 0);
            }
        }
        float pa[4], pb[4];
#pragma unroll
        for (int jj = 0; jj < 4; ++jj) {
            const int j = ja + 4 * gq + jj, dist = 128 + qi - j;
            const bool ok = dist >= 0 && dist <= 128 && (128 * qb - 128 + j) >= 0;
            pa[jj] = ok ? fast_exp2(sa[jj] - slope2 * (float)dist - cshift) : 0.f;
            const int j2 = j + 16, dist2 = dist - 16;
            const bool ok2 = (kt2 < 4) && dist2 >= 0 && dist2 <= 128 && (128 * qb - 128 + j2) >= 0;
            pb[jj] = ok2 ? fast_exp2(sb[jj] - slope2 * (float)dist2 - cshift) : 0.f;
            dsum += pa[jj] + pb[jj];
        }
        u32x4 pw; pw.x = pk2(pa[0], pa[1]); pw.y = pk2(pa[2], pa[3]); pw.z = pk2(pb[0], pb[1]); pw.w = pk2(pb[2], pb[3]);
        const bf16x8 pfrag = __builtin_bit_cast(bf16x8, pw);
        const int rb = (kt2 < 4) ? (32 * kt2 + 16) : (32 * kt2);
#pragma unroll
        for (int dt = 0; dt < 8; ++dt) {
            const s16x4 lo = vtr(vbase + (32 * kt2) * KV_STRIDE + dt * 32);
            const s16x4 hi = vtr(vbase + rb * KV_STRIDE + dt * 32);
            const bf16x8 vf = {lo[0], lo[1], lo[2], lo[3], hi[0], hi[1], hi[2], hi[3]};
            accO[dt] = __builtin_amdgcn_mfma_f32_16x16x32_bf16(vf, pfrag, accO[dt], 0, 0, 0);
        }
    }
    dsum += __shfl_xor(dsum, 16); dsum += __shfl_xor(dsum, 32);
    const float inv = 1.0f / dsum;
    bf16* op = OG + qrow * QKV + g * 512 + h * 128 + 4 * gq;
#pragma unroll
    for (int dt = 0; dt < 8; ++dt) {
        u32x2 w; w.x = pk2(accO[dt][0] * inv, accO[dt][1] * inv); w.y = pk2(accO[dt][2] * inv, accO[dt][3] * inv);
        *(u32x2*)(op + dt * 16) = w;
    }
    if (gq == 0) DG[qrow * 12 + g * 4 + h] = dsum;
    __syncthreads();
}


struct AttnU { int g, b, h, r, qb, d, hc; };
__device__ __forceinline__ AttnU attn_decode(int unit) {
    AttnU a; a.g = unit >> 9; const int r9 = unit & 511, sh = 2 * a.g, nb = 32 >> sh; a.d = 1 << sh;
    a.qb = r9 % nb; int t2 = r9 / nb; a.r = t2 % a.d; t2 /= a.d; a.h = t2 & 3; a.b = t2 >> 2; a.hc = (a.g * 4 + a.h) * 128; return a;
}
constexpr int ATT_BLK = 128 * KV_STRIDE;
__device__ __forceinline__ void attn_load_block(u32x4 (&kn)[4], u32x4 (&vn)[4], const bf16* K, const bf16* V, const AttnU& a, int blk, int tid) {
    const int ch = tid & 15, r0 = tid >> 4;
#pragma unroll
    for (int it = 0; it < 4; ++it) {
        const size_t off = ((size_t)a.b * SEQ + (size_t)(128 * blk + r0 + 32 * it) * a.d + a.r) * QKV + a.hc + ch * 8;
        kn[it] = *(const u32x4*)(K + off); vn[it] = *(const u32x4*)(V + off);
    }
}
__device__ __forceinline__ void attn_store_block(LAS unsigned char* lds, int slot, const u32x4 (&kn)[4], const u32x4 (&vn)[4], int tid) {
    const int ch = tid & 15, r0 = tid >> 4;
#pragma unroll
    for (int it = 0; it < 4; ++it) {
        *(LAS u32x4*)(lds + slot * ATT_BLK + (r0 + 32 * it) * KV_STRIDE + ch * 16) = kn[it];
        *(LAS u32x4*)(lds + (2 + slot) * ATT_BLK + (r0 + 32 * it) * KV_STRIDE + ch * 16) = vn[it];
    }
}
__device__ __forceinline__ void attn_units(LAS unsigned char* lds, const bf16* Q, const bf16* K, const bf16* V, bf16* OG, float* DG, int u0, int nu, float cshift, int wid, int lane, int tid) {
    if (nu <= 0) return;
    int p = 0;
    u32x4 kn[4], vn[4];
    AttnU a = attn_decode(u0);
    attn_load_block(kn, vn, K, V, a, a.qb, tid);
    const int ql = lane & 15, gq = lane >> 4;
    for (int ui = 0; ui < nu; ++ui) {
        a = attn_decode(u0 + ui);
        if (!(ui > 0 && a.qb > 0)) {
            u32x4 kp[4], vp[4];
            if (a.qb == 0) {
#pragma unroll
                for (int it = 0; it < 4; ++it) { kp[it] = (u32x4){0u, 0u, 0u, 0u}; vp[it] = (u32x4){0u, 0u, 0u, 0u}; }
            } else attn_load_block(kp, vp, K, V, a, a.qb - 1, tid);
            attn_store_block(lds, p, kp, vp, tid);
        }
        attn_store_block(lds, 1 - p, kn, vn, tid);
        const int qi = 16 * wid + ql;
        const size_t qrow = (size_t)a.b * SEQ + (size_t)(128 * a.qb + qi) * a.d + a.r;
        bf16x8 qf[4];
#pragma unroll
        for (int kk = 0; kk < 4; ++kk) qf[kk] = *(const bf16x8*)(Q + qrow * QKV + a.hc + 32 * kk + 8 * gq);
        const float slope2 = alibi_slope(a.g * 4 + a.h) * LOG2E * (float)a.d;
        __syncthreads();
        if (ui + 1 < nu) { const AttnU an = attn_decode(u0 + ui + 1); attn_load_block(kn, vn, K, V, an, an.qb, tid); }
        f32x4 accO[8];
#pragma unroll
        for (int dt = 0; dt < 8; ++dt) accO[dt] = (f32x4){0.f, 0.f, 0.f, 0.f};
        float dsum = 0.f;
        const int kl = ql * KV_STRIDE + gq * 16, vl = (4 * gq + (ql >> 2)) * KV_STRIDE + (ql & 3) * 8;
#pragma unroll
        for (int kt2 = 0; kt2 < 5; ++kt2) {
            const int ja = 16 * wid + 32 * kt2, jb = ja + 16;
            const int offA = (((ja >> 7) ^ p) * ATT_BLK) + (ja & 127) * KV_STRIDE;
            const int offB = (kt2 < 4) ? ((((jb >> 7) ^ p) * ATT_BLK) + (jb & 127) * KV_STRIDE) : offA;
            f32x4 sa = {0.f, 0.f, 0.f, 0.f}, sb = {0.f, 0.f, 0.f, 0.f};
#pragma unroll
            for (int kk = 0; kk < 4; ++kk) {
                const bf16x8 ka = *(const LAS bf16x8*)(lds + offA + kl + kk * 64);
                sa = __builtin_amdgcn_mfma_f32_16x16x32_bf16(ka, qf[kk], sa, 0, 0, 0);
            }
            if (kt2 < 4) {
#pragma unroll
                for (int kk = 0; kk < 4; ++kk) {
                    const bf16x8 kb = *(const LAS bf16x8*)(lds + offB + kl + kk * 64);
                    sb = __builtin_amdgcn_mfma_f32_16x16x32_bf16(kb, qf[kk], sb, 0, 0, 0);
                }
            }
            float pa[4], pb[4];
#pragma unroll
            for (int jj = 0; jj < 4; ++jj) {
                const int j = ja + 4 * gq + jj, dist = 128 + qi - j;
                const bool ok = dist >= 0 && dist <= 128 && (128 * a.qb - 128 + j) >= 0;
                pa[jj] = ok ? fast_exp2(sa[jj] - slope2 * (float)dist - cshift) : 0.f;
                const int j2 = j + 16, dist2 = dist - 16;
                const bool ok2 = (kt2 < 4) && dist2 >= 0 && dist2 <= 128 && (128 * a.qb - 128 + j2) >= 0;
                pb[jj] = ok2 ? fast_exp2(sb[jj] - slope2 * (float)dist2 - cshift) : 0.f;
                dsum += pa[jj] + pb[jj];
            }
            u32x4 pw; pw.x = pk2(pa[0], pa[1]); pw.y = pk2(pa[2], pa[3]); pw.z = pk2(pb[0], pb[1]); pw.w = pk2(pb[2], pb[3]);
            const bf16x8 pfrag = __builtin_bit_cast(bf16x8, pw);
#pragma unroll
            for (int dt = 0; dt < 8; ++dt) {
                const s16x4 lo = vtr(lds + 2 * ATT_BLK + offA + vl + dt * 32);
                const s16x4 hi = vtr(lds + 2 * ATT_BLK + offB + vl + dt * 32);
                const bf16x8 vf = {lo[0], lo[1], lo[2], lo[3], hi[0], hi[1], hi[2], hi[3]};
                accO[dt] = __builtin_amdgcn_mfma_f32_16x16x32_bf16(vf, pfrag, accO[dt], 0, 0, 0);
            }
        }
        dsum += __shfl_xor(dsum, 16); dsum += __shfl_xor(dsum, 32);
        const float inv = 1.0f / dsum;
        bf16* op = OG + qrow * QKV + a.g * 512 + a.h * 128 + 4 * gq;
#pragma unroll
        for (int dt = 0; dt < 8; ++dt) {
            u32x2 w; w.x = pk2(accO[dt][0] * inv, accO[dt][1] * inv); w.y = pk2(accO[dt][2] * inv, accO[dt][3] * inv);
            *(u32x2*)(op + dt * 16) = w;
        }
        if (gq == 0) DG[qrow * 12 + a.g * 4 + a.h] = dsum;
        __syncthreads();
        p ^= 1;
    }
}

__device__ __forceinline__ void attn_sample_item(LAS unsigned char* lds, const bf16* Q, const bf16* K, const bf16* V, const float* c0, const float* c1, const float* c2, int layer, bf16* YA, int item, int wid, int lane, int tid) {
    const int b = item >> 2, h = item & 3;
    LAS float* sc = (LAS float*)lds;
    LAS float* qs = (LAS float*)(lds + 2048);
    LAS float* part = (LAS float*)(lds + 4096);
    LAS float* pself = (LAS float*)(lds + 8192);
    const size_t row = (size_t)MP + b;
    if (tid < 384) { const int g = tid >> 7, dd = tid & 127; qs[tid] = bf2f(Q[row * QKV + (g * 4 + h) * 128 + dd]); }
    LDS_WAIT(); __syncthreads();
    const int k = lane >> 2, qd = lane & 3;
    {
        f32x4 kv[3][8];
#pragma unroll
        for (int i = 0; i < 3; ++i) {
            const int jj = 16 * (wid + 8 * i) + k, g = (wid + 8 * i) >> 3  , step = (jj & 127) + 1, d = 1 << (2 * g), lc = 128 << (2 * g);
            const float* cp = (g == 0 ? c0 : (g == 1 ? c1 : c2)) + ((((size_t)(layer * NSMP + b) * lc + (lc - d * step)) * 2 + 0) * 4 + h) * 128 + qd * 32;
#pragma unroll
            for (int e = 0; e < 8; ++e) kv[i][e] = *(const f32x4*)(cp + 4 * e);
        }
#pragma unroll
        for (int i = 0; i < 3; ++i) {
            const int jj = 16 * (wid + 8 * i) + k, g = i, step = (jj & 127) + 1, d = 1 << (2 * g);
            float s = 0.f;
#pragma unroll
            for (int e = 0; e < 8; ++e) { const f32x4 qv = *(const LAS f32x4*)(qs + g * 128 + qd * 32 + 4 * e); s += (kv[i][e].x * qv.x + kv[i][e].y * qv.y) + (kv[i][e].z * qv.z + kv[i][e].w * qv.w); }
            s += __shfl_xor(s, 1); s += __shfl_xor(s, 2);
            s -= alibi_slope(g * 4 + h) * LOG2E * (float)(d * step);
            if (qd == 0) sc[g * 132 + step] = s;
        }
        if (wid < 3) {
            const unsigned kk = *(const unsigned*)(K + row * QKV + (wid * 4 + h) * 128 + 2 * lane);
            float s = __uint_as_float(kk << 16) * qs[wid * 128 + 2 * lane] + __uint_as_float(kk & 0xffff0000u) * qs[wid * 128 + 2 * lane + 1];
            s = wave_sum(s);
            if (lane == 0) sc[wid * 132] = s;
        }
    }
    LDS_WAIT(); __syncthreads();
    float mx = -3.0e38f;
    for (int j = lane; j < 387; j += 64) { const int g = j / 129; mx = fmaxf(mx, sc[g * 132 + (j - g * 129)]); }
    mx = wave_max(mx);
    float den = 0.f;
    for (int j = lane; j < 387; j += 64) { const int g = j / 129; den += fast_exp2(sc[g * 132 + (j - g * 129)] - mx); }
    den = wave_sum(den);
    {
        f32x4 vv[3][8];
#pragma unroll
        for (int i = 0; i < 3; ++i) {
            const int jj = 16 * (wid + 8 * i) + k, g = i, step = (jj & 127) + 1, d = 1 << (2 * g), lc = 128 << (2 * g);
            const float* cp = (g == 0 ? c0 : (g == 1 ? c1 : c2)) + ((((size_t)(layer * NSMP + b) * lc + (lc - d * step)) * 2 + 1) * 4 + h) * 128 + qd * 32;
#pragma unroll
            for (int e = 0; e < 8; ++e) vv[i][e] = *(const f32x4*)(cp + 4 * e);
        }
        f32x4 acc[8];
#pragma unroll
        for (int e = 0; e < 8; ++e) acc[e] = (f32x4){0.f, 0.f, 0.f, 0.f};
#pragma unroll
        for (int i = 0; i < 3; ++i) {
            const int jj = 16 * (wid + 8 * i) + k, step = (jj & 127) + 1;
            const float p = fast_exp2(sc[i * 132 + step] - mx);
#pragma unroll
            for (int e = 0; e < 8; ++e) acc[e] += vv[i][e] * p;
        }
#pragma unroll
        for (int e = 0; e < 8; ++e)
#pragma unroll
            for (int c = 0; c < 4; ++c) { float v = acc[e][c]; v += __shfl_xor(v, 4); v += __shfl_xor(v, 8); v += __shfl_xor(v, 16); v += __shfl_xor(v, 32); acc[e][c] = v; }
        if (k == 0) {
#pragma unroll
            for (int e = 0; e < 8; ++e) *(LAS f32x4*)(part + wid * 128 + qd * 32 + 4 * e) = acc[e];
        }
        if (tid < 3) pself[tid] = fast_exp2(sc[tid * 132] - mx);
    }
    LDS_WAIT(); __syncthreads();
    if (tid < 128) {
        float a = 0.f;
#pragma unroll
        for (int w = 0; w < 8; ++w) a += part[w * 128 + tid];
#pragma unroll
        for (int g = 0; g < 3; ++g) a += pself[g] * bf2f(V[row * QKV + (g * 4 + h) * 128 + tid]);
        YA[row * 512 + h * 128 + tid] = (bf16)(pk2(a / den, 0.f) & 0xffffu);
    }
    LDS_WAIT(); __syncthreads();
}

constexpr int SG_STRIDE = 144;
constexpr int SG_SLAB = 128 * SG_STRIDE;
constexpr int SG_STATS = 4 * SG_SLAB;
__device__ __forceinline__ void sgu_unit(LAS unsigned char* lds, const bf16* U, const bf16* VS, const float* lnw, const float* lnb, const bf16* WSP, const float* bsp, bf16* YS, int unit, int wid, int lane) {
    const int half = unit & 1, bn = unit >> 1;
    const size_t R0 = (size_t)bn * 128;
    LAS f32x2* stats = (LAS f32x2*)(lds + SG_STATS);
    for (int i = 0; i < 16; ++i) {
        const int rl = 16 * wid + i;
        const u32x4 x = *(const u32x4*)(VS + (R0 + rl) * 512 + 8 * lane);
        const float f[8] = {__uint_as_float(x.x << 16), __uint_as_float(x.x & 0xffff0000u), __uint_as_float(x.y << 16), __uint_as_float(x.y & 0xffff0000u),
                            __uint_as_float(x.z << 16), __uint_as_float(x.z & 0xffff0000u), __uint_as_float(x.w << 16), __uint_as_float(x.w & 0xffff0000u)};
        float s = 0.f, s2 = 0.f;
#pragma unroll
        for (int e = 0; e < 8; ++e) { s += f[e]; s2 += f[e] * f[e]; }
        s = wave_sum(s); s2 = wave_sum(s2);
        const float mean = s * (1.0f / 512.0f), var = fmaxf(s2 * (1.0f / 512.0f) - mean * mean, 0.f);
        if (lane == 0) stats[rl] = (f32x2){mean, 1.0f / sqrtf(var + 1e-6f)};
    }
    LDS_WAIT(); __syncthreads();
    const int gl = wid & 3, th = wid >> 2, grp = half * 4 + gl, c0 = grp * 64;
    LAS unsigned char* slab = lds + gl * SG_SLAB;
    {
        const int cc = (lane & 7) * 8;
        const f32x4 w0 = *(const f32x4*)(lnw + c0 + cc), w1 = *(const f32x4*)(lnw + c0 + cc + 4), b0 = *(const f32x4*)(lnb + c0 + cc), b1 = *(const f32x4*)(lnb + c0 + cc + 4);
#pragma unroll
        for (int it = 0; it < 8; ++it) {
            const int rl = th * 64 + it * 8 + (lane >> 3);
            const u32x4 x = *(const u32x4*)(VS + (R0 + rl) * 512 + c0 + cc);
            const f32x2 st = stats[rl];
            f32x4 a = {__uint_as_float(x.x << 16), __uint_as_float(x.x & 0xffff0000u), __uint_as_float(x.y << 16), __uint_as_float(x.y & 0xffff0000u)};
            f32x4 c = {__uint_as_float(x.z << 16), __uint_as_float(x.z & 0xffff0000u), __uint_as_float(x.w << 16), __uint_as_float(x.w & 0xffff0000u)};
            a = (a - st.x) * st.y * w0 + b0; c = (c - st.x) * st.y * w1 + b1;
            u32x4 o; o.x = pk2(a[0], a[1]); o.y = pk2(a[2], a[3]); o.z = pk2(c[0], c[1]); o.w = pk2(c[2], c[3]);
            *(LAS u32x4*)(slab + rl * SG_STRIDE + cc * 2) = o;
        }
    }
    LDS_WAIT(); __syncthreads();
    const int ql = lane & 15, gq = lane >> 4;
    const LAS unsigned char* abase = slab + (8 * gq + (ql >> 2)) * SG_STRIDE + (ql & 3) * 8;
    const bf16* wg = WSP + (size_t)grp * 128 * 128;
#pragma unroll
    for (int ti = 0; ti < 4; ++ti) {
        const int tt = th == 0 ? (ti == 0 ? 0 : (ti == 1 ? 3 : (ti == 2 ? 4 : 7))) : (ti == 0 ? 1 : (ti == 1 ? 2 : (ti == 2 ? 5 : 6)));
        const int t = 16 * tt + ql;
        f32x4 acc[4];
#pragma unroll
        for (int ct = 0; ct < 4; ++ct) acc[ct] = (f32x4){0.f, 0.f, 0.f, 0.f};
        for (int kk = 0; kk <= (tt >> 1); ++kk) {
            const bf16x8 wf = *(const bf16x8*)(wg + (size_t)t * 128 + 32 * kk + 8 * gq);
#pragma unroll
            for (int ct = 0; ct < 4; ++ct) {
                const s16x4 lo = vtr(abase + (32 * kk) * SG_STRIDE + ct * 32);
                const s16x4 hi = vtr(abase + (32 * kk + 4) * SG_STRIDE + ct * 32);
                const bf16x8 af = {lo[0], lo[1], lo[2], lo[3], hi[0], hi[1], hi[2], hi[3]};
                acc[ct] = __builtin_amdgcn_mfma_f32_16x16x32_bf16(af, wf, acc[ct], 0, 0, 0);
            }
        }
        const float bias = bsp[grp * 128 + t];
#pragma unroll
        for (int ct = 0; ct < 4; ++ct) {
            const size_t off = (R0 + t) * 512 + c0 + ct * 16 + 4 * gq;
            const u32x2 uu = *(const u32x2*)(U + off);
            const float u0 = __uint_as_float(uu.x << 16), u1 = __uint_as_float(uu.x & 0xffff0000u), u2 = __uint_as_float(uu.y << 16), u3 = __uint_as_float(uu.y & 0xffff0000u);
            u32x2 o; o.x = pk2(u0 * (acc[ct][0] + bias), u1 * (acc[ct][1] + bias)); o.y = pk2(u2 * (acc[ct][2] + bias), u3 * (acc[ct][3] + bias));
            *(u32x2*)(YS + off) = o;
        }
    }
    LDS_WAIT(); __syncthreads();
}

__device__ __forceinline__ void sgu_sample_row(const bf16* U, const bf16* VS, const float* lnw, const float* lnb, const float* wsp_f32, const float* bsp, bf16* YS, float* out_sv, int b, int lane) {
    const size_t row = (size_t)MP + b;
    const u32x4 x = *(const u32x4*)(VS + row * 512 + 8 * lane);
    float f[8] = {__uint_as_float(x.x << 16), __uint_as_float(x.x & 0xffff0000u), __uint_as_float(x.y << 16), __uint_as_float(x.y & 0xffff0000u),
                  __uint_as_float(x.z << 16), __uint_as_float(x.z & 0xffff0000u), __uint_as_float(x.w << 16), __uint_as_float(x.w & 0xffff0000u)};
    float s = 0.f, s2 = 0.f;
#pragma unroll
    for (int e = 0; e < 8; ++e) { s += f[e]; s2 += f[e] * f[e]; }
    s = wave_sum(s); s2 = wave_sum(s2);
    const float mean = s * (1.0f / 512.0f), var = fmaxf(s2 * (1.0f / 512.0f) - mean * mean, 0.f), rstd = 1.0f / sqrtf(var + 1e-6f);
    const int c = 8 * lane, grp = c >> 6;
    const float w00 = wsp_f32[(size_t)grp * 128 * 128], b0 = bsp[grp * 128];
    const u32x4 uu = *(const u32x4*)(U + row * 512 + c);
    const float uf[8] = {__uint_as_float(uu.x << 16), __uint_as_float(uu.x & 0xffff0000u), __uint_as_float(uu.y << 16), __uint_as_float(uu.y & 0xffff0000u),
                         __uint_as_float(uu.z << 16), __uint_as_float(uu.z & 0xffff0000u), __uint_as_float(uu.w << 16), __uint_as_float(uu.w & 0xffff0000u)};
    float y[8];
#pragma unroll
    for (int e = 0; e < 8; ++e) { const float vn = (f[e] - mean) * rstd * lnw[c + e] + lnb[c + e]; out_sv[c + e] = vn; y[e] = uf[e] * (w00 * vn + b0); }
    u32x4 o; o.x = pk2(y[0], y[1]); o.y = pk2(y[2], y[3]); o.z = pk2(y[4], y[5]); o.w = pk2(y[6], y[7]);
    *(u32x4*)(YS + row * 512 + c) = o;
}

__device__ __forceinline__ void merge_row(const bf16* OG, const float* DG, bf16* YA, int row, int lane) {
    const int h = lane >> 4;
    const float d0 = DG[(size_t)row * 12 + h], d1 = DG[(size_t)row * 12 + 4 + h], d2 = DG[(size_t)row * 12 + 8 + h];
    const float inv = 1.0f / (d0 + d1 + d2);
    const float a0 = d0 * inv, a1 = d1 * inv, a2 = d2 * inv;
    const bf16* p = OG + (size_t)row * QKV + 8 * lane;
    const u32x4 x0 = *(const u32x4*)p, x1 = *(const u32x4*)(p + 512), x2 = *(const u32x4*)(p + 1024);
    u32x4 o;
#define MRG(c) pk2(a0 * __uint_as_float(x0.c << 16) + a1 * __uint_as_float(x1.c << 16) + a2 * __uint_as_float(x2.c << 16), \
                   a0 * __uint_as_float(x0.c & 0xffff0000u) + a1 * __uint_as_float(x1.c & 0xffff0000u) + a2 * __uint_as_float(x2.c & 0xffff0000u))
    o.x = MRG(x); o.y = MRG(y); o.z = MRG(z); o.w = MRG(w);
#undef MRG
    *(u32x4*)(YA + (size_t)row * 512 + 8 * lane) = o;
}


typedef float f32x16 __attribute__((ext_vector_type(16)));
template <class EpiS>
__device__ __forceinline__ void skinny_gemm(LAS unsigned char* lds, const bf16* A, const bf16* Bt, int K, int j, const EpiS& e, int wid, int lane, int tid) {
    const int r = lane & 31, hi = lane >> 5, ks = K >> 3;
    const bf16* ap = A + (size_t)r * K + wid * ks + 8 * hi;
    const bf16* bp = Bt + (size_t)(32 * j + r) * K + wid * ks + 8 * hi;
    f32x16 acc;
#pragma unroll
    for (int i = 0; i < 16; ++i) acc[i] = 0.f;
#pragma unroll 4
    for (int k = 0; k < ks; k += 16) {
        const bf16x8 a = *(const bf16x8*)(ap + k), b = *(const bf16x8*)(bp + k);
        acc = __builtin_amdgcn_mfma_f32_32x32x16_bf16(a, b, acc, 0, 0, 0);
    }
    LAS float* red = (LAS float*)lds;
#pragma unroll
    for (int i = 0; i < 16; ++i) red[wid * 1056 + ((i & 3) + 8 * (i >> 2) + 4 * hi) * 33 + r] = acc[i];
    LDS_WAIT(); __syncthreads();
    for (int e2 = tid; e2 < 1024; e2 += NTHREADS) {
        const int row = e2 >> 5, col = e2 & 31;
        float sum = 0.f;
#pragma unroll
        for (int w = 0; w < 8; ++w) sum += red[w * 1056 + row * 33 + col];
        e(row, 32 * j + col, sum);
    }
    LDS_WAIT(); __syncthreads();
}
struct SkGate1 { const bf16* G; float* T1; __device__ __forceinline__ void operator()(int sr, int col, float v) const { const size_t row = (size_t)MP + sr; T1[row * DM + col] = bf2f(G[row * 2048 + col]) * v; } };
struct SkGate2 { const bf16* G; const float* T1; bf16* MG; __device__ __forceinline__ void operator()(int sr, int col, float v) const { const size_t row = (size_t)MP + sr; MG[row * DM + col] = (bf16)(pk2(T1[row * DM + col] + bf2f(G[row * 2048 + 1024 + col]) * v, 0.f) & 0xffffu); } };
struct SkRes { const float* bs; float* os; const float* gate; __device__ __forceinline__ void operator()(int sr, int col, float v) const { os[(size_t)sr * DM + col] = bs[(size_t)sr * DM + col] + gate[(size_t)(4 + sr) * NADA + col] * v; } };


#define RLX_AGENT __ATOMIC_RELAXED, __HIP_MEMORY_SCOPE_AGENT
#define XB_TMO      128
#define XB_XCNT(j)  (256  + 64 * (j))
#define XB_XSUB(j)  (1280 + 64 * (j))
#define XB_XGEN(j)  (2304 + 64 * (j))
#define XB_TOP      3328
#define XB_TOPGEN   3392
#define XCD_BAR_WORDS 3456
#define XB_SPIN_CAP (1u << 18)

__device__ __forceinline__ unsigned xb_ld(unsigned* p)              { return __hip_atomic_load(p, __ATOMIC_RELAXED, __HIP_MEMORY_SCOPE_AGENT); }
__device__ __forceinline__ unsigned xb_add(unsigned* p, unsigned v) { return __hip_atomic_fetch_add(p, v, __ATOMIC_RELAXED, __HIP_MEMORY_SCOPE_AGENT); }
__device__ __forceinline__ unsigned xb_xcc_id() { return (unsigned)__builtin_amdgcn_s_getreg((3 << 11) | 20) & 0xFu; }
#define XB_SPIN(cond, bar) do { unsigned _sp = 0; while (cond) { __builtin_amdgcn_s_sleep(1); \
    if ((++_sp & 255u) == 0u) { if (xb_ld(&(bar)[XB_TMO])) break; if (_sp > XB_SPIN_CAP) { atomicAdd(&(bar)[XB_TMO], 1u); break; } } } } while (0)

struct XcdBarrier {
    unsigned* bar; unsigned x;
    volatile LAS unsigned* st;
};

__device__ __forceinline__ XcdBarrier xcd_barrier_post(unsigned* bar, volatile LAS unsigned* st) {
    XcdBarrier b; b.bar = bar; b.x = xb_xcc_id(); b.st = st;
    if (threadIdx.x == 0) (void)xb_add(&bar[XB_XCNT(b.x)], 1u);
    return b;
}
__device__ __forceinline__ void xcd_barrier_complete(unsigned* bar, unsigned x, unsigned& nloc, unsigned& nx) {
    const unsigned G = gridDim.x * gridDim.y * gridDim.z;
    unsigned sum, cnt, mine, sp = 0u;
    for (;;) {
        sum = 0u; cnt = 0u; mine = 0u;
#pragma unroll
        for (unsigned j = 0; j < 16; ++j) { const unsigned c = xb_ld(&bar[XB_XCNT(j)]); sum += c; cnt += (c > 0u) ? 1u : 0u; mine = (j == x) ? c : mine; }
        if (sum == G) break;
        __builtin_amdgcn_s_sleep(1);
        if ((++sp & 255u) == 0u) { if (xb_ld(&bar[XB_TMO])) break; if (sp > XB_SPIN_CAP) { atomicAdd(&bar[XB_TMO], 1u); break; } }
    }
    nloc = mine > 0u ? mine : 1u; nx = cnt > 0u ? cnt : 1u;
}

__device__ __forceinline__ void xcd_barrier(const XcdBarrier& b) {
    asm volatile("s_waitcnt vmcnt(0)" ::: "memory");
    __syncthreads();
    if (threadIdx.x == 0) {
        unsigned* bar = b.bar;
        __builtin_amdgcn_s_waitcnt(0);
        unsigned nloc = b.st[0], nx = b.st[1];
        if (nloc == 0u) { xcd_barrier_complete(bar, b.x, nloc, nx); b.st[0] = nloc; b.st[1] = nx; }
        const unsigned old = xb_add(&bar[XB_XSUB(b.x)], 1u);
        const unsigned gen = old / nloc;
        if (old + 1u == (gen + 1u) * nloc) {
            __builtin_amdgcn_fence(__ATOMIC_RELEASE, "agent");
            asm volatile("s_waitcnt vmcnt(0)" ::: "memory");
            const unsigned og = xb_add(&bar[XB_TOP], 1u);
            const unsigned tg = og / nx;
            if (og + 1u == (tg + 1u) * nx) xb_add(&bar[XB_TOPGEN], 1u);
            else XB_SPIN(xb_ld(&bar[XB_TOPGEN]) == tg, bar);
            __builtin_amdgcn_fence(__ATOMIC_ACQUIRE, "agent");
            xb_add(&bar[XB_XGEN(b.x)], 1u);
            asm volatile("s_waitcnt vmcnt(0)" ::: "memory");
        } else {
            XB_SPIN(xb_ld(&bar[XB_XGEN(b.x)]) == gen, bar);
            __builtin_amdgcn_fence(__ATOMIC_ACQUIRE, "agent");
            asm volatile("s_waitcnt vmcnt(0)" ::: "memory");
        }
    }
    __syncthreads();
}

constexpr int LDS_MISC = LDS_EXCH + 8192;
constexpr size_t WS_CTL = 0, CTL_ZERO_BYTES = 65536;
#ifndef PROBE_REP_MASK
#define PROBE_REP_MASK 0
#endif
#define PHON(k) for (int rep_ = 0; rep_ <= (((PROBE_REP_MASK) >> (k)) & 1); ++rep_) if constexpr (((PHM) >> (k)) & 1)
#define GSYNC() do { if constexpr (COOP) { CAS const Args* ap_ = (CAS const Args*)__builtin_amdgcn_kernarg_segment_ptr(); asm volatile("" : "+s"(ap_)); \
    XcdBarrier xb_; xb_.bar = (unsigned*)((unsigned char*)ap_->ws + WS_CTL); xb_.x = xb_xcc_id(); xb_.st = (volatile LAS unsigned*)(lds + LDS_MISC); xcd_barrier(xb_); } } while (0)
#define GSYNC_CG() do { if constexpr (COOP) cg::this_grid().sync(); } while (0)
#define GAS __attribute__((address_space(1)))
#define CAS __attribute__((address_space(4)))
struct Args { GAS const float* in[23]; GAS float* out; GAS unsigned char* ws; };

constexpr int I_ADA = 16 * 192, I_IN = 16 * 240, I_PA = 8 * 32, I_OUT = 16 * 32, I_FI = 16 * 176, I_FO = 44 * 32;
constexpr int I_LAYER = I_ADA + I_IN + 2 * I_PA + I_OUT + I_FI + I_FO;
__device__ __forceinline__ void weight_copy_item(CAS const Args* ap, unsigned char* ws, int l, int r, LAS float* scr, int lane) {
    unsigned char* wl = ws + WS_WL0 + (size_t)l * WL_SIZE;
    if (r < I_IN) { transpose_item(((const float*)ap->in[10]) + (size_t)l * DM * DIN, DM, DIN, (bf16*)(wl + WL_WIN), 0, scr, r, lane); return; } r -= I_IN;
    if (r < I_PA) { transpose_item(((const float*)ap->in[17]) + (size_t)l * 512 * DM, 512, DM, (bf16*)(wl + WL_WPA), 0, scr, r, lane); return; } r -= I_PA;
    if (r < I_PA) { transpose_item(((const float*)ap->in[18]) + (size_t)l * 512 * DM, 512, DM, (bf16*)(wl + WL_WPS), 0, scr, r, lane); return; } r -= I_PA;
    if (r < I_OUT) { transpose_item(((const float*)ap->in[19]) + (size_t)l * DM * DM, DM, DM, (bf16*)(wl + WL_WOUT), 0, scr, r, lane); return; } r -= I_OUT;
    if (r < I_FI) { transpose_item(((const float*)ap->in[21]) + (size_t)l * DM * 2 * DFF, DM, 2 * DFF, (bf16*)(wl + WL_WFI), 1, scr, r, lane); return; } r -= I_FI;
    transpose_item(((const float*)ap->in[22]) + (size_t)l * DFF * DM, DFF, DM, (bf16*)(wl + WL_WFO), 0, scr, r, lane);
}
#define PHASE_ENV() \
    CAS const Args* ap = (CAS const Args*)__builtin_amdgcn_kernarg_segment_ptr(); asm volatile("" : "+s"(ap)); \
    int tid = threadIdx.x; asm volatile("" : "+v"(tid)); \
    const int lane = tid & 63, wid = __builtin_amdgcn_readfirstlane(tid >> 6); \
    int G_ = gridDim.x, bx_ = blockIdx.x; asm volatile("" : "+s"(G_), "+s"(bx_)); const int G = G_, bx = bx_; const int gw = bx * NWAVES + wid, NGW = G * NWAVES; \
    unsigned char* const ws = (unsigned char*)ap->ws; (void)lane; (void)wid; (void)gw; (void)NGW; (void)ws; (void)G; (void)bx
#define WL(l) (ws + WS_WL0 + (size_t)(l) * WL_SIZE)

template <int PHM, bool COOP>
__global__ void __launch_bounds__(NTHREADS, 2) fwd_megakernel(Args args_unused, int l_lo, int l_hi) {
    extern __shared__ __attribute__((aligned(16))) unsigned char lds_raw[];
    LAS unsigned char* lds = (LAS unsigned char*)lds_raw;
    if constexpr (COOP) {
        PHASE_ENV();
        if (tid < 32) ((LAS unsigned*)(lds + LDS_MISC))[tid] = 0u;
        __syncthreads();
        (void)xcd_barrier_post((unsigned*)(ws + WS_CTL), (volatile LAS unsigned*)(lds + LDS_MISC));
    }

    PHON(0) {
        PHASE_ENV();
        bf16* WADA = (bf16*)(ws + WS_WADA); bf16* SC = (bf16*)(ws + WS_SC);
        LAS float* scr = (LAS float*)(lds + wid * 16384);
        for (int it = gw; it < 2 * I_ADA + (I_LAYER - I_ADA); it += NGW) {
            if (it < 2 * I_ADA) { const int l = it / I_ADA; transpose_item(((const float*)ap->in[7]) + (size_t)l * DM * NADA, DM, NADA, WADA + (size_t)l * NADA * DM, 0, scr, it - l * I_ADA, lane); }
            else weight_copy_item(ap, ws, 0, it - 2 * I_ADA, scr, lane);
        }
        const int gt = bx * NTHREADS + tid, NGT = G * NTHREADS;
        const float* wsp = ((const float*)ap->in[15]);
        for (int i = gt; i < 2 * 8 * 128 * 128; i += NGT) {
            const int l = i >> 17, r = i & 131071, t = (r >> 7) & 127, s = r & 127;
            const float w = wsp[i];
            ((bf16*)(WL(l) + WL_WSP))[r] = (bf16)(s <= t ? (pk2(w, 0.f) & 0xffffu) : 0u);
        }
        const float* cpr = ((const float*)ap->in[5]); const float* csm = ((const float*)ap->in[6]);
        for (int i = gt; i < 256 * DM; i += NGT) {
            const int r = i >> 10, k = i & 1023;
            float v = 0.f;
            if (r < 4) v = cpr[r * DM + k]; else if (r < 36) v = csm[(r - 4) * DM + k];
            SC[i] = (bf16)(pk2(v * sigmoidf_(v), 0.f) & 0xffffu);
        }
    }
    GSYNC_CG();
    PHON(1) {
        PHASE_ENV();
        pg8::Gemm g{(const bf16*)(ws + WS_SC), (const bf16*)(ws + WS_WADA), 256, 2 * NADA, DM}; pg8::StaticOrder S; S.init(256, 2 * NADA, G, bx);
        EpiAda E{(float*)(ws + WS_MOD), ((const float*)ap->in[8])};
        pg8::gemm_phase<EpiAda, pg8::StaticOrder, true, true>(lds + LDS_RING, g, S, E);
    }
    GSYNC();

    for (int l = l_lo; l < l_hi; ++l) {
        PHON(2) {
            PHASE_ENV();
            const float* X2 = (const float*)(ws + WS_X2);
            const float* xin_p = l == 0 ? ((const float*)ap->in[0]) : X2;
            const float* xin_s = l == 0 ? ((const float*)ap->in[1]) : X2 + (size_t)MP * DM;
            norm_mod_phase(xin_p, xin_s, ((const float*)ap->in[9]) + l * DM, (const float*)(ws + WS_MOD) + (size_t)l * 36 * NADA, 0, (bf16*)(ws + WS_XN), gw, NGW, lane);
        }
        GSYNC();
        PHON(3) {
            PHASE_ENV();
            pg8::Gemm g{(const bf16*)(ws + WS_XN), (const bf16*)(WL(l) + WL_WIN), MT, DIN, DM}; pg8::StaticOrder S; S.init(MT, DIN, G, bx);
            EpiIn E{ws, ((const float*)ap->in[11]) + l * 384, ((const float*)ap->in[12]) + l * 384, ((float*)ap->out), l, (LAS float*)(lds + LDS_EXCH)};
            pg8::gemm_phase<EpiIn, pg8::StaticOrder, true, true>(lds + LDS_RING, g, S, E);
        }
        PHON(3) {
            if (l == 0) {
                PHASE_ENV();
                constexpr int NU = (MT / 256) * (DIN / 256);
                const int nfull = NU % G;
                if (nfull > 0 && bx >= nfull) {
                    LAS float* scr = (LAS float*)(lds + wid * 16384);
                    const int nw = (G - nfull) * NWAVES, w0 = (bx - nfull) * NWAVES + wid;
                    for (int it = w0; it < I_LAYER - I_ADA; it += nw) weight_copy_item(ap, ws, 1, it, scr, lane);
                } else if (nfull == 0) {
                    LAS float* scr = (LAS float*)(lds + wid * 16384);
                    for (int it = gw; it < I_LAYER - I_ADA; it += NGW) weight_copy_item(ap, ws, 1, it, scr, lane);
                }
            }
        }
        GSYNC();
        PHON(4) {
            PHASE_ENV();
            const bf16 *Qb = (const bf16*)(ws + WS_Q), *Kb = (const bf16*)(ws + WS_K), *Vb = (const bf16*)(ws + WS_V);
            float mq = 0.f, mk = 0.f;
            for (int i = lane; i < 384; i += 64) { mq = fmaxf(mq, fabsf(((const float*)ap->in[11])[l * 384 + i])); mk = fmaxf(mk, fabsf(((const float*)ap->in[12])[l * 384 + i])); }
            mq = wave_max(mq); mk = wave_max(mk);
            const float cshift = 11.3137085f * LOG2E * mq * mk;
            if (G == 256) { const int u0 = bx < 128 ? bx * 7 : 896 + (bx - 128) * 5, nu = bx < 128 ? 7 : 5;
                attn_units(lds, Qb, Kb, Vb, (bf16*)(ws + WS_OG), (float*)(ws + WS_DG), u0, nu, cshift, wid, lane, tid); }
            else { const int per = (1536 + G - 1) / G, u0 = bx * per; attn_units(lds, Qb, Kb, Vb, (bf16*)(ws + WS_OG), (float*)(ws + WS_DG), u0, min(per, 1536 - u0), cshift, wid, lane, tid); }
        }
        PHON(4) {
            PHASE_ENV();
            if (bx >= G / 2) {
                for (int it = bx - G / 2; it < NSMP * 4; it += G - G / 2)
                    attn_sample_item(lds, (const bf16*)(ws + WS_Q), (const bf16*)(ws + WS_K), (const bf16*)(ws + WS_V), ((const float*)ap->in[2]), ((const float*)ap->in[3]), ((const float*)ap->in[4]), l, (bf16*)(ws + WS_YY) + (size_t)MP * 512  , it, wid, lane, tid);
            }
        }
        GSYNC();
        PHON(5) {
            PHASE_ENV();
            const bf16 *Ub = (const bf16*)(ws + WS_U), *VSb = (const bf16*)(ws + WS_VS); bf16 *YS = (bf16*)(ws + WS_YY) + (size_t)MP * 512;
            const bf16* WSP = (const bf16*)(WL(l) + WL_WSP);
            const float* lnw = ((const float*)ap->in[13]) + l * 512; const float* lnb = ((const float*)ap->in[14]) + l * 512; const float* bsp = ((const float*)ap->in[16]) + l * 8 * 128;
            for (int u = bx; u < 256; u += G) sgu_unit(lds, Ub, VSb, lnw, lnb, WSP, bsp, YS, u, wid, lane);
            for (int b = gw; b < NSMP; b += NGW) sgu_sample_row(Ub, VSb, lnw, lnb, ((const float*)ap->in[15]) + (size_t)l * 8 * 128 * 128, bsp, YS + (size_t)32 * 512  , ((float*)ap->out) + O_SV + (size_t)(l * NSMP + b) * 512, b, lane);
            for (int row = gw; row < MP; row += NGW) merge_row((const bf16*)(ws + WS_OG), (const float*)(ws + WS_DG), (bf16*)(ws + WS_YY), row, lane);
        }
        GSYNC();
        PHON(6) {
            PHASE_ENV();
            if (bx < 32) { SkGate1 e{(const bf16*)(ws + WS_G), (float*)(ws + WS_T1)};
                skinny_gemm(lds, (const bf16*)(ws + WS_YY) + (size_t)(2 * MP) * 512, (const bf16*)(WL(l) + WL_WPA), 512, bx, e, wid, lane, tid); }
        }
        PHON(6) {
            PHASE_ENV();
            PairOrder S; S.S0.init(MP, DM, G, bx);
            pg8::Gemm g{(const bf16*)(ws + WS_YY), (const bf16*)(WL(l) + WL_WPA), 2 * MP, 2 * DM, 512}; EpiMerged E{(const bf16*)(ws + WS_G), (bf16*)(ws + WS_MG)};
            pg8::gemm_phase<EpiMerged, PairOrder, true, true>(lds + LDS_RING, g, S, E);
        }
        PHON(6) {
            PHASE_ENV();
            if (bx < 32) { SkGate2 e{(const bf16*)(ws + WS_G), (const float*)(ws + WS_T1), (bf16*)(ws + WS_MG)};
                skinny_gemm(lds, (const bf16*)(ws + WS_YY) + (size_t)(2 * MP + 32) * 512, (const bf16*)(WL(l) + WL_WPS), 512, bx, e, wid, lane, tid); }
        }
        GSYNC();
        PHON(7) {
            PHASE_ENV();
            const float* X2 = (const float*)(ws + WS_X2); float* X1 = (float*)(ws + WS_X1);
            const float* xin_p = l == 0 ? ((const float*)ap->in[0]) : X2;
            const float* xin_s = l == 0 ? ((const float*)ap->in[1]) : X2 + (size_t)MP * DM;
            pg8::Gemm g{(const bf16*)(ws + WS_MG), (const bf16*)(WL(l) + WL_WOUT), MP, DM, DM}; pg8::StaticOrder S; S.init(MP, DM, G, bx);
            EpiRes E{xin_p, xin_s, X1, X1 + (size_t)MP * DM, (const float*)(ws + WS_MOD) + (size_t)l * 36 * NADA + 2048};
            pg8::gemm_phase<EpiRes, pg8::StaticOrder, true, true>(lds + LDS_RING, g, S, E);
        }
        PHON(7) {
            PHASE_ENV();
            if (bx < 32) { const float* X2 = (const float*)(ws + WS_X2);
                SkRes e{l == 0 ? ((const float*)ap->in[1]) : X2 + (size_t)MP * DM, (float*)(ws + WS_X1) + (size_t)MP * DM, (const float*)(ws + WS_MOD) + (size_t)l * 36 * NADA + 2048};
                skinny_gemm(lds, (const bf16*)(ws + WS_MG) + (size_t)MP * DM, (const bf16*)(WL(l) + WL_WOUT), DM, bx, e, wid, lane, tid); }
        }
        GSYNC();
        PHON(8) {
            PHASE_ENV();
            const float* X1 = (const float*)(ws + WS_X1);
            norm_mod_phase(X1, X1 + (size_t)MP * DM, ((const float*)ap->in[20]) + l * DM, (const float*)(ws + WS_MOD) + (size_t)l * 36 * NADA, 3072, (bf16*)(ws + WS_XN), gw, NGW, lane);
        }
        GSYNC();
        PHON(9) {
            PHASE_ENV();
            pg8::Gemm g{(const bf16*)(ws + WS_XN), (const bf16*)(WL(l) + WL_WFI), MT, 2 * DFF, DM}; pg8::StaticOrder S; S.init(MT, 2 * DFF, G, bx);
            EpiSwiglu E{(bf16*)(ws + WS_H)};
            pg8::gemm_phase<EpiSwiglu, pg8::StaticOrder, true, true>(lds + LDS_RING, g, S, E);
        }
        GSYNC();
        PHON(10) {
            PHASE_ENV();
            const float* X1 = (const float*)(ws + WS_X1); float* X2 = (float*)(ws + WS_X2);
            float* xout_p = l == 0 ? X2 : ((float*)ap->out) + O_YP;
            float* xout_s = l == 0 ? X2 + (size_t)MP * DM : ((float*)ap->out) + O_YS;
            pg8::Gemm g{(const bf16*)(ws + WS_H), (const bf16*)(WL(l) + WL_WFO), MP, DM, DFF}; pg8::StaticOrder S; S.init(MP, DM, G, bx);
            EpiRes E{X1, X1 + (size_t)MP * DM, xout_p, xout_s, (const float*)(ws + WS_MOD) + (size_t)l * 36 * NADA + 5120};
            pg8::gemm_phase<EpiRes, pg8::StaticOrder, true, true>(lds + LDS_RING, g, S, E);
        }
        PHON(10) {
            PHASE_ENV();
            if (bx < 32) { float* X2 = (float*)(ws + WS_X2);
                SkRes e{(const float*)(ws + WS_X1) + (size_t)MP * DM, l == 0 ? X2 + (size_t)MP * DM : ((float*)ap->out) + O_YS, (const float*)(ws + WS_MOD) + (size_t)l * 36 * NADA + 5120};
                skinny_gemm(lds, (const bf16*)(ws + WS_H) + (size_t)MP * DFF, (const bf16*)(WL(l) + WL_WFO), DFF, bx, e, wid, lane, tid); }
        }
        if (l + 1 < l_hi) GSYNC();
    }
}


#ifdef EXP_MASK
__global__ void __launch_bounds__(256) dbg_checksum(const unsigned char* ws, float* out) {
    const int lane = threadIdx.x & 63, gw = (blockIdx.x * 256 + threadIdx.x) >> 6, ngw = gridDim.x * 4;
    struct B { size_t off; int cols; int isf; };
    const B bufs[16] = {{WS_XN, 1024, 0}, {WS_Q, 1536, 0}, {WS_K, 1536, 0}, {WS_V, 1536, 0}, {WS_U, 512, 0}, {WS_VS, 512, 0}, {WS_G, 2048, 0}, {WS_OG, 1536, 0},
                        {WS_DG, 12, 1}, {WS_YY, 512, 0}, {WS_YY + (size_t)MP * 1024, 512, 0}, {WS_T1, 1024, 1}, {WS_MG, 1024, 0}, {WS_X1, 1024, 1}, {WS_H, 2816, 0}, {WS_X2, 1024, 1}};
    for (int b = 0; b < 16; ++b) {
        if (!((EXP_MASK >> b) & 1)) continue;
        for (int row = gw; row < MV; row += ngw) {
            float s = 0.f;
            for (int c = lane; c < bufs[b].cols; c += 64) {
                const float v = bufs[b].isf ? ((const float*)(ws + bufs[b].off))[(size_t)row * bufs[b].cols + c] : bf2f(((const bf16*)(ws + bufs[b].off))[(size_t)row * bufs[b].cols + c]);
                s += v * (float)(1 + (c % 7));
            }
            s = wave_sum(s);
            if (lane == 0) out[(size_t)b * MT + row] = s;
        }
    }
    if ((EXP_MASK >> 16) & 1) for (int i = blockIdx.x * 256 + threadIdx.x; i < 72 * NADA; i += gridDim.x * 256) out[16 * MT + i] = ((const float*)(ws + WS_MOD))[i];
}
#endif
#ifndef N_LAUNCH_MODE
#define N_LAUNCH_MODE 1
#endif
template <int PHM> static void launch_phase(const Args& a, int l_lo, int l_hi, int grid, hipStream_t stream) {
    static bool attr = false;
    if (!attr) { (void)hipFuncSetAttribute((const void*)fwd_megakernel<PHM, false>, hipFuncAttributeMaxDynamicSharedMemorySize, LDS_BYTES); attr = true; }
    hipLaunchKernelGGL((fwd_megakernel<PHM, false>), dim3(grid), dim3(NTHREADS), LDS_BYTES, stream, a, l_lo, l_hi);
}
extern "C" void kernel_launch(void* const* d_in, const int* in_sizes, int n_in, void* d_out, int out_size, void* d_ws, size_t ws_size, hipStream_t stream) {
    static int grid = 0;
    if (grid == 0) {
        if (n_in != 23 || (size_t)out_size != O_END || ws_size < WS_END) { fprintf(stderr, "kernel_launch: unexpected shapes (n_in %d out %d ws %zu need %zu)\n", n_in, out_size, ws_size, (size_t)WS_END); grid = -1; return; }
        int dev = 0, cus = 0, per_cu = 0;
        (void)hipGetDevice(&dev);
        (void)hipDeviceGetAttribute(&cus, hipDeviceAttributeMultiprocessorCount, dev);
#if N_LAUNCH_MODE == 1
        if (hipFuncSetAttribute((const void*)fwd_megakernel<0x7FF, true>, hipFuncAttributeMaxDynamicSharedMemorySize, LDS_BYTES) != hipSuccess) { fprintf(stderr, "kernel_launch: hipFuncSetAttribute failed\n"); grid = -1; return; }
        (void)hipOccupancyMaxActiveBlocksPerMultiprocessor(&per_cu, (const void*)fwd_megakernel<0x7FF, true>, NTHREADS, LDS_BYTES);
        (void)hipGetLastError();
        if (per_cu < 1) fprintf(stderr, "kernel_launch: occupancy query says %d blocks per CU\n", per_cu);
#endif
        grid = cus;
    }
    if (grid < 0) return;
    Args a{};
    for (int i = 0; i < 23; ++i) a.in[i] = (GAS const float*)d_in[i];
    a.out = (GAS float*)d_out; a.ws = (GAS unsigned char*)d_ws;
#if N_LAUNCH_MODE == 1
    (void)hipMemsetAsync((unsigned char*)d_ws + WS_CTL, 0, CTL_ZERO_BYTES, stream);
    int l_lo = 0, l_hi = 2;
    void* kargs[] = {&a, &l_lo, &l_hi};
    hipError_t e = hipLaunchCooperativeKernel((const void*)fwd_megakernel<0x7FF, true>, dim3(grid), dim3(NTHREADS), kargs, LDS_BYTES, stream);
    if (e != hipSuccess) fprintf(stderr, "cooperative launch failed: %s (grid %d)\n", hipGetErrorString(e), grid);
#else
#ifdef EXP_MASK
    (void)hipMemsetAsync(d_out, 0, (size_t)out_size * 4, stream);
#endif
    launch_phase<0x001>(a, 0, 0, grid, stream);
    launch_phase<0x002>(a, 0, 0, grid, stream);
#ifdef EXP_MASK
    const int NL = 1;
#else
    const int NL = 2;
#endif
    for (int l = 0; l < NL; ++l) {
        launch_phase<0x004>(a, l, l + 1, grid, stream);
        launch_phase<0x008>(a, l, l + 1, grid, stream);
        launch_phase<0x010>(a, l, l + 1, grid, stream);
        launch_phase<0x020>(a, l, l + 1, grid, stream);
        launch_phase<0x040>(a, l, l + 1, grid, stream);
        launch_phase<0x080>(a, l, l + 1, grid, stream);
        launch_phase<0x100>(a, l, l + 1, grid, stream);
        launch_phase<0x200>(a, l, l + 1, grid, stream);
        launch_phase<0x400>(a, l, l + 1, grid, stream);
    }
#ifdef EXP_MASK
    hipLaunchKernelGGL(dbg_checksum, dim3(1024), dim3(256), 0, stream, (const unsigned char*)d_ws, (float*)d_out);
#endif
#endif
}
```

```cpp
#include <hip/hip_runtime.h>
#include <hip/hip_cooperative_groups.h>
#include <cstdio>
#include <cstdint>
namespace cg = cooperative_groups;
namespace pg8 {
#define PG8_LAS __attribute__((address_space(3)))
typedef unsigned short bf16_t;
typedef short bf16x8 __attribute__((ext_vector_type(8)));
typedef float f32x4 __attribute__((ext_vector_type(4)));
typedef unsigned u32x4 __attribute__((ext_vector_type(4)));
constexpr int BM = 256, BK = 64, HALF = 128, HTB = HALF * BK * 2  , STAGE_BYTES = 8 * HTB, NXCD = 8, WGM = 8;

__host__ __device__ __forceinline__ int lds_byte(int r, int c) { const int st = (r >> 4) * 2 + (c >> 5), rr = r & 15, cc = c & 31, ob = rr * 64 + cc * 2; return st * 1024 + (ob ^ (((ob >> 9) & 1) << 5)); }
__host__ __device__ __forceinline__ void stage_rc(int b, int& R, int& C) { const int st = b / 1024, sb = b % 1024, swz = sb ^ (((sb >> 9) & 1) << 5); R = (st >> 1) * 16 + swz / 64; C = (st & 1) * 32 + (swz % 64) / 2; }
__host__ __device__ __forceinline__ int perm32(int rho) { const int n = rho >> 4, i = rho & 15; return 8 * (i >> 2) + 4 * n + (i & 3); }

struct Unit { int pm, pn; };
struct Gemm { const bf16_t* A; const bf16_t* Bt; int M, N, K; };

struct StaticOrder {
    int nM, nN, nwg, G, c;
    __host__ __device__ void init(int M, int N, int G_, int c_) { nM = M / BM; nN = N / BM; nwg = nM * nN; G = G_; c = c_; }
    __host__ __device__ bool next(int i, Unit& u) const {
        const long L = (long)i * G + c; if (L >= nwg) return false;
        int wgid = (int)L; { const int q = nwg / NXCD, r = nwg % NXCD, xcd = wgid % NXCD, off = wgid / NXCD; wgid = (xcd < r ? xcd * (q + 1) : r * (q + 1) + (xcd - r) * q) + off; }
        const int nig = WGM * nN, gid = wgid / nig, fm = gid * WGM, gsz = (nM - fm) < WGM ? (nM - fm) : WGM;
        u.pm = fm + ((wgid % nig) % gsz); u.pn = (wgid % nig) / gsz; return true;
    }
    __device__ __forceinline__ void a_ready(const Unit&) const {}
    __device__ __forceinline__ void done(const Unit&) const {}
};

typedef __bf16 bf16x2_hw __attribute__((ext_vector_type(2)));
typedef float f32x2_hw __attribute__((ext_vector_type(2)));
__device__ __forceinline__ unsigned cvt_pk_bf16(float lo, float hi) { const f32x2_hw v = {lo, hi}; return __builtin_bit_cast(unsigned, __builtin_convertvector(v, bf16x2_hw)); }
typedef float f32x2 __attribute__((ext_vector_type(2)));
__device__ __forceinline__ f32x2 gelu_pk(f32x2 v) {
    const f32x2 av = __builtin_elementwise_abs(v), d = av * 0.2316418882f + 1.0f;
    f32x2 t; t.x = __builtin_amdgcn_rcpf(d.x); t.y = __builtin_amdgcn_rcpf(d.y);
    f32x2 q = t * 0.5307027145f + (-0.7265760135f); q = q * t + 0.7107068705f; q = q * t + (-0.142248368f); q = q * t + 0.127414796f; q = q * t;
    const f32x2 s = (v * v) * (-0.72134752044f);
    f32x2 e; e.x = __builtin_amdgcn_exp2f(s.x); e.y = __builtin_amdgcn_exp2f(s.y);
    const f32x2 m = v * (q * e), r = v - m;
    f32x2 o; o.x = v.x < 0.f ? m.x : r.x; o.y = v.y < 0.f ? m.y : r.y; return o;
}

template <int ACT  > struct EpiBf16 {
    static constexpr bool PERM = true, AFTER_DRAIN = false; static_assert(ACT == 0 || ACT == 1, "EpiBf16: ACT is 0 (none) or 1 (gelu_pk)");
    bf16_t* O; int ldc; const float* bias; int split_cols; size_t split_stride; float scale0;
    __device__ __forceinline__ void operator()(const f32x4 (&acc)[2][2][4][2], const Unit& u, int wr, int wc, int fr, int fq) const {
        const int row0 = u.pm * BM + wr * 64 + fr; int colt = u.pn * BM; bf16_t* base = O;
        float sc = 1.f; if (split_cols) { const int t = colt / split_cols; base += (size_t)t * split_stride; colt -= t * split_cols; if (t == 0) sc = scale0; }
        const int col0 = colt + wc * 32 + 8 * fq, bcol0 = u.pn * BM + wc * 32 + 8 * fq;
        f32x4 bv[2][2];
#pragma unroll
        for (int bj = 0; bj < 2; ++bj)
#pragma unroll
            for (int n = 0; n < 2; ++n) bv[bj][n] = bias ? *(const f32x4*)(bias + bcol0 + bj * HALF + 4 * n) : (f32x4){0.f, 0.f, 0.f, 0.f};
#pragma unroll
        for (int ai = 0; ai < 2; ++ai)
#pragma unroll
            for (int m = 0; m < 4; ++m) { bf16_t* rowp = base + (size_t)(row0 + ai * HALF + m * 16) * ldc + col0;
#pragma unroll
                for (int bj = 0; bj < 2; ++bj) { f32x4 v0 = acc[ai][bj][m][0] + bv[bj][0], v1 = acc[ai][bj][m][1] + bv[bj][1];
                    if (ACT == 1) { f32x2 a = gelu_pk((f32x2){v0[0], v0[1]}), b = gelu_pk((f32x2){v0[2], v0[3]}), c = gelu_pk((f32x2){v1[0], v1[1]}), d = gelu_pk((f32x2){v1[2], v1[3]});
                        v0 = (f32x4){a.x, a.y, b.x, b.y}; v1 = (f32x4){c.x, c.y, d.x, d.y}; }
                    v0 = v0 * sc; v1 = v1 * sc; u32x4 w; w.x = cvt_pk_bf16(v0[0], v0[1]); w.y = cvt_pk_bf16(v0[2], v0[3]); w.z = cvt_pk_bf16(v1[0], v1[1]); w.w = cvt_pk_bf16(v1[2], v1[3]);
                    *(u32x4*)(rowp + bj * HALF) = w; } }
    }
};

struct PanelStats {
    unsigned* xbuf;
    unsigned* cnt;
    unsigned* tmo;
    int ntn; float eps;
    unsigned code;
    __device__ __forceinline__ bool run(const f32x4 (&v)[2][2][4][2], const Unit& u, int wr, int wc, int fr, int fq, PG8_LAS unsigned char* lds, int wid, int lane) const {
        typedef float f32x2v __attribute__((ext_vector_type(2)));
        PG8_LAS f32x2v* P = (PG8_LAS f32x2v*)lds;
        PG8_LAS f32x2v* S = (PG8_LAS f32x2v*)(lds + 8192);
        PG8_LAS unsigned* flag = (PG8_LAS unsigned*)(lds + 8192 + 2048);
#pragma unroll
        for (int ai = 0; ai < 2; ++ai)
#pragma unroll
            for (int m = 0; m < 4; ++m) {
                float s = 0.f;
#pragma unroll
                for (int bj = 0; bj < 2; ++bj)
#pragma unroll
                    for (int n = 0; n < 2; ++n) { const f32x4 x = v[ai][bj][m][n]; s += (x[0] + x[1]) + (x[2] + x[3]); }
                s += __shfl_xor(s, 16); s += __shfl_xor(s, 32);
                const float mw = s * (1.0f / 64.0f); float q = 0.f;
#pragma unroll
                for (int bj = 0; bj < 2; ++bj)
#pragma unroll
                    for (int n = 0; n < 2; ++n) { const f32x4 d = v[ai][bj][m][n] - mw; q += (d[0] * d[0] + d[1] * d[1]) + (d[2] * d[2] + d[3] * d[3]); }
                q += __shfl_xor(q, 16); q += __shfl_xor(q, 32);
                if (fq == 0) P[(ai * HALF + wr * 64 + m * 16 + fr) * 4 + wc] = (f32x2v){mw, q};
            }
        asm volatile("s_waitcnt lgkmcnt(0)" ::: "memory"); __builtin_amdgcn_s_barrier(); asm volatile("" ::: "memory");
#if defined(BROKEN_EXCHANGE_NO_WAIT)
#warning BROKEN CONTROL BUILD: the row-statistics exchange does not wait; results are wrong by design
        if (blockIdx.x >= 64) { const long long t0_ = clock64(); while (clock64() - t0_ < 60000) __builtin_amdgcn_s_sleep(8); }
#endif
        const int row = wid * 32 + (lane & 31);
        if (lane < 32) {
            const f32x2v a = P[row * 4 + 0], b = P[row * 4 + 1], c = P[row * 4 + 2], d = P[row * 4 + 3];
            const float mt = (a.x + b.x + c.x + d.x) * 0.25f;
            const float da = a.x - mt, db = b.x - mt, dc = c.x - mt, dd = d.x - mt;
            const float m2 = (a.y + b.y) + (c.y + d.y) + 64.0f * ((da * da + db * db) + (dc * dc + dd * dd));
            unsigned long long* slot = (unsigned long long*)xbuf + ((size_t)(u.pm * BM + row) * 4 + u.pn);
            __hip_atomic_store(slot, ((unsigned long long)__float_as_uint(m2) << 32) | __float_as_uint(mt), __ATOMIC_RELAXED, __HIP_MEMORY_SCOPE_AGENT);
        }
        asm volatile("s_waitcnt vmcnt(0)" ::: "memory");
        if (lane == 0) __hip_atomic_fetch_add(cnt + 64 * u.pm, 1u, __ATOMIC_RELAXED, __HIP_MEMORY_SCOPE_AGENT);
        if (wid == 0) {
            bool dead = false; const unsigned long long t0 = __builtin_amdgcn_s_memrealtime(); const unsigned want = 8u * (unsigned)ntn;
            for (;;) {
#if defined(BROKEN_EXCHANGE_NO_WAIT)
                break;
#endif
                if ((unsigned)__builtin_amdgcn_readfirstlane(__hip_atomic_load(cnt + 64 * u.pm, __ATOMIC_RELAXED, __HIP_MEMORY_SCOPE_AGENT)) >= want) break;
                if (__builtin_amdgcn_s_memrealtime() - t0 > 2000000ull) {
                    if (lane == 0) { unsigned expect = 0u; __hip_atomic_compare_exchange_strong(tmo + 1, &expect, code | (unsigned)(u.pm & 0xff), __ATOMIC_RELAXED, __ATOMIC_RELAXED, __HIP_MEMORY_SCOPE_AGENT);
                                     __hip_atomic_store(tmo, 1u, __ATOMIC_RELAXED, __HIP_MEMORY_SCOPE_AGENT); }
                    dead = true; break; }
                __builtin_amdgcn_s_sleep(2);
            }
            __builtin_amdgcn_fence(__ATOMIC_ACQUIRE, "agent");
            if (lane == 0) flag[0] = dead ? 1u : 0u;
        }
        asm volatile("s_waitcnt vmcnt(0) lgkmcnt(0)" ::: "memory"); __builtin_amdgcn_s_barrier(); asm volatile("" ::: "memory");
        const bool bad = flag[0] != 0u;
        if (lane < 32) {
            const unsigned long long* slot = (const unsigned long long*)xbuf + (size_t)(u.pm * BM + row) * 4; float mt[4], m2[4]; float ms = 0.f;
#pragma unroll
            for (int t = 0; t < 4; ++t) { if (t < ntn) { const unsigned long long w = __hip_atomic_load(slot + t, __ATOMIC_RELAXED, __HIP_MEMORY_SCOPE_AGENT); mt[t] = __uint_as_float((unsigned)w); m2[t] = __uint_as_float((unsigned)(w >> 32)); } else { mt[t] = 0.f; m2[t] = 0.f; } ms += mt[t]; }
            const float mean = ms / (float)ntn; float q = 0.f;
#pragma unroll
            for (int t = 0; t < 4; ++t) if (t < ntn) { const float dm = mt[t] - mean; q += m2[t] + 256.0f * dm * dm; }
            S[row] = (f32x2v){mean, 1.0f / sqrtf(q / (256.0f * (float)ntn) + eps)};
        }
        asm volatile("s_waitcnt lgkmcnt(0)" ::: "memory"); __builtin_amdgcn_s_barrier(); asm volatile("" ::: "memory");
        return bad;
    }
};
struct EpiLnRes {
    static constexpr bool PERM = false, AFTER_DRAIN = true;
    const float* base; float* out; int ldc; const float* bias; PanelStats st; unsigned poison;
    __device__ __forceinline__ void fused(f32x4 (&acc)[2][2][4][2], const Unit& u, int wr, int wc, int fr, int fq, PG8_LAS unsigned char* lds, int wid, int lane) const {
        typedef float f32x2v __attribute__((ext_vector_type(2)));
        const PG8_LAS f32x2v* S = (const PG8_LAS f32x2v*)(lds + 8192);
        const int col0 = u.pn * BM + wc * 32 + 4 * fq;
#pragma unroll
        for (int bj = 0; bj < 2; ++bj)
#pragma unroll
            for (int n = 0; n < 2; ++n) { const f32x4 bv = bias ? *(const f32x4*)(bias + col0 + bj * HALF + n * 16) : (f32x4){0.f, 0.f, 0.f, 0.f};
#pragma unroll
                for (int ai = 0; ai < 2; ++ai)
#pragma unroll
                    for (int m = 0; m < 4; ++m) acc[ai][bj][m][n] += bv; }
        f32x4 pre[4][2][2];
#pragma unroll
        for (int m = 0; m < 4; ++m) { const size_t off = (size_t)(u.pm * BM + wr * 64 + m * 16 + fr) * ldc + col0;
#pragma unroll
            for (int bj = 0; bj < 2; ++bj)
#pragma unroll
                for (int n = 0; n < 2; ++n) pre[m][bj][n] = *(const f32x4*)(base + off + bj * HALF + n * 16); }
        const bool bad = st.run(acc, u, wr, wc, fr, fq, lds, wid, lane) || poison != 0u;
        const float qnan = __builtin_nanf("");
#pragma unroll
        for (int ai = 0; ai < 2; ++ai)
#pragma unroll
            for (int m = 0; m < 4; ++m) { const int r = ai * HALF + wr * 64 + m * 16 + fr; const f32x2v sr = S[r]; const size_t off = (size_t)(u.pm * BM + r) * ldc + col0;
#pragma unroll
                for (int bj = 0; bj < 2; ++bj)
#pragma unroll
                    for (int n = 0; n < 2; ++n) { const f32x4 bs = ai == 0 ? pre[m][bj][n] : *(const f32x4*)(base + off + bj * HALF + n * 16); f32x4 o = bs + (acc[ai][bj][m][n] - sr.x) * sr.y;
                        if (bad) o = (f32x4){qnan, qnan, qnan, qnan}; *(f32x4*)(out + off + bj * HALF + n * 16) = o; }
                if (m & 1) asm volatile("" ::: "memory"); }
    }
};
struct EpiLnResLn {
    static constexpr bool PERM = false, AFTER_DRAIN = true;
    const float* base; float* out; bf16_t* xn; int ldc; const float* bias; PanelStats st1, st2; unsigned poison;
    __device__ __forceinline__ void fused(f32x4 (&acc)[2][2][4][2], const Unit& u, int wr, int wc, int fr, int fq, PG8_LAS unsigned char* lds, int wid, int lane) const {
        typedef float f32x2v __attribute__((ext_vector_type(2))); typedef unsigned u32x2v __attribute__((ext_vector_type(2)));
        const PG8_LAS f32x2v* S = (const PG8_LAS f32x2v*)(lds + 8192);
        const int col0 = u.pn * BM + wc * 32 + 4 * fq;
#pragma unroll
        for (int bj = 0; bj < 2; ++bj)
#pragma unroll
            for (int n = 0; n < 2; ++n) { const f32x4 bv = bias ? *(const f32x4*)(bias + col0 + bj * HALF + n * 16) : (f32x4){0.f, 0.f, 0.f, 0.f};
#pragma unroll
                for (int ai = 0; ai < 2; ++ai)
#pragma unroll
                    for (int m = 0; m < 4; ++m) acc[ai][bj][m][n] += bv; }
        bool bad = st1.run(acc, u, wr, wc, fr, fq, lds, wid, lane) || poison != 0u;
        const float qnan = __builtin_nanf("");
#pragma unroll
        for (int ai = 0; ai < 2; ++ai)
#pragma unroll
            for (int m = 0; m < 4; ++m) { const int r = ai * HALF + wr * 64 + m * 16 + fr; const f32x2v sr = S[r]; const size_t off = (size_t)(u.pm * BM + r) * ldc + col0;
#pragma unroll
                for (int bj = 0; bj < 2; ++bj)
#pragma unroll
                    for (int n = 0; n < 2; ++n) { const f32x4 bs = *(const f32x4*)(base + off + bj * HALF + n * 16); acc[ai][bj][m][n] = bs + (acc[ai][bj][m][n] - sr.x) * sr.y; }
                asm volatile("" : "+v"(acc[ai][0][m][0]), "+v"(acc[ai][0][m][1]), "+v"(acc[ai][1][m][0]), "+v"(acc[ai][1][m][1]));
                if (m & 1) asm volatile("" ::: "memory"); }
        const bool bad1 = bad;
        bad = st2.run(acc, u, wr, wc, fr, fq, lds, wid, lane) || bad;
#pragma unroll
        for (int ai = 0; ai < 2; ++ai)
#pragma unroll
            for (int m = 0; m < 4; ++m) { const int r = ai * HALF + wr * 64 + m * 16 + fr; const f32x2v sr = S[r]; const size_t off = (size_t)(u.pm * BM + r) * ldc + col0;
#pragma unroll
                for (int bj = 0; bj < 2; ++bj)
#pragma unroll
                    for (int n = 0; n < 2; ++n) { const f32x4 x1 = acc[ai][bj][m][n]; *(f32x4*)(out + off + bj * HALF + n * 16) = bad1 ? (f32x4){qnan, qnan, qnan, qnan} : x1;
                        const f32x4 o = (x1 - sr.x) * sr.y; u32x2v w; w.x = cvt_pk_bf16(o[0], o[1]); w.y = cvt_pk_bf16(o[2], o[3]);
                        if (bad) { w.x = 0x7fc07fc0u; w.y = 0x7fc07fc0u; } *(u32x2v*)(xn + off + bj * HALF + n * 16) = w; }
                asm volatile("" ::: "memory"); }
    }
};

template <class Epi, class Sched, bool ALIGN_EPI = false, bool SP2 = false>
__device__ __forceinline__ void gemm_phase(PG8_LAS unsigned char* lds, const Gemm g, const Sched& S, const Epi& E) {
    int tid_ = threadIdx.x; asm volatile("" : "+v"(tid_));
    const int tid = tid_, wid = __builtin_amdgcn_readfirstlane(tid >> 6), lane = tid & 63, wr = wid >> 2, wc = wid & 3, fr = lane & 15, fq = lane >> 4;
    const int K = g.K, nt = K / BK;
    unsigned voffA[2], voffB[2];
#pragma unroll
    for (int i = 0; i < 2; ++i) { int R, C; stage_rc(tid * 16 + i * 8192, R, C); const int Rb = Epi::PERM ? ((R & ~31) + perm32(R & 31)) : R;
        voffA[i] = (unsigned)(R * K + C) * 2u; voffB[i] = (unsigned)(Rb * K + C) * 2u; }
    const size_t kstep = (size_t)(BK * 2);
    const size_t hstep = (size_t)HALF * K * 2;
    const size_t tstep = 2 * hstep;
    const unsigned ldsw = (unsigned)wid * 1024u;
    const int aoff = lds_byte(wr * 64 + fr, fq * 8), boff = lds_byte(wc * 32 + fr, fq * 8);
#define PG8_SA(b, h) (((b) * 2 + (h)) * HTB)
#define PG8_SB(b, h) ((4 + (b) * 2 + (h)) * HTB)
#define PG8_STAGE(bufoff, gbase, voff) do { _Pragma("unroll") for (int _i = 0; _i < 2; ++_i) \
        __builtin_amdgcn_global_load_lds((const unsigned*)((const char*)(gbase) + (voff)[_i]), (PG8_LAS unsigned*)(lds + (bufoff) + ldsw + _i * 8192), 16, 0, 0); } while (0)
#define PG8_LDA(dst, b, h) do { _Pragma("unroll") for (int m = 0; m < 4; ++m) _Pragma("unroll") for (int k = 0; k < 2; ++k) dst[m][k] = *(const PG8_LAS bf16x8*)(lds + PG8_SA(b, h) + aoff + m * 2048 + k * 1024); } while (0)
#define PG8_LDB(dst, b, h) do { _Pragma("unroll") for (int n = 0; n < 2; ++n) _Pragma("unroll") for (int k = 0; k < 2; ++k) dst[n][k] = *(const PG8_LAS bf16x8*)(lds + PG8_SB(b, h) + boff + n * 2048 + k * 1024); } while (0)
#define PG8_MMA(ai, bj, At, Bt) do { __builtin_amdgcn_s_setprio(1); _Pragma("unroll") for (int m = 0; m < 4; ++m) _Pragma("unroll") for (int n = 0; n < 2; ++n) _Pragma("unroll") for (int k = 0; k < 2; ++k) \
        acc[ai][bj][m][n] = __builtin_amdgcn_mfma_f32_16x16x32_bf16(Bt[n][k], At[m][k], acc[ai][bj][m][n], 0, 0, 0); __builtin_amdgcn_s_setprio(0); } while (0)
#define PG8_WAIT_V(n) asm volatile("s_waitcnt vmcnt(" #n ")" ::: "memory")
#define PG8_WAIT_L(n) asm volatile("s_waitcnt lgkmcnt(" #n ")" ::: "memory")
#define PG8_BAR __builtin_amdgcn_s_barrier()
#define PG8_SCHED __builtin_amdgcn_sched_barrier(0)
    Unit cur, nxt; int ui = 0;
    if (!S.next(0, cur)) return;
    f32x4 acc[2][2][4][2];
#pragma unroll
    for (int a = 0; a < 2; ++a)
#pragma unroll
        for (int b = 0; b < 2; ++b)
#pragma unroll
            for (int m = 0; m < 4; ++m)
#pragma unroll
                for (int n = 0; n < 2; ++n) acc[a][b][m][n] = (f32x4){0.f, 0.f, 0.f, 0.f};
    bf16x8 At[4][2], B0[2][2], B1[2][2];
    const char* cA = (const char*)g.A + (size_t)cur.pm * tstep; const char* cB = (const char*)g.Bt + (size_t)cur.pn * tstep;
    S.a_ready(cur);
    if constexpr (SP2) {
        PG8_STAGE(PG8_SB(0, 0), cB, voffB); PG8_STAGE(PG8_SB(0, 1), cB + hstep, voffB); PG8_STAGE(PG8_SA(0, 0), cA, voffA); PG8_STAGE(PG8_SA(0, 1), cA + hstep, voffA);
        if (wr == 1) PG8_BAR;
        PG8_WAIT_V(2); PG8_BAR;
        PG8_STAGE(PG8_SB(1, 0), cB + kstep, voffB); PG8_STAGE(PG8_SA(1, 0), cA + kstep, voffA); PG8_STAGE(PG8_SB(1, 1), cB + hstep + kstep, voffB);
        PG8_WAIT_V(6); PG8_BAR;
    } else {
        PG8_STAGE(PG8_SB(0, 0), cB, voffB); PG8_STAGE(PG8_SA(0, 0), cA, voffA); PG8_STAGE(PG8_SB(0, 1), cB + hstep, voffB); PG8_STAGE(PG8_SA(0, 1), cA + hstep, voffA);
        if (wr == 1) PG8_BAR;
        PG8_WAIT_V(4); PG8_BAR;
        PG8_STAGE(PG8_SB(1, 0), cB + kstep, voffB); PG8_STAGE(PG8_SA(1, 0), cA + kstep, voffA); PG8_STAGE(PG8_SB(1, 1), cB + hstep + kstep, voffB);
        PG8_WAIT_V(6); PG8_BAR;
    }
    for (;;) {
        const bool has_next = S.next(ui + 1, nxt);
        const char* nA = has_next ? (const char*)g.A + (size_t)nxt.pm * tstep : cA; const char* nB = has_next ? (const char*)g.Bt + (size_t)nxt.pn * tstep : cB;
        for (int t = 0; t < nt; t += 2) {
            const bool last = (t == nt - 2);
            const char* a1 = cA + (size_t)(t + 1) * kstep;
            const char* a2 = last ? nA : cA + (size_t)(t + 2) * kstep; const char* b2 = last ? nB : cB + (size_t)(t + 2) * kstep;
            const char* a3 = a2 + kstep; const char* b3 = b2 + kstep;
            if (last && has_next) S.a_ready(nxt);
            if constexpr (SP2) {
            PG8_LDB(B0, 0, 0); PG8_LDB(B1, 0, 1); PG8_SCHED; PG8_LDA(At, 0, 0); PG8_STAGE(PG8_SA(1, 1), a1 + hstep, voffA);
            PG8_WAIT_V(8); PG8_WAIT_L(0); PG8_BAR; PG8_MMA(0, 0, At, B0); PG8_MMA(0, 1, At, B1); PG8_BAR; PG8_SCHED;
            PG8_LDA(At, 0, 1); PG8_STAGE(PG8_SB(0, 0), b2, voffB); PG8_STAGE(PG8_SB(0, 1), b2 + hstep, voffB); PG8_STAGE(PG8_SA(0, 0), a2, voffA);
            PG8_WAIT_V(8); PG8_WAIT_L(0); PG8_BAR; PG8_MMA(1, 0, At, B0); PG8_MMA(1, 1, At, B1); PG8_BAR; PG8_SCHED;
            PG8_LDB(B0, 1, 0); PG8_LDB(B1, 1, 1); PG8_SCHED; PG8_LDA(At, 1, 0); PG8_STAGE(PG8_SA(0, 1), a2 + hstep, voffA);
            PG8_WAIT_V(8); PG8_WAIT_L(0); PG8_BAR; PG8_MMA(0, 0, At, B0); PG8_MMA(0, 1, At, B1); PG8_BAR; PG8_SCHED;
            PG8_LDA(At, 1, 1); PG8_STAGE(PG8_SB(1, 0), b3, voffB); PG8_STAGE(PG8_SB(1, 1), b3 + hstep, voffB); PG8_STAGE(PG8_SA(1, 0), a3, voffA);
            PG8_WAIT_V(8); PG8_WAIT_L(0); PG8_BAR; PG8_MMA(1, 0, At, B0); PG8_MMA(1, 1, At, B1); PG8_BAR; PG8_SCHED;
            } else {
            PG8_LDB(B0, 0, 0); PG8_SCHED; PG8_LDA(At, 0, 0); PG8_STAGE(PG8_SA(1, 1), a1 + hstep, voffA);
            PG8_WAIT_L(8); PG8_BAR; PG8_WAIT_L(0); PG8_MMA(0, 0, At, B0); PG8_BAR; PG8_SCHED;
            PG8_LDB(B1, 0, 1); PG8_STAGE(PG8_SB(0, 0), b2, voffB);
            PG8_BAR; PG8_WAIT_L(0); PG8_MMA(0, 1, At, B1); PG8_BAR;
            PG8_LDA(At, 0, 1); PG8_STAGE(PG8_SA(0, 0), a2, voffA);
            PG8_BAR; PG8_WAIT_L(0); PG8_MMA(1, 0, At, B0); PG8_BAR; PG8_SCHED;
            PG8_STAGE(PG8_SB(0, 1), b2 + hstep, voffB);
            PG8_WAIT_V(6); PG8_BAR; PG8_MMA(1, 1, At, B1); PG8_BAR;
            PG8_LDB(B0, 1, 0); PG8_SCHED; PG8_LDA(At, 1, 0); PG8_STAGE(PG8_SA(0, 1), a2 + hstep, voffA);
            PG8_WAIT_L(8); PG8_BAR; PG8_WAIT_L(0); PG8_MMA(0, 0, At, B0); PG8_BAR; PG8_SCHED;
            PG8_LDB(B1, 1, 1); PG8_STAGE(PG8_SB(1, 0), b3, voffB);
            PG8_BAR; PG8_WAIT_L(0); PG8_MMA(0, 1, At, B1); PG8_BAR;
            PG8_LDA(At, 1, 1); PG8_STAGE(PG8_SA(1, 0), a3, voffA);
            PG8_BAR; PG8_WAIT_L(0); PG8_MMA(1, 0, At, B0); PG8_BAR; PG8_SCHED;
            PG8_STAGE(PG8_SB(1, 1), b3 + hstep, voffB);
            PG8_WAIT_V(6); PG8_BAR; PG8_MMA(1, 1, At, B1); PG8_BAR;
            }
        }
        if constexpr (ALIGN_EPI) { if (wr == 0) PG8_BAR; }
        if constexpr (Epi::CHAIN) { if (has_next) E.mid(acc, cur, wr, wc, fr, fq); else E(acc, cur, wr, wc, fr, fq); }
        else if constexpr (!Epi::AFTER_DRAIN) { E(acc, cur, wr, wc, fr, fq); S.done(cur); }
        if (!has_next) break;
        if constexpr (!Epi::CHAIN) {
#pragma unroll
        for (int a = 0; a < 2; ++a)
#pragma unroll
            for (int b = 0; b < 2; ++b)
#pragma unroll
                for (int m = 0; m < 4; ++m)
#pragma unroll
                    for (int n = 0; n < 2; ++n) acc[a][b][m][n] = (f32x4){0.f, 0.f, 0.f, 0.f};
        }
        cur = nxt; cA = nA; cB = nB; ++ui;
        if constexpr (ALIGN_EPI) { if (wr == 1) PG8_BAR; }
    }
    PG8_WAIT_V(0);
    if constexpr (!ALIGN_EPI) { if (wr == 0) PG8_BAR; }
    PG8_BAR;
    if constexpr (Epi::AFTER_DRAIN) { E.fused(acc, cur, wr, wc, fr, fq, lds, wid, lane); S.done(cur); }
#undef PG8_SA
#undef PG8_SB
#undef PG8_STAGE
#undef PG8_LDA
#undef PG8_LDB
#undef PG8_MMA
#undef PG8_WAIT_V
#undef PG8_WAIT_L
#undef PG8_BAR
#undef PG8_SCHED
}
}

#define LAS __attribute__((address_space(3)))
typedef unsigned short bf16;
typedef float f32x4 __attribute__((ext_vector_type(4)));
typedef float f32x2 __attribute__((ext_vector_type(2)));
typedef short bf16x8 __attribute__((ext_vector_type(8)));
typedef short s16x4 __attribute__((ext_vector_type(4)));
typedef short v4i16_t __attribute__((ext_vector_type(4)));
typedef unsigned u32x4 __attribute__((ext_vector_type(4)));
typedef unsigned u32x2 __attribute__((ext_vector_type(2)));

constexpr int NWAVES = 8, NTHREADS = 512;
constexpr int DM = 1024, SEQ = 4096, NBATCH = 4, MP = NBATCH * SEQ, NSMP = 32, MV = MP + NSMP, MT = 16640;
constexpr int DIN = 7680, QKV = 1536, DFF = 2816, NADA = 6144;
constexpr size_t O_YP = 0, O_YS = 16777216, O_KV0P = 16809984, O_KV1P = 17858560, O_KV2P = 22052864,
                 O_KV0S = 38830080, O_KV1S = 38895616, O_KV2S = 38961152, O_SV = 39026688, O_END = 39059456;
constexpr float LOG2E = 1.4426950408889634f;
constexpr float QSCALE = 0.08838834764831845f * LOG2E;

constexpr size_t MiB = 1u << 20;
constexpr size_t alm(size_t x) { return (x + MiB - 1) / MiB * MiB; }
constexpr size_t WS_WADA = 1 * MiB;
constexpr size_t WS_WL0 = WS_WADA + alm(2ull * NADA * DM * 2);
constexpr size_t WL_WIN = 0;
constexpr size_t WL_WPA = WL_WIN + alm((size_t)DIN * DM * 2);
constexpr size_t WL_WPS = WL_WPA + alm(1024ull * 512 * 2);
constexpr size_t WL_WOUT = WL_WPS + alm(1024ull * 512 * 2);
constexpr size_t WL_WFI = WL_WOUT + alm(1024ull * 1024 * 2);
constexpr size_t WL_WFO = WL_WFI + alm(5632ull * 1024 * 2);
constexpr size_t WL_WSP = WL_WFO + alm(1024ull * DFF * 2);
constexpr size_t WL_SIZE = WL_WSP + alm(8ull * 128 * 128 * 2);
constexpr size_t WS_MOD = WS_WL0 + 2 * WL_SIZE;
constexpr size_t WS_SC = WS_MOD + alm(2ull * 36 * NADA * 4);
constexpr size_t WS_XN = WS_SC + alm(256ull * DM * 2);
constexpr size_t WS_Q = WS_XN + alm((size_t)MT * DM * 2);
constexpr size_t WS_K = WS_Q + alm((size_t)MT * QKV * 2);
constexpr size_t WS_V = WS_K + alm((size_t)MT * QKV * 2);
constexpr size_t WS_U = WS_V + alm((size_t)MT * QKV * 2);
constexpr size_t WS_VS = WS_U + alm((size_t)MT * 512 * 2);
constexpr size_t WS_G = WS_VS + alm((size_t)MT * 512 * 2);
constexpr size_t WS_OG = WS_G + alm((size_t)MT * 2048 * 2);
constexpr size_t WS_DG = WS_OG + alm((size_t)MT * QKV * 2);
constexpr size_t WS_YY = WS_DG + alm((size_t)MT * 12 * 4);
constexpr size_t WS_T1 = WS_YY + alm((size_t)(2 * MP + 64) * 512 * 2);
constexpr size_t WS_MG = WS_T1 + alm((size_t)MT * DM * 4);
constexpr size_t WS_X1 = WS_MG + alm((size_t)MT * DM * 2);
constexpr size_t WS_X2 = WS_X1 + alm((size_t)MT * DM * 4);
constexpr size_t WS_H = WS_X2 + alm((size_t)MT * DM * 4);
constexpr size_t WS_END = WS_H + alm((size_t)MT * DFF * 2);

constexpr int LDS_RING = 0, LDS_EXCH = 131072, LDS_BYTES = 155648;

__device__ __forceinline__ float bf2f(unsigned short h) { return __uint_as_float((unsigned)h << 16); }
__device__ __forceinline__ unsigned pk2(float lo, float hi) { return pg8::cvt_pk_bf16(lo, hi); }
__device__ __forceinline__ float fast_exp2(float x) { return __builtin_amdgcn_exp2f(x); }
__device__ __forceinline__ float sigmoidf_(float x) { return __builtin_amdgcn_rcpf(1.0f + fast_exp2(-x * LOG2E)); }
__device__ __forceinline__ float wave_sum(float v) {
#pragma unroll
    for (int o = 1; o < 64; o <<= 1) v += __shfl_xor(v, o);
    return v;
}
__device__ __forceinline__ float wave_max(float v) {
#pragma unroll
    for (int o = 1; o < 64; o <<= 1) v = fmaxf(v, __shfl_xor(v, o));
    return v;
}
__device__ __forceinline__ s16x4 vtr(const LAS unsigned char* p) { return __builtin_bit_cast(s16x4, __builtin_amdgcn_ds_read_tr16_b64_v4i16((LAS v4i16_t*)p)); }
#define LDS_WAIT() asm volatile("s_waitcnt lgkmcnt(0)" ::: "memory")

__device__ __forceinline__ int mod_row(int row) { return row < MP ? (row >> 12) : 4 + (row - MP); }

__device__ __forceinline__ __attribute__((address_space(1))) float* kv_out_ptr(__attribute__((address_space(1))) float* out, int layer, int g, int row, int kvi, int hh) {
    if (row < MP) {
        const int b = row >> 12, t = row & 4095, lw = 128 << (2 * g), tt = t - (SEQ - lw);
        if (tt < 0) return nullptr;
        const size_t base = g == 0 ? O_KV0P : (g == 1 ? O_KV1P : O_KV2P);
        return out + base + ((((size_t)(layer * NBATCH + b) * lw + tt) * 2 + kvi) * 4 + hh) * 128;
    } else if (row < MV) {
        const int b = row - MP;
        const size_t base = g == 0 ? O_KV0S : (g == 1 ? O_KV1S : O_KV2S);
        return out + base + (((size_t)(layer * NSMP + b) * 2 + kvi) * 4 + hh) * 128;
    }
    return nullptr;
}

using pg8::Unit;
typedef pg8::f32x4 (AccT)[2][2][4][2];

__device__ __forceinline__ void st8_bf16g(__attribute__((address_space(1))) bf16* p, f32x4 v0, f32x4 v1) {
    u32x4 w; w.x = pk2(v0[0], v0[1]); w.y = pk2(v0[2], v0[3]); w.z = pk2(v1[0], v1[1]); w.w = pk2(v1[2], v1[3]);
    *(__attribute__((address_space(1))) u32x4*)p = w;
}
__device__ __forceinline__ void st8_bf16(bf16* p, f32x4 v0, f32x4 v1) {
    u32x4 w; w.x = pk2(v0[0], v0[1]); w.y = pk2(v0[2], v0[3]); w.z = pk2(v1[0], v1[1]); w.w = pk2(v1[2], v1[3]);
    *(u32x4*)p = w;
}

#define LAUNDER_S(x) asm volatile("" : "+s"(x))
#define GP(T, p) ((T*)(__attribute__((address_space(1))) T*)(p))
struct EpiAda {
    static constexpr bool PERM = true, AFTER_DRAIN = false, CHAIN = false;
    float* MOD; const float* b_ada;
    __device__ __forceinline__ void operator()(const pg8::f32x4 (&acc)[2][2][4][2], const Unit& u, int wr, int wc, int fr_, int fq_) const {
        int fr = fr_, fq = fq_; asm volatile("" : "+v"(fr), "+v"(fq));
        if (u.pm != 0 || wr != 0) return;
#pragma unroll
        for (int m = 0; m < 3; ++m) {
            const int row = m * 16 + fr;
            if (row >= 36) continue;
#pragma unroll
            for (int bj = 0; bj < 2; ++bj) {
                const int col = u.pn * 256 + bj * 128 + wc * 32 + 8 * fq;
                const int layer = col / NADA, c = col - layer * NADA;
                const float* bp = b_ada + (size_t)layer * NADA + c;
                float* op = MOD + ((size_t)layer * 36 + row) * NADA + c;
                *(f32x4*)op = acc[0][bj][m][0] + *(const f32x4*)bp;
                *(f32x4*)(op + 4) = acc[0][bj][m][1] + *(const f32x4*)(bp + 4);
            }
        }
    }
};

struct EpiIn {
    static constexpr bool PERM = true, AFTER_DRAIN = false, CHAIN = false;
    unsigned char* wsb; const float* qw; const float* kw; float* out; int layer; LAS float* P;
    __device__ __forceinline__ void operator()(const pg8::f32x4 (&acc)[2][2][4][2], const Unit& u, int wr, int wc, int fr_, int fq_) const {
        int fr = fr_, fq = fq_; asm volatile("" : "+v"(fr), "+v"(fq));
        unsigned char* wsl = wsb; const float* qwl = qw; const float* kwl = kw; float* outl = out; LAUNDER_S(wsl); LAUNDER_S(qwl); LAUNDER_S(kwl); LAUNDER_S(outl);
        typedef __attribute__((address_space(1))) bf16 gbf; typedef __attribute__((address_space(1))) float gfl;
        gbf *Q = (gbf*)(wsl + WS_Q), *K = (gbf*)(wsl + WS_K), *V = (gbf*)(wsl + WS_V), *U = (gbf*)(wsl + WS_U), *VS = (gbf*)(wsl + WS_VS), *G = (gbf*)(wsl + WS_G);
        gfl* outg = (gfl*)outl;
        const int pn = u.pn;
        const int cw = wc * 32 + 8 * fq;
        const int rowb = u.pm * 256 + wr * 64 + fr;
        if (pn < 12) {
            const bool isk = pn >= 6;
#pragma unroll
            for (int ai = 0; ai < 2; ++ai)
#pragma unroll
                for (int m = 0; m < 4; ++m)
#pragma unroll
                    for (int bj = 0; bj < 2; ++bj) {
                        const pg8::f32x4 a = acc[ai][bj][m][0], b = acc[ai][bj][m][1];
                        float s = (a[0] * a[0] + a[1] * a[1]) + (a[2] * a[2] + a[3] * a[3]) + (b[0] * b[0] + b[1] * b[1]) + (b[2] * b[2] + b[3] * b[3]);
                        s += __shfl_xor(s, 16); s += __shfl_xor(s, 32);
                        if (fq == 0) P[(ai * 128 + wr * 64 + m * 16 + fr) * 8 + bj * 4 + wc] = s;
                    }
            asm volatile("s_waitcnt lgkmcnt(0)" ::: "memory"); __builtin_amdgcn_s_barrier(); asm volatile("" ::: "memory");
#pragma unroll
            for (int bj = 0; bj < 2; ++bj) {
                const int head = 2 * (isk ? pn - 6 : pn) + bj, g = head >> 2, hh = head & 3;
                const __attribute__((address_space(1))) float* wv = (const __attribute__((address_space(1))) float*)(isk ? kwl : qwl) + g * 128 + cw;
                pg8::f32x4 w0 = *(const __attribute__((address_space(1))) f32x4*)wv, w1 = *(const __attribute__((address_space(1))) f32x4*)(wv + 4);
                if (!isk) { w0 = w0 * QSCALE; w1 = w1 * QSCALE; }
                gbf* dst = (isk ? K : Q) + head * 128 + cw;
#pragma unroll
                for (int ai = 0; ai < 2; ++ai)
#pragma unroll
                    for (int m = 0; m < 4; ++m) {
                        const int rl = ai * 128 + wr * 64 + m * 16 + fr, row = u.pm * 256 + rl;
                        const f32x4 pv = *(const LAS f32x4*)(P + rl * 8 + bj * 4);
                        const float rstd = 1.0f / sqrtf(((pv[0] + pv[1]) + (pv[2] + pv[3])) * (1.0f / 128.0f) + 1e-6f);
                        const pg8::f32x4 v0 = acc[ai][bj][m][0] * rstd * w0, v1 = acc[ai][bj][m][1] * rstd * w1;
                        st8_bf16g(dst + (size_t)row * QKV, v0, v1);
                        if (isk) { gfl* o = kv_out_ptr(outg, layer, g, row, 0, hh); if (o) { *(__attribute__((address_space(1))) f32x4*)(o + cw) = v0; *(__attribute__((address_space(1))) f32x4*)(o + cw + 4) = v1; } }
                    }
            }
        } else if (pn < 18) {
#pragma unroll
            for (int bj = 0; bj < 2; ++bj) {
                const int head = 2 * (pn - 12) + bj, g = head >> 2, hh = head & 3;
                gbf* dst = V + head * 128 + cw;
#pragma unroll
                for (int ai = 0; ai < 2; ++ai)
#pragma unroll
                    for (int m = 0; m < 4; ++m) {
                        const int row = rowb + ai * 128 + m * 16;
                        const pg8::f32x4 v0 = acc[ai][bj][m][0], v1 = acc[ai][bj][m][1];
                        st8_bf16g(dst + (size_t)row * QKV, v0, v1);
                        gfl* o = kv_out_ptr(outg, layer, g, row, 1, hh); if (o) { *(__attribute__((address_space(1))) f32x4*)(o + cw) = v0; *(__attribute__((address_space(1))) f32x4*)(o + cw + 4) = v1; }
                    }
            }
        } else if (pn < 22) {
            gbf* base = (pn < 20 ? U : VS) + ((pn - 18) & 1) * 256 + cw;
#pragma unroll
            for (int bj = 0; bj < 2; ++bj)
#pragma unroll
                for (int ai = 0; ai < 2; ++ai)
#pragma unroll
                    for (int m = 0; m < 4; ++m) {
                        const int row = rowb + ai * 128 + m * 16;
                        const pg8::f32x4 v0 = acc[ai][bj][m][0], v1 = acc[ai][bj][m][1];
                        const pg8::f32x2 a = pg8::gelu_pk((pg8::f32x2){v0[0], v0[1]}), b = pg8::gelu_pk((pg8::f32x2){v0[2], v0[3]}),
                                         c = pg8::gelu_pk((pg8::f32x2){v1[0], v1[1]}), d = pg8::gelu_pk((pg8::f32x2){v1[2], v1[3]});
                        st8_bf16g(base + (size_t)row * 512 + bj * 128, (f32x4){a.x, a.y, b.x, b.y}, (f32x4){c.x, c.y, d.x, d.y});
                    }
        } else {
            gbf* base = G + (pn - 22) * 256 + cw;
#pragma unroll
            for (int bj = 0; bj < 2; ++bj)
#pragma unroll
                for (int ai = 0; ai < 2; ++ai)
#pragma unroll
                    for (int m = 0; m < 4; ++m) {
                        const int row = rowb + ai * 128 + m * 16;
                        const pg8::f32x4 v0 = acc[ai][bj][m][0], v1 = acc[ai][bj][m][1];
                        st8_bf16g(base + (size_t)row * 2048 + bj * 128,
                                 (f32x4){sigmoidf_(v0[0]), sigmoidf_(v0[1]), sigmoidf_(v0[2]), sigmoidf_(v0[3])},
                                 (f32x4){sigmoidf_(v1[0]), sigmoidf_(v1[1]), sigmoidf_(v1[2]), sigmoidf_(v1[3])});
                    }
        }
    }
};

struct EpiGate1 {
    static constexpr bool PERM = true, AFTER_DRAIN = false, CHAIN = false;
    const bf16* G; float* T1;
    __device__ __forceinline__ void operator()(const pg8::f32x4 (&acc)[2][2][4][2], const Unit& u, int wr, int wc, int fr_, int fq_) const {
        int fr = fr_, fq = fq_; asm volatile("" : "+v"(fr), "+v"(fq));
        const int col0 = u.pn * 256 + wc * 32 + 8 * fq, rowb = u.pm * 256 + wr * 64 + fr;
#pragma unroll
        for (int ai = 0; ai < 2; ++ai)
#pragma unroll
            for (int m = 0; m < 4; ++m) {
                const int row = rowb + ai * 128 + m * 16;
#pragma unroll
                for (int bj = 0; bj < 2; ++bj) {
                    const int col = col0 + bj * 128;
                    const u32x4 gv = *(const u32x4*)(G + (size_t)row * 2048 + col);
                    const f32x4 g0 = {__uint_as_float(gv.x << 16), __uint_as_float(gv.x & 0xffff0000u), __uint_as_float(gv.y << 16), __uint_as_float(gv.y & 0xffff0000u)};
                    const f32x4 g1 = {__uint_as_float(gv.z << 16), __uint_as_float(gv.z & 0xffff0000u), __uint_as_float(gv.w << 16), __uint_as_float(gv.w & 0xffff0000u)};
                    float* o = T1 + (size_t)row * DM + col;
                    *(f32x4*)o = g0 * acc[ai][bj][m][0]; *(f32x4*)(o + 4) = g1 * acc[ai][bj][m][1];
                }
            }
    }
};
struct EpiGate2 {
    static constexpr bool PERM = true, AFTER_DRAIN = false, CHAIN = false;
    const bf16* G; const float* T1; bf16* MG;
    __device__ __forceinline__ void operator()(const pg8::f32x4 (&acc)[2][2][4][2], const Unit& u, int wr, int wc, int fr_, int fq_) const {
        int fr = fr_, fq = fq_; asm volatile("" : "+v"(fr), "+v"(fq));
        const int col0 = u.pn * 256 + wc * 32 + 8 * fq, rowb = u.pm * 256 + wr * 64 + fr;
#pragma unroll
        for (int ai = 0; ai < 2; ++ai)
#pragma unroll
            for (int m = 0; m < 4; ++m) {
                const int row = rowb + ai * 128 + m * 16;
#pragma unroll
                for (int bj = 0; bj < 2; ++bj) {
                    const int col = col0 + bj * 128;
                    const u32x4 gv = *(const u32x4*)(G + (size_t)row * 2048 + 1024 + col);
                    const f32x4 g0 = {__uint_as_float(gv.x << 16), __uint_as_float(gv.x & 0xffff0000u), __uint_as_float(gv.y << 16), __uint_as_float(gv.y & 0xffff0000u)};
                    const f32x4 g1 = {__uint_as_float(gv.z << 16), __uint_as_float(gv.z & 0xffff0000u), __uint_as_float(gv.w << 16), __uint_as_float(gv.w & 0xffff0000u)};
                    const float* t = T1 + (size_t)row * DM + col;
                    const f32x4 t0 = *(const f32x4*)t, t1 = *(const f32x4*)(t + 4);
                    st8_bf16(MG + (size_t)row * DM + col, t0 + g0 * acc[ai][bj][m][0], t1 + g1 * acc[ai][bj][m][1]);
                }
            }
    }
};

struct PairOrder {
    pg8::StaticOrder S0;
    __device__ bool next(int i, Unit& u) const { if (i >= 2) return false; Unit b; if (!S0.next(0, b)) return false; u.pm = b.pm + (i ? MP / 256 : 0); u.pn = b.pn + (i ? 4 : 0); return true; }
    __device__ __forceinline__ void a_ready(const Unit&) const {}
    __device__ __forceinline__ void done(const Unit&) const {}
};
__device__ __forceinline__ void unpack8(const u32x4 gv, f32x4& g0, f32x4& g1) {
    g0 = (f32x4){__uint_as_float(gv.x << 16), __uint_as_float(gv.x & 0xffff0000u), __uint_as_float(gv.y << 16), __uint_as_float(gv.y & 0xffff0000u)};
    g1 = (f32x4){__uint_as_float(gv.z << 16), __uint_as_float(gv.z & 0xffff0000u), __uint_as_float(gv.w << 16), __uint_as_float(gv.w & 0xffff0000u)};
}
struct EpiMerged {
    static constexpr bool PERM = true, AFTER_DRAIN = false, CHAIN = true;
    const bf16* G; bf16* MG;
    __device__ __forceinline__ void mid(pg8::f32x4 (&acc)[2][2][4][2], const Unit& u, int wr, int wc, int fr_, int fq_) const {
        int fr = fr_, fq = fq_; asm volatile("" : "+v"(fr), "+v"(fq));
        const int col0 = u.pn * 256 + wc * 32 + 8 * fq, rowb = u.pm * 256 + wr * 64 + fr;
#pragma unroll
        for (int ai = 0; ai < 2; ++ai)
#pragma unroll
            for (int m = 0; m < 4; ++m) {
                const int row = rowb + ai * 128 + m * 16;
#pragma unroll
                for (int bj = 0; bj < 2; ++bj) {
                    const int col = col0 + bj * 128;
                    f32x4 a0, a1, b0, b1;
                    unpack8(*(const u32x4*)(G + (size_t)row * 2048 + col), a0, a1);
                    unpack8(*(const u32x4*)(G + (size_t)row * 2048 + 1024 + col), b0, b1);
#pragma unroll
                    for (int e = 0; e < 4; ++e) {
                        acc[ai][bj][m][0][e] *= a0[e] * __builtin_amdgcn_rcpf(fmaxf(b0[e], 1e-30f));
                        acc[ai][bj][m][1][e] *= a1[e] * __builtin_amdgcn_rcpf(fmaxf(b1[e], 1e-30f));
                    }
                }
            }
    }
    __device__ __forceinline__ void operator()(const pg8::f32x4 (&acc)[2][2][4][2], const Unit& u, int wr, int wc, int fr_, int fq_) const {
        int fr = fr_, fq = fq_; asm volatile("" : "+v"(fr), "+v"(fq));
        const int col0 = (u.pn - 4) * 256 + wc * 32 + 8 * fq, rowb = (u.pm - MP / 256) * 256 + wr * 64 + fr;
#pragma unroll
        for (int ai = 0; ai < 2; ++ai)
#pragma unroll
            for (int m = 0; m < 4; ++m) {
                const int row = rowb + ai * 128 + m * 16;
#pragma unroll
                for (int bj = 0; bj < 2; ++bj) {
                    const int col = col0 + bj * 128;
                    f32x4 b0, b1;
                    unpack8(*(const u32x4*)(G + (size_t)row * 2048 + 1024 + col), b0, b1);
                    st8_bf16(MG + (size_t)row * DM + col, b0 * acc[ai][bj][m][0], b1 * acc[ai][bj][m][1]);
                }
            }
    }
};
struct EpiRes {
    static constexpr bool PERM = true, AFTER_DRAIN = false, CHAIN = false;
    const float* bp; const float* bs; float* op; float* os; const float* gate;
    __device__ __forceinline__ void operator()(const pg8::f32x4 (&acc)[2][2][4][2], const Unit& u, int wr, int wc, int fr_, int fq_) const {
        int fr = fr_, fq = fq_; asm volatile("" : "+v"(fr), "+v"(fq));
        const int col0 = u.pn * 256 + wc * 32 + 8 * fq, rowb = u.pm * 256 + wr * 64 + fr;
#pragma unroll
        for (int ai = 0; ai < 2; ++ai)
#pragma unroll
            for (int m = 0; m < 4; ++m) {
                const int row = rowb + ai * 128 + m * 16;
                if (row < MV) {
                    const float* b = row < MP ? bp + (size_t)row * DM : bs + (size_t)(row - MP) * DM;
                    float* o = row < MP ? op + (size_t)row * DM : os + (size_t)(row - MP) * DM;
                    const float* gt = gate + (size_t)mod_row(row) * NADA;
#pragma unroll
                    for (int bj = 0; bj < 2; ++bj) {
                        const int col = col0 + bj * 128;
                        const f32x4 b0 = *(const f32x4*)(b + col), b1 = *(const f32x4*)(b + col + 4);
                        const f32x4 g0 = *(const f32x4*)(gt + col), g1 = *(const f32x4*)(gt + col + 4);
                        *(f32x4*)(o + col) = b0 + g0 * acc[ai][bj][m][0]; *(f32x4*)(o + col + 4) = b1 + g1 * acc[ai][bj][m][1];
                    }
                }
            }
    }
};
struct EpiSwiglu {
    static constexpr bool PERM = true, AFTER_DRAIN = false, CHAIN = false;
    bf16* H;
    __device__ __forceinline__ void operator()(const pg8::f32x4 (&acc)[2][2][4][2], const Unit& u, int wr, int wc, int fr_, int fq_) const {
        int fr = fr_, fq = fq_; asm volatile("" : "+v"(fr), "+v"(fq));
        const int col = u.pn * 128 + wc * 32 + 8 * fq, rowb = u.pm * 256 + wr * 64 + fr;
#pragma unroll
        for (int ai = 0; ai < 2; ++ai)
#pragma unroll
            for (int m = 0; m < 4; ++m) {
                const int row = rowb + ai * 128 + m * 16;
                f32x4 r0, r1;
#pragma unroll
                for (int e = 0; e < 4; ++e) {
                    const float a0 = acc[ai][0][m][0][e], a1 = acc[ai][0][m][1][e];
                    r0[e] = a0 * sigmoidf_(a0) * acc[ai][1][m][0][e];
                    r1[e] = a1 * sigmoidf_(a1) * acc[ai][1][m][1][e];
                }
                st8_bf16(H + (size_t)row * DFF + col, r0, r1);
            }
    }
};

__device__ __forceinline__ void transpose_item(const float* W, int K, int N, bf16* WT, int mode, LAS float* scr, int item, int lane) {
    const int nblk = N / 32, kb = item / nblk, nb = item % nblk, k0 = 64 * kb, n0 = 32 * nb;
    float wv[32];
#pragma unroll
    for (int i = 0; i < 32; ++i) wv[i] = W[(size_t)(k0 + 2 * i + (lane >> 5)) * N + n0 + (lane & 31)];
#pragma unroll
    for (int i = 0; i < 32; ++i) scr[(2 * i + (lane >> 5)) * 33 + (lane & 31)] = wv[i];
    LDS_WAIT(); asm volatile("" ::: "memory");
    int drow0 = n0;
    if (mode == 1) { const int bj = n0 >= DFF ? 1 : 0; const int j0 = n0 - bj * DFF; drow0 = (j0 >> 7) * 256 + bj * 128 + (j0 & 127); }
    const int c = lane & 7;
#pragma unroll
    for (int j = 0; j < 4; ++j) { const int n = (lane >> 3) + 8 * j; const LAS float* s = scr + (8 * c) * 33 + n;
        u32x4 o; o.x = pk2(s[0 * 33], s[1 * 33]); o.y = pk2(s[2 * 33], s[3 * 33]); o.z = pk2(s[4 * 33], s[5 * 33]); o.w = pk2(s[6 * 33], s[7 * 33]);
        *(u32x4*)(WT + (size_t)(drow0 + n) * K + k0 + 8 * c) = o; }
    LDS_WAIT(); asm volatile("" ::: "memory");
}

__device__ __forceinline__ void norm_mod_phase(const float* xp, const float* xs, const float* nw, const float* modl, int sh_off, bf16* XN, int gw, int NGW, int lane) {
    f32x4 w[4];
#pragma unroll
    for (int j = 0; j < 4; ++j) w[j] = *(const f32x4*)(nw + 4 * lane + 256 * j);
    for (int row0 = gw; row0 < MT; row0 += 2 * NGW) {
        f32x4 v[2][4];
#pragma unroll
        for (int q = 0; q < 2; ++q) {
            const int row = row0 + q * NGW;
            if (row < MV) {
                const float* xrow = row < MP ? xp + (size_t)row * DM : xs + (size_t)(row - MP) * DM;
#pragma unroll
                for (int j = 0; j < 4; ++j) v[q][j] = ((const f32x4*)xrow)[lane + 64 * j];
            } else {
#pragma unroll
                for (int j = 0; j < 4; ++j) v[q][j] = (f32x4){0.f, 0.f, 0.f, 0.f};
            }
        }
#pragma unroll
        for (int q = 0; q < 2; ++q) {
            const int row = row0 + q * NGW;
            if (row >= MT) continue;
            unsigned long long* o8 = (unsigned long long*)(XN + (size_t)row * DM) + lane;
            if (row >= MV) {
#pragma unroll
                for (int j = 0; j < 4; ++j) o8[64 * j] = 0ull;
                continue;
            }
            float s = 0.f;
#pragma unroll
            for (int j = 0; j < 4; ++j) s += (v[q][j].x * v[q][j].x + v[q][j].y * v[q][j].y) + (v[q][j].z * v[q][j].z + v[q][j].w * v[q][j].w);
            const float rstd = 1.0f / sqrtf(wave_sum(s) * (1.0f / DM) + 1e-6f);
            const float* mr = modl + (size_t)mod_row(row) * NADA + sh_off;
#pragma unroll
            for (int j = 0; j < 4; ++j) {
                const int col = 4 * lane + 256 * j;
                const f32x4 shv = *(const f32x4*)(mr + col), scv = *(const f32x4*)(mr + 1024 + col);
                const f32x4 y = v[q][j] * rstd * w[j] * (scv + 1.0f) + shv;
                o8[64 * j] = (unsigned long long)pk2(y.x, y.y) | ((unsigned long long)pk2(y.z, y.w) << 32);
            }
        }
    }
}

constexpr int KV_STRIDE = 272;
constexpr int ATT_K_OFF = 0, ATT_V_OFF = 256 * KV_STRIDE;
__device__ __forceinline__ float alibi_slope(int head12) { return exp2f(-8.0f * (float)(head12 + 1) / 12.0f); }

__device__ __forceinline__ void attn_unit(LAS unsigned char* lds, const bf16* Q, const bf16* K, const bf16* V, bf16* OG, float* DG, int unit, float cshift, int wid, int lane, int tid) {
    const int g = unit >> 9, r9 = unit & 511, sh = 2 * g, d = 1 << sh, nb = 32 >> sh;
    const int qb = r9 % nb; int t2 = r9 / nb; const int r = t2 % d; t2 /= d; const int h = t2 & 3, b = t2 >> 2;
    const int hc = (g * 4 + h) * 128;
    {
        const int ch = tid & 15, r0 = tid >> 4;
        u32x4 kv[8], vv[8];
#pragma unroll
        for (int it = 0; it < 8; ++it) {
            const int j = r0 + 32 * it, mk = 128 * qb - 128 + j;
            if (qb > 0 || it >= 4) {
                const size_t off = ((size_t)b * SEQ + (size_t)mk * d + r) * QKV + hc + ch * 8;
                kv[it] = *(const u32x4*)(K + off); vv[it] = *(const u32x4*)(V + off);
            } else { kv[it] = (u32x4){0u, 0u, 0u, 0u}; vv[it] = (u32x4){0u, 0u, 0u, 0u}; }
        }
#pragma unroll
        for (int it = 0; it < 8; ++it) {
            const int j = r0 + 32 * it;
            *(LAS u32x4*)(lds + ATT_K_OFF + j * KV_STRIDE + ch * 16) = kv[it];
            *(LAS u32x4*)(lds + ATT_V_OFF + j * KV_STRIDE + ch * 16) = vv[it];
        }
    }
    const int ql = lane & 15, gq = lane >> 4;
    const int qi = 16 * wid + ql;
    const size_t qrow = (size_t)b * SEQ + (size_t)(128 * qb + qi) * d + r;
    bf16x8 qf[4];
#pragma unroll
    for (int kk = 0; kk < 4; ++kk) qf[kk] = *(const bf16x8*)(Q + qrow * QKV + hc + 32 * kk + 8 * gq);
    const float slope2 = alibi_slope(g * 4 + h) * LOG2E * (float)d;
    __syncthreads();
    f32x4 accO[8];
#pragma unroll
    for (int dt = 0; dt < 8; ++dt) accO[dt] = (f32x4){0.f, 0.f, 0.f, 0.f};
    float dsum = 0.f;
    const LAS unsigned char* kbase = lds + ATT_K_OFF + (16 * wid + ql) * KV_STRIDE + gq * 16;
    const LAS unsigned char* vbase = lds + ATT_V_OFF + (16 * wid + 4 * gq + (ql >> 2)) * KV_STRIDE + (ql & 3) * 8;
#pragma unroll
    for (int kt2 = 0; kt2 < 5; ++kt2) {
        const int ja = 16 * wid + 32 * kt2;
        f32x4 sa = {0.f, 0.f, 0.f, 0.f}, sb = {0.f, 0.f, 0.f, 0.f};
#pragma unroll
        for (int kk = 0; kk < 4; ++kk) {
            const bf16x8 ka = *(const LAS bf16x8*)(kbase + (32 * kt2) * KV_STRIDE + kk * 64);
            sa = __builtin_amdgcn_mfma_f32_16x16x32_bf16(ka, qf[kk], sa, 0, 0, 0);
        }
        if (kt2 < 4) {
#pragma unroll
            for (int kk = 0; kk < 4; ++kk) {
                const bf16x8 kb = *(const LAS bf16x8*)(kbase + (32 * kt2 + 16) * KV_STRIDE + kk * 64);
                sb = __builtin_amdgcn_mfma_f32_16x16x32_bf16(kb, qf[kk], sb, 0, 0, 0);
            }
        }
        float pa[4], pb[4];
#pragma unroll
        for (int jj = 0; jj < 4; ++jj) {
            const int j = ja + 4 * gq + jj, dist = 128 + qi - j;
            const bool ok = dist >= 0 && dist <= 128 && (128 * qb - 128 + j) >= 0;
            pa[jj] = ok ? fast_exp2(sa[jj] - slope2 * (float)dist - cshift) : 0.f;
            const int j2 = j + 16, dist2 = dist - 16;
            const bool ok2 = (kt2 < 4) && dist2 >= 0 && dist2 <= 128 && (128 * qb - 128 + j2) >= 0;
            pb[jj] = ok2 ? fast_exp2(sb[jj] - slope2 * (float)dist2 - cshift) : 0.f;
            dsum += pa[jj] + pb[jj];
        }
        u32x4 pw; pw.x = pk2(pa[0], pa[1]); pw.y = pk2(pa[2], pa[3]); pw.z = pk2(pb[0], pb[1]); pw.w = pk2(pb[2], pb[3]);
        const bf16x8 pfrag = __builtin_bit_cast(bf16x8, pw);
        const int rb = (kt2 < 4) ? (32 * kt2 + 16) : (32 * kt2);
#pragma unroll
        for (int dt = 0; dt < 8; ++dt) {
            const s16x4 lo = vtr(vbase + (32 * kt2) * KV_STRIDE + dt * 32);
            const s16x4 hi = vtr(vbase + rb * KV_STRIDE + dt * 32);
            const bf16x8 vf = {lo[0], lo[1], lo[2], lo[3], hi[0], hi[1], hi[2], hi[3]};
            accO[dt] = __builtin_amdgcn_mfma_f32_16x16x32_bf16(vf, pfrag, accO[dt], 0, 0, 0);
        }
    }
    dsum += __shfl_xor(dsum, 16); dsum += __shfl_xor(dsum, 32);
    const float inv = 1.0f / dsum;
    bf16* op = OG + qrow * QKV + g * 512 + h * 128 + 4 * gq;
#pragma unroll
    for (int dt = 0; dt < 8; ++dt) {
        u32x2 w; w.x = pk2(accO[dt][0] * inv, accO[dt][1] * inv); w.y = pk2(accO[dt][2] * inv, accO[dt][3] * inv);
        *(u32x2*)(op + dt * 16) = w;
    }
    if (gq == 0) DG[qrow * 12 + g * 4 + h] = dsum;
    __syncthreads();
}


struct AttnU { int g, b, h, r, qb, d, hc; };
__device__ __forceinline__ AttnU attn_decode(int unit) {
    AttnU a; a.g = unit >> 9; const int r9 = unit & 511, sh = 2 * a.g, nb = 32 >> sh; a.d = 1 << sh;
    a.qb = r9 % nb; int t2 = r9 / nb; a.r = t2 % a.d; t2 /= a.d; a.h = t2 & 3; a.b = t2 >> 2; a.hc = (a.g * 4 + a.h) * 128; return a;
}
constexpr int ATT_BLK = 128 * KV_STRIDE;
__device__ __forceinline__ void attn_load_block(u32x4 (&kn)[4], u32x4 (&vn)[4], const bf16* K, const bf16* V, const AttnU& a, int blk, int tid) {
    const int ch = tid & 15, r0 = tid >> 4;
#pragma unroll
    for (int it = 0; it < 4; ++it) {
        const size_t off = ((size_t)a.b * SEQ + (size_t)(128 * blk + r0 + 32 * it) * a.d + a.r) * QKV + a.hc + ch * 8;
        kn[it] = *(const u32x4*)(K + off); vn[it] = *(const u32x4*)(V + off);
    }
}
__device__ __forceinline__ void attn_store_block(LAS unsigned char* lds, int slot, const u32x4 (&kn)[4], const u32x4 (&vn)[4], int tid) {
    const int ch = tid & 15, r0 = tid >> 4;
#pragma unroll
    for (int it = 0; it < 4; ++it) {
        *(LAS u32x4*)(lds + slot * ATT_BLK + (r0 + 32 * it) * KV_STRIDE + ch * 16) = kn[it];
        *(LAS u32x4*)(lds + (2 + slot) * ATT_BLK + (r0 + 32 * it) * KV_STRIDE + ch * 16) = vn[it];
    }
}
__device__ __forceinline__ void attn_units(LAS unsigned char* lds, const bf16* Q, const bf16* K, const bf16* V, bf16* OG, float* DG, int u0, int nu, float cshift, int wid, int lane, int tid) {
    if (nu <= 0) return;
    int p = 0;
    u32x4 kn[4], vn[4];
    AttnU a = attn_decode(u0);
    attn_load_block(kn, vn, K, V, a, a.qb, tid);
    const int ql = lane & 15, gq = lane >> 4;
    for (int ui = 0; ui < nu; ++ui) {
        a = attn_decode(u0 + ui);
        if (!(ui > 0 && a.qb > 0)) {
            u32x4 kp[4], vp[4];
            if (a.qb == 0) {
#pragma unroll
                for (int it = 0; it < 4; ++it) { kp[it] = (u32x4){0u, 0u, 0u, 0u}; vp[it] = (u32x4){0u, 0u, 0u, 0u}; }
            } else attn_load_block(kp, vp, K, V, a, a.qb - 1, tid);
            attn_store_block(lds, p, kp, vp, tid);
        }
        attn_store_block(lds, 1 - p, kn, vn, tid);
        const int qi = 16 * wid + ql;
        const size_t qrow = (size_t)a.b * SEQ + (size_t)(128 * a.qb + qi) * a.d + a.r;
        bf16x8 qf[4];
#pragma unroll
        for (int kk = 0; kk < 4; ++kk) qf[kk] = *(const bf16x8*)(Q + qrow * QKV + a.hc + 32 * kk + 8 * gq);
        const float slope2 = alibi_slope(a.g * 4 + a.h) * LOG2E * (float)a.d;
        __syncthreads();
        if (ui + 1 < nu) { const AttnU an = attn_decode(u0 + ui + 1); attn_load_block(kn, vn, K, V, an, an.qb, tid); }
        f32x4 accO[8];
#pragma unroll
        for (int dt = 0; dt < 8; ++dt) accO[dt] = (f32x4){0.f, 0.f, 0.f, 0.f};
        float dsum = 0.f;
        const int kl = ql * KV_STRIDE + gq * 16, vl = (4 * gq + (ql >> 2)) * KV_STRIDE + (ql & 3) * 8;
#pragma unroll
        for (int kt2 = 0; kt2 < 5; ++kt2) {
            const int ja = 16 * wid + 32 * kt2, jb = ja + 16;
            const int offA = (((ja >> 7) ^ p) * ATT_BLK) + (ja & 127) * KV_STRIDE;
            const int offB = (kt2 < 4) ? ((((jb >> 7) ^ p) * ATT_BLK) + (jb & 127) * KV_STRIDE) : offA;
            f32x4 sa = {0.f, 0.f, 0.f, 0.f}, sb = {0.f, 0.f, 0.f, 0.f};
#pragma unroll
            for (int kk = 0; kk < 4; ++kk) {
                const bf16x8 ka = *(const LAS bf16x8*)(lds + offA + kl + kk * 64);
                sa = __builtin_amdgcn_mfma_f32_16x16x32_bf16(ka, qf[kk], sa, 0, 0, 0);
            }
            if (kt2 < 4) {
#pragma unroll
                for (int kk = 0; kk < 4; ++kk) {
                    const bf16x8 kb = *(const LAS bf16x8*)(lds + offB + kl + kk * 64);
                    sb = __builtin_amdgcn_mfma_f32_16x16x32_bf16(kb, qf[kk], sb, 0, 0, 0);
                }
            }
            float pa[4], pb[4];
#pragma unroll
            for (int jj = 0; jj < 4; ++jj) {
                const int j = ja + 4 * gq + jj, dist = 128 + qi - j;
                const bool ok = dist >= 0 && dist <= 128 && (128 * a.qb - 128 + j) >= 0;
                pa[jj] = ok ? fast_exp2(sa[jj] - slope2 * (float)dist - cshift) : 0.f;
                const int j2 = j + 16, dist2 = dist - 16;
                const bool ok2 = (kt2 < 4) && dist2 >= 0 && dist2 <= 128 && (128 * a.qb - 128 + j2) >= 0;
                pb[jj] = ok2 ? fast_exp2(sb[jj] - slope2 * (float)dist2 - cshift) : 0.f;
                dsum += pa[jj] + pb[jj];
            }
            u32x4 pw; pw.x = pk2(pa[0], pa[1]); pw.y = pk2(pa[2], pa[3]); pw.z = pk2(pb[0], pb[1]); pw.w = pk2(pb[2], pb[3]);
            const bf16x8 pfrag = __builtin_bit_cast(bf16x8, pw);
#pragma unroll
            for (int dt = 0; dt < 8; ++dt) {
                const s16x4 lo = vtr(lds + 2 * ATT_BLK + offA + vl + dt * 32);
                const s16x4 hi = vtr(lds + 2 * ATT_BLK + offB + vl + dt * 32);
                const bf16x8 vf = {lo[0], lo[1], lo[2], lo[3], hi[0], hi[1], hi[2], hi[3]};
                accO[dt] = __builtin_amdgcn_mfma_f32_16x16x32_bf16(vf, pfrag, accO[dt], 0, 0, 0);
            }
        }
        dsum += __shfl_xor(dsum, 16); dsum += __shfl_xor(dsum, 32);
        const float inv = 1.0f / dsum;
        bf16* op = OG + qrow * QKV + a.g * 512 + a.h * 128 + 4 * gq;
#pragma unroll
        for (int dt = 0; dt < 8; ++dt) {
            u32x2 w; w.x = pk2(accO[dt][0] * inv, accO[dt][1] * inv); w.y = pk2(accO[dt][2] * inv, accO[dt][3] * inv);
            *(u32x2*)(op + dt * 16) = w;
        }
        if (gq == 0) DG[qrow * 12 + a.g * 4 + a.h] = dsum;
        __syncthreads();
        p ^= 1;
    }
}

__device__ __forceinline__ void attn_sample_item(LAS unsigned char* lds, const bf16* Q, const bf16* K, const bf16* V, const float* c0, const float* c1, const float* c2, int layer, bf16* YA, int item, int wid, int lane, int tid) {
    const int b = item >> 2, h = item & 3;
    LAS float* sc = (LAS float*)lds;
    LAS float* qs = (LAS float*)(lds + 2048);
    LAS float* part = (LAS float*)(lds + 4096);
    LAS float* pself = (LAS float*)(lds + 8192);
    const size_t row = (size_t)MP + b;
    if (tid < 384) { const int g = tid >> 7, dd = tid & 127; qs[tid] = bf2f(Q[row * QKV + (g * 4 + h) * 128 + dd]); }
    LDS_WAIT(); __syncthreads();
    const int k = lane >> 2, qd = lane & 3;
    {
        f32x4 kv[3][8];
#pragma unroll
        for (int i = 0; i < 3; ++i) {
            const int jj = 16 * (wid + 8 * i) + k, g = (wid + 8 * i) >> 3  , step = (jj & 127) + 1, d = 1 << (2 * g), lc = 128 << (2 * g);
            const float* cp = (g == 0 ? c0 : (g == 1 ? c1 : c2)) + ((((size_t)(layer * NSMP + b) * lc + (lc - d * step)) * 2 + 0) * 4 + h) * 128 + qd * 32;
#pragma unroll
            for (int e = 0; e < 8; ++e) kv[i][e] = *(const f32x4*)(cp + 4 * e);
        }
#pragma unroll
        for (int i = 0; i < 3; ++i) {
            const int jj = 16 * (wid + 8 * i) + k, g = i, step = (jj & 127) + 1, d = 1 << (2 * g);
            float s = 0.f;
#pragma unroll
            for (int e = 0; e < 8; ++e) { const f32x4 qv = *(const LAS f32x4*)(qs + g * 128 + qd * 32 + 4 * e); s += (kv[i][e].x * qv.x + kv[i][e].y * qv.y) + (kv[i][e].z * qv.z + kv[i][e].w * qv.w); }
            s += __shfl_xor(s, 1); s += __shfl_xor(s, 2);
            s -= alibi_slope(g * 4 + h) * LOG2E * (float)(d * step);
            if (qd == 0) sc[g * 132 + step] = s;
        }
        if (wid < 3) {
            const unsigned kk = *(const unsigned*)(K + row * QKV + (wid * 4 + h) * 128 + 2 * lane);
            float s = __uint_as_float(kk << 16) * qs[wid * 128 + 2 * lane] + __uint_as_float(kk & 0xffff0000u) * qs[wid * 128 + 2 * lane + 1];
            s = wave_sum(s);
            if (lane == 0) sc[wid * 132] = s;
        }
    }
    LDS_WAIT(); __syncthreads();
    float mx = -3.0e38f;
    for (int j = lane; j < 387; j += 64) { const int g = j / 129; mx = fmaxf(mx, sc[g * 132 + (j - g * 129)]); }
    mx = wave_max(mx);
    float den = 0.f;
    for (int j = lane; j < 387; j += 64) { const int g = j / 129; den += fast_exp2(sc[g * 132 + (j - g * 129)] - mx); }
    den = wave_sum(den);
    {
        f32x4 vv[3][8];
#pragma unroll
        for (int i = 0; i < 3; ++i) {
            const int jj = 16 * (wid + 8 * i) + k, g = i, step = (jj & 127) + 1, d = 1 << (2 * g), lc = 128 << (2 * g);
            const float* cp = (g == 0 ? c0 : (g == 1 ? c1 : c2)) + ((((size_t)(layer * NSMP + b) * lc + (lc - d * step)) * 2 + 1) * 4 + h) * 128 + qd * 32;
#pragma unroll
            for (int e = 0; e < 8; ++e) vv[i][e] = *(const f32x4*)(cp + 4 * e);
        }
        f32x4 acc[8];
#pragma unroll
        for (int e = 0; e < 8; ++e) acc[e] = (f32x4){0.f, 0.f, 0.f, 0.f};
#pragma unroll
        for (int i = 0; i < 3; ++i) {
            const int jj = 16 * (wid + 8 * i) + k, step = (jj & 127) + 1;
            const float p = fast_exp2(sc[i * 132 + step] - mx);
#pragma unroll
            for (int e = 0; e < 8; ++e) acc[e] += vv[i][e] * p;
        }
#pragma unroll
        for (int e = 0; e < 8; ++e)
#pragma unroll
            for (int c = 0; c < 4; ++c) { float v = acc[e][c]; v += __shfl_xor(v, 4); v += __shfl_xor(v, 8); v += __shfl_xor(v, 16); v += __shfl_xor(v, 32); acc[e][c] = v; }
        if (k == 0) {
#pragma unroll
            for (int e = 0; e < 8; ++e) *(LAS f32x4*)(part + wid * 128 + qd * 32 + 4 * e) = acc[e];
        }
        if (tid < 3) pself[tid] = fast_exp2(sc[tid * 132] - mx);
    }
    LDS_WAIT(); __syncthreads();
    if (tid < 128) {
        float a = 0.f;
#pragma unroll
        for (int w = 0; w < 8; ++w) a += part[w * 128 + tid];
#pragma unroll
        for (int g = 0; g < 3; ++g) a += pself[g] * bf2f(V[row * QKV + (g * 4 + h) * 128 + tid]);
        YA[row * 512 + h * 128 + tid] = (bf16)(pk2(a / den, 0.f) & 0xffffu);
    }
    LDS_WAIT(); __syncthreads();
}

constexpr int SG_STRIDE = 144;
constexpr int SG_SLAB = 128 * SG_STRIDE;
constexpr int SG_STATS = 4 * SG_SLAB;
__device__ __forceinline__ void sgu_unit(LAS unsigned char* lds, const bf16* U, const bf16* VS, const float* lnw, const float* lnb, const bf16* WSP, const float* bsp, bf16* YS, int unit, int wid, int lane) {
    const int half = unit & 1, bn = unit >> 1;
    const size_t R0 = (size_t)bn * 128;
    LAS f32x2* stats = (LAS f32x2*)(lds + SG_STATS);
    u32x4 xs16[16];
#pragma unroll
    for (int i = 0; i < 16; ++i) xs16[i] = *(const u32x4*)(VS + (R0 + 16 * wid + i) * 512 + 8 * lane);
#pragma unroll
    for (int i = 0; i < 16; ++i) {
        const int rl = 16 * wid + i;
        const u32x4 x = xs16[i];
        const float f[8] = {__uint_as_float(x.x << 16), __uint_as_float(x.x & 0xffff0000u), __uint_as_float(x.y << 16), __uint_as_float(x.y & 0xffff0000u),
                            __uint_as_float(x.z << 16), __uint_as_float(x.z & 0xffff0000u), __uint_as_float(x.w << 16), __uint_as_float(x.w & 0xffff0000u)};
        float s = 0.f, s2 = 0.f;
#pragma unroll
        for (int e = 0; e < 8; ++e) { s += f[e]; s2 += f[e] * f[e]; }
        s = wave_sum(s); s2 = wave_sum(s2);
        const float mean = s * (1.0f / 512.0f), var = fmaxf(s2 * (1.0f / 512.0f) - mean * mean, 0.f);
        if (lane == 0) stats[rl] = (f32x2){mean, 1.0f / sqrtf(var + 1e-6f)};
    }
    LDS_WAIT(); __syncthreads();
    const int gl = wid & 3, th = wid >> 2, grp = half * 4 + gl, c0 = grp * 64;
    LAS unsigned char* slab = lds + gl * SG_SLAB;
    {
        const int cc = (lane & 7) * 8;
        const f32x4 w0 = *(const f32x4*)(lnw + c0 + cc), w1 = *(const f32x4*)(lnw + c0 + cc + 4), b0 = *(const f32x4*)(lnb + c0 + cc), b1 = *(const f32x4*)(lnb + c0 + cc + 4);
#pragma unroll
        for (int it = 0; it < 8; ++it) {
            const int rl = th * 64 + it * 8 + (lane >> 3);
            const u32x4 x = *(const u32x4*)(VS + (R0 + rl) * 512 + c0 + cc);
            const f32x2 st = stats[rl];
            f32x4 a = {__uint_as_float(x.x << 16), __uint_as_float(x.x & 0xffff0000u), __uint_as_float(x.y << 16), __uint_as_float(x.y & 0xffff0000u)};
            f32x4 c = {__uint_as_float(x.z << 16), __uint_as_float(x.z & 0xffff0000u), __uint_as_float(x.w << 16), __uint_as_float(x.w & 0xffff0000u)};
            a = (a - st.x) * st.y * w0 + b0; c = (c - st.x) * st.y * w1 + b1;
            u32x4 o; o.x = pk2(a[0], a[1]); o.y = pk2(a[2], a[3]); o.z = pk2(c[0], c[1]); o.w = pk2(c[2], c[3]);
            *(LAS u32x4*)(slab + rl * SG_STRIDE + cc * 2) = o;
        }
    }
    LDS_WAIT(); __syncthreads();
    const int ql = lane & 15, gq = lane >> 4;
    const LAS unsigned char* abase = slab + (8 * gq + (ql >> 2)) * SG_STRIDE + (ql & 3) * 8;
    const bf16* wg = WSP + (size_t)grp * 128 * 128;
#pragma unroll
    for (int ti = 0; ti < 4; ++ti) {
        const int tt = th == 0 ? (ti == 0 ? 0 : (ti == 1 ? 3 : (ti == 2 ? 4 : 7))) : (ti == 0 ? 1 : (ti == 1 ? 2 : (ti == 2 ? 5 : 6)));
        const int t = 16 * tt + ql;
        f32x4 acc[4];
#pragma unroll
        for (int ct = 0; ct < 4; ++ct) acc[ct] = (f32x4){0.f, 0.f, 0.f, 0.f};
        for (int kk = 0; kk <= (tt >> 1); ++kk) {
            const bf16x8 wf = *(const bf16x8*)(wg + (size_t)t * 128 + 32 * kk + 8 * gq);
#pragma unroll
            for (int ct = 0; ct < 4; ++ct) {
                const s16x4 lo = vtr(abase + (32 * kk) * SG_STRIDE + ct * 32);
                const s16x4 hi = vtr(abase + (32 * kk + 4) * SG_STRIDE + ct * 32);
                const bf16x8 af = {lo[0], lo[1], lo[2], lo[3], hi[0], hi[1], hi[2], hi[3]};
                acc[ct] = __builtin_amdgcn_mfma_f32_16x16x32_bf16(af, wf, acc[ct], 0, 0, 0);
            }
        }
        const float bias = bsp[grp * 128 + t];
#pragma unroll
        for (int ct = 0; ct < 4; ++ct) {
            const size_t off = (R0 + t) * 512 + c0 + ct * 16 + 4 * gq;
            const u32x2 uu = *(const u32x2*)(U + off);
            const float u0 = __uint_as_float(uu.x << 16), u1 = __uint_as_float(uu.x & 0xffff0000u), u2 = __uint_as_float(uu.y << 16), u3 = __uint_as_float(uu.y & 0xffff0000u);
            u32x2 o; o.x = pk2(u0 * (acc[ct][0] + bias), u1 * (acc[ct][1] + bias)); o.y = pk2(u2 * (acc[ct][2] + bias), u3 * (acc[ct][3] + bias));
            *(u32x2*)(YS + off) = o;
        }
    }
    LDS_WAIT(); __syncthreads();
}

__device__ __forceinline__ void sgu_sample_row(const bf16* U, const bf16* VS, const float* lnw, const float* lnb, const float* wsp_f32, const float* bsp, bf16* YS, float* out_sv, int b, int lane) {
    const size_t row = (size_t)MP + b;
    const u32x4 x = *(const u32x4*)(VS + row * 512 + 8 * lane);
    float f[8] = {__uint_as_float(x.x << 16), __uint_as_float(x.x & 0xffff0000u), __uint_as_float(x.y << 16), __uint_as_float(x.y & 0xffff0000u),
                  __uint_as_float(x.z << 16), __uint_as_float(x.z & 0xffff0000u), __uint_as_float(x.w << 16), __uint_as_float(x.w & 0xffff0000u)};
    float s = 0.f, s2 = 0.f;
#pragma unroll
    for (int e = 0; e < 8; ++e) { s += f[e]; s2 += f[e] * f[e]; }
    s = wave_sum(s); s2 = wave_sum(s2);
    const float mean = s * (1.0f / 512.0f), var = fmaxf(s2 * (1.0f / 512.0f) - mean * mean, 0.f), rstd = 1.0f / sqrtf(var + 1e-6f);
    const int c = 8 * lane, grp = c >> 6;
    const float w00 = wsp_f32[(size_t)grp * 128 * 128], b0 = bsp[grp * 128];
    const u32x4 uu = *(const u32x4*)(U + row * 512 + c);
    const float uf[8] = {__uint_as_float(uu.x << 16), __uint_as_float(uu.x & 0xffff0000u), __uint_as_float(uu.y << 16), __uint_as_float(uu.y & 0xffff0000u),
                         __uint_as_float(uu.z << 16), __uint_as_float(uu.z & 0xffff0000u), __uint_as_float(uu.w << 16), __uint_as_float(uu.w & 0xffff0000u)};
    float y[8];
#pragma unroll
    for (int e = 0; e < 8; ++e) { const float vn = (f[e] - mean) * rstd * lnw[c + e] + lnb[c + e]; out_sv[c + e] = vn; y[e] = uf[e] * (w00 * vn + b0); }
    u32x4 o; o.x = pk2(y[0], y[1]); o.y = pk2(y[2], y[3]); o.z = pk2(y[4], y[5]); o.w = pk2(y[6], y[7]);
    *(u32x4*)(YS + row * 512 + c) = o;
}

__device__ __forceinline__ void merge_row(const bf16* OG, const float* DG, bf16* YA, int row, int lane) {
    const int h = lane >> 4;
    const float d0 = DG[(size_t)row * 12 + h], d1 = DG[(size_t)row * 12 + 4 + h], d2 = DG[(size_t)row * 12 + 8 + h];
    const float inv = 1.0f / (d0 + d1 + d2);
    const float a0 = d0 * inv, a1 = d1 * inv, a2 = d2 * inv;
    const bf16* p = OG + (size_t)row * QKV + 8 * lane;
    const u32x4 x0 = *(const u32x4*)p, x1 = *(const u32x4*)(p + 512), x2 = *(const u32x4*)(p + 1024);
    u32x4 o;
#define MRG(c) pk2(a0 * __uint_as_float(x0.c << 16) + a1 * __uint_as_float(x1.c << 16) + a2 * __uint_as_float(x2.c << 16), \
                   a0 * __uint_as_float(x0.c & 0xffff0000u) + a1 * __uint_as_float(x1.c & 0xffff0000u) + a2 * __uint_as_float(x2.c & 0xffff0000u))
    o.x = MRG(x); o.y = MRG(y); o.z = MRG(z); o.w = MRG(w);
#undef MRG
    *(u32x4*)(YA + (size_t)row * 512 + 8 * lane) = o;
}


__device__ __forceinline__ void merge_rows4(const bf16* OG, const float* DG, bf16* YA, int row0, int stride, int lane) {
    const int h = lane >> 4;
    u32x4 x[4][3]; float dg[4][3];
#pragma unroll
    for (int q = 0; q < 4; ++q) {
        const int row = min(row0 + q * stride, MP - 1);
        const bf16* p = OG + (size_t)row * QKV + 8 * lane;
        x[q][0] = *(const u32x4*)p; x[q][1] = *(const u32x4*)(p + 512); x[q][2] = *(const u32x4*)(p + 1024);
        dg[q][0] = DG[(size_t)row * 12 + h]; dg[q][1] = DG[(size_t)row * 12 + 4 + h]; dg[q][2] = DG[(size_t)row * 12 + 8 + h];
    }
#pragma unroll
    for (int q = 0; q < 4; ++q) {
        const int row = row0 + q * stride;
        if (row >= MP) continue;
        const float inv = 1.0f / (dg[q][0] + dg[q][1] + dg[q][2]);
        const float a0 = dg[q][0] * inv, a1 = dg[q][1] * inv, a2 = dg[q][2] * inv;
        u32x4 o;
#define MRG(c) pk2(a0 * __uint_as_float(x[q][0].c << 16) + a1 * __uint_as_float(x[q][1].c << 16) + a2 * __uint_as_float(x[q][2].c << 16), \
                   a0 * __uint_as_float(x[q][0].c & 0xffff0000u) + a1 * __uint_as_float(x[q][1].c & 0xffff0000u) + a2 * __uint_as_float(x[q][2].c & 0xffff0000u))
        o.x = MRG(x); o.y = MRG(y); o.z = MRG(z); o.w = MRG(w);
#undef MRG
        *(u32x4*)(YA + (size_t)row * 512 + 8 * lane) = o;
    }
}
typedef float f32x16 __attribute__((ext_vector_type(16)));
template <class EpiS>
__device__ __forceinline__ void skinny_gemm(LAS unsigned char* lds, const bf16* A, const bf16* Bt, int K, int j, const EpiS& e, int wid, int lane, int tid) {
    const int r = lane & 31, hi = lane >> 5, ks = K >> 3;
    const bf16* ap = A + (size_t)r * K + wid * ks + 8 * hi;
    const bf16* bp = Bt + (size_t)(32 * j + r) * K + wid * ks + 8 * hi;
    f32x16 acc;
#pragma unroll
    for (int i = 0; i < 16; ++i) acc[i] = 0.f;
#pragma unroll 4
    for (int k = 0; k < ks; k += 16) {
        const bf16x8 a = *(const bf16x8*)(ap + k), b = *(const bf16x8*)(bp + k);
        acc = __builtin_amdgcn_mfma_f32_32x32x16_bf16(a, b, acc, 0, 0, 0);
    }
    LAS float* red = (LAS float*)lds;
#pragma unroll
    for (int i = 0; i < 16; ++i) red[wid * 1056 + ((i & 3) + 8 * (i >> 2) + 4 * hi) * 33 + r] = acc[i];
    LDS_WAIT(); __syncthreads();
    for (int e2 = tid; e2 < 1024; e2 += NTHREADS) {
        const int row = e2 >> 5, col = e2 & 31;
        float sum = 0.f;
#pragma unroll
        for (int w = 0; w < 8; ++w) sum += red[w * 1056 + row * 33 + col];
        e(row, 32 * j + col, sum);
    }
    LDS_WAIT(); __syncthreads();
}
struct SkGate1 { const bf16* G; float* T1; __device__ __forceinline__ void operator()(int sr, int col, float v) const { const size_t row = (size_t)MP + sr; T1[row * DM + col] = bf2f(G[row * 2048 + col]) * v; } };
struct SkGate2 { const bf16* G; const float* T1; bf16* MG; __device__ __forceinline__ void operator()(int sr, int col, float v) const { const size_t row = (size_t)MP + sr; MG[row * DM + col] = (bf16)(pk2(T1[row * DM + col] + bf2f(G[row * 2048 + 1024 + col]) * v, 0.f) & 0xffffu); } };
struct SkRes { const float* bs; float* os; const float* gate; __device__ __forceinline__ void operator()(int sr, int col, float v) const { os[(size_t)sr * DM + col] = bs[(size_t)sr * DM + col] + gate[(size_t)(4 + sr) * NADA + col] * v; } };


#define RLX_AGENT __ATOMIC_RELAXED, __HIP_MEMORY_SCOPE_AGENT
#define XB_TMO      128
#define XB_XCNT(j)  (256  + 64 * (j))
#define XB_XSUB(j)  (1280 + 64 * (j))
#define XB_XGEN(j)  (2304 + 64 * (j))
#define XB_TOP      3328
#define XB_TOPGEN   3392
#define XCD_BAR_WORDS 3456
#define XB_SPIN_CAP (1u << 18)

__device__ __forceinline__ unsigned xb_ld(unsigned* p)              { return __hip_atomic_load(p, __ATOMIC_RELAXED, __HIP_MEMORY_SCOPE_AGENT); }
__device__ __forceinline__ unsigned xb_add(unsigned* p, unsigned v) { return __hip_atomic_fetch_add(p, v, __ATOMIC_RELAXED, __HIP_MEMORY_SCOPE_AGENT); }
__device__ __forceinline__ unsigned xb_xcc_id() { return (unsigned)__builtin_amdgcn_s_getreg((3 << 11) | 20) & 0xFu; }
#define XB_SPIN(cond, bar) do { unsigned _sp = 0; while (cond) { __builtin_amdgcn_s_sleep(1); \
    if ((++_sp & 255u) == 0u) { if (xb_ld(&(bar)[XB_TMO])) break; if (_sp > XB_SPIN_CAP) { atomicAdd(&(bar)[XB_TMO], 1u); break; } } } } while (0)

struct XcdBarrier {
    unsigned* bar; unsigned x;
    volatile LAS unsigned* st;
};

__device__ __forceinline__ XcdBarrier xcd_barrier_post(unsigned* bar, volatile LAS unsigned* st) {
    XcdBarrier b; b.bar = bar; b.x = xb_xcc_id(); b.st = st;
    if (threadIdx.x == 0) (void)xb_add(&bar[XB_XCNT(b.x)], 1u);
    return b;
}
__device__ __forceinline__ void xcd_barrier_complete(unsigned* bar, unsigned x, unsigned& nloc, unsigned& nx) {
    const unsigned G = gridDim.x * gridDim.y * gridDim.z;
    unsigned sum, cnt, mine, sp = 0u;
    for (;;) {
        sum = 0u; cnt = 0u; mine = 0u;
#pragma unroll
        for (unsigned j = 0; j < 16; ++j) { const unsigned c = xb_ld(&bar[XB_XCNT(j)]); sum += c; cnt += (c > 0u) ? 1u : 0u; mine = (j == x) ? c : mine; }
        if (sum == G) break;
        __builtin_amdgcn_s_sleep(1);
        if ((++sp & 255u) == 0u) { if (xb_ld(&bar[XB_TMO])) break; if (sp > XB_SPIN_CAP) { atomicAdd(&bar[XB_TMO], 1u); break; } }
    }
    nloc = mine > 0u ? mine : 1u; nx = cnt > 0u ? cnt : 1u;
}

__device__ __forceinline__ void xcd_barrier(const XcdBarrier& b) {
    asm volatile("s_waitcnt vmcnt(0)" ::: "memory");
    __syncthreads();
    if (threadIdx.x == 0) {
        unsigned* bar = b.bar;
        __builtin_amdgcn_s_waitcnt(0);
        unsigned nloc = b.st[0], nx = b.st[1];
        if (nloc == 0u) { xcd_barrier_complete(bar, b.x, nloc, nx); b.st[0] = nloc; b.st[1] = nx; }
        const unsigned old = xb_add(&bar[XB_XSUB(b.x)], 1u);
        const unsigned gen = old / nloc;
        if (old + 1u == (gen + 1u) * nloc) {
            __builtin_amdgcn_fence(__ATOMIC_RELEASE, "agent");
            asm volatile("s_waitcnt vmcnt(0)" ::: "memory");
            const unsigned og = xb_add(&bar[XB_TOP], 1u);
            const unsigned tg = og / nx;
            if (og + 1u == (tg + 1u) * nx) xb_add(&bar[XB_TOPGEN], 1u);
            else XB_SPIN(xb_ld(&bar[XB_TOPGEN]) == tg, bar);
            __builtin_amdgcn_fence(__ATOMIC_ACQUIRE, "agent");
            xb_add(&bar[XB_XGEN(b.x)], 1u);
            asm volatile("s_waitcnt vmcnt(0)" ::: "memory");
        } else {
            XB_SPIN(xb_ld(&bar[XB_XGEN(b.x)]) == gen, bar);
            __builtin_amdgcn_fence(__ATOMIC_ACQUIRE, "agent");
            asm volatile("s_waitcnt vmcnt(0)" ::: "memory");
        }
    }
    __syncthreads();
}

constexpr int LDS_MISC = LDS_EXCH + 8192;
constexpr size_t WS_CTL = 0, CTL_ZERO_BYTES = 65536;
#ifndef PROBE_REP_MASK
#define PROBE_REP_MASK 0
#endif
#define PHON(k) for (int rep_ = 0; rep_ <= (((PROBE_REP_MASK) >> (k)) & 1); ++rep_) if constexpr (((PHM) >> (k)) & 1)
#define GSYNC() do { if constexpr (COOP) { CAS const Args* ap_ = (CAS const Args*)__builtin_amdgcn_kernarg_segment_ptr(); asm volatile("" : "+s"(ap_)); \
    XcdBarrier xb_; xb_.bar = (unsigned*)((unsigned char*)ap_->ws + WS_CTL); xb_.x = xb_xcc_id(); xb_.st = (volatile LAS unsigned*)(lds + LDS_MISC); xcd_barrier(xb_); } } while (0)
#define GSYNC_CG() do { if constexpr (COOP) cg::this_grid().sync(); } while (0)
#define GAS __attribute__((address_space(1)))
#define CAS __attribute__((address_space(4)))
struct Args { GAS const float* in[23]; GAS float* out; GAS unsigned char* ws; };

constexpr int I_ADA = 16 * 192, I_IN = 16 * 240, I_PA = 8 * 32, I_OUT = 16 * 32, I_FI = 16 * 176, I_FO = 44 * 32;
constexpr int I_LAYER = I_ADA + I_IN + 2 * I_PA + I_OUT + I_FI + I_FO;
__device__ __forceinline__ void weight_copy_item(CAS const Args* ap, unsigned char* ws, int l, int r, LAS float* scr, int lane) {
    unsigned char* wl = ws + WS_WL0 + (size_t)l * WL_SIZE;
    if (r < I_IN) { transpose_item(((const float*)ap->in[10]) + (size_t)l * DM * DIN, DM, DIN, (bf16*)(wl + WL_WIN), 0, scr, r, lane); return; } r -= I_IN;
    if (r < I_PA) { transpose_item(((const float*)ap->in[17]) + (size_t)l * 512 * DM, 512, DM, (bf16*)(wl + WL_WPA), 0, scr, r, lane); return; } r -= I_PA;
    if (r < I_PA) { transpose_item(((const float*)ap->in[18]) + (size_t)l * 512 * DM, 512, DM, (bf16*)(wl + WL_WPS), 0, scr, r, lane); return; } r -= I_PA;
    if (r < I_OUT) { transpose_item(((const float*)ap->in[19]) + (size_t)l * DM * DM, DM, DM, (bf16*)(wl + WL_WOUT), 0, scr, r, lane); return; } r -= I_OUT;
    if (r < I_FI) { transpose_item(((const float*)ap->in[21]) + (size_t)l * DM * 2 * DFF, DM, 2 * DFF, (bf16*)(wl + WL_WFI), 1, scr, r, lane); return; } r -= I_FI;
    transpose_item(((const float*)ap->in[22]) + (size_t)l * DFF * DM, DFF, DM, (bf16*)(wl + WL_WFO), 0, scr, r, lane);
}
#define PHASE_ENV() \
    CAS const Args* ap = (CAS const Args*)__builtin_amdgcn_kernarg_segment_ptr(); asm volatile("" : "+s"(ap)); \
    int tid = threadIdx.x; asm volatile("" : "+v"(tid)); \
    const int lane = tid & 63, wid = __builtin_amdgcn_readfirstlane(tid >> 6); \
    int G_ = gridDim.x, bx_ = blockIdx.x; asm volatile("" : "+s"(G_), "+s"(bx_)); const int G = G_, bx = bx_; const int gw = bx * NWAVES + wid, NGW = G * NWAVES; \
    unsigned char* const ws = (unsigned char*)ap->ws; (void)lane; (void)wid; (void)gw; (void)NGW; (void)ws; (void)G; (void)bx
#define WL(l) (ws + WS_WL0 + (size_t)(l) * WL_SIZE)

template <int PHM, bool COOP>
__global__ void __launch_bounds__(NTHREADS, 2) fwd_megakernel(Args args_unused, int l_lo, int l_hi) {
    extern __shared__ __attribute__((aligned(16))) unsigned char lds_raw[];
    LAS unsigned char* lds = (LAS unsigned char*)lds_raw;
    if constexpr (COOP) {
        PHASE_ENV();
        if (tid < 32) ((LAS unsigned*)(lds + LDS_MISC))[tid] = 0u;
        __syncthreads();
        (void)xcd_barrier_post((unsigned*)(ws + WS_CTL), (volatile LAS unsigned*)(lds + LDS_MISC));
    }

    PHON(0) {
        PHASE_ENV();
        bf16* WADA = (bf16*)(ws + WS_WADA); bf16* SC = (bf16*)(ws + WS_SC);
        LAS float* scr = (LAS float*)(lds + wid * 16384);
        for (int it = gw; it < 2 * I_ADA + (I_LAYER - I_ADA); it += NGW) {
            if (it < 2 * I_ADA) { const int l = it / I_ADA; transpose_item(((const float*)ap->in[7]) + (size_t)l * DM * NADA, DM, NADA, WADA + (size_t)l * NADA * DM, 0, scr, it - l * I_ADA, lane); }
            else weight_copy_item(ap, ws, 0, it - 2 * I_ADA, scr, lane);
        }
        const int gt = bx * NTHREADS + tid, NGT = G * NTHREADS;
        const float* wsp = ((const float*)ap->in[15]);
        for (int i = gt; i < 2 * 8 * 128 * 128; i += NGT) {
            const int l = i >> 17, r = i & 131071, t = (r >> 7) & 127, s = r & 127;
            const float w = wsp[i];
            ((bf16*)(WL(l) + WL_WSP))[r] = (bf16)(s <= t ? (pk2(w, 0.f) & 0xffffu) : 0u);
        }
        const float* cpr = ((const float*)ap->in[5]); const float* csm = ((const float*)ap->in[6]);
        for (int i = gt; i < 256 * DM; i += NGT) {
            const int r = i >> 10, k = i & 1023;
            float v = 0.f;
            if (r < 4) v = cpr[r * DM + k]; else if (r < 36) v = csm[(r - 4) * DM + k];
            SC[i] = (bf16)(pk2(v * sigmoidf_(v), 0.f) & 0xffffu);
        }
    }
    GSYNC_CG();
    PHON(1) {
        PHASE_ENV();
        pg8::Gemm g{(const bf16*)(ws + WS_SC), (const bf16*)(ws + WS_WADA), 256, 2 * NADA, DM}; pg8::StaticOrder S; S.init(256, 2 * NADA, G, bx);
        EpiAda E{(float*)(ws + WS_MOD), ((const float*)ap->in[8])};
        pg8::gemm_phase<EpiAda, pg8::StaticOrder, true, true>(lds + LDS_RING, g, S, E);
    }
    GSYNC();

    for (int l = l_lo; l < l_hi; ++l) {
        PHON(2) {
            PHASE_ENV();
            const float* X2 = (const float*)(ws + WS_X2);
            const float* xin_p = l == 0 ? ((const float*)ap->in[0]) : X2;
            const float* xin_s = l == 0 ? ((const float*)ap->in[1]) : X2 + (size_t)MP * DM;
            norm_mod_phase(xin_p, xin_s, ((const float*)ap->in[9]) + l * DM, (const float*)(ws + WS_MOD) + (size_t)l * 36 * NADA, 0, (bf16*)(ws + WS_XN), gw, NGW, lane);
        }
        GSYNC();
        PHON(3) {
            PHASE_ENV();
            pg8::Gemm g{(const bf16*)(ws + WS_XN), (const bf16*)(WL(l) + WL_WIN), MT, DIN, DM}; pg8::StaticOrder S; S.init(MT, DIN, G, bx);
            EpiIn E{ws, ((const float*)ap->in[11]) + l * 384, ((const float*)ap->in[12]) + l * 384, ((float*)ap->out), l, (LAS float*)(lds + LDS_EXCH)};
            pg8::gemm_phase<EpiIn, pg8::StaticOrder, true, true>(lds + LDS_RING, g, S, E);
        }
        PHON(3) {
            if (l == 0) {
                PHASE_ENV();
                constexpr int NU = (MT / 256) * (DIN / 256);
                const int nfull = NU % G;
                if (nfull > 0 && bx >= nfull) {
                    LAS float* scr = (LAS float*)(lds + wid * 16384);
                    const int nw = (G - nfull) * NWAVES, w0 = (bx - nfull) * NWAVES + wid;
                    for (int it = w0; it < I_LAYER - I_ADA; it += nw) weight_copy_item(ap, ws, 1, it, scr, lane);
                } else if (nfull == 0) {
                    LAS float* scr = (LAS float*)(lds + wid * 16384);
                    for (int it = gw; it < I_LAYER - I_ADA; it += NGW) weight_copy_item(ap, ws, 1, it, scr, lane);
                }
            }
        }
        GSYNC();
        PHON(4) {
            PHASE_ENV();
            const bf16 *Qb = (const bf16*)(ws + WS_Q), *Kb = (const bf16*)(ws + WS_K), *Vb = (const bf16*)(ws + WS_V);
            float mq = 0.f, mk = 0.f;
            for (int i = lane; i < 384; i += 64) { mq = fmaxf(mq, fabsf(((const float*)ap->in[11])[l * 384 + i])); mk = fmaxf(mk, fabsf(((const float*)ap->in[12])[l * 384 + i])); }
            mq = wave_max(mq); mk = wave_max(mk);
            const float cshift = 11.3137085f * LOG2E * mq * mk;
            if (G == 256) { const int u0 = bx < 128 ? bx * 7 : 896 + (bx - 128) * 5, nu = bx < 128 ? 7 : 5;
                attn_units(lds, Qb, Kb, Vb, (bf16*)(ws + WS_OG), (float*)(ws + WS_DG), u0, nu, cshift, wid, lane, tid); }
            else { const int per = (1536 + G - 1) / G, u0 = bx * per; attn_units(lds, Qb, Kb, Vb, (bf16*)(ws + WS_OG), (float*)(ws + WS_DG), u0, min(per, 1536 - u0), cshift, wid, lane, tid); }
        }
        PHON(4) {
            PHASE_ENV();
            if (bx >= G / 2) {
                for (int it = bx - G / 2; it < NSMP * 4; it += G - G / 2)
                    attn_sample_item(lds, (const bf16*)(ws + WS_Q), (const bf16*)(ws + WS_K), (const bf16*)(ws + WS_V), ((const float*)ap->in[2]), ((const float*)ap->in[3]), ((const float*)ap->in[4]), l, (bf16*)(ws + WS_YY) + (size_t)MP * 512  , it, wid, lane, tid);
            }
        }
        GSYNC();
        PHON(5) {
            PHASE_ENV();
            const bf16 *Ub = (const bf16*)(ws + WS_U), *VSb = (const bf16*)(ws + WS_VS); bf16 *YS = (bf16*)(ws + WS_YY) + (size_t)MP * 512;
            const bf16* WSP = (const bf16*)(WL(l) + WL_WSP);
            const float* lnw = ((const float*)ap->in[13]) + l * 512; const float* lnb = ((const float*)ap->in[14]) + l * 512; const float* bsp = ((const float*)ap->in[16]) + l * 8 * 128;
            for (int u = bx; u < 256; u += G) sgu_unit(lds, Ub, VSb, lnw, lnb, WSP, bsp, YS, u, wid, lane);
            for (int b = gw; b < NSMP; b += NGW) sgu_sample_row(Ub, VSb, lnw, lnb, ((const float*)ap->in[15]) + (size_t)l * 8 * 128 * 128, bsp, YS + (size_t)32 * 512  , ((float*)ap->out) + O_SV + (size_t)(l * NSMP + b) * 512, b, lane);
            for (int row = gw; row < MP; row += 4 * NGW) merge_rows4((const bf16*)(ws + WS_OG), (const float*)(ws + WS_DG), (bf16*)(ws + WS_YY), row, NGW, lane);
        }
        GSYNC();
        PHON(6) {
            PHASE_ENV();
            if (bx < 32) { SkGate1 e{(const bf16*)(ws + WS_G), (float*)(ws + WS_T1)};
                skinny_gemm(lds, (const bf16*)(ws + WS_YY) + (size_t)(2 * MP) * 512, (const bf16*)(WL(l) + WL_WPA), 512, bx, e, wid, lane, tid); }
        }
        PHON(6) {
            PHASE_ENV();
            PairOrder S; S.S0.init(MP, DM, G, bx);
            pg8::Gemm g{(const bf16*)(ws + WS_YY), (const bf16*)(WL(l) + WL_WPA), 2 * MP, 2 * DM, 512}; EpiMerged E{(const bf16*)(ws + WS_G), (bf16*)(ws + WS_MG)};
            pg8::gemm_phase<EpiMerged, PairOrder, true, true>(lds + LDS_RING, g, S, E);
        }
        PHON(6) {
            PHASE_ENV();
            if (bx < 32) { SkGate2 e{(const bf16*)(ws + WS_G), (const float*)(ws + WS_T1), (bf16*)(ws + WS_MG)};
                skinny_gemm(lds, (const bf16*)(ws + WS_YY) + (size_t)(2 * MP + 32) * 512, (const bf16*)(WL(l) + WL_WPS), 512, bx, e, wid, lane, tid); }
        }
        GSYNC();
        PHON(7) {
            PHASE_ENV();
            const float* X2 = (const float*)(ws + WS_X2); float* X1 = (float*)(ws + WS_X1);
            const float* xin_p = l == 0 ? ((const float*)ap->in[0]) : X2;
            const float* xin_s = l == 0 ? ((const float*)ap->in[1]) : X2 + (size_t)MP * DM;
            pg8::Gemm g{(const bf16*)(ws + WS_MG), (const bf16*)(WL(l) + WL_WOUT), MP, DM, DM}; pg8::StaticOrder S; S.init(MP, DM, G, bx);
            EpiRes E{xin_p, xin_s, X1, X1 + (size_t)MP * DM, (const float*)(ws + WS_MOD) + (size_t)l * 36 * NADA + 2048};
            pg8::gemm_phase<EpiRes, pg8::StaticOrder, true, true>(lds + LDS_RING, g, S, E);
        }
        PHON(7) {
            PHASE_ENV();
            if (bx < 32) { const float* X2 = (const float*)(ws + WS_X2);
                SkRes e{l == 0 ? ((const float*)ap->in[1]) : X2 + (size_t)MP * DM, (float*)(ws + WS_X1) + (size_t)MP * DM, (const float*)(ws + WS_MOD) + (size_t)l * 36 * NADA + 2048};
                skinny_gemm(lds, (const bf16*)(ws + WS_MG) + (size_t)MP * DM, (const bf16*)(WL(l) + WL_WOUT), DM, bx, e, wid, lane, tid); }
        }
        GSYNC();
        PHON(8) {
            PHASE_ENV();
            const float* X1 = (const float*)(ws + WS_X1);
            norm_mod_phase(X1, X1 + (size_t)MP * DM, ((const float*)ap->in[20]) + l * DM, (const float*)(ws + WS_MOD) + (size_t)l * 36 * NADA, 3072, (bf16*)(ws + WS_XN), gw, NGW, lane);
        }
        GSYNC();
        PHON(9) {
            PHASE_ENV();
            pg8::Gemm g{(const bf16*)(ws + WS_XN), (const bf16*)(WL(l) + WL_WFI), MT, 2 * DFF, DM}; pg8::StaticOrder S; S.init(MT, 2 * DFF, G, bx);
            EpiSwiglu E{(bf16*)(ws + WS_H)};
            pg8::gemm_phase<EpiSwiglu, pg8::StaticOrder, true, true>(lds + LDS_RING, g, S, E);
        }
        GSYNC();
        PHON(10) {
            PHASE_ENV();
            const float* X1 = (const float*)(ws + WS_X1); float* X2 = (float*)(ws + WS_X2);
            float* xout_p = l == 0 ? X2 : ((float*)ap->out) + O_YP;
            float* xout_s = l == 0 ? X2 + (size_t)MP * DM : ((float*)ap->out) + O_YS;
            pg8::Gemm g{(const bf16*)(ws + WS_H), (const bf16*)(WL(l) + WL_WFO), MP, DM, DFF}; pg8::StaticOrder S; S.init(MP, DM, G, bx);
            EpiRes E{X1, X1 + (size_t)MP * DM, xout_p, xout_s, (const float*)(ws + WS_MOD) + (size_t)l * 36 * NADA + 5120};
            pg8::gemm_phase<EpiRes, pg8::StaticOrder, true, true>(lds + LDS_RING, g, S, E);
        }
        PHON(10) {
            PHASE_ENV();
            if (bx < 32) { float* X2 = (float*)(ws + WS_X2);
                SkRes e{(const float*)(ws + WS_X1) + (size_t)MP * DM, l == 0 ? X2 + (size_t)MP * DM : ((float*)ap->out) + O_YS, (const float*)(ws + WS_MOD) + (size_t)l * 36 * NADA + 5120};
                skinny_gemm(lds, (const bf16*)(ws + WS_H) + (size_t)MP * DFF, (const bf16*)(WL(l) + WL_WFO), DFF, bx, e, wid, lane, tid); }
        }
        if (l + 1 < l_hi) GSYNC();
    }
}


#ifdef EXP_MASK
__global__ void __launch_bounds__(256) dbg_checksum(const unsigned char* ws, float* out) {
    const int lane = threadIdx.x & 63, gw = (blockIdx.x * 256 + threadIdx.x) >> 6, ngw = gridDim.x * 4;
    struct B { size_t off; int cols; int isf; };
    const B bufs[16] = {{WS_XN, 1024, 0}, {WS_Q, 1536, 0}, {WS_K, 1536, 0}, {WS_V, 1536, 0}, {WS_U, 512, 0}, {WS_VS, 512, 0}, {WS_G, 2048, 0}, {WS_OG, 1536, 0},
                        {WS_DG, 12, 1}, {WS_YY, 512, 0}, {WS_YY + (size_t)MP * 1024, 512, 0}, {WS_T1, 1024, 1}, {WS_MG, 1024, 0}, {WS_X1, 1024, 1}, {WS_H, 2816, 0}, {WS_X2, 1024, 1}};
    for (int b = 0; b < 16; ++b) {
        if (!((EXP_MASK >> b) & 1)) continue;
        for (int row = gw; row < MV; row += ngw) {
            float s = 0.f;
            for (int c = lane; c < bufs[b].cols; c += 64) {
                const float v = bufs[b].isf ? ((const float*)(ws + bufs[b].off))[(size_t)row * bufs[b].cols + c] : bf2f(((const bf16*)(ws + bufs[b].off))[(size_t)row * bufs[b].cols + c]);
                s += v * (float)(1 + (c % 7));
            }
            s = wave_sum(s);
            if (lane == 0) out[(size_t)b * MT + row] = s;
        }
    }
    if ((EXP_MASK >> 16) & 1) for (int i = blockIdx.x * 256 + threadIdx.x; i < 72 * NADA; i += gridDim.x * 256) out[16 * MT + i] = ((const float*)(ws + WS_MOD))[i];
}
#endif
#ifndef N_LAUNCH_MODE
#define N_LAUNCH_MODE 1
#endif
template <int PHM> static void launch_phase(const Args& a, int l_lo, int l_hi, int grid, hipStream_t stream) {
    static bool attr = false;
    if (!attr) { (void)hipFuncSetAttribute((const void*)fwd_megakernel<PHM, false>, hipFuncAttributeMaxDynamicSharedMemorySize, LDS_BYTES); attr = true; }
    hipLaunchKernelGGL((fwd_megakernel<PHM, false>), dim3(grid), dim3(NTHREADS), LDS_BYTES, stream, a, l_lo, l_hi);
}
extern "C" void kernel_launch(void* const* d_in, const int* in_sizes, int n_in, void* d_out, int out_size, void* d_ws, size_t ws_size, hipStream_t stream) {
    static int grid = 0;
    if (grid == 0) {
        if (n_in != 23 || (size_t)out_size != O_END || ws_size < WS_END) { fprintf(stderr, "kernel_launch: unexpected shapes (n_in %d out %d ws %zu need %zu)\n", n_in, out_size, ws_size, (size_t)WS_END); grid = -1; return; }
        int dev = 0, cus = 0, per_cu = 0;
        (void)hipGetDevice(&dev);
        (void)hipDeviceGetAttribute(&cus, hipDeviceAttributeMultiprocessorCount, dev);
#if N_LAUNCH_MODE == 1
        if (hipFuncSetAttribute((const void*)fwd_megakernel<0x7FF, true>, hipFuncAttributeMaxDynamicSharedMemorySize, LDS_BYTES) != hipSuccess) { fprintf(stderr, "kernel_launch: hipFuncSetAttribute failed\n"); grid = -1; return; }
        (void)hipOccupancyMaxActiveBlocksPerMultiprocessor(&per_cu, (const void*)fwd_megakernel<0x7FF, true>, NTHREADS, LDS_BYTES);
        (void)hipGetLastError();
        if (per_cu < 1) fprintf(stderr, "kernel_launch: occupancy query says %d blocks per CU\n", per_cu);
#endif
        grid = cus;
    }
    if (grid < 0) return;
    Args a{};
    for (int i = 0; i < 23; ++i) a.in[i] = (GAS const float*)d_in[i];
    a.out = (GAS float*)d_out; a.ws = (GAS unsigned char*)d_ws;
#if N_LAUNCH_MODE == 1
    (void)hipMemsetAsync((unsigned char*)d_ws + WS_CTL, 0, CTL_ZERO_BYTES, stream);
    int l_lo = 0, l_hi = 2;
    void* kargs[] = {&a, &l_lo, &l_hi};
    hipError_t e = hipLaunchCooperativeKernel((const void*)fwd_megakernel<0x7FF, true>, dim3(grid), dim3(NTHREADS), kargs, LDS_BYTES, stream);
    if (e != hipSuccess) fprintf(stderr, "cooperative launch failed: %s (grid %d)\n", hipGetErrorString(e), grid);
#else
#ifdef EXP_MASK
    (void)hipMemsetAsync(d_out, 0, (size_t)out_size * 4, stream);
#endif
    launch_phase<0x001>(a, 0, 0, grid, stream);
    launch_phase<0x002>(a, 0, 0, grid, stream);
#ifdef EXP_MASK
    const int NL = 1;
#else
    const int NL = 2;
#endif
    for (int l = 0; l < NL; ++l) {
        launch_phase<0x004>(a, l, l + 1, grid, stream);
        launch_phase<0x008>(a, l, l + 1, grid, stream);
        launch_phase<0x010>(a, l, l + 1, grid, stream);
        launch_phase<0x020>(a, l, l + 1, grid, stream);
        launch_phase<0x040>(a, l, l + 1, grid, stream);
        launch_phase<0x080>(a, l, l + 1, grid, stream);
        launch_phase<0x100>(a, l, l + 1, grid, stream);
        launch_phase<0x200>(a, l, l + 1, grid, stream);
        launch_phase<0x400>(a, l, l + 1, grid, stream);
    }
#ifdef EXP_MASK
    hipLaunchKernelGGL(dbg_checksum, dim3(1024), dim3(256), 0, stream, (const unsigned char*)d_ws, (float*)d_out);
#endif
#endif
}
```

```cpp
#include <hip/hip_runtime.h>
#include <hip/hip_cooperative_groups.h>
#include <cstdio>
#include <cstdint>
namespace cg = cooperative_groups;
namespace pg8 {
#define PG8_LAS __attribute__((address_space(3)))
typedef unsigned short bf16_t;
typedef short bf16x8 __attribute__((ext_vector_type(8)));
typedef float f32x4 __attribute__((ext_vector_type(4)));
typedef unsigned u32x4 __attribute__((ext_vector_type(4)));
constexpr int BM = 256, BK = 64, HALF = 128, HTB = HALF * BK * 2  , STAGE_BYTES = 8 * HTB, NXCD = 8, WGM = 8;

__host__ __device__ __forceinline__ int lds_byte(int r, int c) { const int st = (r >> 4) * 2 + (c >> 5), rr = r & 15, cc = c & 31, ob = rr * 64 + cc * 2; return st * 1024 + (ob ^ (((ob >> 9) & 1) << 5)); }
__host__ __device__ __forceinline__ void stage_rc(int b, int& R, int& C) { const int st = b / 1024, sb = b % 1024, swz = sb ^ (((sb >> 9) & 1) << 5); R = (st >> 1) * 16 + swz / 64; C = (st & 1) * 32 + (swz % 64) / 2; }
__host__ __device__ __forceinline__ int perm32(int rho) { const int n = rho >> 4, i = rho & 15; return 8 * (i >> 2) + 4 * n + (i & 3); }

struct Unit { int pm, pn; };
struct Gemm { const bf16_t* A; const bf16_t* Bt; int M, N, K; };

struct StaticOrder {
    int nM, nN, nwg, G, c;
    __host__ __device__ void init(int M, int N, int G_, int c_) { nM = M / BM; nN = N / BM; nwg = nM * nN; G = G_; c = c_; }
    __host__ __device__ bool next(int i, Unit& u) const {
        const long L = (long)i * G + c; if (L >= nwg) return false;
        int wgid = (int)L; { const int q = nwg / NXCD, r = nwg % NXCD, xcd = wgid % NXCD, off = wgid / NXCD; wgid = (xcd < r ? xcd * (q + 1) : r * (q + 1) + (xcd - r) * q) + off; }
        const int nig = WGM * nN, gid = wgid / nig, fm = gid * WGM, gsz = (nM - fm) < WGM ? (nM - fm) : WGM;
        u.pm = fm + ((wgid % nig) % gsz); u.pn = (wgid % nig) / gsz; return true;
    }
    __device__ __forceinline__ void a_ready(const Unit&) const {}
    __device__ __forceinline__ void done(const Unit&) const {}
};

typedef __bf16 bf16x2_hw __attribute__((ext_vector_type(2)));
typedef float f32x2_hw __attribute__((ext_vector_type(2)));
__device__ __forceinline__ unsigned cvt_pk_bf16(float lo, float hi) { const f32x2_hw v = {lo, hi}; return __builtin_bit_cast(unsigned, __builtin_convertvector(v, bf16x2_hw)); }
typedef float f32x2 __attribute__((ext_vector_type(2)));
__device__ __forceinline__ f32x2 gelu_pk(f32x2 v) {
    const f32x2 av = __builtin_elementwise_abs(v), d = av * 0.2316418882f + 1.0f;
    f32x2 t; t.x = __builtin_amdgcn_rcpf(d.x); t.y = __builtin_amdgcn_rcpf(d.y);
    f32x2 q = t * 0.5307027145f + (-0.7265760135f); q = q * t + 0.7107068705f; q = q * t + (-0.142248368f); q = q * t + 0.127414796f; q = q * t;
    const f32x2 s = (v * v) * (-0.72134752044f);
    f32x2 e; e.x = __builtin_amdgcn_exp2f(s.x); e.y = __builtin_amdgcn_exp2f(s.y);
    const f32x2 m = v * (q * e), r = v - m;
    f32x2 o; o.x = v.x < 0.f ? m.x : r.x; o.y = v.y < 0.f ? m.y : r.y; return o;
}

template <int ACT  > struct EpiBf16 {
    static constexpr bool PERM = true, AFTER_DRAIN = false; static_assert(ACT == 0 || ACT == 1, "EpiBf16: ACT is 0 (none) or 1 (gelu_pk)");
    bf16_t* O; int ldc; const float* bias; int split_cols; size_t split_stride; float scale0;
    __device__ __forceinline__ void operator()(const f32x4 (&acc)[2][2][4][2], const Unit& u, int wr, int wc, int fr, int fq) const {
        const int row0 = u.pm * BM + wr * 64 + fr; int colt = u.pn * BM; bf16_t* base = O;
        float sc = 1.f; if (split_cols) { const int t = colt / split_cols; base += (size_t)t * split_stride; colt -= t * split_cols; if (t == 0) sc = scale0; }
        const int col0 = colt + wc * 32 + 8 * fq, bcol0 = u.pn * BM + wc * 32 + 8 * fq;
        f32x4 bv[2][2];
#pragma unroll
        for (int bj = 0; bj < 2; ++bj)
#pragma unroll
            for (int n = 0; n < 2; ++n) bv[bj][n] = bias ? *(const f32x4*)(bias + bcol0 + bj * HALF + 4 * n) : (f32x4){0.f, 0.f, 0.f, 0.f};
#pragma unroll
        for (int ai = 0; ai < 2; ++ai)
#pragma unroll
            for (int m = 0; m < 4; ++m) { bf16_t* rowp = base + (size_t)(row0 + ai * HALF + m * 16) * ldc + col0;
#pragma unroll
                for (int bj = 0; bj < 2; ++bj) { f32x4 v0 = acc[ai][bj][m][0] + bv[bj][0], v1 = acc[ai][bj][m][1] + bv[bj][1];
                    if (ACT == 1) { f32x2 a = gelu_pk((f32x2){v0[0], v0[1]}), b = gelu_pk((f32x2){v0[2], v0[3]}), c = gelu_pk((f32x2){v1[0], v1[1]}), d = gelu_pk((f32x2){v1[2], v1[3]});
                        v0 = (f32x4){a.x, a.y, b.x, b.y}; v1 = (f32x4){c.x, c.y, d.x, d.y}; }
                    v0 = v0 * sc; v1 = v1 * sc; u32x4 w; w.x = cvt_pk_bf16(v0[0], v0[1]); w.y = cvt_pk_bf16(v0[2], v0[3]); w.z = cvt_pk_bf16(v1[0], v1[1]); w.w = cvt_pk_bf16(v1[2], v1[3]);
                    *(u32x4*)(rowp + bj * HALF) = w; } }
    }
};

struct PanelStats {
    unsigned* xbuf;
    unsigned* cnt;
    unsigned* tmo;
    int ntn; float eps;
    unsigned code;
    __device__ __forceinline__ bool run(const f32x4 (&v)[2][2][4][2], const Unit& u, int wr, int wc, int fr, int fq, PG8_LAS unsigned char* lds, int wid, int lane) const {
        typedef float f32x2v __attribute__((ext_vector_type(2)));
        PG8_LAS f32x2v* P = (PG8_LAS f32x2v*)lds;
        PG8_LAS f32x2v* S = (PG8_LAS f32x2v*)(lds + 8192);
        PG8_LAS unsigned* flag = (PG8_LAS unsigned*)(lds + 8192 + 2048);
#pragma unroll
        for (int ai = 0; ai < 2; ++ai)
#pragma unroll
            for (int m = 0; m < 4; ++m) {
                float s = 0.f;
#pragma unroll
                for (int bj = 0; bj < 2; ++bj)
#pragma unroll
                    for (int n = 0; n < 2; ++n) { const f32x4 x = v[ai][bj][m][n]; s += (x[0] + x[1]) + (x[2] + x[3]); }
                s += __shfl_xor(s, 16); s += __shfl_xor(s, 32);
                const float mw = s * (1.0f / 64.0f); float q = 0.f;
#pragma unroll
                for (int bj = 0; bj < 2; ++bj)
#pragma unroll
                    for (int n = 0; n < 2; ++n) { const f32x4 d = v[ai][bj][m][n] - mw; q += (d[0] * d[0] + d[1] * d[1]) + (d[2] * d[2] + d[3] * d[3]); }
                q += __shfl_xor(q, 16); q += __shfl_xor(q, 32);
                if (fq == 0) P[(ai * HALF + wr * 64 + m * 16 + fr) * 4 + wc] = (f32x2v){mw, q};
            }
        asm volatile("s_waitcnt lgkmcnt(0)" ::: "memory"); __builtin_amdgcn_s_barrier(); asm volatile("" ::: "memory");
#if defined(BROKEN_EXCHANGE_NO_WAIT)
#warning BROKEN CONTROL BUILD: the row-statistics exchange does not wait; results are wrong by design
        if (blockIdx.x >= 64) { const long long t0_ = clock64(); while (clock64() - t0_ < 60000) __builtin_amdgcn_s_sleep(8); }
#endif
        const int row = wid * 32 + (lane & 31);
        if (lane < 32) {
            const f32x2v a = P[row * 4 + 0], b = P[row * 4 + 1], c = P[row * 4 + 2], d = P[row * 4 + 3];
            const float mt = (a.x + b.x + c.x + d.x) * 0.25f;
            const float da = a.x - mt, db = b.x - mt, dc = c.x - mt, dd = d.x - mt;
            const float m2 = (a.y + b.y) + (c.y + d.y) + 64.0f * ((da * da + db * db) + (dc * dc + dd * dd));
            unsigned long long* slot = (unsigned long long*)xbuf + ((size_t)(u.pm * BM + row) * 4 + u.pn);
            __hip_atomic_store(slot, ((unsigned long long)__float_as_uint(m2) << 32) | __float_as_uint(mt), __ATOMIC_RELAXED, __HIP_MEMORY_SCOPE_AGENT);
        }
        asm volatile("s_waitcnt vmcnt(0)" ::: "memory");
        if (lane == 0) __hip_atomic_fetch_add(cnt + 64 * u.pm, 1u, __ATOMIC_RELAXED, __HIP_MEMORY_SCOPE_AGENT);
        if (wid == 0) {
            bool dead = false; const unsigned long long t0 = __builtin_amdgcn_s_memrealtime(); const unsigned want = 8u * (unsigned)ntn;
            for (;;) {
#if defined(BROKEN_EXCHANGE_NO_WAIT)
                break;
#endif
                if ((unsigned)__builtin_amdgcn_readfirstlane(__hip_atomic_load(cnt + 64 * u.pm, __ATOMIC_RELAXED, __HIP_MEMORY_SCOPE_AGENT)) >= want) break;
                if (__builtin_amdgcn_s_memrealtime() - t0 > 2000000ull) {
                    if (lane == 0) { unsigned expect = 0u; __hip_atomic_compare_exchange_strong(tmo + 1, &expect, code | (unsigned)(u.pm & 0xff), __ATOMIC_RELAXED, __ATOMIC_RELAXED, __HIP_MEMORY_SCOPE_AGENT);
                                     __hip_atomic_store(tmo, 1u, __ATOMIC_RELAXED, __HIP_MEMORY_SCOPE_AGENT); }
                    dead = true; break; }
                __builtin_amdgcn_s_sleep(2);
            }
            __builtin_amdgcn_fence(__ATOMIC_ACQUIRE, "agent");
            if (lane == 0) flag[0] = dead ? 1u : 0u;
        }
        asm volatile("s_waitcnt vmcnt(0) lgkmcnt(0)" ::: "memory"); __builtin_amdgcn_s_barrier(); asm volatile("" ::: "memory");
        const bool bad = flag[0] != 0u;
        if (lane < 32) {
            const unsigned long long* slot = (const unsigned long long*)xbuf + (size_t)(u.pm * BM + row) * 4; float mt[4], m2[4]; float ms = 0.f;
#pragma unroll
            for (int t = 0; t < 4; ++t) { if (t < ntn) { const unsigned long long w = __hip_atomic_load(slot + t, __ATOMIC_RELAXED, __HIP_MEMORY_SCOPE_AGENT); mt[t] = __uint_as_float((unsigned)w); m2[t] = __uint_as_float((unsigned)(w >> 32)); } else { mt[t] = 0.f; m2[t] = 0.f; } ms += mt[t]; }
            const float mean = ms / (float)ntn; float q = 0.f;
#pragma unroll
            for (int t = 0; t < 4; ++t) if (t < ntn) { const float dm = mt[t] - mean; q += m2[t] + 256.0f * dm * dm; }
            S[row] = (f32x2v){mean, 1.0f / sqrtf(q / (256.0f * (float)ntn) + eps)};
        }
        asm volatile("s_waitcnt lgkmcnt(0)" ::: "memory"); __builtin_amdgcn_s_barrier(); asm volatile("" ::: "memory");
        return bad;
    }
};
struct EpiLnRes {
    static constexpr bool PERM = false, AFTER_DRAIN = true;
    const float* base; float* out; int ldc; const float* bias; PanelStats st; unsigned poison;
    __device__ __forceinline__ void fused(f32x4 (&acc)[2][2][4][2], const Unit& u, int wr, int wc, int fr, int fq, PG8_LAS unsigned char* lds, int wid, int lane) const {
        typedef float f32x2v __attribute__((ext_vector_type(2)));
        const PG8_LAS f32x2v* S = (const PG8_LAS f32x2v*)(lds + 8192);
        const int col0 = u.pn * BM + wc * 32 + 4 * fq;
#pragma unroll
        for (int bj = 0; bj < 2; ++bj)
#pragma unroll
            for (int n = 0; n < 2; ++n) { const f32x4 bv = bias ? *(const f32x4*)(bias + col0 + bj * HALF + n * 16) : (f32x4){0.f, 0.f, 0.f, 0.f};
#pragma unroll
                for (int ai = 0; ai < 2; ++ai)
#pragma unroll
                    for (int m = 0; m < 4; ++m) acc[ai][bj][m][n] += bv; }
        f32x4 pre[4][2][2];
#pragma unroll
        for (int m = 0; m < 4; ++m) { const size_t off = (size_t)(u.pm * BM + wr * 64 + m * 16 + fr) * ldc + col0;
#pragma unroll
            for (int bj = 0; bj < 2; ++bj)
#pragma unroll
                for (int n = 0; n < 2; ++n) pre[m][bj][n] = *(const f32x4*)(base + off + bj * HALF + n * 16); }
        const bool bad = st.run(acc, u, wr, wc, fr, fq, lds, wid, lane) || poison != 0u;
        const float qnan = __builtin_nanf("");
#pragma unroll
        for (int ai = 0; ai < 2; ++ai)
#pragma unroll
            for (int m = 0; m < 4; ++m) { const int r = ai * HALF + wr * 64 + m * 16 + fr; const f32x2v sr = S[r]; const size_t off = (size_t)(u.pm * BM + r) * ldc + col0;
#pragma unroll
                for (int bj = 0; bj < 2; ++bj)
#pragma unroll
                    for (int n = 0; n < 2; ++n) { const f32x4 bs = ai == 0 ? pre[m][bj][n] : *(const f32x4*)(base + off + bj * HALF + n * 16); f32x4 o = bs + (acc[ai][bj][m][n] - sr.x) * sr.y;
                        if (bad) o = (f32x4){qnan, qnan, qnan, qnan}; *(f32x4*)(out + off + bj * HALF + n * 16) = o; }
                if (m & 1) asm volatile("" ::: "memory"); }
    }
};
struct EpiLnResLn {
    static constexpr bool PERM = false, AFTER_DRAIN = true;
    const float* base; float* out; bf16_t* xn; int ldc; const float* bias; PanelStats st1, st2; unsigned poison;
    __device__ __forceinline__ void fused(f32x4 (&acc)[2][2][4][2], const Unit& u, int wr, int wc, int fr, int fq, PG8_LAS unsigned char* lds, int wid, int lane) const {
        typedef float f32x2v __attribute__((ext_vector_type(2))); typedef unsigned u32x2v __attribute__((ext_vector_type(2)));
        const PG8_LAS f32x2v* S = (const PG8_LAS f32x2v*)(lds + 8192);
        const int col0 = u.pn * BM + wc * 32 + 4 * fq;
#pragma unroll
        for (int bj = 0; bj < 2; ++bj)
#pragma unroll
            for (int n = 0; n < 2; ++n) { const f32x4 bv = bias ? *(const f32x4*)(bias + col0 + bj * HALF + n * 16) : (f32x4){0.f, 0.f, 0.f, 0.f};
#pragma unroll
                for (int ai = 0; ai < 2; ++ai)
#pragma unroll
                    for (int m = 0; m < 4; ++m) acc[ai][bj][m][n] += bv; }
        bool bad = st1.run(acc, u, wr, wc, fr, fq, lds, wid, lane) || poison != 0u;
        const float qnan = __builtin_nanf("");
#pragma unroll
        for (int ai = 0; ai < 2; ++ai)
#pragma unroll
            for (int m = 0; m < 4; ++m) { const int r = ai * HALF + wr * 64 + m * 16 + fr; const f32x2v sr = S[r]; const size_t off = (size_t)(u.pm * BM + r) * ldc + col0;
#pragma unroll
                for (int bj = 0; bj < 2; ++bj)
#pragma unroll
                    for (int n = 0; n < 2; ++n) { const f32x4 bs = *(const f32x4*)(base + off + bj * HALF + n * 16); acc[ai][bj][m][n] = bs + (acc[ai][bj][m][n] - sr.x) * sr.y; }
                asm volatile("" : "+v"(acc[ai][0][m][0]), "+v"(acc[ai][0][m][1]), "+v"(acc[ai][1][m][0]), "+v"(acc[ai][1][m][1]));
                if (m & 1) asm volatile("" ::: "memory"); }
        const bool bad1 = bad;
        bad = st2.run(acc, u, wr, wc, fr, fq, lds, wid, lane) || bad;
#pragma unroll
        for (int ai = 0; ai < 2; ++ai)
#pragma unroll
            for (int m = 0; m < 4; ++m) { const int r = ai * HALF + wr * 64 + m * 16 + fr; const f32x2v sr = S[r]; const size_t off = (size_t)(u.pm * BM + r) * ldc + col0;
#pragma unroll
                for (int bj = 0; bj < 2; ++bj)
#pragma unroll
                    for (int n = 0; n < 2; ++n) { const f32x4 x1 = acc[ai][bj][m][n]; *(f32x4*)(out + off + bj * HALF + n * 16) = bad1 ? (f32x4){qnan, qnan, qnan, qnan} : x1;
                        const f32x4 o = (x1 - sr.x) * sr.y; u32x2v w; w.x = cvt_pk_bf16(o[0], o[1]); w.y = cvt_pk_bf16(o[2], o[3]);
                        if (bad) { w.x = 0x7fc07fc0u; w.y = 0x7fc07fc0u; } *(u32x2v*)(xn + off + bj * HALF + n * 16) = w; }
                asm volatile("" ::: "memory"); }
    }
};

template <class Epi, class Sched, bool ALIGN_EPI = false, bool SP2 = false>
__device__ __forceinline__ void gemm_phase(PG8_LAS unsigned char* lds, const Gemm g, const Sched& S, const Epi& E) {
    int tid_ = threadIdx.x; asm volatile("" : "+v"(tid_));
    const int tid = tid_, wid = __builtin_amdgcn_readfirstlane(tid >> 6), lane = tid & 63, wr = wid >> 2, wc = wid & 3, fr = lane & 15, fq = lane >> 4;
    const int K = g.K, nt = K / BK;
    unsigned voffA[2], voffB[2];
#pragma unroll
    for (int i = 0; i < 2; ++i) { int R, C; stage_rc(tid * 16 + i * 8192, R, C); const int Rb = Epi::PERM ? ((R & ~31) + perm32(R & 31)) : R;
        voffA[i] = (unsigned)(R * K + C) * 2u; voffB[i] = (unsigned)(Rb * K + C) * 2u; }
    const size_t kstep = (size_t)(BK * 2);
    const size_t hstep = (size_t)HALF * K * 2;
    const size_t tstep = 2 * hstep;
    const unsigned ldsw = (unsigned)wid * 1024u;
    const int aoff = lds_byte(wr * 64 + fr, fq * 8), boff = lds_byte(wc * 32 + fr, fq * 8);
#define PG8_SA(b, h) (((b) * 2 + (h)) * HTB)
#define PG8_SB(b, h) ((4 + (b) * 2 + (h)) * HTB)
#define PG8_STAGE(bufoff, gbase, voff) do { _Pragma("unroll") for (int _i = 0; _i < 2; ++_i) \
        __builtin_amdgcn_global_load_lds((const unsigned*)((const char*)(gbase) + (voff)[_i]), (PG8_LAS unsigned*)(lds + (bufoff) + ldsw + _i * 8192), 16, 0, 0); } while (0)
#define PG8_LDA(dst, b, h) do { _Pragma("unroll") for (int m = 0; m < 4; ++m) _Pragma("unroll") for (int k = 0; k < 2; ++k) dst[m][k] = *(const PG8_LAS bf16x8*)(lds + PG8_SA(b, h) + aoff + m * 2048 + k * 1024); } while (0)
#define PG8_LDB(dst, b, h) do { _Pragma("unroll") for (int n = 0; n < 2; ++n) _Pragma("unroll") for (int k = 0; k < 2; ++k) dst[n][k] = *(const PG8_LAS bf16x8*)(lds + PG8_SB(b, h) + boff + n * 2048 + k * 1024); } while (0)
#define PG8_MMA(ai, bj, At, Bt) do { __builtin_amdgcn_s_setprio(1); _Pragma("unroll") for (int m = 0; m < 4; ++m) _Pragma("unroll") for (int n = 0; n < 2; ++n) _Pragma("unroll") for (int k = 0; k < 2; ++k) \
        acc[ai][bj][m][n] = __builtin_amdgcn_mfma_f32_16x16x32_bf16(Bt[n][k], At[m][k], acc[ai][bj][m][n], 0, 0, 0); __builtin_amdgcn_s_setprio(0); } while (0)
#define PG8_WAIT_V(n) asm volatile("s_waitcnt vmcnt(" #n ")" ::: "memory")
#define PG8_WAIT_L(n) asm volatile("s_waitcnt lgkmcnt(" #n ")" ::: "memory")
#define PG8_BAR __builtin_amdgcn_s_barrier()
#define PG8_SCHED __builtin_amdgcn_sched_barrier(0)
    Unit cur, nxt; int ui = 0;
    if (!S.next(0, cur)) return;
    f32x4 acc[2][2][4][2];
#pragma unroll
    for (int a = 0; a < 2; ++a)
#pragma unroll
        for (int b = 0; b < 2; ++b)
#pragma unroll
            for (int m = 0; m < 4; ++m)
#pragma unroll
                for (int n = 0; n < 2; ++n) acc[a][b][m][n] = (f32x4){0.f, 0.f, 0.f, 0.f};
    bf16x8 At[4][2], B0[2][2], B1[2][2];
    const char* cA = (const char*)g.A + (size_t)cur.pm * tstep; const char* cB = (const char*)g.Bt + (size_t)cur.pn * tstep;
    S.a_ready(cur);
    if constexpr (SP2) {
        PG8_STAGE(PG8_SB(0, 0), cB, voffB); PG8_STAGE(PG8_SB(0, 1), cB + hstep, voffB); PG8_STAGE(PG8_SA(0, 0), cA, voffA); PG8_STAGE(PG8_SA(0, 1), cA + hstep, voffA);
        if (wr == 1) PG8_BAR;
        PG8_WAIT_V(2); PG8_BAR;
        PG8_STAGE(PG8_SB(1, 0), cB + kstep, voffB); PG8_STAGE(PG8_SA(1, 0), cA + kstep, voffA); PG8_STAGE(PG8_SB(1, 1), cB + hstep + kstep, voffB);
        PG8_WAIT_V(6); PG8_BAR;
    } else {
        PG8_STAGE(PG8_SB(0, 0), cB, voffB); PG8_STAGE(PG8_SA(0, 0), cA, voffA); PG8_STAGE(PG8_SB(0, 1), cB + hstep, voffB); PG8_STAGE(PG8_SA(0, 1), cA + hstep, voffA);
        if (wr == 1) PG8_BAR;
        PG8_WAIT_V(4); PG8_BAR;
        PG8_STAGE(PG8_SB(1, 0), cB + kstep, voffB); PG8_STAGE(PG8_SA(1, 0), cA + kstep, voffA); PG8_STAGE(PG8_SB(1, 1), cB + hstep + kstep, voffB);
        PG8_WAIT_V(6); PG8_BAR;
    }
    for (;;) {
        const bool has_next = S.next(ui + 1, nxt);
        const char* nA = has_next ? (const char*)g.A + (size_t)nxt.pm * tstep : cA; const char* nB = has_next ? (const char*)g.Bt + (size_t)nxt.pn * tstep : cB;
        for (int t = 0; t < nt; t += 2) {
            const bool last = (t == nt - 2);
            const char* a1 = cA + (size_t)(t + 1) * kstep;
            const char* a2 = last ? nA : cA + (size_t)(t + 2) * kstep; const char* b2 = last ? nB : cB + (size_t)(t + 2) * kstep;
            const char* a3 = a2 + kstep; const char* b3 = b2 + kstep;
            if (last && has_next) S.a_ready(nxt);
            if constexpr (SP2) {
            PG8_LDB(B0, 0, 0); PG8_LDB(B1, 0, 1); PG8_SCHED; PG8_LDA(At, 0, 0); PG8_STAGE(PG8_SA(1, 1), a1 + hstep, voffA);
            PG8_WAIT_V(8); PG8_WAIT_L(0); PG8_BAR; PG8_MMA(0, 0, At, B0); PG8_MMA(0, 1, At, B1); PG8_BAR; PG8_SCHED;
            PG8_LDA(At, 0, 1); PG8_STAGE(PG8_SB(0, 0), b2, voffB); PG8_STAGE(PG8_SB(0, 1), b2 + hstep, voffB); PG8_STAGE(PG8_SA(0, 0), a2, voffA);
            PG8_WAIT_V(8); PG8_WAIT_L(0); PG8_BAR; PG8_MMA(1, 0, At, B0); PG8_MMA(1, 1, At, B1); PG8_BAR; PG8_SCHED;
            PG8_LDB(B0, 1, 0); PG8_LDB(B1, 1, 1); PG8_SCHED; PG8_LDA(At, 1, 0); PG8_STAGE(PG8_SA(0, 1), a2 + hstep, voffA);
            PG8_WAIT_V(8); PG8_WAIT_L(0); PG8_BAR; PG8_MMA(0, 0, At, B0); PG8_MMA(0, 1, At, B1); PG8_BAR; PG8_SCHED;
            PG8_LDA(At, 1, 1); PG8_STAGE(PG8_SB(1, 0), b3, voffB); PG8_STAGE(PG8_SB(1, 1), b3 + hstep, voffB); PG8_STAGE(PG8_SA(1, 0), a3, voffA);
            PG8_WAIT_V(8); PG8_WAIT_L(0); PG8_BAR; PG8_MMA(1, 0, At, B0); PG8_MMA(1, 1, At, B1); PG8_BAR; PG8_SCHED;
            } else {
            PG8_LDB(B0, 0, 0); PG8_SCHED; PG8_LDA(At, 0, 0); PG8_STAGE(PG8_SA(1, 1), a1 + hstep, voffA);
            PG8_WAIT_L(8); PG8_BAR; PG8_WAIT_L(0); PG8_MMA(0, 0, At, B0); PG8_BAR; PG8_SCHED;
            PG8_LDB(B1, 0, 1); PG8_STAGE(PG8_SB(0, 0), b2, voffB);
            PG8_BAR; PG8_WAIT_L(0); PG8_MMA(0, 1, At, B1); PG8_BAR;
            PG8_LDA(At, 0, 1); PG8_STAGE(PG8_SA(0, 0), a2, voffA);
            PG8_BAR; PG8_WAIT_L(0); PG8_MMA(1, 0, At, B0); PG8_BAR; PG8_SCHED;
            PG8_STAGE(PG8_SB(0, 1), b2 + hstep, voffB);
            PG8_WAIT_V(6); PG8_BAR; PG8_MMA(1, 1, At, B1); PG8_BAR;
            PG8_LDB(B0, 1, 0); PG8_SCHED; PG8_LDA(At, 1, 0); PG8_STAGE(PG8_SA(0, 1), a2 + hstep, voffA);
            PG8_WAIT_L(8); PG8_BAR; PG8_WAIT_L(0); PG8_MMA(0, 0, At, B0); PG8_BAR; PG8_SCHED;
            PG8_LDB(B1, 1, 1); PG8_STAGE(PG8_SB(1, 0), b3, voffB);
            PG8_BAR; PG8_WAIT_L(0); PG8_MMA(0, 1, At, B1); PG8_BAR;
            PG8_LDA(At, 1, 1); PG8_STAGE(PG8_SA(1, 0), a3, voffA);
            PG8_BAR; PG8_WAIT_L(0); PG8_MMA(1, 0, At, B0); PG8_BAR; PG8_SCHED;
            PG8_STAGE(PG8_SB(1, 1), b3 + hstep, voffB);
            PG8_WAIT_V(6); PG8_BAR; PG8_MMA(1, 1, At, B1); PG8_BAR;
            }
        }
        if constexpr (ALIGN_EPI) { if (wr == 0) PG8_BAR; }
        if constexpr (Epi::CHAIN) { if (has_next) E.mid(acc, cur, wr, wc, fr, fq); else E(acc, cur, wr, wc, fr, fq); }
        else if constexpr (!Epi::AFTER_DRAIN) { E(acc, cur, wr, wc, fr, fq); S.done(cur); }
        if (!has_next) break;
        if constexpr (!Epi::CHAIN) {
#pragma unroll
        for (int a = 0; a < 2; ++a)
#pragma unroll
            for (int b = 0; b < 2; ++b)
#pragma unroll
                for (int m = 0; m < 4; ++m)
#pragma unroll
                    for (int n = 0; n < 2; ++n) acc[a][b][m][n] = (f32x4){0.f, 0.f, 0.f, 0.f};
        }
        cur = nxt; cA = nA; cB = nB; ++ui;
        if constexpr (ALIGN_EPI) { if (wr == 1) PG8_BAR; }
    }
    PG8_WAIT_V(0);
    if constexpr (!ALIGN_EPI) { if (wr == 0) PG8_BAR; }
    PG8_BAR;
    if constexpr (Epi::AFTER_DRAIN) { E.fused(acc, cur, wr, wc, fr, fq, lds, wid, lane); S.done(cur); }
#undef PG8_SA
#undef PG8_SB
#undef PG8_STAGE
#undef PG8_LDA
#undef PG8_LDB
#undef PG8_MMA
#undef PG8_WAIT_V
#undef PG8_WAIT_L
#undef PG8_BAR
#undef PG8_SCHED
}
}

#define LAS __attribute__((address_space(3)))
typedef unsigned short bf16;
typedef float f32x4 __attribute__((ext_vector_type(4)));
typedef float f32x2 __attribute__((ext_vector_type(2)));
typedef short bf16x8 __attribute__((ext_vector_type(8)));
typedef short s16x4 __attribute__((ext_vector_type(4)));
typedef short v4i16_t __attribute__((ext_vector_type(4)));
typedef unsigned u32x4 __attribute__((ext_vector_type(4)));
typedef unsigned u32x2 __attribute__((ext_vector_type(2)));

constexpr int NWAVES = 8, NTHREADS = 512;
constexpr int DM = 1024, SEQ = 4096, NBATCH = 4, MP = NBATCH * SEQ, NSMP = 32, MV = MP + NSMP, MT = 16640;
constexpr int DIN = 7680, QKV = 1536, DFF = 2816, NADA = 6144;
constexpr size_t O_YP = 0, O_YS = 16777216, O_KV0P = 16809984, O_KV1P = 17858560, O_KV2P = 22052864,
                 O_KV0S = 38830080, O_KV1S = 38895616, O_KV2S = 38961152, O_SV = 39026688, O_END = 39059456;
constexpr float LOG2E = 1.4426950408889634f;
constexpr float QSCALE = 0.08838834764831845f * LOG2E;

constexpr size_t MiB = 1u << 20;
constexpr size_t alm(size_t x) { return (x + MiB - 1) / MiB * MiB; }
constexpr size_t WS_WADA = 1 * MiB;
constexpr size_t WS_WL0 = WS_WADA + alm(2ull * NADA * DM * 2);
constexpr size_t WL_WIN = 0;
constexpr size_t WL_WPA = WL_WIN + alm((size_t)DIN * DM * 2);
constexpr size_t WL_WPS = WL_WPA + alm(1024ull * 512 * 2);
constexpr size_t WL_WOUT = WL_WPS + alm(1024ull * 512 * 2);
constexpr size_t WL_WFI = WL_WOUT + alm(1024ull * 1024 * 2);
constexpr size_t WL_WFO = WL_WFI + alm(5632ull * 1024 * 2);
constexpr size_t WL_WSP = WL_WFO + alm(1024ull * DFF * 2);
constexpr size_t WL_SIZE = WL_WSP + alm(8ull * 128 * 128 * 2);
constexpr size_t WS_MOD = WS_WL0 + 2 * WL_SIZE;
constexpr size_t WS_SC = WS_MOD + alm(2ull * 36 * NADA * 4);
constexpr size_t WS_XN = WS_SC + alm(256ull * DM * 2);
constexpr size_t WS_Q = WS_XN + alm((size_t)MT * DM * 2);
constexpr size_t WS_K = WS_Q + alm((size_t)MT * QKV * 2);
constexpr size_t WS_V = WS_K + alm((size_t)MT * QKV * 2);
constexpr size_t WS_U = WS_V + alm((size_t)MT * QKV * 2);
constexpr size_t WS_VS = WS_U + alm((size_t)MT * 512 * 2);
constexpr size_t WS_G = WS_VS + alm((size_t)MT * 512 * 2);
constexpr size_t WS_OG = WS_G + alm((size_t)MT * 2048 * 2);
constexpr size_t WS_DG = WS_OG + alm((size_t)MT * QKV * 2);
constexpr size_t WS_YY = WS_DG + alm((size_t)MT * 12 * 4);
constexpr size_t WS_T1 = WS_YY + alm((size_t)(2 * MP + 64) * 512 * 2);
constexpr size_t WS_MG = WS_T1 + alm((size_t)MT * DM * 4);
constexpr size_t WS_X1 = WS_MG + alm((size_t)MT * DM * 2);
constexpr size_t WS_X2 = WS_X1 + alm((size_t)MT * DM * 4);
constexpr size_t WS_H = WS_X2 + alm((size_t)MT * DM * 4);
constexpr size_t WS_END = WS_H + alm((size_t)MT * DFF * 2);

constexpr int LDS_RING = 0, LDS_EXCH = 131072, LDS_BYTES = 155648;

__device__ __forceinline__ float bf2f(unsigned short h) { return __uint_as_float((unsigned)h << 16); }
__device__ __forceinline__ unsigned pk2(float lo, float hi) { return pg8::cvt_pk_bf16(lo, hi); }
__device__ __forceinline__ float fast_exp2(float x) { return __builtin_amdgcn_exp2f(x); }
__device__ __forceinline__ float sigmoidf_(float x) { return __builtin_amdgcn_rcpf(1.0f + fast_exp2(-x * LOG2E)); }
__device__ __forceinline__ float wave_sum(float v) {
#pragma unroll
    for (int o = 1; o < 64; o <<= 1) v += __shfl_xor(v, o);
    return v;
}
__device__ __forceinline__ float wave_max(float v) {
#pragma unroll
    for (int o = 1; o < 64; o <<= 1) v = fmaxf(v, __shfl_xor(v, o));
    return v;
}
__device__ __forceinline__ s16x4 vtr(const LAS unsigned char* p) { return __builtin_bit_cast(s16x4, __builtin_amdgcn_ds_read_tr16_b64_v4i16((LAS v4i16_t*)p)); }
#define LDS_WAIT() asm volatile("s_waitcnt lgkmcnt(0)" ::: "memory")

__device__ __forceinline__ int mod_row(int row) { return row < MP ? (row >> 12) : 4 + (row - MP); }

__device__ __forceinline__ __attribute__((address_space(1))) float* kv_out_ptr(__attribute__((address_space(1))) float* out, int layer, int g, int row, int kvi, int hh) {
    if (row < MP) {
        const int b = row >> 12, t = row & 4095, lw = 128 << (2 * g), tt = t - (SEQ - lw);
        if (tt < 0) return nullptr;
        const size_t base = g == 0 ? O_KV0P : (g == 1 ? O_KV1P : O_KV2P);
        return out + base + ((((size_t)(layer * NBATCH + b) * lw + tt) * 2 + kvi) * 4 + hh) * 128;
    } else if (row < MV) {
        const int b = row - MP;
        const size_t base = g == 0 ? O_KV0S : (g == 1 ? O_KV1S : O_KV2S);
        return out + base + (((size_t)(layer * NSMP + b) * 2 + kvi) * 4 + hh) * 128;
    }
    return nullptr;
}

using pg8::Unit;
typedef pg8::f32x4 (AccT)[2][2][4][2];

__device__ __forceinline__ void st8_bf16g(__attribute__((address_space(1))) bf16* p, f32x4 v0, f32x4 v1) {
    u32x4 w; w.x = pk2(v0[0], v0[1]); w.y = pk2(v0[2], v0[3]); w.z = pk2(v1[0], v1[1]); w.w = pk2(v1[2], v1[3]);
    *(__attribute__((address_space(1))) u32x4*)p = w;
}
__device__ __forceinline__ void st8_bf16(bf16* p, f32x4 v0, f32x4 v1) {
    u32x4 w; w.x = pk2(v0[0], v0[1]); w.y = pk2(v0[2], v0[3]); w.z = pk2(v1[0], v1[1]); w.w = pk2(v1[2], v1[3]);
    *(u32x4*)p = w;
}

#define LAUNDER_S(x) asm volatile("" : "+s"(x))
#define GP(T, p) ((T*)(__attribute__((address_space(1))) T*)(p))
struct EpiAda {
    static constexpr bool PERM = true, AFTER_DRAIN = false, CHAIN = false;
    float* MOD; const float* b_ada;
    __device__ __forceinline__ void operator()(const pg8::f32x4 (&acc)[2][2][4][2], const Unit& u, int wr, int wc, int fr_, int fq_) const {
        int fr = fr_, fq = fq_; asm volatile("" : "+v"(fr), "+v"(fq));
        if (u.pm != 0 || wr != 0) return;
#pragma unroll
        for (int m = 0; m < 3; ++m) {
            const int row = m * 16 + fr;
            if (row >= 36) continue;
#pragma unroll
            for (int bj = 0; bj < 2; ++bj) {
                const int col = u.pn * 256 + bj * 128 + wc * 32 + 8 * fq;
                const int layer = col / NADA, c = col - layer * NADA;
                const float* bp = b_ada + (size_t)layer * NADA + c;
                float* op = MOD + ((size_t)layer * 36 + row) * NADA + c;
                *(f32x4*)op = acc[0][bj][m][0] + *(const f32x4*)bp;
                *(f32x4*)(op + 4) = acc[0][bj][m][1] + *(const f32x4*)(bp + 4);
            }
        }
    }
};

struct EpiIn {
    static constexpr bool PERM = true, AFTER_DRAIN = false, CHAIN = false;
    unsigned char* wsb; const float* qw; const float* kw; float* out; int layer; LAS float* P;
    __device__ __forceinline__ void operator()(const pg8::f32x4 (&acc)[2][2][4][2], const Unit& u, int wr, int wc, int fr_, int fq_) const {
        int fr = fr_, fq = fq_; asm volatile("" : "+v"(fr), "+v"(fq));
        unsigned char* wsl = wsb; const float* qwl = qw; const float* kwl = kw; float* outl = out; LAUNDER_S(wsl); LAUNDER_S(qwl); LAUNDER_S(kwl); LAUNDER_S(outl);
        typedef __attribute__((address_space(1))) bf16 gbf; typedef __attribute__((address_space(1))) float gfl;
        gbf *Q = (gbf*)(wsl + WS_Q), *K = (gbf*)(wsl + WS_K), *V = (gbf*)(wsl + WS_V), *U = (gbf*)(wsl + WS_U), *VS = (gbf*)(wsl + WS_VS), *G = (gbf*)(wsl + WS_G);
        gfl* outg = (gfl*)outl;
        const int pn = u.pn;
        const int cw = wc * 32 + 8 * fq;
        const int rowb = u.pm * 256 + wr * 64 + fr;
        if (pn < 12) {
            const bool isk = pn >= 6;
#pragma unroll
            for (int ai = 0; ai < 2; ++ai)
#pragma unroll
                for (int m = 0; m < 4; ++m)
#pragma unroll
                    for (int bj = 0; bj < 2; ++bj) {
                        const pg8::f32x4 a = acc[ai][bj][m][0], b = acc[ai][bj][m][1];
                        float s = (a[0] * a[0] + a[1] * a[1]) + (a[2] * a[2] + a[3] * a[3]) + (b[0] * b[0] + b[1] * b[1]) + (b[2] * b[2] + b[3] * b[3]);
                        s += __shfl_xor(s, 16); s += __shfl_xor(s, 32);
                        if (fq == 0) P[(ai * 128 + wr * 64 + m * 16 + fr) * 8 + bj * 4 + wc] = s;
                    }
            asm volatile("s_waitcnt lgkmcnt(0)" ::: "memory"); __builtin_amdgcn_s_barrier(); asm volatile("" ::: "memory");
#pragma unroll
            for (int bj = 0; bj < 2; ++bj) {
                const int head = 2 * (isk ? pn - 6 : pn) + bj, g = head >> 2, hh = head & 3;
                const __attribute__((address_space(1))) float* wv = (const __attribute__((address_space(1))) float*)(isk ? kwl : qwl) + g * 128 + cw;
                pg8::f32x4 w0 = *(const __attribute__((address_space(1))) f32x4*)wv, w1 = *(const __attribute__((address_space(1))) f32x4*)(wv + 4);
                if (!isk) { w0 = w0 * QSCALE; w1 = w1 * QSCALE; }
                gbf* dst = (isk ? K : Q) + head * 128 + cw;
#pragma unroll
                for (int ai = 0; ai < 2; ++ai)
#pragma unroll
                    for (int m = 0; m < 4; ++m) {
                        const int rl = ai * 128 + wr * 64 + m * 16 + fr, row = u.pm * 256 + rl;
                        const f32x4 pv = *(const LAS f32x4*)(P + rl * 8 + bj * 4);
                        const float rstd = 1.0f / sqrtf(((pv[0] + pv[1]) + (pv[2] + pv[3])) * (1.0f / 128.0f) + 1e-6f);
                        const pg8::f32x4 v0 = acc[ai][bj][m][0] * rstd * w0, v1 = acc[ai][bj][m][1] * rstd * w1;
                        st8_bf16g(dst + (size_t)row * QKV, v0, v1);
                        if (isk) { gfl* o = kv_out_ptr(outg, layer, g, row, 0, hh); if (o) { *(__attribute__((address_space(1))) f32x4*)(o + cw) = v0; *(__attribute__((address_space(1))) f32x4*)(o + cw + 4) = v1; } }
                    }
            }
        } else if (pn < 18) {
#pragma unroll
            for (int bj = 0; bj < 2; ++bj) {
                const int head = 2 * (pn - 12) + bj, g = head >> 2, hh = head & 3;
                gbf* dst = V + head * 128 + cw;
#pragma unroll
                for (int ai = 0; ai < 2; ++ai)
#pragma unroll
                    for (int m = 0; m < 4; ++m) {
                        const int row = rowb + ai * 128 + m * 16;
                        const pg8::f32x4 v0 = acc[ai][bj][m][0], v1 = acc[ai][bj][m][1];
                        st8_bf16g(dst + (size_t)row * QKV, v0, v1);
                        gfl* o = kv_out_ptr(outg, layer, g, row, 1, hh); if (o) { *(__attribute__((address_space(1))) f32x4*)(o + cw) = v0; *(__attribute__((address_space(1))) f32x4*)(o + cw + 4) = v1; }
                    }
            }
        } else if (pn < 22) {
            gbf* base = (pn < 20 ? U : VS) + ((pn - 18) & 1) * 256 + cw;
#pragma unroll
            for (int bj = 0; bj < 2; ++bj)
#pragma unroll
                for (int ai = 0; ai < 2; ++ai)
#pragma unroll
                    for (int m = 0; m < 4; ++m) {
                        const int row = rowb + ai * 128 + m * 16;
                        const pg8::f32x4 v0 = acc[ai][bj][m][0], v1 = acc[ai][bj][m][1];
                        const pg8::f32x2 a = pg8::gelu_pk((pg8::f32x2){v0[0], v0[1]}), b = pg8::gelu_pk((pg8::f32x2){v0[2], v0[3]}),
                                         c = pg8::gelu_pk((pg8::f32x2){v1[0], v1[1]}), d = pg8::gelu_pk((pg8::f32x2){v1[2], v1[3]});
                        st8_bf16g(base + (size_t)row * 512 + bj * 128, (f32x4){a.x, a.y, b.x, b.y}, (f32x4){c.x, c.y, d.x, d.y});
                    }
        } else {
            gbf* base = G + (pn - 22) * 256 + cw;
#pragma unroll
            for (int bj = 0; bj < 2; ++bj)
#pragma unroll
                for (int ai = 0; ai < 2; ++ai)
#pragma unroll
                    for (int m = 0; m < 4; ++m) {
                        const int row = rowb + ai * 128 + m * 16;
                        const pg8::f32x4 v0 = acc[ai][bj][m][0], v1 = acc[ai][bj][m][1];
                        st8_bf16g(base + (size_t)row * 2048 + bj * 128,
                                 (f32x4){sigmoidf_(v0[0]), sigmoidf_(v0[1]), sigmoidf_(v0[2]), sigmoidf_(v0[3])},
                                 (f32x4){sigmoidf_(v1[0]), sigmoidf_(v1[1]), sigmoidf_(v1[2]), sigmoidf_(v1[3])});
                    }
        }
    }
};

struct EpiGate1 {
    static constexpr bool PERM = true, AFTER_DRAIN = false, CHAIN = false;
    const bf16* G; float* T1;
    __device__ __forceinline__ void operator()(const pg8::f32x4 (&acc)[2][2][4][2], const Unit& u, int wr, int wc, int fr_, int fq_) const {
        int fr = fr_, fq = fq_; asm volatile("" : "+v"(fr), "+v"(fq));
        const int col0 = u.pn * 256 + wc * 32 + 8 * fq, rowb = u.pm * 256 + wr * 64 + fr;
#pragma unroll
        for (int ai = 0; ai < 2; ++ai)
#pragma unroll
            for (int m = 0; m < 4; ++m) {
                const int row = rowb + ai * 128 + m * 16;
#pragma unroll
                for (int bj = 0; bj < 2; ++bj) {
                    const int col = col0 + bj * 128;
                    const u32x4 gv = *(const u32x4*)(G + (size_t)row * 2048 + col);
                    const f32x4 g0 = {__uint_as_float(gv.x << 16), __uint_as_float(gv.x & 0xffff0000u), __uint_as_float(gv.y << 16), __uint_as_float(gv.y & 0xffff0000u)};
                    const f32x4 g1 = {__uint_as_float(gv.z << 16), __uint_as_float(gv.z & 0xffff0000u), __uint_as_float(gv.w << 16), __uint_as_float(gv.w & 0xffff0000u)};
                    float* o = T1 + (size_t)row * DM + col;
                    *(f32x4*)o = g0 * acc[ai][bj][m][0]; *(f32x4*)(o + 4) = g1 * acc[ai][bj][m][1];
                }
            }
    }
};
struct EpiGate2 {
    static constexpr bool PERM = true, AFTER_DRAIN = false, CHAIN = false;
    const bf16* G; const float* T1; bf16* MG;
    __device__ __forceinline__ void operator()(const pg8::f32x4 (&acc)[2][2][4][2], const Unit& u, int wr, int wc, int fr_, int fq_) const {
        int fr = fr_, fq = fq_; asm volatile("" : "+v"(fr), "+v"(fq));
        const int col0 = u.pn * 256 + wc * 32 + 8 * fq, rowb = u.pm * 256 + wr * 64 + fr;
#pragma unroll
        for (int ai = 0; ai < 2; ++ai)
#pragma unroll
            for (int m = 0; m < 4; ++m) {
                const int row = rowb + ai * 128 + m * 16;
#pragma unroll
                for (int bj = 0; bj < 2; ++bj) {
                    const int col = col0 + bj * 128;
                    const u32x4 gv = *(const u32x4*)(G + (size_t)row * 2048 + 1024 + col);
                    const f32x4 g0 = {__uint_as_float(gv.x << 16), __uint_as_float(gv.x & 0xffff0000u), __uint_as_float(gv.y << 16), __uint_as_float(gv.y & 0xffff0000u)};
                    const f32x4 g1 = {__uint_as_float(gv.z << 16), __uint_as_float(gv.z & 0xffff0000u), __uint_as_float(gv.w << 16), __uint_as_float(gv.w & 0xffff0000u)};
                    const float* t = T1 + (size_t)row * DM + col;
                    const f32x4 t0 = *(const f32x4*)t, t1 = *(const f32x4*)(t + 4);
                    st8_bf16(MG + (size_t)row * DM + col, t0 + g0 * acc[ai][bj][m][0], t1 + g1 * acc[ai][bj][m][1]);
                }
            }
    }
};

struct PairOrder {
    pg8::StaticOrder S0;
    __device__ bool next(int i, Unit& u) const { if (i >= 2) return false; Unit b; if (!S0.next(0, b)) return false; u.pm = b.pm + (i ? MP / 256 : 0); u.pn = b.pn + (i ? 4 : 0); return true; }
    __device__ __forceinline__ void a_ready(const Unit&) const {}
    __device__ __forceinline__ void done(const Unit&) const {}
};
__device__ __forceinline__ void unpack8(const u32x4 gv, f32x4& g0, f32x4& g1) {
    g0 = (f32x4){__uint_as_float(gv.x << 16), __uint_as_float(gv.x & 0xffff0000u), __uint_as_float(gv.y << 16), __uint_as_float(gv.y & 0xffff0000u)};
    g1 = (f32x4){__uint_as_float(gv.z << 16), __uint_as_float(gv.z & 0xffff0000u), __uint_as_float(gv.w << 16), __uint_as_float(gv.w & 0xffff0000u)};
}
struct EpiMerged {
    static constexpr bool PERM = true, AFTER_DRAIN = false, CHAIN = true;
    const bf16* G; bf16* MG;
    __device__ __forceinline__ void mid(pg8::f32x4 (&acc)[2][2][4][2], const Unit& u, int wr, int wc, int fr_, int fq_) const {
        int fr = fr_, fq = fq_; asm volatile("" : "+v"(fr), "+v"(fq));
        const int col0 = u.pn * 256 + wc * 32 + 8 * fq, rowb = u.pm * 256 + wr * 64 + fr;
#pragma unroll
        for (int ai = 0; ai < 2; ++ai)
#pragma unroll
            for (int m = 0; m < 4; ++m) {
                const int row = rowb + ai * 128 + m * 16;
#pragma unroll
                for (int bj = 0; bj < 2; ++bj) {
                    const int col = col0 + bj * 128;
                    f32x4 a0, a1, b0, b1;
                    unpack8(*(const u32x4*)(G + (size_t)row * 2048 + col), a0, a1);
                    unpack8(*(const u32x4*)(G + (size_t)row * 2048 + 1024 + col), b0, b1);
#pragma unroll
                    for (int e = 0; e < 4; ++e) {
                        acc[ai][bj][m][0][e] *= a0[e] * __builtin_amdgcn_rcpf(fmaxf(b0[e], 1e-30f));
                        acc[ai][bj][m][1][e] *= a1[e] * __builtin_amdgcn_rcpf(fmaxf(b1[e], 1e-30f));
                    }
                }
            }
    }
    __device__ __forceinline__ void operator()(const pg8::f32x4 (&acc)[2][2][4][2], const Unit& u, int wr, int wc, int fr_, int fq_) const {
        int fr = fr_, fq = fq_; asm volatile("" : "+v"(fr), "+v"(fq));
        const int col0 = (u.pn - 4) * 256 + wc * 32 + 8 * fq, rowb = (u.pm - MP / 256) * 256 + wr * 64 + fr;
#pragma unroll
        for (int ai = 0; ai < 2; ++ai)
#pragma unroll
            for (int m = 0; m < 4; ++m) {
                const int row = rowb + ai * 128 + m * 16;
#pragma unroll
                for (int bj = 0; bj < 2; ++bj) {
                    const int col = col0 + bj * 128;
                    f32x4 b0, b1;
                    unpack8(*(const u32x4*)(G + (size_t)row * 2048 + 1024 + col), b0, b1);
                    st8_bf16(MG + (size_t)row * DM + col, b0 * acc[ai][bj][m][0], b1 * acc[ai][bj][m][1]);
                }
            }
    }
};
struct EpiRes {
    static constexpr bool PERM = true, AFTER_DRAIN = false, CHAIN = false;
    const float* bp; const float* bs; float* op; float* os; const float* gate;
    __device__ __forceinline__ void operator()(const pg8::f32x4 (&acc)[2][2][4][2], const Unit& u, int wr, int wc, int fr_, int fq_) const {
        int fr = fr_, fq = fq_; asm volatile("" : "+v"(fr), "+v"(fq));
        const int col0 = u.pn * 256 + wc * 32 + 8 * fq, rowb = u.pm * 256 + wr * 64 + fr;
#pragma unroll
        for (int ai = 0; ai < 2; ++ai)
#pragma unroll
            for (int m = 0; m < 4; ++m) {
                const int row = rowb + ai * 128 + m * 16;
                if (row < MV) {
                    const float* b = row < MP ? bp + (size_t)row * DM : bs + (size_t)(row - MP) * DM;
                    float* o = row < MP ? op + (size_t)row * DM : os + (size_t)(row - MP) * DM;
                    const float* gt = gate + (size_t)mod_row(row) * NADA;
#pragma unroll
                    for (int bj = 0; bj < 2; ++bj) {
                        const int col = col0 + bj * 128;
                        const f32x4 b0 = *(const f32x4*)(b + col), b1 = *(const f32x4*)(b + col + 4);
                        const f32x4 g0 = *(const f32x4*)(gt + col), g1 = *(const f32x4*)(gt + col + 4);
                        *(f32x4*)(o + col) = b0 + g0 * acc[ai][bj][m][0]; *(f32x4*)(o + col + 4) = b1 + g1 * acc[ai][bj][m][1];
                    }
                }
            }
    }
};
struct EpiSwiglu {
    static constexpr bool PERM = true, AFTER_DRAIN = false, CHAIN = false;
    bf16* H;
    __device__ __forceinline__ void operator()(const pg8::f32x4 (&acc)[2][2][4][2], const Unit& u, int wr, int wc, int fr_, int fq_) const {
        int fr = fr_, fq = fq_; asm volatile("" : "+v"(fr), "+v"(fq));
        const int col = u.pn * 128 + wc * 32 + 8 * fq, rowb = u.pm * 256 + wr * 64 + fr;
#pragma unroll
        for (int ai = 0; ai < 2; ++ai)
#pragma unroll
            for (int m = 0; m < 4; ++m) {
                const int row = rowb + ai * 128 + m * 16;
                f32x4 r0, r1;
#pragma unroll
                for (int e = 0; e < 4; ++e) {
                    const float a0 = acc[ai][0][m][0][e], a1 = acc[ai][0][m][1][e];
                    r0[e] = a0 * sigmoidf_(a0) * acc[ai][1][m][0][e];
                    r1[e] = a1 * sigmoidf_(a1) * acc[ai][1][m][1][e];
                }
                st8_bf16(H + (size_t)row * DFF + col, r0, r1);
            }
    }
};

__device__ __forceinline__ void transpose_item(const float* W, int K, int N, bf16* WT, int mode, LAS float* scr, int item, int lane) {
    const int nblk = N / 32, kb = item / nblk, nb = item % nblk, k0 = 64 * kb, n0 = 32 * nb;
    float wv[32];
#pragma unroll
    for (int i = 0; i < 32; ++i) wv[i] = W[(size_t)(k0 + 2 * i + (lane >> 5)) * N + n0 + (lane & 31)];
#pragma unroll
    for (int i = 0; i < 32; ++i) scr[(2 * i + (lane >> 5)) * 33 + (lane & 31)] = wv[i];
    LDS_WAIT(); asm volatile("" ::: "memory");
    int drow0 = n0;
    if (mode == 1) { const int bj = n0 >= DFF ? 1 : 0; const int j0 = n0 - bj * DFF; drow0 = (j0 >> 7) * 256 + bj * 128 + (j0 & 127); }
    const int c = lane & 7;
#pragma unroll
    for (int j = 0; j < 4; ++j) { const int n = (lane >> 3) + 8 * j; const LAS float* s = scr + (8 * c) * 33 + n;
        u32x4 o; o.x = pk2(s[0 * 33], s[1 * 33]); o.y = pk2(s[2 * 33], s[3 * 33]); o.z = pk2(s[4 * 33], s[5 * 33]); o.w = pk2(s[6 * 33], s[7 * 33]);
        *(u32x4*)(WT + (size_t)(drow0 + n) * K + k0 + 8 * c) = o; }
    LDS_WAIT(); asm volatile("" ::: "memory");
}

__device__ __forceinline__ void norm_mod_phase(const float* xp, const float* xs, const float* nw, const float* modl, int sh_off, bf16* XN, int gw, int NGW, int lane) {
    f32x4 w[4];
#pragma unroll
    for (int j = 0; j < 4; ++j) w[j] = *(const f32x4*)(nw + 4 * lane + 256 * j);
    for (int row0 = gw; row0 < MT; row0 += 2 * NGW) {
        f32x4 v[2][4];
#pragma unroll
        for (int q = 0; q < 2; ++q) {
            const int row = row0 + q * NGW;
            if (row < MV) {
                const float* xrow = row < MP ? xp + (size_t)row * DM : xs + (size_t)(row - MP) * DM;
#pragma unroll
                for (int j = 0; j < 4; ++j) v[q][j] = ((const f32x4*)xrow)[lane + 64 * j];
            } else {
#pragma unroll
                for (int j = 0; j < 4; ++j) v[q][j] = (f32x4){0.f, 0.f, 0.f, 0.f};
            }
        }
#pragma unroll
        for (int q = 0; q < 2; ++q) {
            const int row = row0 + q * NGW;
            if (row >= MT) continue;
            unsigned long long* o8 = (unsigned long long*)(XN + (size_t)row * DM) + lane;
            if (row >= MV) {
#pragma unroll
                for (int j = 0; j < 4; ++j) o8[64 * j] = 0ull;
                continue;
            }
            float s = 0.f;
#pragma unroll
            for (int j = 0; j < 4; ++j) s += (v[q][j].x * v[q][j].x + v[q][j].y * v[q][j].y) + (v[q][j].z * v[q][j].z + v[q][j].w * v[q][j].w);
            const float rstd = 1.0f / sqrtf(wave_sum(s) * (1.0f / DM) + 1e-6f);
            const float* mr = modl + (size_t)mod_row(row) * NADA + sh_off;
#pragma unroll
            for (int j = 0; j < 4; ++j) {
                const int col = 4 * lane + 256 * j;
                const f32x4 shv = *(const f32x4*)(mr + col), scv = *(const f32x4*)(mr + 1024 + col);
                const f32x4 y = v[q][j] * rstd * w[j] * (scv + 1.0f) + shv;
                o8[64 * j] = (unsigned long long)pk2(y.x, y.y) | ((unsigned long long)pk2(y.z, y.w) << 32);
            }
        }
    }
}

constexpr int KV_STRIDE = 272;
constexpr int ATT_K_OFF = 0, ATT_V_OFF = 256 * KV_STRIDE;
__device__ __forceinline__ float alibi_slope(int head12) { return exp2f(-8.0f * (float)(head12 + 1) / 12.0f); }

__device__ __forceinline__ void attn_unit(LAS unsigned char* lds, const bf16* Q, const bf16* K, const bf16* V, bf16* OG, float* DG, int unit, float cshift, int wid, int lane, int tid) {
    const int g = unit >> 9, r9 = unit & 511, sh = 2 * g, d = 1 << sh, nb = 32 >> sh;
    const int qb = r9 % nb; int t2 = r9 / nb; const int r = t2 % d; t2 /= d; const int h = t2 & 3, b = t2 >> 2;
    const int hc = (g * 4 + h) * 128;
    {
        const int ch = tid & 15, r0 = tid >> 4;
        u32x4 kv[8], vv[8];
#pragma unroll
        for (int it = 0; it < 8; ++it) {
            const int j = r0 + 32 * it, mk = 128 * qb - 128 + j;
            if (qb > 0 || it >= 4) {
                const size_t off = ((size_t)b * SEQ + (size_t)mk * d + r) * QKV + hc + ch * 8;
                kv[it] = *(const u32x4*)(K + off); vv[it] = *(const u32x4*)(V + off);
            } else { kv[it] = (u32x4){0u, 0u, 0u, 0u}; vv[it] = (u32x4){0u, 0u, 0u, 0u}; }
        }
#pragma unroll
        for (int it = 0; it < 8; ++it) {
            const int j = r0 + 32 * it;
            *(LAS u32x4*)(lds + ATT_K_OFF + j * KV_STRIDE + ch * 16) = kv[it];
            *(LAS u32x4*)(lds + ATT_V_OFF + j * KV_STRIDE + ch * 16) = vv[it];
        }
    }
    const int ql = lane & 15, gq = lane >> 4;
    const int qi = 16 * wid + ql;
    const size_t qrow = (size_t)b * SEQ + (size_t)(128 * qb + qi) * d + r;
    bf16x8 qf[4];
#pragma unroll
    for (int kk = 0; kk < 4; ++kk) qf[kk] = *(const bf16x8*)(Q + qrow * QKV + hc + 32 * kk + 8 * gq);
    const float slope2 = alibi_slope(g * 4 + h) * LOG2E * (float)d;
    __syncthreads();
    f32x4 accO[8];
#pragma unroll
    for (int dt = 0; dt < 8; ++dt) accO[dt] = (f32x4){0.f, 0.f, 0.f, 0.f};
    float dsum = 0.f;
    const LAS unsigned char* kbase = lds + ATT_K_OFF + (16 * wid + ql) * KV_STRIDE + gq * 16;
    const LAS unsigned char* vbase = lds + ATT_V_OFF + (16 * wid + 4 * gq + (ql >> 2)) * KV_STRIDE + (ql & 3) * 8;
#pragma unroll
    for (int kt2 = 0; kt2 < 5; ++kt2) {
        const int ja = 16 * wid + 32 * kt2;
        f32x4 sa = {0.f, 0.f, 0.f, 0.f}, sb = {0.f, 0.f, 0.f, 0.f};
#pragma unroll
        for (int kk = 0; kk < 4; ++kk) {
            const bf16x8 ka = *(const LAS bf16x8*)(kbase + (32 * kt2) * KV_STRIDE + kk * 64);
            sa = __builtin_amdgcn_mfma_f32_16x16x32_bf16(ka, qf[kk], sa, 0, 0, 0);
        }
        if (kt2 < 4) {
#pragma unroll
            for (int kk = 0; kk < 4; ++kk) {
                const bf16x8 kb = *(const LAS bf16x8*)(kbase + (32 * kt2 + 16) * KV_STRIDE + kk * 64);
                sb = __builtin_amdgcn_mfma_f32_16x16x32_bf16(kb, qf[kk], sb, 0, 0, 0);
            }
        }
        float pa[4], pb[4];
#pragma unroll
        for (int jj = 0; jj < 4; ++jj) {
            const int j = ja + 4 * gq + jj, dist = 128 + qi - j;
            const bool ok = dist >= 0 && dist <= 128 && (128 * qb - 128 + j) >= 0;
            pa[jj] = ok ? fast_exp2(sa[jj] - slope2 * (float)dist - cshift) : 0.f;
            const int j2 = j + 16, dist2 = dist - 16;
            const bool ok2 = (kt2 < 4) && dist2 >= 0 && dist2 <= 128 && (128 * qb - 128 + j2) >= 0;
            pb[jj] = ok2 ? fast_exp2(sb[jj] - slope2 * (float)dist2 - cshift) : 0.f;
            dsum += pa[jj] + pb[jj];
        }
        u32x4 pw; pw.x = pk2(pa[0], pa[1]); pw.y = pk2(pa[2], pa[3]); pw.z = pk2(pb[0], pb[1]); pw.w = pk2(pb[2], pb[3]);
        const bf16x8 pfrag = __builtin_bit_cast(bf16x8, pw);
        const int rb = (kt2 < 4) ? (32 * kt2 + 16) : (32 * kt2);
#pragma unroll
        for (int dt = 0; dt < 8; ++dt) {
            const s16x4 lo = vtr(vbase + (32 * kt2) * KV_STRIDE + dt * 32);
            const s16x4 hi = vtr(vbase + rb * KV_STRIDE + dt * 32);
            const bf16x8 vf = {lo[0], lo[1], lo[2], lo[3], hi[0], hi[1], hi[2], hi[3]};
            accO[dt] = __builtin_amdgcn_mfma_f32_16x16x32_bf16(vf, pfrag, accO[dt], 0, 0, 0);
        }
    }
    dsum += __shfl_xor(dsum, 16); dsum += __shfl_xor(dsum, 32);
    const float inv = 1.0f / dsum;
    bf16* op = OG + qrow * QKV + g * 512 + h * 128 + 4 * gq;
#pragma unroll
    for (int dt = 0; dt < 8; ++dt) {
        u32x2 w; w.x = pk2(accO[dt][0] * inv, accO[dt][1] * inv); w.y = pk2(accO[dt][2] * inv, accO[dt][3] * inv);
        *(u32x2*)(op + dt * 16) = w;
    }
    if (gq == 0) DG[qrow * 12 + g * 4 + h] = dsum;
    __syncthreads();
}


struct AttnU { int g, b, h, r, qb, d, hc; };
__device__ __forceinline__ AttnU attn_decode(int unit) {
    AttnU a; a.g = unit >> 9; const int r9 = unit & 511, sh = 2 * a.g, nb = 32 >> sh; a.d = 1 << sh;
    a.qb = r9 % nb; int t2 = r9 / nb; a.r = t2 % a.d; t2 /= a.d; a.h = t2 & 3; a.b = t2 >> 2; a.hc = (a.g * 4 + a.h) * 128; return a;
}
constexpr int ATT_BLK = 128 * KV_STRIDE;
__device__ __forceinline__ void attn_load_block(u32x4 (&kn)[4], u32x4 (&vn)[4], const bf16* K, const bf16* V, const AttnU& a, int blk, int tid) {
    const int ch = tid & 15, r0 = tid >> 4;
#pragma unroll
    for (int it = 0; it < 4; ++it) {
        const size_t off = ((size_t)a.b * SEQ + (size_t)(128 * blk + r0 + 32 * it) * a.d + a.r) * QKV + a.hc + ch * 8;
        kn[it] = *(const u32x4*)(K + off); vn[it] = *(const u32x4*)(V + off);
    }
}
__device__ __forceinline__ void attn_store_block(LAS unsigned char* lds, int slot, const u32x4 (&kn)[4], const u32x4 (&vn)[4], int tid) {
    const int ch = tid & 15, r0 = tid >> 4;
#pragma unroll
    for (int it = 0; it < 4; ++it) {
        *(LAS u32x4*)(lds + slot * ATT_BLK + (r0 + 32 * it) * KV_STRIDE + ch * 16) = kn[it];
        *(LAS u32x4*)(lds + (2 + slot) * ATT_BLK + (r0 + 32 * it) * KV_STRIDE + ch * 16) = vn[it];
    }
}
__device__ __forceinline__ void attn_units(LAS unsigned char* lds, const bf16* Q, const bf16* K, const bf16* V, bf16* OG, float* DG, int u0, int nu, float cshift, int wid, int lane, int tid) {
    if (nu <= 0) return;
    int p = 0;
    u32x4 kn[4], vn[4];
    AttnU a = attn_decode(u0);
    attn_load_block(kn, vn, K, V, a, a.qb, tid);
    const int ql = lane & 15, gq = lane >> 4;
    for (int ui = 0; ui < nu; ++ui) {
        a = attn_decode(u0 + ui);
        if (!(ui > 0 && a.qb > 0)) {
            u32x4 kp[4], vp[4];
            if (a.qb == 0) {
#pragma unroll
                for (int it = 0; it < 4; ++it) { kp[it] = (u32x4){0u, 0u, 0u, 0u}; vp[it] = (u32x4){0u, 0u, 0u, 0u}; }
            } else attn_load_block(kp, vp, K, V, a, a.qb - 1, tid);
            attn_store_block(lds, p, kp, vp, tid);
        }
        attn_store_block(lds, 1 - p, kn, vn, tid);
        const int qi = 16 * wid + ql;
        const size_t qrow = (size_t)a.b * SEQ + (size_t)(128 * a.qb + qi) * a.d + a.r;
        bf16x8 qf[4];
#pragma unroll
        for (int kk = 0; kk < 4; ++kk) qf[kk] = *(const bf16x8*)(Q + qrow * QKV + a.hc + 32 * kk + 8 * gq);
        const float slope2 = alibi_slope(a.g * 4 + a.h) * LOG2E * (float)a.d;
        __syncthreads();
        if (ui + 1 < nu) { const AttnU an = attn_decode(u0 + ui + 1); attn_load_block(kn, vn, K, V, an, an.qb, tid); }
        f32x4 accO[8];
#pragma unroll
        for (int dt = 0; dt < 8; ++dt) accO[dt] = (f32x4){0.f, 0.f, 0.f, 0.f};
        float dsum = 0.f;
        const int kl = ql * KV_STRIDE + gq * 16, vl = (4 * gq + (ql >> 2)) * KV_STRIDE + (ql & 3) * 8;
#pragma unroll
        for (int kt2 = 0; kt2 < 5; ++kt2) {
            const int ja = 16 * wid + 32 * kt2, jb = ja + 16;
            const int offA = (((ja >> 7) ^ p) * ATT_BLK) + (ja & 127) * KV_STRIDE;
            const int offB = (kt2 < 4) ? ((((jb >> 7) ^ p) * ATT_BLK) + (jb & 127) * KV_STRIDE) : offA;
            f32x4 sa = {0.f, 0.f, 0.f, 0.f}, sb = {0.f, 0.f, 0.f, 0.f};
#pragma unroll
            for (int kk = 0; kk < 4; ++kk) {
                const bf16x8 ka = *(const LAS bf16x8*)(lds + offA + kl + kk * 64);
                sa = __builtin_amdgcn_mfma_f32_16x16x32_bf16(ka, qf[kk], sa, 0, 0, 0);
            }
            if (kt2 < 4) {
#pragma unroll
                for (int kk = 0; kk < 4; ++kk) {
                    const bf16x8 kb = *(const LAS bf16x8*)(lds + offB + kl + kk * 64);
                    sb = __builtin_amdgcn_mfma_f32_16x16x32_bf16(kb, qf[kk], sb, 0, 0, 0);
                }
            }
            float pa[4], pb[4];
#pragma unroll
            for (int jj = 0; jj < 4; ++jj) {
                const int j = ja + 4 * gq + jj, dist = 128 + qi - j;
                const bool ok = dist >= 0 && dist <= 128 && (128 * a.qb - 128 + j) >= 0;
                pa[jj] = ok ? fast_exp2(sa[jj] - slope2 * (float)dist - cshift) : 0.f;
                const int j2 = j + 16, dist2 = dist - 16;
                const bool ok2 = (kt2 < 4) && dist2 >= 0 && dist2 <= 128 && (128 * a.qb - 128 + j2) >= 0;
                pb[jj] = ok2 ? fast_exp2(sb[jj] - slope2 * (float)dist2 - cshift) : 0.f;
                dsum += pa[jj] + pb[jj];
            }
            u32x4 pw; pw.x = pk2(pa[0], pa[1]); pw.y = pk2(pa[2], pa[3]); pw.z = pk2(pb[0], pb[1]); pw.w = pk2(pb[2], pb[3]);
            const bf16x8 pfrag = __builtin_bit_cast(bf16x8, pw);
#pragma unroll
            for (int dt = 0; dt < 8; ++dt) {
                const s16x4 lo = vtr(lds + 2 * ATT_BLK + offA + vl + dt * 32);
                const s16x4 hi = vtr(lds + 2 * ATT_BLK + offB + vl + dt * 32);
                const bf16x8 vf = {lo[0], lo[1], lo[2], lo[3], hi[0], hi[1], hi[2], hi[3]};
                accO[dt] = __builtin_amdgcn_mfma_f32_16x16x32_bf16(vf, pfrag, accO[dt], 0, 0, 0);
            }
        }
        dsum += __shfl_xor(dsum, 16); dsum += __shfl_xor(dsum, 32);
        const float inv = 1.0f / dsum;
        bf16* op = OG + qrow * QKV + a.g * 512 + a.h * 128 + 4 * gq;
#pragma unroll
        for (int dt = 0; dt < 8; ++dt) {
            u32x2 w; w.x = pk2(accO[dt][0] * inv, accO[dt][1] * inv); w.y = pk2(accO[dt][2] * inv, accO[dt][3] * inv);
            *(u32x2*)(op + dt * 16) = w;
        }
        if (gq == 0) DG[qrow * 12 + a.g * 4 + a.h] = dsum;
        __syncthreads();
        p ^= 1;
    }
}

__device__ __forceinline__ void attn_sample_item(LAS unsigned char* lds, const bf16* Q, const bf16* K, const bf16* V, const float* c0, const float* c1, const float* c2, int layer, bf16* YA, int item, int wid, int lane, int tid) {
    const int b = item >> 2, h = item & 3;
    LAS float* sc = (LAS float*)lds;
    LAS float* qs = (LAS float*)(lds + 2048);
    LAS float* part = (LAS float*)(lds + 4096);
    LAS float* pself = (LAS float*)(lds + 8192);
    const size_t row = (size_t)MP + b;
    if (tid < 384) { const int g = tid >> 7, dd = tid & 127; qs[tid] = bf2f(Q[row * QKV + (g * 4 + h) * 128 + dd]); }
    LDS_WAIT(); __syncthreads();
    const int k = lane >> 2, qd = lane & 3;
    {
        f32x4 kv[3][8];
#pragma unroll
        for (int i = 0; i < 3; ++i) {
            const int jj = 16 * (wid + 8 * i) + k, g = (wid + 8 * i) >> 3  , step = (jj & 127) + 1, d = 1 << (2 * g), lc = 128 << (2 * g);
            const float* cp = (g == 0 ? c0 : (g == 1 ? c1 : c2)) + ((((size_t)(layer * NSMP + b) * lc + (lc - d * step)) * 2 + 0) * 4 + h) * 128 + qd * 32;
#pragma unroll
            for (int e = 0; e < 8; ++e) kv[i][e] = *(const f32x4*)(cp + 4 * e);
        }
#pragma unroll
        for (int i = 0; i < 3; ++i) {
            const int jj = 16 * (wid + 8 * i) + k, g = i, step = (jj & 127) + 1, d = 1 << (2 * g);
            float s = 0.f;
#pragma unroll
            for (int e = 0; e < 8; ++e) { const f32x4 qv = *(const LAS f32x4*)(qs + g * 128 + qd * 32 + 4 * e); s += (kv[i][e].x * qv.x + kv[i][e].y * qv.y) + (kv[i][e].z * qv.z + kv[i][e].w * qv.w); }
            s += __shfl_xor(s, 1); s += __shfl_xor(s, 2);
            s -= alibi_slope(g * 4 + h) * LOG2E * (float)(d * step);
            if (qd == 0) sc[g * 132 + step] = s;
        }
        if (wid < 3) {
            const unsigned kk = *(const unsigned*)(K + row * QKV + (wid * 4 + h) * 128 + 2 * lane);
            float s = __uint_as_float(kk << 16) * qs[wid * 128 + 2 * lane] + __uint_as_float(kk & 0xffff0000u) * qs[wid * 128 + 2 * lane + 1];
            s = wave_sum(s);
            if (lane == 0) sc[wid * 132] = s;
        }
    }
    LDS_WAIT(); __syncthreads();
    float mx = -3.0e38f;
    for (int j = lane; j < 387; j += 64) { const int g = j / 129; mx = fmaxf(mx, sc[g * 132 + (j - g * 129)]); }
    mx = wave_max(mx);
    float den = 0.f;
    for (int j = lane; j < 387; j += 64) { const int g = j / 129; den += fast_exp2(sc[g * 132 + (j - g * 129)] - mx); }
    den = wave_sum(den);
    {
        f32x4 vv[3][8];
#pragma unroll
        for (int i = 0; i < 3; ++i) {
            const int jj = 16 * (wid + 8 * i) + k, g = i, step = (jj & 127) + 1, d = 1 << (2 * g), lc = 128 << (2 * g);
            const float* cp = (g == 0 ? c0 : (g == 1 ? c1 : c2)) + ((((size_t)(layer * NSMP + b) * lc + (lc - d * step)) * 2 + 1) * 4 + h) * 128 + qd * 32;
#pragma unroll
            for (int e = 0; e < 8; ++e) vv[i][e] = *(const f32x4*)(cp + 4 * e);
        }
        f32x4 acc[8];
#pragma unroll
        for (int e = 0; e < 8; ++e) acc[e] = (f32x4){0.f, 0.f, 0.f, 0.f};
#pragma unroll
        for (int i = 0; i < 3; ++i) {
            const int jj = 16 * (wid + 8 * i) + k, step = (jj & 127) + 1;
            const float p = fast_exp2(sc[i * 132 + step] - mx);
#pragma unroll
            for (int e = 0; e < 8; ++e) acc[e] += vv[i][e] * p;
        }
#pragma unroll
        for (int e = 0; e < 8; ++e)
#pragma unroll
            for (int c = 0; c < 4; ++c) { float v = acc[e][c]; v += __shfl_xor(v, 4); v += __shfl_xor(v, 8); v += __shfl_xor(v, 16); v += __shfl_xor(v, 32); acc[e][c] = v; }
        if (k == 0) {
#pragma unroll
            for (int e = 0; e < 8; ++e) *(LAS f32x4*)(part + wid * 128 + qd * 32 + 4 * e) = acc[e];
        }
        if (tid < 3) pself[tid] = fast_exp2(sc[tid * 132] - mx);
    }
    LDS_WAIT(); __syncthreads();
    if (tid < 128) {
        float a = 0.f;
#pragma unroll
        for (int w = 0; w < 8; ++w) a += part[w * 128 + tid];
#pragma unroll
        for (int g = 0; g < 3; ++g) a += pself[g] * bf2f(V[row * QKV + (g * 4 + h) * 128 + tid]);
        YA[row * 512 + h * 128 + tid] = (bf16)(pk2(a / den, 0.f) & 0xffffu);
    }
    LDS_WAIT(); __syncthreads();
}

constexpr int SG_STRIDE = 144;
constexpr int SG_SLAB = 128 * SG_STRIDE;
constexpr int SG_STATS = 4 * SG_SLAB;
__device__ __forceinline__ void sgu_unit(LAS unsigned char* lds, const bf16* U, const bf16* VS, const float* lnw, const float* lnb, const bf16* WSP, const float* bsp, bf16* YS, int unit, int wid, int lane) {
    const int half = unit & 1, bn = unit >> 1;
    const size_t R0 = (size_t)bn * 128;
    LAS f32x2* stats = (LAS f32x2*)(lds + SG_STATS);
    u32x4 xs16[16];
#pragma unroll
    for (int i = 0; i < 16; ++i) xs16[i] = *(const u32x4*)(VS + (R0 + 16 * wid + i) * 512 + 8 * lane);
#pragma unroll
    for (int i = 0; i < 16; ++i) {
        const int rl = 16 * wid + i;
        const u32x4 x = xs16[i];
        const float f[8] = {__uint_as_float(x.x << 16), __uint_as_float(x.x & 0xffff0000u), __uint_as_float(x.y << 16), __uint_as_float(x.y & 0xffff0000u),
                            __uint_as_float(x.z << 16), __uint_as_float(x.z & 0xffff0000u), __uint_as_float(x.w << 16), __uint_as_float(x.w & 0xffff0000u)};
        float s = 0.f, s2 = 0.f;
#pragma unroll
        for (int e = 0; e < 8; ++e) { s += f[e]; s2 += f[e] * f[e]; }
        s = wave_sum(s); s2 = wave_sum(s2);
        const float mean = s * (1.0f / 512.0f), var = fmaxf(s2 * (1.0f / 512.0f) - mean * mean, 0.f);
        if (lane == 0) stats[rl] = (f32x2){mean, 1.0f / sqrtf(var + 1e-6f)};
    }
    LDS_WAIT(); __syncthreads();
    const int gl = wid & 3, th = wid >> 2, grp = half * 4 + gl, c0 = grp * 64;
    LAS unsigned char* slab = lds + gl * SG_SLAB;
    {
        const int cc = (lane & 7) * 8;
        const f32x4 w0 = *(const f32x4*)(lnw + c0 + cc), w1 = *(const f32x4*)(lnw + c0 + cc + 4), b0 = *(const f32x4*)(lnb + c0 + cc), b1 = *(const f32x4*)(lnb + c0 + cc + 4);
#pragma unroll
        for (int it = 0; it < 8; ++it) {
            const int rl = th * 64 + it * 8 + (lane >> 3);
            const u32x4 x = *(const u32x4*)(VS + (R0 + rl) * 512 + c0 + cc);
            const f32x2 st = stats[rl];
            f32x4 a = {__uint_as_float(x.x << 16), __uint_as_float(x.x & 0xffff0000u), __uint_as_float(x.y << 16), __uint_as_float(x.y & 0xffff0000u)};
            f32x4 c = {__uint_as_float(x.z << 16), __uint_as_float(x.z & 0xffff0000u), __uint_as_float(x.w << 16), __uint_as_float(x.w & 0xffff0000u)};
            a = (a - st.x) * st.y * w0 + b0; c = (c - st.x) * st.y * w1 + b1;
            u32x4 o; o.x = pk2(a[0], a[1]); o.y = pk2(a[2], a[3]); o.z = pk2(c[0], c[1]); o.w = pk2(c[2], c[3]);
            *(LAS u32x4*)(slab + rl * SG_STRIDE + cc * 2) = o;
        }
    }
    LDS_WAIT(); __syncthreads();
    const int ql = lane & 15, gq = lane >> 4;
    const LAS unsigned char* abase = slab + (8 * gq + (ql >> 2)) * SG_STRIDE + (ql & 3) * 8;
    const bf16* wg = WSP + (size_t)grp * 128 * 128;
#pragma unroll
    for (int ti = 0; ti < 4; ++ti) {
        const int tt = th == 0 ? (ti == 0 ? 0 : (ti == 1 ? 3 : (ti == 2 ? 4 : 7))) : (ti == 0 ? 1 : (ti == 1 ? 2 : (ti == 2 ? 5 : 6)));
        const int t = 16 * tt + ql;
        f32x4 acc[4];
#pragma unroll
        for (int ct = 0; ct < 4; ++ct) acc[ct] = (f32x4){0.f, 0.f, 0.f, 0.f};
        for (int kk = 0; kk <= (tt >> 1); ++kk) {
            const bf16x8 wf = *(const bf16x8*)(wg + (size_t)t * 128 + 32 * kk + 8 * gq);
#pragma unroll
            for (int ct = 0; ct < 4; ++ct) {
                const s16x4 lo = vtr(abase + (32 * kk) * SG_STRIDE + ct * 32);
                const s16x4 hi = vtr(abase + (32 * kk + 4) * SG_STRIDE + ct * 32);
                const bf16x8 af = {lo[0], lo[1], lo[2], lo[3], hi[0], hi[1], hi[2], hi[3]};
                acc[ct] = __builtin_amdgcn_mfma_f32_16x16x32_bf16(af, wf, acc[ct], 0, 0, 0);
            }
        }
        const float bias = bsp[grp * 128 + t];
#pragma unroll
        for (int ct = 0; ct < 4; ++ct) {
            const size_t off = (R0 + t) * 512 + c0 + ct * 16 + 4 * gq;
            const u32x2 uu = *(const u32x2*)(U + off);
            const float u0 = __uint_as_float(uu.x << 16), u1 = __uint_as_float(uu.x & 0xffff0000u), u2 = __uint_as_float(uu.y << 16), u3 = __uint_as_float(uu.y & 0xffff0000u);
            u32x2 o; o.x = pk2(u0 * (acc[ct][0] + bias), u1 * (acc[ct][1] + bias)); o.y = pk2(u2 * (acc[ct][2] + bias), u3 * (acc[ct][3] + bias));
            *(u32x2*)(YS + off) = o;
        }
    }
    LDS_WAIT(); __syncthreads();
}

__device__ __forceinline__ void sgu_sample_row(const bf16* U, const bf16* VS, const float* lnw, const float* lnb, const float* wsp_f32, const float* bsp, bf16* YS, float* out_sv, int b, int lane) {
    const size_t row = (size_t)MP + b;
    const u32x4 x = *(const u32x4*)(VS + row * 512 + 8 * lane);
    float f[8] = {__uint_as_float(x.x << 16), __uint_as_float(x.x & 0xffff0000u), __uint_as_float(x.y << 16), __uint_as_float(x.y & 0xffff0000u),
                  __uint_as_float(x.z << 16), __uint_as_float(x.z & 0xffff0000u), __uint_as_float(x.w << 16), __uint_as_float(x.w & 0xffff0000u)};
    float s = 0.f, s2 = 0.f;
#pragma unroll
    for (int e = 0; e < 8; ++e) { s += f[e]; s2 += f[e] * f[e]; }
    s = wave_sum(s); s2 = wave_sum(s2);
    const float mean = s * (1.0f / 512.0f), var = fmaxf(s2 * (1.0f / 512.0f) - mean * mean, 0.f), rstd = 1.0f / sqrtf(var + 1e-6f);
    const int c = 8 * lane, grp = c >> 6;
    const float w00 = wsp_f32[(size_t)grp * 128 * 128], b0 = bsp[grp * 128];
    const u32x4 uu = *(const u32x4*)(U + row * 512 + c);
    const float uf[8] = {__uint_as_float(uu.x << 16), __uint_as_float(uu.x & 0xffff0000u), __uint_as_float(uu.y << 16), __uint_as_float(uu.y & 0xffff0000u),
                         __uint_as_float(uu.z << 16), __uint_as_float(uu.z & 0xffff0000u), __uint_as_float(uu.w << 16), __uint_as_float(uu.w & 0xffff0000u)};
    float y[8];
#pragma unroll
    for (int e = 0; e < 8; ++e) { const float vn = (f[e] - mean) * rstd * lnw[c + e] + lnb[c + e]; out_sv[c + e] = vn; y[e] = uf[e] * (w00 * vn + b0); }
    u32x4 o; o.x = pk2(y[0], y[1]); o.y = pk2(y[2], y[3]); o.z = pk2(y[4], y[5]); o.w = pk2(y[6], y[7]);
    *(u32x4*)(YS + row * 512 + c) = o;
}

__device__ __forceinline__ void merge_row(const bf16* OG, const float* DG, bf16* YA, int row, int lane) {
    const int h = lane >> 4;
    const float d0 = DG[(size_t)row * 12 + h], d1 = DG[(size_t)row * 12 + 4 + h], d2 = DG[(size_t)row * 12 + 8 + h];
    const float inv = 1.0f / (d0 + d1 + d2);
    const float a0 = d0 * inv, a1 = d1 * inv, a2 = d2 * inv;
    const bf16* p = OG + (size_t)row * QKV + 8 * lane;
    const u32x4 x0 = *(const u32x4*)p, x1 = *(const u32x4*)(p + 512), x2 = *(const u32x4*)(p + 1024);
    u32x4 o;
#define MRG(c) pk2(a0 * __uint_as_float(x0.c << 16) + a1 * __uint_as_float(x1.c << 16) + a2 * __uint_as_float(x2.c << 16), \
                   a0 * __uint_as_float(x0.c & 0xffff0000u) + a1 * __uint_as_float(x1.c & 0xffff0000u) + a2 * __uint_as_float(x2.c & 0xffff0000u))
    o.x = MRG(x); o.y = MRG(y); o.z = MRG(z); o.w = MRG(w);
#undef MRG
    *(u32x4*)(YA + (size_t)row * 512 + 8 * lane) = o;
}


__device__ __forceinline__ void merge_rows4(const bf16* OG, const float* DG, bf16* YA, int row0, int stride, int lane) {
    const int h = lane >> 4;
    u32x4 x[4][3]; float dg[4][3];
#pragma unroll
    for (int q = 0; q < 4; ++q) {
        const int row = min(row0 + q * stride, MP - 1);
        const bf16* p = OG + (size_t)row * QKV + 8 * lane;
        x[q][0] = *(const u32x4*)p; x[q][1] = *(const u32x4*)(p + 512); x[q][2] = *(const u32x4*)(p + 1024);
        dg[q][0] = DG[(size_t)row * 12 + h]; dg[q][1] = DG[(size_t)row * 12 + 4 + h]; dg[q][2] = DG[(size_t)row * 12 + 8 + h];
    }
#pragma unroll
    for (int q = 0; q < 4; ++q) {
        const int row = row0 + q * stride;
        if (row >= MP) continue;
        const float inv = 1.0f / (dg[q][0] + dg[q][1] + dg[q][2]);
        const float a0 = dg[q][0] * inv, a1 = dg[q][1] * inv, a2 = dg[q][2] * inv;
        u32x4 o;
#define MRG(c) pk2(a0 * __uint_as_float(x[q][0].c << 16) + a1 * __uint_as_float(x[q][1].c << 16) + a2 * __uint_as_float(x[q][2].c << 16), \
                   a0 * __uint_as_float(x[q][0].c & 0xffff0000u) + a1 * __uint_as_float(x[q][1].c & 0xffff0000u) + a2 * __uint_as_float(x[q][2].c & 0xffff0000u))
        o.x = MRG(x); o.y = MRG(y); o.z = MRG(z); o.w = MRG(w);
#undef MRG
        *(u32x4*)(YA + (size_t)row * 512 + 8 * lane) = o;
    }
}
typedef float f32x16 __attribute__((ext_vector_type(16)));
template <class EpiS>
__device__ __forceinline__ void skinny_gemm(LAS unsigned char* lds, const bf16* A, const bf16* Bt, int K, int j, const EpiS& e, int wid, int lane, int tid) {
    const int r = lane & 31, hi = lane >> 5, ks = K >> 3;
    const bf16* ap = A + (size_t)r * K + wid * ks + 8 * hi;
    const bf16* bp = Bt + (size_t)(32 * j + r) * K + wid * ks + 8 * hi;
    f32x16 acc;
#pragma unroll
    for (int i = 0; i < 16; ++i) acc[i] = 0.f;
#pragma unroll 4
    for (int k = 0; k < ks; k += 16) {
        const bf16x8 a = *(const bf16x8*)(ap + k), b = *(const bf16x8*)(bp + k);
        acc = __builtin_amdgcn_mfma_f32_32x32x16_bf16(a, b, acc, 0, 0, 0);
    }
    LAS float* red = (LAS float*)lds;
#pragma unroll
    for (int i = 0; i < 16; ++i) red[wid * 1056 + ((i & 3) + 8 * (i >> 2) + 4 * hi) * 33 + r] = acc[i];
    LDS_WAIT(); __syncthreads();
    for (int e2 = tid; e2 < 1024; e2 += NTHREADS) {
        const int row = e2 >> 5, col = e2 & 31;
        float sum = 0.f;
#pragma unroll
        for (int w = 0; w < 8; ++w) sum += red[w * 1056 + row * 33 + col];
        e(row, 32 * j + col, sum);
    }
    LDS_WAIT(); __syncthreads();
}
struct SkAda { float* MOD; const float* b_ada; int rg; __device__ __forceinline__ void operator()(int sr, int col, float v) const { const int layer = col / NADA, c = col - layer * NADA; const int mrow = rg == 0 ? 4 + sr : sr; if (rg == 0 || sr < 4) MOD[((size_t)layer * 36 + mrow) * NADA + c] = v + b_ada[(size_t)layer * NADA + c]; } };
struct SkGate1 { const bf16* G; float* T1; __device__ __forceinline__ void operator()(int sr, int col, float v) const { const size_t row = (size_t)MP + sr; T1[row * DM + col] = bf2f(G[row * 2048 + col]) * v; } };
struct SkGate2 { const bf16* G; const float* T1; bf16* MG; __device__ __forceinline__ void operator()(int sr, int col, float v) const { const size_t row = (size_t)MP + sr; MG[row * DM + col] = (bf16)(pk2(T1[row * DM + col] + bf2f(G[row * 2048 + 1024 + col]) * v, 0.f) & 0xffffu); } };
struct SkRes { const float* bs; float* os; const float* gate; __device__ __forceinline__ void operator()(int sr, int col, float v) const { os[(size_t)sr * DM + col] = bs[(size_t)sr * DM + col] + gate[(size_t)(4 + sr) * NADA + col] * v; } };


#define RLX_AGENT __ATOMIC_RELAXED, __HIP_MEMORY_SCOPE_AGENT
#define XB_TMO      128
#define XB_XCNT(j)  (256  + 64 * (j))
#define XB_XSUB(j)  (1280 + 64 * (j))
#define XB_XGEN(j)  (2304 + 64 * (j))
#define XB_TOP      3328
#define XB_TOPGEN   3392
#define XCD_BAR_WORDS 3456
#define XB_SPIN_CAP (1u << 18)

__device__ __forceinline__ unsigned xb_ld(unsigned* p)              { return __hip_atomic_load(p, __ATOMIC_RELAXED, __HIP_MEMORY_SCOPE_AGENT); }
__device__ __forceinline__ unsigned xb_add(unsigned* p, unsigned v) { return __hip_atomic_fetch_add(p, v, __ATOMIC_RELAXED, __HIP_MEMORY_SCOPE_AGENT); }
__device__ __forceinline__ unsigned xb_xcc_id() { return (unsigned)__builtin_amdgcn_s_getreg((3 << 11) | 20) & 0xFu; }
#define XB_SPIN(cond, bar) do { unsigned _sp = 0; while (cond) { __builtin_amdgcn_s_sleep(1); \
    if ((++_sp & 255u) == 0u) { if (xb_ld(&(bar)[XB_TMO])) break; if (_sp > XB_SPIN_CAP) { atomicAdd(&(bar)[XB_TMO], 1u); break; } } } } while (0)

struct XcdBarrier {
    unsigned* bar; unsigned x;
    volatile LAS unsigned* st;
};

__device__ __forceinline__ XcdBarrier xcd_barrier_post(unsigned* bar, volatile LAS unsigned* st) {
    XcdBarrier b; b.bar = bar; b.x = xb_xcc_id(); b.st = st;
    if (threadIdx.x == 0) (void)xb_add(&bar[XB_XCNT(b.x)], 1u);
    return b;
}
__device__ __forceinline__ void xcd_barrier_complete(unsigned* bar, unsigned x, unsigned& nloc, unsigned& nx) {
    const unsigned G = gridDim.x * gridDim.y * gridDim.z;
    unsigned sum, cnt, mine, sp = 0u;
    for (;;) {
        sum = 0u; cnt = 0u; mine = 0u;
#pragma unroll
        for (unsigned j = 0; j < 16; ++j) { const unsigned c = xb_ld(&bar[XB_XCNT(j)]); sum += c; cnt += (c > 0u) ? 1u : 0u; mine = (j == x) ? c : mine; }
        if (sum == G) break;
        __builtin_amdgcn_s_sleep(1);
        if ((++sp & 255u) == 0u) { if (xb_ld(&bar[XB_TMO])) break; if (sp > XB_SPIN_CAP) { atomicAdd(&bar[XB_TMO], 1u); break; } }
    }
    nloc = mine > 0u ? mine : 1u; nx = cnt > 0u ? cnt : 1u;
}

__device__ __forceinline__ void xcd_barrier(const XcdBarrier& b) {
    asm volatile("s_waitcnt vmcnt(0)" ::: "memory");
    __syncthreads();
    if (threadIdx.x == 0) {
        unsigned* bar = b.bar;
        __builtin_amdgcn_s_waitcnt(0);
        unsigned nloc = b.st[0], nx = b.st[1];
        if (nloc == 0u) { xcd_barrier_complete(bar, b.x, nloc, nx); b.st[0] = nloc; b.st[1] = nx; }
        const unsigned old = xb_add(&bar[XB_XSUB(b.x)], 1u);
        const unsigned gen = old / nloc;
        if (old + 1u == (gen + 1u) * nloc) {
            __builtin_amdgcn_fence(__ATOMIC_RELEASE, "agent");
            asm volatile("s_waitcnt vmcnt(0)" ::: "memory");
            const unsigned og = xb_add(&bar[XB_TOP], 1u);
            const unsigned tg = og / nx;
            if (og + 1u == (tg + 1u) * nx) xb_add(&bar[XB_TOPGEN], 1u);
            else XB_SPIN(xb_ld(&bar[XB_TOPGEN]) == tg, bar);
            __builtin_amdgcn_fence(__ATOMIC_ACQUIRE, "agent");
            xb_add(&bar[XB_XGEN(b.x)], 1u);
            asm volatile("s_waitcnt vmcnt(0)" ::: "memory");
        } else {
            XB_SPIN(xb_ld(&bar[XB_XGEN(b.x)]) == gen, bar);
            __builtin_amdgcn_fence(__ATOMIC_ACQUIRE, "agent");
            asm volatile("s_waitcnt vmcnt(0)" ::: "memory");
        }
    }
    __syncthreads();
}

constexpr int LDS_MISC = LDS_EXCH + 8192;
constexpr size_t WS_CTL = 0, CTL_ZERO_BYTES = 65536;
#ifndef PROBE_REP_MASK
#define PROBE_REP_MASK 0
#endif
#define PHON(k) for (int rep_ = 0; rep_ <= (((PROBE_REP_MASK) >> (k)) & 1); ++rep_) if constexpr (((PHM) >> (k)) & 1)
#define GSYNC() do { if constexpr (COOP) { CAS const Args* ap_ = (CAS const Args*)__builtin_amdgcn_kernarg_segment_ptr(); asm volatile("" : "+s"(ap_)); \
    XcdBarrier xb_; xb_.bar = (unsigned*)((unsigned char*)ap_->ws + WS_CTL); xb_.x = xb_xcc_id(); xb_.st = (volatile LAS unsigned*)(lds + LDS_MISC); xcd_barrier(xb_); } } while (0)
#define GSYNC_CG() do { if constexpr (COOP) cg::this_grid().sync(); } while (0)
#define GAS __attribute__((address_space(1)))
#define CAS __attribute__((address_space(4)))
struct Args { GAS const float* in[23]; GAS float* out; GAS unsigned char* ws; };

constexpr int I_ADA = 16 * 192, I_IN = 16 * 240, I_PA = 8 * 32, I_OUT = 16 * 32, I_FI = 16 * 176, I_FO = 44 * 32;
constexpr int I_LAYER = I_ADA + I_IN + 2 * I_PA + I_OUT + I_FI + I_FO;
__device__ __forceinline__ void weight_copy_item(CAS const Args* ap, unsigned char* ws, int l, int r, LAS float* scr, int lane) {
    unsigned char* wl = ws + WS_WL0 + (size_t)l * WL_SIZE;
    if (r < I_IN) { transpose_item(((const float*)ap->in[10]) + (size_t)l * DM * DIN, DM, DIN, (bf16*)(wl + WL_WIN), 0, scr, r, lane); return; } r -= I_IN;
    if (r < I_PA) { transpose_item(((const float*)ap->in[17]) + (size_t)l * 512 * DM, 512, DM, (bf16*)(wl + WL_WPA), 0, scr, r, lane); return; } r -= I_PA;
    if (r < I_PA) { transpose_item(((const float*)ap->in[18]) + (size_t)l * 512 * DM, 512, DM, (bf16*)(wl + WL_WPS), 0, scr, r, lane); return; } r -= I_PA;
    if (r < I_OUT) { transpose_item(((const float*)ap->in[19]) + (size_t)l * DM * DM, DM, DM, (bf16*)(wl + WL_WOUT), 0, scr, r, lane); return; } r -= I_OUT;
    if (r < I_FI) { transpose_item(((const float*)ap->in[21]) + (size_t)l * DM * 2 * DFF, DM, 2 * DFF, (bf16*)(wl + WL_WFI), 1, scr, r, lane); return; } r -= I_FI;
    transpose_item(((const float*)ap->in[22]) + (size_t)l * DFF * DM, DFF, DM, (bf16*)(wl + WL_WFO), 0, scr, r, lane);
}
#define PHASE_ENV() \
    CAS const Args* ap = (CAS const Args*)__builtin_amdgcn_kernarg_segment_ptr(); asm volatile("" : "+s"(ap)); \
    int tid = threadIdx.x; asm volatile("" : "+v"(tid)); \
    const int lane = tid & 63, wid = __builtin_amdgcn_readfirstlane(tid >> 6); \
    int G_ = gridDim.x, bx_ = blockIdx.x; asm volatile("" : "+s"(G_), "+s"(bx_)); const int G = G_, bx = bx_; const int gw = bx * NWAVES + wid, NGW = G * NWAVES; \
    unsigned char* const ws = (unsigned char*)ap->ws; (void)lane; (void)wid; (void)gw; (void)NGW; (void)ws; (void)G; (void)bx
#define WL(l) (ws + WS_WL0 + (size_t)(l) * WL_SIZE)

template <int PHM, bool COOP>
__global__ void __launch_bounds__(NTHREADS, 2) fwd_megakernel(Args args_unused, int l_lo, int l_hi) {
    extern __shared__ __attribute__((aligned(16))) unsigned char lds_raw[];
    LAS unsigned char* lds = (LAS unsigned char*)lds_raw;
    if constexpr (COOP) { if (l_lo < 0) cg::this_grid().sync(); }
    if constexpr (COOP) {
        PHASE_ENV();
        if (tid < 32) ((LAS unsigned*)(lds + LDS_MISC))[tid] = 0u;
        __syncthreads();
        (void)xcd_barrier_post((unsigned*)(ws + WS_CTL), (volatile LAS unsigned*)(lds + LDS_MISC));
    }

    PHON(0) {
        PHASE_ENV();
        bf16* WADA = (bf16*)(ws + WS_WADA); bf16* SC = (bf16*)(ws + WS_SC);
        LAS float* scr = (LAS float*)(lds + wid * 16384);
        for (int it = gw; it < 2 * I_ADA + (I_LAYER - I_ADA); it += NGW) {
            if (it < 2 * I_ADA) { const int l = it / I_ADA; transpose_item(((const float*)ap->in[7]) + (size_t)l * DM * NADA, DM, NADA, WADA + (size_t)l * NADA * DM, 0, scr, it - l * I_ADA, lane); }
            else weight_copy_item(ap, ws, 0, it - 2 * I_ADA, scr, lane);
        }
        const int gt = bx * NTHREADS + tid, NGT = G * NTHREADS;
        const float* wsp = ((const float*)ap->in[15]);
        for (int i = gt; i < 2 * 8 * 128 * 128; i += NGT) {
            const int l = i >> 17, r = i & 131071, t = (r >> 7) & 127, s = r & 127;
            const float w = wsp[i];
            ((bf16*)(WL(l) + WL_WSP))[r] = (bf16)(s <= t ? (pk2(w, 0.f) & 0xffffu) : 0u);
        }
        const float* cpr = ((const float*)ap->in[5]); const float* csm = ((const float*)ap->in[6]);
        for (int i = gt; i < 64 * DM; i += NGT) {
            const int r = i >> 10, k = i & 1023;
            float v = 0.f;
            if (r < 32) v = csm[r * DM + k]; else if (r < 36) v = cpr[(r - 32) * DM + k];
            SC[i] = (bf16)(pk2(v * sigmoidf_(v), 0.f) & 0xffffu);
        }
    }
    GSYNC();
    PHON(1) {
        PHASE_ENV();
        for (int t = bx; t < 768; t += G) {
            const int rg = t / 384, j = t - rg * 384;
            SkAda e{(float*)(ws + WS_MOD), ((const float*)ap->in[8]), rg};
            skinny_gemm(lds, (const bf16*)(ws + WS_SC) + (size_t)rg * 32 * DM, (const bf16*)(ws + WS_WADA), DM, j, e, wid, lane, tid);
        }
    }
    GSYNC();

    for (int l = l_lo; l < l_hi; ++l) {
        PHON(2) {
            PHASE_ENV();
            const float* X2 = (const float*)(ws + WS_X2);
            const float* xin_p = l == 0 ? ((const float*)ap->in[0]) : X2;
            const float* xin_s = l == 0 ? ((const float*)ap->in[1]) : X2 + (size_t)MP * DM;
            norm_mod_phase(xin_p, xin_s, ((const float*)ap->in[9]) + l * DM, (const float*)(ws + WS_MOD) + (size_t)l * 36 * NADA, 0, (bf16*)(ws + WS_XN), gw, NGW, lane);
        }
        GSYNC();
        PHON(3) {
            PHASE_ENV();
            pg8::Gemm g{(const bf16*)(ws + WS_XN), (const bf16*)(WL(l) + WL_WIN), MT, DIN, DM}; pg8::StaticOrder S; S.init(MT, DIN, G, bx);
            EpiIn E{ws, ((const float*)ap->in[11]) + l * 384, ((const float*)ap->in[12]) + l * 384, ((float*)ap->out), l, (LAS float*)(lds + LDS_EXCH)};
            pg8::gemm_phase<EpiIn, pg8::StaticOrder, true, true>(lds + LDS_RING, g, S, E);
        }
        PHON(3) {
            if (l == 0) {
                PHASE_ENV();
                constexpr int NU = (MT / 256) * (DIN / 256);
                const int nfull = NU % G;
                if (nfull > 0 && bx >= nfull) {
                    LAS float* scr = (LAS float*)(lds + wid * 16384);
                    const int nw = (G - nfull) * NWAVES, w0 = (bx - nfull) * NWAVES + wid;
                    for (int it = w0; it < I_LAYER - I_ADA; it += nw) weight_copy_item(ap, ws, 1, it, scr, lane);
                } else if (nfull == 0) {
                    LAS float* scr = (LAS float*)(lds + wid * 16384);
                    for (int it = gw; it < I_LAYER - I_ADA; it += NGW) weight_copy_item(ap, ws, 1, it, scr, lane);
                }
            }
        }
        GSYNC();
        PHON(4) {
            PHASE_ENV();
            const bf16 *Qb = (const bf16*)(ws + WS_Q), *Kb = (const bf16*)(ws + WS_K), *Vb = (const bf16*)(ws + WS_V);
            float mq = 0.f, mk = 0.f;
            for (int i = lane; i < 384; i += 64) { mq = fmaxf(mq, fabsf(((const float*)ap->in[11])[l * 384 + i])); mk = fmaxf(mk, fabsf(((const float*)ap->in[12])[l * 384 + i])); }
            mq = wave_max(mq); mk = wave_max(mk);
            const float cshift = 11.3137085f * LOG2E * mq * mk;
            if (G == 256) { const int u0 = bx < 128 ? bx * 7 : 896 + (bx - 128) * 5, nu = bx < 128 ? 7 : 5;
                attn_units(lds, Qb, Kb, Vb, (bf16*)(ws + WS_OG), (float*)(ws + WS_DG), u0, nu, cshift, wid, lane, tid); }
            else { const int per = (1536 + G - 1) / G, u0 = bx * per; attn_units(lds, Qb, Kb, Vb, (bf16*)(ws + WS_OG), (float*)(ws + WS_DG), u0, min(per, 1536 - u0), cshift, wid, lane, tid); }
        }
        PHON(4) {
            PHASE_ENV();
            if (bx >= G / 2) {
                for (int it = bx - G / 2; it < NSMP * 4; it += G - G / 2)
                    attn_sample_item(lds, (const bf16*)(ws + WS_Q), (const bf16*)(ws + WS_K), (const bf16*)(ws + WS_V), ((const float*)ap->in[2]), ((const float*)ap->in[3]), ((const float*)ap->in[4]), l, (bf16*)(ws + WS_YY) + (size_t)MP * 512  , it, wid, lane, tid);
            }
        }
        GSYNC();
        PHON(5) {
            PHASE_ENV();
            const bf16 *Ub = (const bf16*)(ws + WS_U), *VSb = (const bf16*)(ws + WS_VS); bf16 *YS = (bf16*)(ws + WS_YY) + (size_t)MP * 512;
            const bf16* WSP = (const bf16*)(WL(l) + WL_WSP);
            const float* lnw = ((const float*)ap->in[13]) + l * 512; const float* lnb = ((const float*)ap->in[14]) + l * 512; const float* bsp = ((const float*)ap->in[16]) + l * 8 * 128;
            for (int u = bx; u < 256; u += G) sgu_unit(lds, Ub, VSb, lnw, lnb, WSP, bsp, YS, u, wid, lane);
            for (int b = gw; b < NSMP; b += NGW) sgu_sample_row(Ub, VSb, lnw, lnb, ((const float*)ap->in[15]) + (size_t)l * 8 * 128 * 128, bsp, YS + (size_t)32 * 512  , ((float*)ap->out) + O_SV + (size_t)(l * NSMP + b) * 512, b, lane);
            for (int row = gw; row < MP; row += 4 * NGW) merge_rows4((const bf16*)(ws + WS_OG), (const float*)(ws + WS_DG), (bf16*)(ws + WS_YY), row, NGW, lane);
        }
        GSYNC();
        PHON(6) {
            PHASE_ENV();
            if (bx < 32) { SkGate1 e{(const bf16*)(ws + WS_G), (float*)(ws + WS_T1)};
                skinny_gemm(lds, (const bf16*)(ws + WS_YY) + (size_t)(2 * MP) * 512, (const bf16*)(WL(l) + WL_WPA), 512, bx, e, wid, lane, tid); }
        }
        PHON(6) {
            PHASE_ENV();
            PairOrder S; S.S0.init(MP, DM, G, bx);
            pg8::Gemm g{(const bf16*)(ws + WS_YY), (const bf16*)(WL(l) + WL_WPA), 2 * MP, 2 * DM, 512}; EpiMerged E{(const bf16*)(ws + WS_G), (bf16*)(ws + WS_MG)};
            pg8::gemm_phase<EpiMerged, PairOrder, true, true>(lds + LDS_RING, g, S, E);
        }
        PHON(6) {
            PHASE_ENV();
            if (bx < 32) { SkGate2 e{(const bf16*)(ws + WS_G), (const float*)(ws + WS_T1), (bf16*)(ws + WS_MG)};
                skinny_gemm(lds, (const bf16*)(ws + WS_YY) + (size_t)(2 * MP + 32) * 512, (const bf16*)(WL(l) + WL_WPS), 512, bx, e, wid, lane, tid); }
        }
        GSYNC();
        PHON(7) {
            PHASE_ENV();
            const float* X2 = (const float*)(ws + WS_X2); float* X1 = (float*)(ws + WS_X1);
            const float* xin_p = l == 0 ? ((const float*)ap->in[0]) : X2;
            const float* xin_s = l == 0 ? ((const float*)ap->in[1]) : X2 + (size_t)MP * DM;
            pg8::Gemm g{(const bf16*)(ws + WS_MG), (const bf16*)(WL(l) + WL_WOUT), MP, DM, DM}; pg8::StaticOrder S; S.init(MP, DM, G, bx);
            EpiRes E{xin_p, xin_s, X1, X1 + (size_t)MP * DM, (const float*)(ws + WS_MOD) + (size_t)l * 36 * NADA + 2048};
            pg8::gemm_phase<EpiRes, pg8::StaticOrder, true, true>(lds + LDS_RING, g, S, E);
        }
        PHON(7) {
            PHASE_ENV();
            if (bx < 32) { const float* X2 = (const float*)(ws + WS_X2);
                SkRes e{l == 0 ? ((const float*)ap->in[1]) : X2 + (size_t)MP * DM, (float*)(ws + WS_X1) + (size_t)MP * DM, (const float*)(ws + WS_MOD) + (size_t)l * 36 * NADA + 2048};
                skinny_gemm(lds, (const bf16*)(ws + WS_MG) + (size_t)MP * DM, (const bf16*)(WL(l) + WL_WOUT), DM, bx, e, wid, lane, tid); }
        }
        GSYNC();
        PHON(8) {
            PHASE_ENV();
            const float* X1 = (const float*)(ws + WS_X1);
            norm_mod_phase(X1, X1 + (size_t)MP * DM, ((const float*)ap->in[20]) + l * DM, (const float*)(ws + WS_MOD) + (size_t)l * 36 * NADA, 3072, (bf16*)(ws + WS_XN), gw, NGW, lane);
        }
        GSYNC();
        PHON(9) {
            PHASE_ENV();
            pg8::Gemm g{(const bf16*)(ws + WS_XN), (const bf16*)(WL(l) + WL_WFI), MT, 2 * DFF, DM}; pg8::StaticOrder S; S.init(MT, 2 * DFF, G, bx);
            EpiSwiglu E{(bf16*)(ws + WS_H)};
            pg8::gemm_phase<EpiSwiglu, pg8::StaticOrder, true, true>(lds + LDS_RING, g, S, E);
        }
        GSYNC();
        PHON(10) {
            PHASE_ENV();
            const float* X1 = (const float*)(ws + WS_X1); float* X2 = (float*)(ws + WS_X2);
            float* xout_p = l == 0 ? X2 : ((float*)ap->out) + O_YP;
            float* xout_s = l == 0 ? X2 + (size_t)MP * DM : ((float*)ap->out) + O_YS;
            pg8::Gemm g{(const bf16*)(ws + WS_H), (const bf16*)(WL(l) + WL_WFO), MP, DM, DFF}; pg8::StaticOrder S; S.init(MP, DM, G, bx);
            EpiRes E{X1, X1 + (size_t)MP * DM, xout_p, xout_s, (const float*)(ws + WS_MOD) + (size_t)l * 36 * NADA + 5120};
            pg8::gemm_phase<EpiRes, pg8::StaticOrder, true, true>(lds + LDS_RING, g, S, E);
        }
        PHON(10) {
            PHASE_ENV();
            if (bx < 32) { float* X2 = (float*)(ws + WS_X2);
                SkRes e{(const float*)(ws + WS_X1) + (size_t)MP * DM, l == 0 ? X2 + (size_t)MP * DM : ((float*)ap->out) + O_YS, (const float*)(ws + WS_MOD) + (size_t)l * 36 * NADA + 5120};
                skinny_gemm(lds, (const bf16*)(ws + WS_H) + (size_t)MP * DFF, (const bf16*)(WL(l) + WL_WFO), DFF, bx, e, wid, lane, tid); }
        }
        if (l + 1 < l_hi) GSYNC();
    }
}


#ifdef EXP_MASK
__global__ void __launch_bounds__(256) dbg_checksum(const unsigned char* ws, float* out) {
    const int lane = threadIdx.x & 63, gw = (blockIdx.x * 256 + threadIdx.x) >> 6, ngw = gridDim.x * 4;
    struct B { size_t off; int cols; int isf; };
    const B bufs[16] = {{WS_XN, 1024, 0}, {WS_Q, 1536, 0}, {WS_K, 1536, 0}, {WS_V, 1536, 0}, {WS_U, 512, 0}, {WS_VS, 512, 0}, {WS_G, 2048, 0}, {WS_OG, 1536, 0},
                        {WS_DG, 12, 1}, {WS_YY, 512, 0}, {WS_YY + (size_t)MP * 1024, 512, 0}, {WS_T1, 1024, 1}, {WS_MG, 1024, 0}, {WS_X1, 1024, 1}, {WS_H, 2816, 0}, {WS_X2, 1024, 1}};
    for (int b = 0; b < 16; ++b) {
        if (!((EXP_MASK >> b) & 1)) continue;
        for (int row = gw; row < MV; row += ngw) {
            float s = 0.f;
            for (int c = lane; c < bufs[b].cols; c += 64) {
                const float v = bufs[b].isf ? ((const float*)(ws + bufs[b].off))[(size_t)row * bufs[b].cols + c] : bf2f(((const bf16*)(ws + bufs[b].off))[(size_t)row * bufs[b].cols + c]);
                s += v * (float)(1 + (c % 7));
            }
            s = wave_sum(s);
            if (lane == 0) out[(size_t)b * MT + row] = s;
        }
    }
    if ((EXP_MASK >> 16) & 1) for (int i = blockIdx.x * 256 + threadIdx.x; i < 72 * NADA; i += gridDim.x * 256) out[16 * MT + i] = ((const float*)(ws + WS_MOD))[i];
}
#endif
#ifndef N_LAUNCH_MODE
#define N_LAUNCH_MODE 1
#endif
template <int PHM> static void launch_phase(const Args& a, int l_lo, int l_hi, int grid, hipStream_t stream) {
    static bool attr = false;
    if (!attr) { (void)hipFuncSetAttribute((const void*)fwd_megakernel<PHM, false>, hipFuncAttributeMaxDynamicSharedMemorySize, LDS_BYTES); attr = true; }
    hipLaunchKernelGGL((fwd_megakernel<PHM, false>), dim3(grid), dim3(NTHREADS), LDS_BYTES, stream, a, l_lo, l_hi);
}
extern "C" void kernel_launch(void* const* d_in, const int* in_sizes, int n_in, void* d_out, int out_size, void* d_ws, size_t ws_size, hipStream_t stream) {
    static int grid = 0;
    if (grid == 0) {
        if (n_in != 23 || (size_t)out_size != O_END || ws_size < WS_END) { fprintf(stderr, "kernel_launch: unexpected shapes (n_in %d out %d ws %zu need %zu)\n", n_in, out_size, ws_size, (size_t)WS_END); grid = -1; return; }
        int dev = 0, cus = 0, per_cu = 0;
        (void)hipGetDevice(&dev);
        (void)hipDeviceGetAttribute(&cus, hipDeviceAttributeMultiprocessorCount, dev);
#if N_LAUNCH_MODE == 1
        if (hipFuncSetAttribute((const void*)fwd_megakernel<0x7FF, true>, hipFuncAttributeMaxDynamicSharedMemorySize, LDS_BYTES) != hipSuccess) { fprintf(stderr, "kernel_launch: hipFuncSetAttribute failed\n"); grid = -1; return; }
        (void)hipOccupancyMaxActiveBlocksPerMultiprocessor(&per_cu, (const void*)fwd_megakernel<0x7FF, true>, NTHREADS, LDS_BYTES);
        (void)hipGetLastError();
        if (per_cu < 1) fprintf(stderr, "kernel_launch: occupancy query says %d blocks per CU\n", per_cu);
#endif
        grid = cus;
    }
    if (grid < 0) return;
    Args a{};
    for (int i = 0; i < 23; ++i) a.in[i] = (GAS const float*)d_in[i];
    a.out = (GAS float*)d_out; a.ws = (GAS unsigned char*)d_ws;
#if N_LAUNCH_MODE == 1
    (void)hipMemsetAsync((unsigned char*)d_ws + WS_CTL, 0, CTL_ZERO_BYTES, stream);
    int l_lo = 0, l_hi = 2;
    void* kargs[] = {&a, &l_lo, &l_hi};
    hipError_t e = hipLaunchCooperativeKernel((const void*)fwd_megakernel<0x7FF, true>, dim3(grid), dim3(NTHREADS), kargs, LDS_BYTES, stream);
    if (e != hipSuccess) fprintf(stderr, "cooperative launch failed: %s (grid %d)\n", hipGetErrorString(e), grid);
#else
#ifdef EXP_MASK
    (void)hipMemsetAsync(d_out, 0, (size_t)out_size * 4, stream);
#endif
    launch_phase<0x001>(a, 0, 0, grid, stream);
    launch_phase<0x002>(a, 0, 0, grid, stream);
#ifdef EXP_MASK
    const int NL = 1;
#else
    const int NL = 2;
#endif
    for (int l = 0; l < NL; ++l) {
        launch_phase<0x004>(a, l, l + 1, grid, stream);
        launch_phase<0x008>(a, l, l + 1, grid, stream);
        launch_phase<0x010>(a, l, l + 1, grid, stream);
        launch_phase<0x020>(a, l, l + 1, grid, stream);
        launch_phase<0x040>(a, l, l + 1, grid, stream);
        launch_phase<0x080>(a, l, l + 1, grid, stream);
        launch_phase<0x100>(a, l, l + 1, grid, stream);
        launch_phase<0x200>(a, l, l + 1, grid, stream);
        launch_phase<0x400>(a, l, l + 1, grid, stream);
    }
#ifdef EXP_MASK
    hipLaunchKernelGGL(dbg_checksum, dim3(1024), dim3(256), 0, stream, (const unsigned char*)d_ws, (float*)d_out);
#endif
#endif
}
```

```cpp
#include <hip/hip_runtime.h>
#include <hip/hip_cooperative_groups.h>
#include <cstdio>
#include <cstdint>
namespace cg = cooperative_groups;
namespace pg8 {
#define PG8_LAS __attribute__((address_space(3)))
typedef unsigned short bf16_t;
typedef short bf16x8 __attribute__((ext_vector_type(8)));
typedef float f32x4 __attribute__((ext_vector_type(4)));
typedef unsigned u32x4 __attribute__((ext_vector_type(4)));
constexpr int BM = 256, BK = 64, HALF = 128, HTB = HALF * BK * 2  , STAGE_BYTES = 8 * HTB, NXCD = 8, WGM = 8;

__host__ __device__ __forceinline__ int lds_byte(int r, int c) { const int st = (r >> 4) * 2 + (c >> 5), rr = r & 15, cc = c & 31, ob = rr * 64 + cc * 2; return st * 1024 + (ob ^ (((ob >> 9) & 1) << 5)); }
__host__ __device__ __forceinline__ void stage_rc(int b, int& R, int& C) { const int st = b / 1024, sb = b % 1024, swz = sb ^ (((sb >> 9) & 1) << 5); R = (st >> 1) * 16 + swz / 64; C = (st & 1) * 32 + (swz % 64) / 2; }
__host__ __device__ __forceinline__ int perm32(int rho) { const int n = rho >> 4, i = rho & 15; return 8 * (i >> 2) + 4 * n + (i & 3); }

struct Unit { int pm, pn; };
struct Gemm { const bf16_t* A; const bf16_t* Bt; int M, N, K; };

struct StaticOrder {
    int nM, nN, nwg, G, c;
    __host__ __device__ void init(int M, int N, int G_, int c_) { nM = M / BM; nN = N / BM; nwg = nM * nN; G = G_; c = c_; }
    __host__ __device__ bool next(int i, Unit& u) const {
        const long L = (long)i * G + c; if (L >= nwg) return false;
        int wgid = (int)L; { const int q = nwg / NXCD, r = nwg % NXCD, xcd = wgid % NXCD, off = wgid / NXCD; wgid = (xcd < r ? xcd * (q + 1) : r * (q + 1) + (xcd - r) * q) + off; }
        const int nig = WGM * nN, gid = wgid / nig, fm = gid * WGM, gsz = (nM - fm) < WGM ? (nM - fm) : WGM;
        u.pm = fm + ((wgid % nig) % gsz); u.pn = (wgid % nig) / gsz; return true;
    }
    __device__ __forceinline__ void a_ready(const Unit&) const {}
    __device__ __forceinline__ void done(const Unit&) const {}
};

typedef __bf16 bf16x2_hw __attribute__((ext_vector_type(2)));
typedef float f32x2_hw __attribute__((ext_vector_type(2)));
__device__ __forceinline__ unsigned cvt_pk_bf16(float lo, float hi) { const f32x2_hw v = {lo, hi}; return __builtin_bit_cast(unsigned, __builtin_convertvector(v, bf16x2_hw)); }
typedef float f32x2 __attribute__((ext_vector_type(2)));
__device__ __forceinline__ f32x2 gelu_pk(f32x2 v) {
    const f32x2 av = __builtin_elementwise_abs(v), d = av * 0.2316418882f + 1.0f;
    f32x2 t; t.x = __builtin_amdgcn_rcpf(d.x); t.y = __builtin_amdgcn_rcpf(d.y);
    f32x2 q = t * 0.5307027145f + (-0.7265760135f); q = q * t + 0.7107068705f; q = q * t + (-0.142248368f); q = q * t + 0.127414796f; q = q * t;
    const f32x2 s = (v * v) * (-0.72134752044f);
    f32x2 e; e.x = __builtin_amdgcn_exp2f(s.x); e.y = __builtin_amdgcn_exp2f(s.y);
    const f32x2 m = v * (q * e), r = v - m;
    f32x2 o; o.x = v.x < 0.f ? m.x : r.x; o.y = v.y < 0.f ? m.y : r.y; return o;
}

template <int ACT  > struct EpiBf16 {
    static constexpr bool PERM = true, AFTER_DRAIN = false; static_assert(ACT == 0 || ACT == 1, "EpiBf16: ACT is 0 (none) or 1 (gelu_pk)");
    bf16_t* O; int ldc; const float* bias; int split_cols; size_t split_stride; float scale0;
    __device__ __forceinline__ void operator()(const f32x4 (&acc)[2][2][4][2], const Unit& u, int wr, int wc, int fr, int fq) const {
        const int row0 = u.pm * BM + wr * 64 + fr; int colt = u.pn * BM; bf16_t* base = O;
        float sc = 1.f; if (split_cols) { const int t = colt / split_cols; base += (size_t)t * split_stride; colt -= t * split_cols; if (t == 0) sc = scale0; }
        const int col0 = colt + wc * 32 + 8 * fq, bcol0 = u.pn * BM + wc * 32 + 8 * fq;
        f32x4 bv[2][2];
#pragma unroll
        for (int bj = 0; bj < 2; ++bj)
#pragma unroll
            for (int n = 0; n < 2; ++n) bv[bj][n] = bias ? *(const f32x4*)(bias + bcol0 + bj * HALF + 4 * n) : (f32x4){0.f, 0.f, 0.f, 0.f};
#pragma unroll
        for (int ai = 0; ai < 2; ++ai)
#pragma unroll
            for (int m = 0; m < 4; ++m) { bf16_t* rowp = base + (size_t)(row0 + ai * HALF + m * 16) * ldc + col0;
#pragma unroll
                for (int bj = 0; bj < 2; ++bj) { f32x4 v0 = acc[ai][bj][m][0] + bv[bj][0], v1 = acc[ai][bj][m][1] + bv[bj][1];
                    if (ACT == 1) { f32x2 a = gelu_pk((f32x2){v0[0], v0[1]}), b = gelu_pk((f32x2){v0[2], v0[3]}), c = gelu_pk((f32x2){v1[0], v1[1]}), d = gelu_pk((f32x2){v1[2], v1[3]});
                        v0 = (f32x4){a.x, a.y, b.x, b.y}; v1 = (f32x4){c.x, c.y, d.x, d.y}; }
                    v0 = v0 * sc; v1 = v1 * sc; u32x4 w; w.x = cvt_pk_bf16(v0[0], v0[1]); w.y = cvt_pk_bf16(v0[2], v0[3]); w.z = cvt_pk_bf16(v1[0], v1[1]); w.w = cvt_pk_bf16(v1[2], v1[3]);
                    *(u32x4*)(rowp + bj * HALF) = w; } }
    }
};

struct PanelStats {
    unsigned* xbuf;
    unsigned* cnt;
    unsigned* tmo;
    int ntn; float eps;
    unsigned code;
    __device__ __forceinline__ bool run(const f32x4 (&v)[2][2][4][2], const Unit& u, int wr, int wc, int fr, int fq, PG8_LAS unsigned char* lds, int wid, int lane) const {
        typedef float f32x2v __attribute__((ext_vector_type(2)));
        PG8_LAS f32x2v* P = (PG8_LAS f32x2v*)lds;
        PG8_LAS f32x2v* S = (PG8_LAS f32x2v*)(lds + 8192);
        PG8_LAS unsigned* flag = (PG8_LAS unsigned*)(lds + 8192 + 2048);
#pragma unroll
        for (int ai = 0; ai < 2; ++ai)
#pragma unroll
            for (int m = 0; m < 4; ++m) {
                float s = 0.f;
#pragma unroll
                for (int bj = 0; bj < 2; ++bj)
#pragma unroll
                    for (int n = 0; n < 2; ++n) { const f32x4 x = v[ai][bj][m][n]; s += (x[0] + x[1]) + (x[2] + x[3]); }
                s += __shfl_xor(s, 16); s += __shfl_xor(s, 32);
                const float mw = s * (1.0f / 64.0f); float q = 0.f;
#pragma unroll
                for (int bj = 0; bj < 2; ++bj)
#pragma unroll
                    for (int n = 0; n < 2; ++n) { const f32x4 d = v[ai][bj][m][n] - mw; q += (d[0] * d[0] + d[1] * d[1]) + (d[2] * d[2] + d[3] * d[3]); }
                q += __shfl_xor(q, 16); q += __shfl_xor(q, 32);
                if (fq == 0) P[(ai * HALF + wr * 64 + m * 16 + fr) * 4 + wc] = (f32x2v){mw, q};
            }
        asm volatile("s_waitcnt lgkmcnt(0)" ::: "memory"); __builtin_amdgcn_s_barrier(); asm volatile("" ::: "memory");
#if defined(BROKEN_EXCHANGE_NO_WAIT)
#warning BROKEN CONTROL BUILD: the row-statistics exchange does not wait; results are wrong by design
        if (blockIdx.x >= 64) { const long long t0_ = clock64(); while (clock64() - t0_ < 60000) __builtin_amdgcn_s_sleep(8); }
#endif
        const int row = wid * 32 + (lane & 31);
        if (lane < 32) {
            const f32x2v a = P[row * 4 + 0], b = P[row * 4 + 1], c = P[row * 4 + 2], d = P[row * 4 + 3];
            const float mt = (a.x + b.x + c.x + d.x) * 0.25f;
            const float da = a.x - mt, db = b.x - mt, dc = c.x - mt, dd = d.x - mt;
            const float m2 = (a.y + b.y) + (c.y + d.y) + 64.0f * ((da * da + db * db) + (dc * dc + dd * dd));
            unsigned long long* slot = (unsigned long long*)xbuf + ((size_t)(u.pm * BM + row) * 4 + u.pn);
            __hip_atomic_store(slot, ((unsigned long long)__float_as_uint(m2) << 32) | __float_as_uint(mt), __ATOMIC_RELAXED, __HIP_MEMORY_SCOPE_AGENT);
        }
        asm volatile("s_waitcnt vmcnt(0)" ::: "memory");
        if (lane == 0) __hip_atomic_fetch_add(cnt + 64 * u.pm, 1u, __ATOMIC_RELAXED, __HIP_MEMORY_SCOPE_AGENT);
        if (wid == 0) {
            bool dead = false; const unsigned long long t0 = __builtin_amdgcn_s_memrealtime(); const unsigned want = 8u * (unsigned)ntn;
            for (;;) {
#if defined(BROKEN_EXCHANGE_NO_WAIT)
                break;
#endif
                if ((unsigned)__builtin_amdgcn_readfirstlane(__hip_atomic_load(cnt + 64 * u.pm, __ATOMIC_RELAXED, __HIP_MEMORY_SCOPE_AGENT)) >= want) break;
                if (__builtin_amdgcn_s_memrealtime() - t0 > 2000000ull) {
                    if (lane == 0) { unsigned expect = 0u; __hip_atomic_compare_exchange_strong(tmo + 1, &expect, code | (unsigned)(u.pm & 0xff), __ATOMIC_RELAXED, __ATOMIC_RELAXED, __HIP_MEMORY_SCOPE_AGENT);
                                     __hip_atomic_store(tmo, 1u, __ATOMIC_RELAXED, __HIP_MEMORY_SCOPE_AGENT); }
                    dead = true; break; }
                __builtin_amdgcn_s_sleep(2);
            }
            __builtin_amdgcn_fence(__ATOMIC_ACQUIRE, "agent");
            if (lane == 0) flag[0] = dead ? 1u : 0u;
        }
        asm volatile("s_waitcnt vmcnt(0) lgkmcnt(0)" ::: "memory"); __builtin_amdgcn_s_barrier(); asm volatile("" ::: "memory");
        const bool bad = flag[0] != 0u;
        if (lane < 32) {
            const unsigned long long* slot = (const unsigned long long*)xbuf + (size_t)(u.pm * BM + row) * 4; float mt[4], m2[4]; float ms = 0.f;
#pragma unroll
            for (int t = 0; t < 4; ++t) { if (t < ntn) { const unsigned long long w = __hip_atomic_load(slot + t, __ATOMIC_RELAXED, __HIP_MEMORY_SCOPE_AGENT); mt[t] = __uint_as_float((unsigned)w); m2[t] = __uint_as_float((unsigned)(w >> 32)); } else { mt[t] = 0.f; m2[t] = 0.f; } ms += mt[t]; }
            const float mean = ms / (float)ntn; float q = 0.f;
#pragma unroll
            for (int t = 0; t < 4; ++t) if (t < ntn) { const float dm = mt[t] - mean; q += m2[t] + 256.0f * dm * dm; }
            S[row] = (f32x2v){mean, 1.0f / sqrtf(q / (256.0f * (float)ntn) + eps)};
        }
        asm volatile("s_waitcnt lgkmcnt(0)" ::: "memory"); __builtin_amdgcn_s_barrier(); asm volatile("" ::: "memory");
        return bad;
    }
};
struct EpiLnRes {
    static constexpr bool PERM = false, AFTER_DRAIN = true;
    const float* base; float* out; int ldc; const float* bias; PanelStats st; unsigned poison;
    __device__ __forceinline__ void fused(f32x4 (&acc)[2][2][4][2], const Unit& u, int wr, int wc, int fr, int fq, PG8_LAS unsigned char* lds, int wid, int lane) const {
        typedef float f32x2v __attribute__((ext_vector_type(2)));
        const PG8_LAS f32x2v* S = (const PG8_LAS f32x2v*)(lds + 8192);
        const int col0 = u.pn * BM + wc * 32 + 4 * fq;
#pragma unroll
        for (int bj = 0; bj < 2; ++bj)
#pragma unroll
            for (int n = 0; n < 2; ++n) { const f32x4 bv = bias ? *(const f32x4*)(bias + col0 + bj * HALF + n * 16) : (f32x4){0.f, 0.f, 0.f, 0.f};
#pragma unroll
                for (int ai = 0; ai < 2; ++ai)
#pragma unroll
                    for (int m = 0; m < 4; ++m) acc[ai][bj][m][n] += bv; }
        f32x4 pre[4][2][2];
#pragma unroll
        for (int m = 0; m < 4; ++m) { const size_t off = (size_t)(u.pm * BM + wr * 64 + m * 16 + fr) * ldc + col0;
#pragma unroll
            for (int bj = 0; bj < 2; ++bj)
#pragma unroll
                for (int n = 0; n < 2; ++n) pre[m][bj][n] = *(const f32x4*)(base + off + bj * HALF + n * 16); }
        const bool bad = st.run(acc, u, wr, wc, fr, fq, lds, wid, lane) || poison != 0u;
        const float qnan = __builtin_nanf("");
#pragma unroll
        for (int ai = 0; ai < 2; ++ai)
#pragma unroll
            for (int m = 0; m < 4; ++m) { const int r = ai * HALF + wr * 64 + m * 16 + fr; const f32x2v sr = S[r]; const size_t off = (size_t)(u.pm * BM + r) * ldc + col0;
#pragma unroll
                for (int bj = 0; bj < 2; ++bj)
#pragma unroll
                    for (int n = 0; n < 2; ++n) { const f32x4 bs = ai == 0 ? pre[m][bj][n] : *(const f32x4*)(base + off + bj * HALF + n * 16); f32x4 o = bs + (acc[ai][bj][m][n] - sr.x) * sr.y;
                        if (bad) o = (f32x4){qnan, qnan, qnan, qnan}; *(f32x4*)(out + off + bj * HALF + n * 16) = o; }
                if (m & 1) asm volatile("" ::: "memory"); }
    }
};
struct EpiLnResLn {
    static constexpr bool PERM = false, AFTER_DRAIN = true;
    const float* base; float* out; bf16_t* xn; int ldc; const float* bias; PanelStats st1, st2; unsigned poison;
    __device__ __forceinline__ void fused(f32x4 (&acc)[2][2][4][2], const Unit& u, int wr, int wc, int fr, int fq, PG8_LAS unsigned char* lds, int wid, int lane) const {
        typedef float f32x2v __attribute__((ext_vector_type(2))); typedef unsigned u32x2v __attribute__((ext_vector_type(2)));
        const PG8_LAS f32x2v* S = (const PG8_LAS f32x2v*)(lds + 8192);
        const int col0 = u.pn * BM + wc * 32 + 4 * fq;
#pragma unroll
        for (int bj = 0; bj < 2; ++bj)
#pragma unroll
            for (int n = 0; n < 2; ++n) { const f32x4 bv = bias ? *(const f32x4*)(bias + col0 + bj * HALF + n * 16) : (f32x4){0.f, 0.f, 0.f, 0.f};
#pragma unroll
                for (int ai = 0; ai < 2; ++ai)
#pragma unroll
                    for (int m = 0; m < 4; ++m) acc[ai][bj][m][n] += bv; }
        bool bad = st1.run(acc, u, wr, wc, fr, fq, lds, wid, lane) || poison != 0u;
        const float qnan = __builtin_nanf("");
#pragma unroll
        for (int ai = 0; ai < 2; ++ai)
#pragma unroll
            for (int m = 0; m < 4; ++m) { const int r = ai * HALF + wr * 64 + m * 16 + fr; const f32x2v sr = S[r]; const size_t off = (size_t)(u.pm * BM + r) * ldc + col0;
#pragma unroll
                for (int bj = 0; bj < 2; ++bj)
#pragma unroll
                    for (int n = 0; n < 2; ++n) { const f32x4 bs = *(const f32x4*)(base + off + bj * HALF + n * 16); acc[ai][bj][m][n] = bs + (acc[ai][bj][m][n] - sr.x) * sr.y; }
                asm volatile("" : "+v"(acc[ai][0][m][0]), "+v"(acc[ai][0][m][1]), "+v"(acc[ai][1][m][0]), "+v"(acc[ai][1][m][1]));
                if (m & 1) asm volatile("" ::: "memory"); }
        const bool bad1 = bad;
        bad = st2.run(acc, u, wr, wc, fr, fq, lds, wid, lane) || bad;
#pragma unroll
        for (int ai = 0; ai < 2; ++ai)
#pragma unroll
            for (int m = 0; m < 4; ++m) { const int r = ai * HALF + wr * 64 + m * 16 + fr; const f32x2v sr = S[r]; const size_t off = (size_t)(u.pm * BM + r) * ldc + col0;
#pragma unroll
                for (int bj = 0; bj < 2; ++bj)
#pragma unroll
                    for (int n = 0; n < 2; ++n) { const f32x4 x1 = acc[ai][bj][m][n]; *(f32x4*)(out + off + bj * HALF + n * 16) = bad1 ? (f32x4){qnan, qnan, qnan, qnan} : x1;
                        const f32x4 o = (x1 - sr.x) * sr.y; u32x2v w; w.x = cvt_pk_bf16(o[0], o[1]); w.y = cvt_pk_bf16(o[2], o[3]);
                        if (bad) { w.x = 0x7fc07fc0u; w.y = 0x7fc07fc0u; } *(u32x2v*)(xn + off + bj * HALF + n * 16) = w; }
                asm volatile("" ::: "memory"); }
    }
};

template <class Epi, class Sched, bool ALIGN_EPI = false, bool SP2 = false>
__device__ __forceinline__ void gemm_phase(PG8_LAS unsigned char* lds, const Gemm g, const Sched& S, const Epi& E) {
    int tid_ = threadIdx.x; asm volatile("" : "+v"(tid_));
    const int tid = tid_, wid = __builtin_amdgcn_readfirstlane(tid >> 6), lane = tid & 63, wr = wid >> 2, wc = wid & 3, fr = lane & 15, fq = lane >> 4;
    const int K = g.K, nt = K / BK;
    unsigned voffA[2], voffB[2];
#pragma unroll
    for (int i = 0; i < 2; ++i) { int R, C; stage_rc(tid * 16 + i * 8192, R, C); const int Rb = Epi::PERM ? ((R & ~31) + perm32(R & 31)) : R;
        voffA[i] = (unsigned)(R * K + C) * 2u; voffB[i] = (unsigned)(Rb * K + C) * 2u; }
    const size_t kstep = (size_t)(BK * 2);
    const size_t hstep = (size_t)HALF * K * 2;
    const size_t tstep = 2 * hstep;
    const unsigned ldsw = (unsigned)wid * 1024u;
    const int aoff = lds_byte(wr * 64 + fr, fq * 8), boff = lds_byte(wc * 32 + fr, fq * 8);
#define PG8_SA(b, h) (((b) * 2 + (h)) * HTB)
#define PG8_SB(b, h) ((4 + (b) * 2 + (h)) * HTB)
#define PG8_STAGE(bufoff, gbase, voff) do { _Pragma("unroll") for (int _i = 0; _i < 2; ++_i) \
        __builtin_amdgcn_global_load_lds((const unsigned*)((const char*)(gbase) + (voff)[_i]), (PG8_LAS unsigned*)(lds + (bufoff) + ldsw + _i * 8192), 16, 0, 0); } while (0)
#define PG8_LDA(dst, b, h) do { _Pragma("unroll") for (int m = 0; m < 4; ++m) _Pragma("unroll") for (int k = 0; k < 2; ++k) dst[m][k] = *(const PG8_LAS bf16x8*)(lds + PG8_SA(b, h) + aoff + m * 2048 + k * 1024); } while (0)
#define PG8_LDB(dst, b, h) do { _Pragma("unroll") for (int n = 0; n < 2; ++n) _Pragma("unroll") for (int k = 0; k < 2; ++k) dst[n][k] = *(const PG8_LAS bf16x8*)(lds + PG8_SB(b, h) + boff + n * 2048 + k * 1024); } while (0)
#define PG8_MMA(ai, bj, At, Bt) do { __builtin_amdgcn_s_setprio(1); _Pragma("unroll") for (int m = 0; m < 4; ++m) _Pragma("unroll") for (int n = 0; n < 2; ++n) _Pragma("unroll") for (int k = 0; k < 2; ++k) \
        acc[ai][bj][m][n] = __builtin_amdgcn_mfma_f32_16x16x32_bf16(Bt[n][k], At[m][k], acc[ai][bj][m][n], 0, 0, 0); __builtin_amdgcn_s_setprio(0); } while (0)
#define PG8_WAIT_V(n) asm volatile("s_waitcnt vmcnt(" #n ")" ::: "memory")
#define PG8_WAIT_L(n) asm volatile("s_waitcnt lgkmcnt(" #n ")" ::: "memory")
#define PG8_BAR __builtin_amdgcn_s_barrier()
#define PG8_SCHED __builtin_amdgcn_sched_barrier(0)
    Unit cur, nxt; int ui = 0;
    if (!S.next(0, cur)) return;
    f32x4 acc[2][2][4][2];
#pragma unroll
    for (int a = 0; a < 2; ++a)
#pragma unroll
        for (int b = 0; b < 2; ++b)
#pragma unroll
            for (int m = 0; m < 4; ++m)
#pragma unroll
                for (int n = 0; n < 2; ++n) acc[a][b][m][n] = (f32x4){0.f, 0.f, 0.f, 0.f};
    bf16x8 At[4][2], B0[2][2], B1[2][2];
    const char* cA = (const char*)g.A + (size_t)cur.pm * tstep; const char* cB = (const char*)g.Bt + (size_t)cur.pn * tstep;
    S.a_ready(cur);
    if constexpr (SP2) {
        PG8_STAGE(PG8_SB(0, 0), cB, voffB); PG8_STAGE(PG8_SB(0, 1), cB + hstep, voffB); PG8_STAGE(PG8_SA(0, 0), cA, voffA); PG8_STAGE(PG8_SA(0, 1), cA + hstep, voffA);
        if (wr == 1) PG8_BAR;
        PG8_WAIT_V(2); PG8_BAR;
        PG8_STAGE(PG8_SB(1, 0), cB + kstep, voffB); PG8_STAGE(PG8_SA(1, 0), cA + kstep, voffA); PG8_STAGE(PG8_SB(1, 1), cB + hstep + kstep, voffB);
        PG8_WAIT_V(6); PG8_BAR;
    } else {
        PG8_STAGE(PG8_SB(0, 0), cB, voffB); PG8_STAGE(PG8_SA(0, 0), cA, voffA); PG8_STAGE(PG8_SB(0, 1), cB + hstep, voffB); PG8_STAGE(PG8_SA(0, 1), cA + hstep, voffA);
        if (wr == 1) PG8_BAR;
        PG8_WAIT_V(4); PG8_BAR;
        PG8_STAGE(PG8_SB(1, 0), cB + kstep, voffB); PG8_STAGE(PG8_SA(1, 0), cA + kstep, voffA); PG8_STAGE(PG8_SB(1, 1), cB + hstep + kstep, voffB);
        PG8_WAIT_V(6); PG8_BAR;
    }
    for (;;) {
        const bool has_next = S.next(ui + 1, nxt);
        const char* nA = has_next ? (const char*)g.A + (size_t)nxt.pm * tstep : cA; const char* nB = has_next ? (const char*)g.Bt + (size_t)nxt.pn * tstep : cB;
        for (int t = 0; t < nt; t += 2) {
            const bool last = (t == nt - 2);
            const char* a1 = cA + (size_t)(t + 1) * kstep;
            const char* a2 = last ? nA : cA + (size_t)(t + 2) * kstep; const char* b2 = last ? nB : cB + (size_t)(t + 2) * kstep;
            const char* a3 = a2 + kstep; const char* b3 = b2 + kstep;
            if (last && has_next) S.a_ready(nxt);
            if constexpr (SP2) {
            PG8_LDB(B0, 0, 0); PG8_LDB(B1, 0, 1); PG8_SCHED; PG8_LDA(At, 0, 0); PG8_STAGE(PG8_SA(1, 1), a1 + hstep, voffA);
            PG8_WAIT_V(8); PG8_WAIT_L(0); PG8_BAR; PG8_MMA(0, 0, At, B0); PG8_MMA(0, 1, At, B1); PG8_BAR; PG8_SCHED;
            PG8_LDA(At, 0, 1); PG8_STAGE(PG8_SB(0, 0), b2, voffB); PG8_STAGE(PG8_SB(0, 1), b2 + hstep, voffB); PG8_STAGE(PG8_SA(0, 0), a2, voffA);
            PG8_WAIT_V(8); PG8_WAIT_L(0); PG8_BAR; PG8_MMA(1, 0, At, B0); PG8_MMA(1, 1, At, B1); PG8_BAR; PG8_SCHED;
            PG8_LDB(B0, 1, 0); PG8_LDB(B1, 1, 1); PG8_SCHED; PG8_LDA(At, 1, 0); PG8_STAGE(PG8_SA(0, 1), a2 + hstep, voffA);
            PG8_WAIT_V(8); PG8_WAIT_L(0); PG8_BAR; PG8_MMA(0, 0, At, B0); PG8_MMA(0, 1, At, B1); PG8_BAR; PG8_SCHED;
            PG8_LDA(At, 1, 1); PG8_STAGE(PG8_SB(1, 0), b3, voffB); PG8_STAGE(PG8_SB(1, 1), b3 + hstep, voffB); PG8_STAGE(PG8_SA(1, 0), a3, voffA);
            PG8_WAIT_V(8); PG8_WAIT_L(0); PG8_BAR; PG8_MMA(1, 0, At, B0); PG8_MMA(1, 1, At, B1); PG8_BAR; PG8_SCHED;
            } else {
            PG8_LDB(B0, 0, 0); PG8_SCHED; PG8_LDA(At, 0, 0); PG8_STAGE(PG8_SA(1, 1), a1 + hstep, voffA);
            PG8_WAIT_L(8); PG8_BAR; PG8_WAIT_L(0); PG8_MMA(0, 0, At, B0); PG8_BAR; PG8_SCHED;
            PG8_LDB(B1, 0, 1); PG8_STAGE(PG8_SB(0, 0), b2, voffB);
            PG8_BAR; PG8_WAIT_L(0); PG8_MMA(0, 1, At, B1); PG8_BAR;
            PG8_LDA(At, 0, 1); PG8_STAGE(PG8_SA(0, 0), a2, voffA);
            PG8_BAR; PG8_WAIT_L(0); PG8_MMA(1, 0, At, B0); PG8_BAR; PG8_SCHED;
            PG8_STAGE(PG8_SB(0, 1), b2 + hstep, voffB);
            PG8_WAIT_V(6); PG8_BAR; PG8_MMA(1, 1, At, B1); PG8_BAR;
            PG8_LDB(B0, 1, 0); PG8_SCHED; PG8_LDA(At, 1, 0); PG8_STAGE(PG8_SA(0, 1), a2 + hstep, voffA);
            PG8_WAIT_L(8); PG8_BAR; PG8_WAIT_L(0); PG8_MMA(0, 0, At, B0); PG8_BAR; PG8_SCHED;
            PG8_LDB(B1, 1, 1); PG8_STAGE(PG8_SB(1, 0), b3, voffB);
            PG8_BAR; PG8_WAIT_L(0); PG8_MMA(0, 1, At, B1); PG8_BAR;
            PG8_LDA(At, 1, 1); PG8_STAGE(PG8_SA(1, 0), a3, voffA);
            PG8_BAR; PG8_WAIT_L(0); PG8_MMA(1, 0, At, B0); PG8_BAR; PG8_SCHED;
            PG8_STAGE(PG8_SB(1, 1), b3 + hstep, voffB);
            PG8_WAIT_V(6); PG8_BAR; PG8_MMA(1, 1, At, B1); PG8_BAR;
            }
        }
        if constexpr (ALIGN_EPI) { if (wr == 0) PG8_BAR; }
        if constexpr (Epi::CHAIN) { if (has_next) E.mid(acc, cur, wr, wc, fr, fq); else E(acc, cur, wr, wc, fr, fq); }
        else if constexpr (!Epi::AFTER_DRAIN) { E(acc, cur, wr, wc, fr, fq); S.done(cur); }
        if (!has_next) break;
        if constexpr (!Epi::CHAIN) {
#pragma unroll
        for (int a = 0; a < 2; ++a)
#pragma unroll
            for (int b = 0; b < 2; ++b)
#pragma unroll
                for (int m = 0; m < 4; ++m)
#pragma unroll
                    for (int n = 0; n < 2; ++n) acc[a][b][m][n] = (f32x4){0.f, 0.f, 0.f, 0.f};
        }
        cur = nxt; cA = nA; cB = nB; ++ui;
        if constexpr (ALIGN_EPI) { if (wr == 1) PG8_BAR; }
    }
    PG8_WAIT_V(0);
    if constexpr (!ALIGN_EPI) { if (wr == 0) PG8_BAR; }
    PG8_BAR;
    if constexpr (Epi::AFTER_DRAIN) { E.fused(acc, cur, wr, wc, fr, fq, lds, wid, lane); S.done(cur); }
#undef PG8_SA
#undef PG8_SB
#undef PG8_STAGE
#undef PG8_LDA
#undef PG8_LDB
#undef PG8_MMA
#undef PG8_WAIT_V
#undef PG8_WAIT_L
#undef PG8_BAR
#undef PG8_SCHED
}
}

#define LAS __attribute__((address_space(3)))
typedef unsigned short bf16;
typedef float f32x4 __attribute__((ext_vector_type(4)));
typedef float f32x2 __attribute__((ext_vector_type(2)));
typedef short bf16x8 __attribute__((ext_vector_type(8)));
typedef short s16x4 __attribute__((ext_vector_type(4)));
typedef short v4i16_t __attribute__((ext_vector_type(4)));
typedef unsigned u32x4 __attribute__((ext_vector_type(4)));
typedef unsigned u32x2 __attribute__((ext_vector_type(2)));

constexpr int NWAVES = 8, NTHREADS = 512;
constexpr int DM = 1024, SEQ = 4096, NBATCH = 4, MP = NBATCH * SEQ, NSMP = 32, MV = MP + NSMP, MT = 16640;
constexpr int DIN = 7680, QKV = 1536, DFF = 2816, NADA = 6144;
constexpr size_t O_YP = 0, O_YS = 16777216, O_KV0P = 16809984, O_KV1P = 17858560, O_KV2P = 22052864,
                 O_KV0S = 38830080, O_KV1S = 38895616, O_KV2S = 38961152, O_SV = 39026688, O_END = 39059456;
constexpr float LOG2E = 1.4426950408889634f;
constexpr float QSCALE = 0.08838834764831845f * LOG2E;

constexpr size_t MiB = 1u << 20;
constexpr size_t alm(size_t x) { return (x + MiB - 1) / MiB * MiB; }
constexpr size_t WS_WADA = 1 * MiB;
constexpr size_t WS_WL0 = WS_WADA + alm(2ull * NADA * DM * 2);
constexpr size_t WL_WIN = 0;
constexpr size_t WL_WPA = WL_WIN + alm((size_t)DIN * DM * 2);
constexpr size_t WL_WPS = WL_WPA + alm(1024ull * 512 * 2);
constexpr size_t WL_WOUT = WL_WPS + alm(1024ull * 512 * 2);
constexpr size_t WL_WFI = WL_WOUT + alm(1024ull * 1024 * 2);
constexpr size_t WL_WFO = WL_WFI + alm(5632ull * 1024 * 2);
constexpr size_t WL_WSP = WL_WFO + alm(1024ull * DFF * 2);
constexpr size_t WL_SIZE = WL_WSP + alm(8ull * 128 * 128 * 2);
constexpr size_t WS_MOD = WS_WL0 + 2 * WL_SIZE;
constexpr size_t WS_SC = WS_MOD + alm(2ull * 36 * NADA * 4);
constexpr size_t WS_XN = WS_SC + alm(256ull * DM * 2);
constexpr size_t WS_Q = WS_XN + alm((size_t)MT * DM * 2);
constexpr size_t WS_K = WS_Q + alm((size_t)MT * QKV * 2);
constexpr size_t WS_V = WS_K + alm((size_t)MT * QKV * 2);
constexpr size_t WS_U = WS_V + alm((size_t)MT * QKV * 2);
constexpr size_t WS_VS = WS_U + alm((size_t)MT * 512 * 2);
constexpr size_t WS_G = WS_VS + alm((size_t)MT * 512 * 2);
constexpr size_t WS_OG = WS_G + alm((size_t)MT * 2048 * 2);
constexpr size_t WS_DG = WS_OG + alm((size_t)MT * QKV * 2);
constexpr size_t WS_YY = WS_DG + alm((size_t)MT * 12 * 4);
constexpr size_t WS_T1 = WS_YY + alm((size_t)(2 * MP + 64) * 512 * 2);
constexpr size_t WS_MG = WS_T1 + alm((size_t)MT * DM * 4);
constexpr size_t WS_X1 = WS_MG + alm((size_t)MT * DM * 2);
constexpr size_t WS_X2 = WS_X1 + alm((size_t)MT * DM * 4);
constexpr size_t WS_H = WS_X2 + alm((size_t)MT * DM * 4);
constexpr size_t WS_END = WS_H + alm((size_t)MT * DFF * 2);

constexpr int LDS_RING = 0, LDS_EXCH = 131072, LDS_BYTES = 155648;

__device__ __forceinline__ float bf2f(unsigned short h) { return __uint_as_float((unsigned)h << 16); }
__device__ __forceinline__ unsigned pk2(float lo, float hi) { return pg8::cvt_pk_bf16(lo, hi); }
__device__ __forceinline__ float fast_exp2(float x) { return __builtin_amdgcn_exp2f(x); }
__device__ __forceinline__ float sigmoidf_(float x) { return __builtin_amdgcn_rcpf(1.0f + fast_exp2(-x * LOG2E)); }
__device__ __forceinline__ float wave_sum(float v) {
#pragma unroll
    for (int o = 1; o < 64; o <<= 1) v += __shfl_xor(v, o);
    return v;
}
__device__ __forceinline__ float wave_max(float v) {
#pragma unroll
    for (int o = 1; o < 64; o <<= 1) v = fmaxf(v, __shfl_xor(v, o));
    return v;
}
__device__ __forceinline__ s16x4 vtr(const LAS unsigned char* p) { return __builtin_bit_cast(s16x4, __builtin_amdgcn_ds_read_tr16_b64_v4i16((LAS v4i16_t*)p)); }
#define LDS_WAIT() asm volatile("s_waitcnt lgkmcnt(0)" ::: "memory")

__device__ __forceinline__ int mod_row(int row) { return row < MP ? (row >> 12) : 4 + (row - MP); }

__device__ __forceinline__ __attribute__((address_space(1))) float* kv_out_ptr(__attribute__((address_space(1))) float* out, int layer, int g, int row, int kvi, int hh) {
    if (row < MP) {
        const int b = row >> 12, t = row & 4095, lw = 128 << (2 * g), tt = t - (SEQ - lw);
        if (tt < 0) return nullptr;
        const size_t base = g == 0 ? O_KV0P : (g == 1 ? O_KV1P : O_KV2P);
        return out + base + ((((size_t)(layer * NBATCH + b) * lw + tt) * 2 + kvi) * 4 + hh) * 128;
    } else if (row < MV) {
        const int b = row - MP;
        const size_t base = g == 0 ? O_KV0S : (g == 1 ? O_KV1S : O_KV2S);
        return out + base + (((size_t)(layer * NSMP + b) * 2 + kvi) * 4 + hh) * 128;
    }
    return nullptr;
}

using pg8::Unit;
typedef pg8::f32x4 (AccT)[2][2][4][2];

__device__ __forceinline__ void st8_bf16g(__attribute__((address_space(1))) bf16* p, f32x4 v0, f32x4 v1) {
    u32x4 w; w.x = pk2(v0[0], v0[1]); w.y = pk2(v0[2], v0[3]); w.z = pk2(v1[0], v1[1]); w.w = pk2(v1[2], v1[3]);
    *(__attribute__((address_space(1))) u32x4*)p = w;
}
__device__ __forceinline__ void st8_bf16(bf16* p, f32x4 v0, f32x4 v1) {
    u32x4 w; w.x = pk2(v0[0], v0[1]); w.y = pk2(v0[2], v0[3]); w.z = pk2(v1[0], v1[1]); w.w = pk2(v1[2], v1[3]);
    *(u32x4*)p = w;
}

#define LAUNDER_S(x) asm volatile("" : "+s"(x))
#define GP(T, p) ((T*)(__attribute__((address_space(1))) T*)(p))
struct EpiAda {
    static constexpr bool PERM = true, AFTER_DRAIN = false, CHAIN = false;
    float* MOD; const float* b_ada;
    __device__ __forceinline__ void operator()(const pg8::f32x4 (&acc)[2][2][4][2], const Unit& u, int wr, int wc, int fr_, int fq_) const {
        int fr = fr_, fq = fq_; asm volatile("" : "+v"(fr), "+v"(fq));
        if (u.pm != 0 || wr != 0) return;
#pragma unroll
        for (int m = 0; m < 3; ++m) {
            const int row = m * 16 + fr;
            if (row >= 36) continue;
#pragma unroll
            for (int bj = 0; bj < 2; ++bj) {
                const int col = u.pn * 256 + bj * 128 + wc * 32 + 8 * fq;
                const int layer = col / NADA, c = col - layer * NADA;
                const float* bp = b_ada + (size_t)layer * NADA + c;
                float* op = MOD + ((size_t)layer * 36 + row) * NADA + c;
                *(f32x4*)op = acc[0][bj][m][0] + *(const f32x4*)bp;
                *(f32x4*)(op + 4) = acc[0][bj][m][1] + *(const f32x4*)(bp + 4);
            }
        }
    }
};

struct EpiIn {
    static constexpr bool PERM = true, AFTER_DRAIN = false, CHAIN = false;
    unsigned char* wsb; const float* qw; const float* kw; float* out; int layer; LAS float* P;
    __device__ __forceinline__ void operator()(const pg8::f32x4 (&acc)[2][2][4][2], const Unit& u, int wr, int wc, int fr_, int fq_) const {
        int fr = fr_, fq = fq_; asm volatile("" : "+v"(fr), "+v"(fq));
        unsigned char* wsl = wsb; const float* qwl = qw; const float* kwl = kw; float* outl = out; LAUNDER_S(wsl); LAUNDER_S(qwl); LAUNDER_S(kwl); LAUNDER_S(outl);
        typedef __attribute__((address_space(1))) bf16 gbf; typedef __attribute__((address_space(1))) float gfl;
        gbf *Q = (gbf*)(wsl + WS_Q), *K = (gbf*)(wsl + WS_K), *V = (gbf*)(wsl + WS_V), *U = (gbf*)(wsl + WS_U), *VS = (gbf*)(wsl + WS_VS), *G = (gbf*)(wsl + WS_G);
        gfl* outg = (gfl*)outl;
        const int pn = u.pn;
        const int cw = wc * 32 + 8 * fq;
        const int rowb = u.pm * 256 + wr * 64 + fr;
        if (pn < 12) {
            const bool isk = pn >= 6;
#pragma unroll
            for (int ai = 0; ai < 2; ++ai)
#pragma unroll
                for (int m = 0; m < 4; ++m)
#pragma unroll
                    for (int bj = 0; bj < 2; ++bj) {
                        const pg8::f32x4 a = acc[ai][bj][m][0], b = acc[ai][bj][m][1];
                        float s = (a[0] * a[0] + a[1] * a[1]) + (a[2] * a[2] + a[3] * a[3]) + (b[0] * b[0] + b[1] * b[1]) + (b[2] * b[2] + b[3] * b[3]);
                        s += __shfl_xor(s, 16); s += __shfl_xor(s, 32);
                        if (fq == 0) P[(ai * 128 + wr * 64 + m * 16 + fr) * 8 + bj * 4 + wc] = s;
                    }
            asm volatile("s_waitcnt lgkmcnt(0)" ::: "memory"); __builtin_amdgcn_s_barrier(); asm volatile("" ::: "memory");
#pragma unroll
            for (int bj = 0; bj < 2; ++bj) {
                const int head = 2 * (isk ? pn - 6 : pn) + bj, g = head >> 2, hh = head & 3;
                const __attribute__((address_space(1))) float* wv = (const __attribute__((address_space(1))) float*)(isk ? kwl : qwl) + g * 128 + cw;
                pg8::f32x4 w0 = *(const __attribute__((address_space(1))) f32x4*)wv, w1 = *(const __attribute__((address_space(1))) f32x4*)(wv + 4);
                if (!isk) { w0 = w0 * QSCALE; w1 = w1 * QSCALE; }
                gbf* dst = (isk ? K : Q) + head * 128 + cw;
#pragma unroll
                for (int ai = 0; ai < 2; ++ai)
#pragma unroll
                    for (int m = 0; m < 4; ++m) {
                        const int rl = ai * 128 + wr * 64 + m * 16 + fr, row = u.pm * 256 + rl;
                        const f32x4 pv = *(const LAS f32x4*)(P + rl * 8 + bj * 4);
                        const float rstd = 1.0f / sqrtf(((pv[0] + pv[1]) + (pv[2] + pv[3])) * (1.0f / 128.0f) + 1e-6f);
                        const pg8::f32x4 v0 = acc[ai][bj][m][0] * rstd * w0, v1 = acc[ai][bj][m][1] * rstd * w1;
                        st8_bf16g(dst + (size_t)row * QKV, v0, v1);
                        if (isk) { gfl* o = kv_out_ptr(outg, layer, g, row, 0, hh); if (o) { *(__attribute__((address_space(1))) f32x4*)(o + cw) = v0; *(__attribute__((address_space(1))) f32x4*)(o + cw + 4) = v1; } }
                    }
            }
        } else if (pn < 18) {
#pragma unroll
            for (int bj = 0; bj < 2; ++bj) {
                const int head = 2 * (pn - 12) + bj, g = head >> 2, hh = head & 3;
                gbf* dst = V + head * 128 + cw;
#pragma unroll
                for (int ai = 0; ai < 2; ++ai)
#pragma unroll
                    for (int m = 0; m < 4; ++m) {
                        const int row = rowb + ai * 128 + m * 16;
                        const pg8::f32x4 v0 = acc[ai][bj][m][0], v1 = acc[ai][bj][m][1];
                        st8_bf16g(dst + (size_t)row * QKV, v0, v1);
                        gfl* o = kv_out_ptr(outg, layer, g, row, 1, hh); if (o) { *(__attribute__((address_space(1))) f32x4*)(o + cw) = v0; *(__attribute__((address_space(1))) f32x4*)(o + cw + 4) = v1; }
                    }
            }
        } else if (pn < 22) {
            gbf* base = (pn < 20 ? U : VS) + ((pn - 18) & 1) * 256 + cw;
#pragma unroll
            for (int bj = 0; bj < 2; ++bj)
#pragma unroll
                for (int ai = 0; ai < 2; ++ai)
#pragma unroll
                    for (int m = 0; m < 4; ++m) {
                        const int row = rowb + ai * 128 + m * 16;
                        const pg8::f32x4 v0 = acc[ai][bj][m][0], v1 = acc[ai][bj][m][1];
                        const pg8::f32x2 a = pg8::gelu_pk((pg8::f32x2){v0[0], v0[1]}), b = pg8::gelu_pk((pg8::f32x2){v0[2], v0[3]}),
                                         c = pg8::gelu_pk((pg8::f32x2){v1[0], v1[1]}), d = pg8::gelu_pk((pg8::f32x2){v1[2], v1[3]});
                        st8_bf16g(base + (size_t)row * 512 + bj * 128, (f32x4){a.x, a.y, b.x, b.y}, (f32x4){c.x, c.y, d.x, d.y});
                    }
        } else {
            gbf* base = G + (pn - 22) * 256 + cw;
#pragma unroll
            for (int bj = 0; bj < 2; ++bj)
#pragma unroll
                for (int ai = 0; ai < 2; ++ai)
#pragma unroll
                    for (int m = 0; m < 4; ++m) {
                        const int row = rowb + ai * 128 + m * 16;
                        const pg8::f32x4 v0 = acc[ai][bj][m][0], v1 = acc[ai][bj][m][1];
                        st8_bf16g(base + (size_t)row * 2048 + bj * 128,
                                 (f32x4){sigmoidf_(v0[0]), sigmoidf_(v0[1]), sigmoidf_(v0[2]), sigmoidf_(v0[3])},
                                 (f32x4){sigmoidf_(v1[0]), sigmoidf_(v1[1]), sigmoidf_(v1[2]), sigmoidf_(v1[3])});
                    }
        }
    }
};

struct EpiGate1 {
    static constexpr bool PERM = true, AFTER_DRAIN = false, CHAIN = false;
    const bf16* G; float* T1;
    __device__ __forceinline__ void operator()(const pg8::f32x4 (&acc)[2][2][4][2], const Unit& u, int wr, int wc, int fr_, int fq_) const {
        int fr = fr_, fq = fq_; asm volatile("" : "+v"(fr), "+v"(fq));
        const int col0 = u.pn * 256 + wc * 32 + 8 * fq, rowb = u.pm * 256 + wr * 64 + fr;
#pragma unroll
        for (int ai = 0; ai < 2; ++ai)
#pragma unroll
            for (int m = 0; m < 4; ++m) {
                const int row = rowb + ai * 128 + m * 16;
#pragma unroll
                for (int bj = 0; bj < 2; ++bj) {
                    const int col = col0 + bj * 128;
                    const u32x4 gv = *(const u32x4*)(G + (size_t)row * 2048 + col);
                    const f32x4 g0 = {__uint_as_float(gv.x << 16), __uint_as_float(gv.x & 0xffff0000u), __uint_as_float(gv.y << 16), __uint_as_float(gv.y & 0xffff0000u)};
                    const f32x4 g1 = {__uint_as_float(gv.z << 16), __uint_as_float(gv.z & 0xffff0000u), __uint_as_float(gv.w << 16), __uint_as_float(gv.w & 0xffff0000u)};
                    float* o = T1 + (size_t)row * DM + col;
                    *(f32x4*)o = g0 * acc[ai][bj][m][0]; *(f32x4*)(o + 4) = g1 * acc[ai][bj][m][1];
                }
            }
    }
};
struct EpiGate2 {
    static constexpr bool PERM = true, AFTER_DRAIN = false, CHAIN = false;
    const bf16* G; const float* T1; bf16* MG;
    __device__ __forceinline__ void operator()(const pg8::f32x4 (&acc)[2][2][4][2], const Unit& u, int wr, int wc, int fr_, int fq_) const {
        int fr = fr_, fq = fq_; asm volatile("" : "+v"(fr), "+v"(fq));
        const int col0 = u.pn * 256 + wc * 32 + 8 * fq, rowb = u.pm * 256 + wr * 64 + fr;
#pragma unroll
        for (int ai = 0; ai < 2; ++ai)
#pragma unroll
            for (int m = 0; m < 4; ++m) {
                const int row = rowb + ai * 128 + m * 16;
#pragma unroll
                for (int bj = 0; bj < 2; ++bj) {
                    const int col = col0 + bj * 128;
                    const u32x4 gv = *(const u32x4*)(G + (size_t)row * 2048 + 1024 + col);
                    const f32x4 g0 = {__uint_as_float(gv.x << 16), __uint_as_float(gv.x & 0xffff0000u), __uint_as_float(gv.y << 16), __uint_as_float(gv.y & 0xffff0000u)};
                    const f32x4 g1 = {__uint_as_float(gv.z << 16), __uint_as_float(gv.z & 0xffff0000u), __uint_as_float(gv.w << 16), __uint_as_float(gv.w & 0xffff0000u)};
                    const float* t = T1 + (size_t)row * DM + col;
                    const f32x4 t0 = *(const f32x4*)t, t1 = *(const f32x4*)(t + 4);
                    st8_bf16(MG + (size_t)row * DM + col, t0 + g0 * acc[ai][bj][m][0], t1 + g1 * acc[ai][bj][m][1]);
                }
            }
    }
};

struct PairOrder {
    pg8::StaticOrder S0;
    __device__ bool next(int i, Unit& u) const { if (i >= 2) return false; Unit b; if (!S0.next(0, b)) return false; u.pm = b.pm + (i ? MP / 256 : 0); u.pn = b.pn + (i ? 4 : 0); return true; }
    __device__ __forceinline__ void a_ready(const Unit&) const {}
    __device__ __forceinline__ void done(const Unit&) const {}
};
__device__ __forceinline__ void unpack8(const u32x4 gv, f32x4& g0, f32x4& g1) {
    g0 = (f32x4){__uint_as_float(gv.x << 16), __uint_as_float(gv.x & 0xffff0000u), __uint_as_float(gv.y << 16), __uint_as_float(gv.y & 0xffff0000u)};
    g1 = (f32x4){__uint_as_float(gv.z << 16), __uint_as_float(gv.z & 0xffff0000u), __uint_as_float(gv.w << 16), __uint_as_float(gv.w & 0xffff0000u)};
}
struct EpiMerged {
    static constexpr bool PERM = true, AFTER_DRAIN = false, CHAIN = true;
    const bf16* G; bf16* MG;
    __device__ __forceinline__ void mid(pg8::f32x4 (&acc)[2][2][4][2], const Unit& u, int wr, int wc, int fr_, int fq_) const {
        int fr = fr_, fq = fq_; asm volatile("" : "+v"(fr), "+v"(fq));
        const int col0 = u.pn * 256 + wc * 32 + 8 * fq, rowb = u.pm * 256 + wr * 64 + fr;
#pragma unroll
        for (int ai = 0; ai < 2; ++ai)
#pragma unroll
            for (int m = 0; m < 4; ++m) {
                const int row = rowb + ai * 128 + m * 16;
#pragma unroll
                for (int bj = 0; bj < 2; ++bj) {
                    const int col = col0 + bj * 128;
                    f32x4 a0, a1, b0, b1;
                    unpack8(*(const u32x4*)(G + (size_t)row * 2048 + col), a0, a1);
                    unpack8(*(const u32x4*)(G + (size_t)row * 2048 + 1024 + col), b0, b1);
#pragma unroll
                    for (int e = 0; e < 4; ++e) {
                        acc[ai][bj][m][0][e] *= a0[e] * __builtin_amdgcn_rcpf(fmaxf(b0[e], 1e-30f));
                        acc[ai][bj][m][1][e] *= a1[e] * __builtin_amdgcn_rcpf(fmaxf(b1[e], 1e-30f));
                    }
                }
            }
    }
    __device__ __forceinline__ void operator()(const pg8::f32x4 (&acc)[2][2][4][2], const Unit& u, int wr, int wc, int fr_, int fq_) const {
        int fr = fr_, fq = fq_; asm volatile("" : "+v"(fr), "+v"(fq));
        const int col0 = (u.pn - 4) * 256 + wc * 32 + 8 * fq, rowb = (u.pm - MP / 256) * 256 + wr * 64 + fr;
#pragma unroll
        for (int ai = 0; ai < 2; ++ai)
#pragma unroll
            for (int m = 0; m < 4; ++m) {
                const int row = rowb + ai * 128 + m * 16;
#pragma unroll
                for (int bj = 0; bj < 2; ++bj) {
                    const int col = col0 + bj * 128;
                    f32x4 b0, b1;
                    unpack8(*(const u32x4*)(G + (size_t)row * 2048 + 1024 + col), b0, b1);
                    st8_bf16(MG + (size_t)row * DM + col, b0 * acc[ai][bj][m][0], b1 * acc[ai][bj][m][1]);
                }
            }
    }
};
struct EpiRes {
    static constexpr bool PERM = true, AFTER_DRAIN = false, CHAIN = false;
    const float* bp; const float* bs; float* op; float* os; const float* gate;
    __device__ __forceinline__ void operator()(const pg8::f32x4 (&acc)[2][2][4][2], const Unit& u, int wr, int wc, int fr_, int fq_) const {
        int fr = fr_, fq = fq_; asm volatile("" : "+v"(fr), "+v"(fq));
        const int col0 = u.pn * 256 + wc * 32 + 8 * fq, rowb = u.pm * 256 + wr * 64 + fr;
#pragma unroll
        for (int ai = 0; ai < 2; ++ai)
#pragma unroll
            for (int m = 0; m < 4; ++m) {
                const int row = rowb + ai * 128 + m * 16;
                if (row < MV) {
                    const float* b = row < MP ? bp + (size_t)row * DM : bs + (size_t)(row - MP) * DM;
                    float* o = row < MP ? op + (size_t)row * DM : os + (size_t)(row - MP) * DM;
                    const float* gt = gate + (size_t)mod_row(row) * NADA;
#pragma unroll
                    for (int bj = 0; bj < 2; ++bj) {
                        const int col = col0 + bj * 128;
                        const f32x4 b0 = *(const f32x4*)(b + col), b1 = *(const f32x4*)(b + col + 4);
                        const f32x4 g0 = *(const f32x4*)(gt + col), g1 = *(const f32x4*)(gt + col + 4);
                        *(f32x4*)(o + col) = b0 + g0 * acc[ai][bj][m][0]; *(f32x4*)(o + col + 4) = b1 + g1 * acc[ai][bj][m][1];
                    }
                }
            }
    }
};
struct EpiSwiglu {
    static constexpr bool PERM = true, AFTER_DRAIN = false, CHAIN = false;
    bf16* H;
    __device__ __forceinline__ void operator()(const pg8::f32x4 (&acc)[2][2][4][2], const Unit& u, int wr, int wc, int fr_, int fq_) const {
        int fr = fr_, fq = fq_; asm volatile("" : "+v"(fr), "+v"(fq));
        const int col = u.pn * 128 + wc * 32 + 8 * fq, rowb = u.pm * 256 + wr * 64 + fr;
#pragma unroll
        for (int ai = 0; ai < 2; ++ai)
#pragma unroll
            for (int m = 0; m < 4; ++m) {
                const int row = rowb + ai * 128 + m * 16;
                f32x4 r0, r1;
#pragma unroll
                for (int e = 0; e < 4; ++e) {
                    const float a0 = acc[ai][0][m][0][e], a1 = acc[ai][0][m][1][e];
                    r0[e] = a0 * sigmoidf_(a0) * acc[ai][1][m][0][e];
                    r1[e] = a1 * sigmoidf_(a1) * acc[ai][1][m][1][e];
                }
                st8_bf16(H + (size_t)row * DFF + col, r0, r1);
            }
    }
};

__device__ __forceinline__ void transpose_item(const float* W, int K, int N, bf16* WT, int mode, LAS float* scr, int item, int lane) {
    const int nblk = N / 32, kb = item / nblk, nb = item % nblk, k0 = 64 * kb, n0 = 32 * nb;
    float wv[32];
#pragma unroll
    for (int i = 0; i < 32; ++i) wv[i] = W[(size_t)(k0 + 2 * i + (lane >> 5)) * N + n0 + (lane & 31)];
#pragma unroll
    for (int i = 0; i < 32; ++i) scr[(2 * i + (lane >> 5)) * 33 + (lane & 31)] = wv[i];
    LDS_WAIT(); asm volatile("" ::: "memory");
    int drow0 = n0;
    if (mode == 1) { const int bj = n0 >= DFF ? 1 : 0; const int j0 = n0 - bj * DFF; drow0 = (j0 >> 7) * 256 + bj * 128 + (j0 & 127); }
    const int c = lane & 7;
#pragma unroll
    for (int j = 0; j < 4; ++j) { const int n = (lane >> 3) + 8 * j; const LAS float* s = scr + (8 * c) * 33 + n;
        u32x4 o; o.x = pk2(s[0 * 33], s[1 * 33]); o.y = pk2(s[2 * 33], s[3 * 33]); o.z = pk2(s[4 * 33], s[5 * 33]); o.w = pk2(s[6 * 33], s[7 * 33]);
        *(u32x4*)(WT + (size_t)(drow0 + n) * K + k0 + 8 * c) = o; }
    LDS_WAIT(); asm volatile("" ::: "memory");
}

__device__ __forceinline__ void norm_mod_phase(const float* xp, const float* xs, const float* nw, const float* modl, int sh_off, bf16* XN, int gw, int NGW, int lane) {
    f32x4 w[4];
#pragma unroll
    for (int j = 0; j < 4; ++j) w[j] = *(const f32x4*)(nw + 4 * lane + 256 * j);
    for (int row0 = gw; row0 < MT; row0 += 2 * NGW) {
        f32x4 v[2][4];
#pragma unroll
        for (int q = 0; q < 2; ++q) {
            const int row = row0 + q * NGW;
            if (row < MV) {
                const float* xrow = row < MP ? xp + (size_t)row * DM : xs + (size_t)(row - MP) * DM;
#pragma unroll
                for (int j = 0; j < 4; ++j) v[q][j] = ((const f32x4*)xrow)[lane + 64 * j];
            } else {
#pragma unroll
                for (int j = 0; j < 4; ++j) v[q][j] = (f32x4){0.f, 0.f, 0.f, 0.f};
            }
        }
#pragma unroll
        for (int q = 0; q < 2; ++q) {
            const int row = row0 + q * NGW;
            if (row >= MT) continue;
            unsigned long long* o8 = (unsigned long long*)(XN + (size_t)row * DM) + lane;
            if (row >= MV) {
#pragma unroll
                for (int j = 0; j < 4; ++j) o8[64 * j] = 0ull;
                continue;
            }
            float s = 0.f;
#pragma unroll
            for (int j = 0; j < 4; ++j) s += (v[q][j].x * v[q][j].x + v[q][j].y * v[q][j].y) + (v[q][j].z * v[q][j].z + v[q][j].w * v[q][j].w);
            const float rstd = 1.0f / sqrtf(wave_sum(s) * (1.0f / DM) + 1e-6f);
            const float* mr = modl + (size_t)mod_row(row) * NADA + sh_off;
#pragma unroll
            for (int j = 0; j < 4; ++j) {
                const int col = 4 * lane + 256 * j;
                const f32x4 shv = *(const f32x4*)(mr + col), scv = *(const f32x4*)(mr + 1024 + col);
                const f32x4 y = v[q][j] * rstd * w[j] * (scv + 1.0f) + shv;
                o8[64 * j] = (unsigned long long)pk2(y.x, y.y) | ((unsigned long long)pk2(y.z, y.w) << 32);
            }
        }
    }
}

constexpr int KV_STRIDE = 272;
constexpr int ATT_K_OFF = 0, ATT_V_OFF = 256 * KV_STRIDE;
__device__ __forceinline__ float alibi_slope(int head12) { return exp2f(-8.0f * (float)(head12 + 1) / 12.0f); }

__device__ __forceinline__ void attn_unit(LAS unsigned char* lds, const bf16* Q, const bf16* K, const bf16* V, bf16* OG, float* DG, int unit, float cshift, int wid, int lane, int tid) {
    const int g = unit >> 9, r9 = unit & 511, sh = 2 * g, d = 1 << sh, nb = 32 >> sh;
    const int qb = r9 % nb; int t2 = r9 / nb; const int r = t2 % d; t2 /= d; const int h = t2 & 3, b = t2 >> 2;
    const int hc = (g * 4 + h) * 128;
    {
        const int ch = tid & 15, r0 = tid >> 4;
        u32x4 kv[8], vv[8];
#pragma unroll
        for (int it = 0; it < 8; ++it) {
            const int j = r0 + 32 * it, mk = 128 * qb - 128 + j;
            if (qb > 0 || it >= 4) {
                const size_t off = ((size_t)b * SEQ + (size_t)mk * d + r) * QKV + hc + ch * 8;
                kv[it] = *(const u32x4*)(K + off); vv[it] = *(const u32x4*)(V + off);
            } else { kv[it] = (u32x4){0u, 0u, 0u, 0u}; vv[it] = (u32x4){0u, 0u, 0u, 0u}; }
        }
#pragma unroll
        for (int it = 0; it < 8; ++it) {
            const int j = r0 + 32 * it;
            *(LAS u32x4*)(lds + ATT_K_OFF + j * KV_STRIDE + ch * 16) = kv[it];
            *(LAS u32x4*)(lds + ATT_V_OFF + j * KV_STRIDE + ch * 16) = vv[it];
        }
    }
    const int ql = lane & 15, gq = lane >> 4;
    const int qi = 16 * wid + ql;
    const size_t qrow = (size_t)b * SEQ + (size_t)(128 * qb + qi) * d + r;
    bf16x8 qf[4];
#pragma unroll
    for (int kk = 0; kk < 4; ++kk) qf[kk] = *(const bf16x8*)(Q + qrow * QKV + hc + 32 * kk + 8 * gq);
    const float slope2 = alibi_slope(g * 4 + h) * LOG2E * (float)d;
    __syncthreads();
    f32x4 accO[8];
#pragma unroll
    for (int dt = 0; dt < 8; ++dt) accO[dt] = (f32x4){0.f, 0.f, 0.f, 0.f};
    float dsum = 0.f;
    const LAS unsigned char* kbase = lds + ATT_K_OFF + (16 * wid + ql) * KV_STRIDE + gq * 16;
    const LAS unsigned char* vbase = lds + ATT_V_OFF + (16 * wid + 4 * gq + (ql >> 2)) * KV_STRIDE + (ql & 3) * 8;
#pragma unroll
    for (int kt2 = 0; kt2 < 5; ++kt2) {
        const int ja = 16 * wid + 32 * kt2;
        f32x4 sa = {0.f, 0.f, 0.f, 0.f}, sb = {0.f, 0.f, 0.f, 0.f};
#pragma unroll
        for (int kk = 0; kk < 4; ++kk) {
            const bf16x8 ka = *(const LAS bf16x8*)(kbase + (32 * kt2) * KV_STRIDE + kk * 64);
            sa = __builtin_amdgcn_mfma_f32_16x16x32_bf16(ka, qf[kk], sa, 0, 0, 0);
        }
        if (kt2 < 4) {
#pragma unroll
            for (int kk = 0; kk < 4; ++kk) {
                const bf16x8 kb = *(const LAS bf16x8*)(kbase + (32 * kt2 + 16) * KV_STRIDE + kk * 64);
                sb = __builtin_amdgcn_mfma_f32_16x16x32_bf16(kb, qf[kk], sb, 0, 0, 0);
            }
        }
        float pa[4], pb[4];
#pragma unroll
        for (int jj = 0; jj < 4; ++jj) {
            const int j = ja + 4 * gq + jj, dist = 128 + qi - j;
            const bool ok = dist >= 0 && dist <= 128 && (128 * qb - 128 + j) >= 0;
            pa[jj] = ok ? fast_exp2(sa[jj] - slope2 * (float)dist - cshift) : 0.f;
            const int j2 = j + 16, dist2 = dist - 16;
            const bool ok2 = (kt2 < 4) && dist2 >= 0 && dist2 <= 128 && (128 * qb - 128 + j2) >= 0;
            pb[jj] = ok2 ? fast_exp2(sb[jj] - slope2 * (float)dist2 - cshift) : 0.f;
            dsum += pa[jj] + pb[jj];
        }
        u32x4 pw; pw.x = pk2(pa[0], pa[1]); pw.y = pk2(pa[2], pa[3]); pw.z = pk2(pb[0], pb[1]); pw.w = pk2(pb[2], pb[3]);
        const bf16x8 pfrag = __builtin_bit_cast(bf16x8, pw);
        const int rb = (kt2 < 4) ? (32 * kt2 + 16) : (32 * kt2);
#pragma unroll
        for (int dt = 0; dt < 8; ++dt) {
            const s16x4 lo = vtr(vbase + (32 * kt2) * KV_STRIDE + dt * 32);
            const s16x4 hi = vtr(vbase + rb * KV_STRIDE + dt * 32);
            const bf16x8 vf = {lo[0], lo[1], lo[2], lo[3], hi[0], hi[1], hi[2], hi[3]};
            accO[dt] = __builtin_amdgcn_mfma_f32_16x16x32_bf16(vf, pfrag, accO[dt], 0, 0, 0);
        }
    }
    dsum += __shfl_xor(dsum, 16); dsum += __shfl_xor(dsum, 32);
    const float inv = 1.0f / dsum;
    bf16* op = OG + qrow * QKV + g * 512 + h * 128 + 4 * gq;
#pragma unroll
    for (int dt = 0; dt < 8; ++dt) {
        u32x2 w; w.x = pk2(accO[dt][0] * inv, accO[dt][1] * inv); w.y = pk2(accO[dt][2] * inv, accO[dt][3] * inv);
        *(u32x2*)(op + dt * 16) = w;
    }
    if (gq == 0) DG[qrow * 12 + g * 4 + h] = dsum;
    __syncthreads();
}


struct AttnU { int g, b, h, r, qb, d, hc; };
__device__ __forceinline__ AttnU attn_decode(int unit) {
    AttnU a; a.g = unit >> 9; const int r9 = unit & 511, sh = 2 * a.g, nb = 32 >> sh; a.d = 1 << sh;
    a.qb = r9 % nb; int t2 = r9 / nb; a.r = t2 % a.d; t2 /= a.d; a.h = t2 & 3; a.b = t2 >> 2; a.hc = (a.g * 4 + a.h) * 128; return a;
}
constexpr int ATT_BLK = 128 * KV_STRIDE;
__device__ __forceinline__ void attn_load_block(u32x4 (&kn)[4], u32x4 (&vn)[4], const bf16* K, const bf16* V, const AttnU& a, int blk, int tid) {
    const int ch = tid & 15, r0 = tid >> 4;
#pragma unroll
    for (int it = 0; it < 4; ++it) {
        const size_t off = ((size_t)a.b * SEQ + (size_t)(128 * blk + r0 + 32 * it) * a.d + a.r) * QKV + a.hc + ch * 8;
        kn[it] = *(const u32x4*)(K + off); vn[it] = *(const u32x4*)(V + off);
    }
}
__device__ __forceinline__ void attn_store_block(LAS unsigned char* lds, int slot, const u32x4 (&kn)[4], const u32x4 (&vn)[4], int tid) {
    const int ch = tid & 15, r0 = tid >> 4;
#pragma unroll
    for (int it = 0; it < 4; ++it) {
        *(LAS u32x4*)(lds + slot * ATT_BLK + (r0 + 32 * it) * KV_STRIDE + ch * 16) = kn[it];
        *(LAS u32x4*)(lds + (2 + slot) * ATT_BLK + (r0 + 32 * it) * KV_STRIDE + ch * 16) = vn[it];
    }
}
__device__ __forceinline__ void attn_units(LAS unsigned char* lds, const bf16* Q, const bf16* K, const bf16* V, bf16* OG, float* DG, int u0, int nu, float cshift, int wid, int lane, int tid) {
    if (nu <= 0) return;
    int p = 0;
    u32x4 kn[4], vn[4];
    AttnU a = attn_decode(u0);
    attn_load_block(kn, vn, K, V, a, a.qb, tid);
    const int ql = lane & 15, gq = lane >> 4;
    for (int ui = 0; ui < nu; ++ui) {
        a = attn_decode(u0 + ui);
        if (!(ui > 0 && a.qb > 0)) {
            u32x4 kp[4], vp[4];
            if (a.qb == 0) {
#pragma unroll
                for (int it = 0; it < 4; ++it) { kp[it] = (u32x4){0u, 0u, 0u, 0u}; vp[it] = (u32x4){0u, 0u, 0u, 0u}; }
            } else attn_load_block(kp, vp, K, V, a, a.qb - 1, tid);
            attn_store_block(lds, p, kp, vp, tid);
        }
        attn_store_block(lds, 1 - p, kn, vn, tid);
        const int qi = 16 * wid + ql;
        const size_t qrow = (size_t)a.b * SEQ + (size_t)(128 * a.qb + qi) * a.d + a.r;
        bf16x8 qf[4];
#pragma unroll
        for (int kk = 0; kk < 4; ++kk) qf[kk] = *(const bf16x8*)(Q + qrow * QKV + a.hc + 32 * kk + 8 * gq);
        const float slope2 = alibi_slope(a.g * 4 + a.h) * LOG2E * (float)a.d;
        __syncthreads();
        if (ui + 1 < nu) { const AttnU an = attn_decode(u0 + ui + 1); attn_load_block(kn, vn, K, V, an, an.qb, tid); }
        f32x4 accO[8];
#pragma unroll
        for (int dt = 0; dt < 8; ++dt) accO[dt] = (f32x4){0.f, 0.f, 0.f, 0.f};
        float dsum = 0.f;
        const int kl = ql * KV_STRIDE + gq * 16, vl = (4 * gq + (ql >> 2)) * KV_STRIDE + (ql & 3) * 8;
#pragma unroll
        for (int kt2 = 0; kt2 < 5; ++kt2) {
            const int ja = 16 * wid + 32 * kt2, jb = ja + 16;
            const int offA = (((ja >> 7) ^ p) * ATT_BLK) + (ja & 127) * KV_STRIDE;
            const int offB = (kt2 < 4) ? ((((jb >> 7) ^ p) * ATT_BLK) + (jb & 127) * KV_STRIDE) : offA;
            f32x4 sa = {0.f, 0.f, 0.f, 0.f}, sb = {0.f, 0.f, 0.f, 0.f};
#pragma unroll
            for (int kk = 0; kk < 4; ++kk) {
                const bf16x8 ka = *(const LAS bf16x8*)(lds + offA + kl + kk * 64);
                sa = __builtin_amdgcn_mfma_f32_16x16x32_bf16(ka, qf[kk], sa, 0, 0, 0);
            }
            if (kt2 < 4) {
#pragma unroll
                for (int kk = 0; kk < 4; ++kk) {
                    const bf16x8 kb = *(const LAS bf16x8*)(lds + offB + kl + kk * 64);
                    sb = __builtin_amdgcn_mfma_f32_16x16x32_bf16(kb, qf[kk], sb, 0, 0, 0);
                }
            }
            float pa[4], pb[4];
#pragma unroll
            for (int jj = 0; jj < 4; ++jj) {
                const int j = ja + 4 * gq + jj, dist = 128 + qi - j;
                const bool ok = dist >= 0 && dist <= 128 && (128 * a.qb - 128 + j) >= 0;
                pa[jj] = ok ? fast_exp2(sa[jj] - slope2 * (float)dist - cshift) : 0.f;
                const int j2 = j + 16, dist2 = dist - 16;
                const bool ok2 = (kt2 < 4) && dist2 >= 0 && dist2 <= 128 && (128 * a.qb - 128 + j2) >= 0;
                pb[jj] = ok2 ? fast_exp2(sb[jj] - slope2 * (float)dist2 - cshift) : 0.f;
                dsum += pa[jj] + pb[jj];
            }
            u32x4 pw; pw.x = pk2(pa[0], pa[1]); pw.y = pk2(pa[2], pa[3]); pw.z = pk2(pb[0], pb[1]); pw.w = pk2(pb[2], pb[3]);
            const bf16x8 pfrag = __builtin_bit_cast(bf16x8, pw);
#pragma unroll
            for (int dt = 0; dt < 8; ++dt) {
                const s16x4 lo = vtr(lds + 2 * ATT_BLK + offA + vl + dt * 32);
                const s16x4 hi = vtr(lds + 2 * ATT_BLK + offB + vl + dt * 32);
                const bf16x8 vf = {lo[0], lo[1], lo[2], lo[3], hi[0], hi[1], hi[2], hi[3]};
                accO[dt] = __builtin_amdgcn_mfma_f32_16x16x32_bf16(vf, pfrag, accO[dt], 0, 0, 0);
            }
        }
        dsum += __shfl_xor(dsum, 16); dsum += __shfl_xor(dsum, 32);
        const float inv = 1.0f / dsum;
        bf16* op = OG + qrow * QKV + a.g * 512 + a.h * 128 + 4 * gq;
#pragma unroll
        for (int dt = 0; dt < 8; ++dt) {
            u32x2 w; w.x = pk2(accO[dt][0] * inv, accO[dt][1] * inv); w.y = pk2(accO[dt][2] * inv, accO[dt][3] * inv);
            *(u32x2*)(op + dt * 16) = w;
        }
        if (gq == 0) DG[qrow * 12 + a.g * 4 + a.h] = dsum;
        __syncthreads();
        p ^= 1;
    }
}

__device__ __forceinline__ void attn_sample_item(LAS unsigned char* lds, const bf16* Q, const bf16* K, const bf16* V, const float* c0, const float* c1, const float* c2, int layer, bf16* YA, int item, int wid, int lane, int tid) {
    const int b = item >> 2, h = item & 3;
    LAS float* sc = (LAS float*)lds;
    LAS float* qs = (LAS float*)(lds + 2048);
    LAS float* part = (LAS float*)(lds + 4096);
    LAS float* pself = (LAS float*)(lds + 8192);
    const size_t row = (size_t)MP + b;
    if (tid < 384) { const int g = tid >> 7, dd = tid & 127; qs[tid] = bf2f(Q[row * QKV + (g * 4 + h) * 128 + dd]); }
    LDS_WAIT(); __syncthreads();
    const int k = lane >> 2, qd = lane & 3;
    {
        f32x4 kv[3][8];
#pragma unroll
        for (int i = 0; i < 3; ++i) {
            const int jj = 16 * (wid + 8 * i) + k, g = (wid + 8 * i) >> 3  , step = (jj & 127) + 1, d = 1 << (2 * g), lc = 128 << (2 * g);
            const float* cp = (g == 0 ? c0 : (g == 1 ? c1 : c2)) + ((((size_t)(layer * NSMP + b) * lc + (lc - d * step)) * 2 + 0) * 4 + h) * 128 + qd * 32;
#pragma unroll
            for (int e = 0; e < 8; ++e) kv[i][e] = *(const f32x4*)(cp + 4 * e);
        }
#pragma unroll
        for (int i = 0; i < 3; ++i) {
            const int jj = 16 * (wid + 8 * i) + k, g = i, step = (jj & 127) + 1, d = 1 << (2 * g);
            float s = 0.f;
#pragma unroll
            for (int e = 0; e < 8; ++e) { const f32x4 qv = *(const LAS f32x4*)(qs + g * 128 + qd * 32 + 4 * e); s += (kv[i][e].x * qv.x + kv[i][e].y * qv.y) + (kv[i][e].z * qv.z + kv[i][e].w * qv.w); }
            s += __shfl_xor(s, 1); s += __shfl_xor(s, 2);
            s -= alibi_slope(g * 4 + h) * LOG2E * (float)(d * step);
            if (qd == 0) sc[g * 132 + step] = s;
        }
        if (wid < 3) {
            const unsigned kk = *(const unsigned*)(K + row * QKV + (wid * 4 + h) * 128 + 2 * lane);
            float s = __uint_as_float(kk << 16) * qs[wid * 128 + 2 * lane] + __uint_as_float(kk & 0xffff0000u) * qs[wid * 128 + 2 * lane + 1];
            s = wave_sum(s);
            if (lane == 0) sc[wid * 132] = s;
        }
    }
    LDS_WAIT(); __syncthreads();
    float mx = -3.0e38f;
    for (int j = lane; j < 387; j += 64) { const int g = j / 129; mx = fmaxf(mx, sc[g * 132 + (j - g * 129)]); }
    mx = wave_max(mx);
    float den = 0.f;
    for (int j = lane; j < 387; j += 64) { const int g = j / 129; den += fast_exp2(sc[g * 132 + (j - g * 129)] - mx); }
    den = wave_sum(den);
    {
        f32x4 vv[3][8];
#pragma unroll
        for (int i = 0; i < 3; ++i) {
            const int jj = 16 * (wid + 8 * i) + k, g = i, step = (jj & 127) + 1, d = 1 << (2 * g), lc = 128 << (2 * g);
            const float* cp = (g == 0 ? c0 : (g == 1 ? c1 : c2)) + ((((size_t)(layer * NSMP + b) * lc + (lc - d * step)) * 2 + 1) * 4 + h) * 128 + qd * 32;
#pragma unroll
            for (int e = 0; e < 8; ++e) vv[i][e] = *(const f32x4*)(cp + 4 * e);
        }
        f32x4 acc[8];
#pragma unroll
        for (int e = 0; e < 8; ++e) acc[e] = (f32x4){0.f, 0.f, 0.f, 0.f};
#pragma unroll
        for (int i = 0; i < 3; ++i) {
            const int jj = 16 * (wid + 8 * i) + k, step = (jj & 127) + 1;
            const float p = fast_exp2(sc[i * 132 + step] - mx);
#pragma unroll
            for (int e = 0; e < 8; ++e) acc[e] += vv[i][e] * p;
        }
#pragma unroll
        for (int e = 0; e < 8; ++e)
#pragma unroll
            for (int c = 0; c < 4; ++c) { float v = acc[e][c]; v += __shfl_xor(v, 4); v += __shfl_xor(v, 8); v += __shfl_xor(v, 16); v += __shfl_xor(v, 32); acc[e][c] = v; }
        if (k == 0) {
#pragma unroll
            for (int e = 0; e < 8; ++e) *(LAS f32x4*)(part + wid * 128 + qd * 32 + 4 * e) = acc[e];
        }
        if (tid < 3) pself[tid] = fast_exp2(sc[tid * 132] - mx);
    }
    LDS_WAIT(); __syncthreads();
    if (tid < 128) {
        float a = 0.f;
#pragma unroll
        for (int w = 0; w < 8; ++w) a += part[w * 128 + tid];
#pragma unroll
        for (int g = 0; g < 3; ++g) a += pself[g] * bf2f(V[row * QKV + (g * 4 + h) * 128 + tid]);
        YA[row * 512 + h * 128 + tid] = (bf16)(pk2(a / den, 0.f) & 0xffffu);
    }
    LDS_WAIT(); __syncthreads();
}

constexpr int SG_STRIDE = 144;
constexpr int SG_SLAB = 128 * SG_STRIDE;
constexpr int SG_STATS = 4 * SG_SLAB;
__device__ __forceinline__ void sgu_unit(LAS unsigned char* lds, const bf16* U, const bf16* VS, const float* lnw, const float* lnb, const bf16* WSP, const float* bsp, bf16* YS, int unit, int wid, int lane) {
    const int half = unit & 1, bn = unit >> 1;
    const size_t R0 = (size_t)bn * 128;
    LAS f32x2* stats = (LAS f32x2*)(lds + SG_STATS);
    u32x4 xs16[16];
#pragma unroll
    for (int i = 0; i < 16; ++i) xs16[i] = *(const u32x4*)(VS + (R0 + 16 * wid + i) * 512 + 8 * lane);
#pragma unroll
    for (int i = 0; i < 16; ++i) {
        const int rl = 16 * wid + i;
        const u32x4 x = xs16[i];
        const float f[8] = {__uint_as_float(x.x << 16), __uint_as_float(x.x & 0xffff0000u), __uint_as_float(x.y << 16), __uint_as_float(x.y & 0xffff0000u),
                            __uint_as_float(x.z << 16), __uint_as_float(x.z & 0xffff0000u), __uint_as_float(x.w << 16), __uint_as_float(x.w & 0xffff0000u)};
        float s = 0.f, s2 = 0.f;
#pragma unroll
        for (int e = 0; e < 8; ++e) { s += f[e]; s2 += f[e] * f[e]; }
        s = wave_sum(s); s2 = wave_sum(s2);
        const float mean = s * (1.0f / 512.0f), var = fmaxf(s2 * (1.0f / 512.0f) - mean * mean, 0.f);
        if (lane == 0) stats[rl] = (f32x2){mean, 1.0f / sqrtf(var + 1e-6f)};
    }
    LDS_WAIT(); __syncthreads();
    const int gl = wid & 3, th = wid >> 2, grp = half * 4 + gl, c0 = grp * 64;
    LAS unsigned char* slab = lds + gl * SG_SLAB;
    {
        const int cc = (lane & 7) * 8;
        const f32x4 w0 = *(const f32x4*)(lnw + c0 + cc), w1 = *(const f32x4*)(lnw + c0 + cc + 4), b0 = *(const f32x4*)(lnb + c0 + cc), b1 = *(const f32x4*)(lnb + c0 + cc + 4);
#pragma unroll
        for (int it = 0; it < 8; ++it) {
            const int rl = th * 64 + it * 8 + (lane >> 3);
            const u32x4 x = *(const u32x4*)(VS + (R0 + rl) * 512 + c0 + cc);
            const f32x2 st = stats[rl];
            f32x4 a = {__uint_as_float(x.x << 16), __uint_as_float(x.x & 0xffff0000u), __uint_as_float(x.y << 16), __uint_as_float(x.y & 0xffff0000u)};
            f32x4 c = {__uint_as_float(x.z << 16), __uint_as_float(x.z & 0xffff0000u), __uint_as_float(x.w << 16), __uint_as_float(x.w & 0xffff0000u)};
            a = (a - st.x) * st.y * w0 + b0; c = (c - st.x) * st.y * w1 + b1;
            u32x4 o; o.x = pk2(a[0], a[1]); o.y = pk2(a[2], a[3]); o.z = pk2(c[0], c[1]); o.w = pk2(c[2], c[3]);
            *(LAS u32x4*)(slab + rl * SG_STRIDE + cc * 2) = o;
        }
    }
    LDS_WAIT(); __syncthreads();
    const int ql = lane & 15, gq = lane >> 4;
    const LAS unsigned char* abase = slab + (8 * gq + (ql >> 2)) * SG_STRIDE + (ql & 3) * 8;
    const bf16* wg = WSP + (size_t)grp * 128 * 128;
#pragma unroll
    for (int ti = 0; ti < 4; ++ti) {
        const int tt = th == 0 ? (ti == 0 ? 0 : (ti == 1 ? 3 : (ti == 2 ? 4 : 7))) : (ti == 0 ? 1 : (ti == 1 ? 2 : (ti == 2 ? 5 : 6)));
        const int t = 16 * tt + ql;
        f32x4 acc[4];
#pragma unroll
        for (int ct = 0; ct < 4; ++ct) acc[ct] = (f32x4){0.f, 0.f, 0.f, 0.f};
        for (int kk = 0; kk <= (tt >> 1); ++kk) {
            const bf16x8 wf = *(const bf16x8*)(wg + (size_t)t * 128 + 32 * kk + 8 * gq);
#pragma unroll
            for (int ct = 0; ct < 4; ++ct) {
                const s16x4 lo = vtr(abase + (32 * kk) * SG_STRIDE + ct * 32);
                const s16x4 hi = vtr(abase + (32 * kk + 4) * SG_STRIDE + ct * 32);
                const bf16x8 af = {lo[0], lo[1], lo[2], lo[3], hi[0], hi[1], hi[2], hi[3]};
                acc[ct] = __builtin_amdgcn_mfma_f32_16x16x32_bf16(af, wf, acc[ct], 0, 0, 0);
            }
        }
        const float bias = bsp[grp * 128 + t];
#pragma unroll
        for (int ct = 0; ct < 4; ++ct) {
            const size_t off = (R0 + t) * 512 + c0 + ct * 16 + 4 * gq;
            const u32x2 uu = *(const u32x2*)(U + off);
            const float u0 = __uint_as_float(uu.x << 16), u1 = __uint_as_float(uu.x & 0xffff0000u), u2 = __uint_as_float(uu.y << 16), u3 = __uint_as_float(uu.y & 0xffff0000u);
            u32x2 o; o.x = pk2(u0 * (acc[ct][0] + bias), u1 * (acc[ct][1] + bias)); o.y = pk2(u2 * (acc[ct][2] + bias), u3 * (acc[ct][3] + bias));
            *(u32x2*)(YS + off) = o;
        }
    }
    LDS_WAIT(); __syncthreads();
}

__device__ __forceinline__ void sgu_sample_row(const bf16* U, const bf16* VS, const float* lnw, const float* lnb, const float* wsp_f32, const float* bsp, bf16* YS, float* out_sv, int b, int lane) {
    const size_t row = (size_t)MP + b;
    const u32x4 x = *(const u32x4*)(VS + row * 512 + 8 * lane);
    float f[8] = {__uint_as_float(x.x << 16), __uint_as_float(x.x & 0xffff0000u), __uint_as_float(x.y << 16), __uint_as_float(x.y & 0xffff0000u),
                  __uint_as_float(x.z << 16), __uint_as_float(x.z & 0xffff0000u), __uint_as_float(x.w << 16), __uint_as_float(x.w & 0xffff0000u)};
    float s = 0.f, s2 = 0.f;
#pragma unroll
    for (int e = 0; e < 8; ++e) { s += f[e]; s2 += f[e] * f[e]; }
    s = wave_sum(s); s2 = wave_sum(s2);
    const float mean = s * (1.0f / 512.0f), var = fmaxf(s2 * (1.0f / 512.0f) - mean * mean, 0.f), rstd = 1.0f / sqrtf(var + 1e-6f);
    const int c = 8 * lane, grp = c >> 6;
    const float w00 = wsp_f32[(size_t)grp * 128 * 128], b0 = bsp[grp * 128];
    const u32x4 uu = *(const u32x4*)(U + row * 512 + c);
    const float uf[8] = {__uint_as_float(uu.x << 16), __uint_as_float(uu.x & 0xffff0000u), __uint_as_float(uu.y << 16), __uint_as_float(uu.y & 0xffff0000u),
                         __uint_as_float(uu.z << 16), __uint_as_float(uu.z & 0xffff0000u), __uint_as_float(uu.w << 16), __uint_as_float(uu.w & 0xffff0000u)};
    float y[8];
#pragma unroll
    for (int e = 0; e < 8; ++e) { const float vn = (f[e] - mean) * rstd * lnw[c + e] + lnb[c + e]; out_sv[c + e] = vn; y[e] = uf[e] * (w00 * vn + b0); }
    u32x4 o; o.x = pk2(y[0], y[1]); o.y = pk2(y[2], y[3]); o.z = pk2(y[4], y[5]); o.w = pk2(y[6], y[7]);
    *(u32x4*)(YS + row * 512 + c) = o;
}

__device__ __forceinline__ void merge_row(const bf16* OG, const float* DG, bf16* YA, int row, int lane) {
    const int h = lane >> 4;
    const float d0 = DG[(size_t)row * 12 + h], d1 = DG[(size_t)row * 12 + 4 + h], d2 = DG[(size_t)row * 12 + 8 + h];
    const float inv = 1.0f / (d0 + d1 + d2);
    const float a0 = d0 * inv, a1 = d1 * inv, a2 = d2 * inv;
    const bf16* p = OG + (size_t)row * QKV + 8 * lane;
    const u32x4 x0 = *(const u32x4*)p, x1 = *(const u32x4*)(p + 512), x2 = *(const u32x4*)(p + 1024);
    u32x4 o;
#define MRG(c) pk2(a0 * __uint_as_float(x0.c << 16) + a1 * __uint_as_float(x1.c << 16) + a2 * __uint_as_float(x2.c << 16), \
                   a0 * __uint_as_float(x0.c & 0xffff0000u) + a1 * __uint_as_float(x1.c & 0xffff0000u) + a2 * __uint_as_float(x2.c & 0xffff0000u))
    o.x = MRG(x); o.y = MRG(y); o.z = MRG(z); o.w = MRG(w);
#undef MRG
    *(u32x4*)(YA + (size_t)row * 512 + 8 * lane) = o;
}


__device__ __forceinline__ void merge_rows4(const bf16* OG, const float* DG, bf16* YA, int row0, int stride, int lane) {
    const int h = lane >> 4;
    u32x4 x[4][3]; float dg[4][3];
#pragma unroll
    for (int q = 0; q < 4; ++q) {
        const int row = min(row0 + q * stride, MP - 1);
        const bf16* p = OG + (size_t)row * QKV + 8 * lane;
        x[q][0] = *(const u32x4*)p; x[q][1] = *(const u32x4*)(p + 512); x[q][2] = *(const u32x4*)(p + 1024);
        dg[q][0] = DG[(size_t)row * 12 + h]; dg[q][1] = DG[(size_t)row * 12 + 4 + h]; dg[q][2] = DG[(size_t)row * 12 + 8 + h];
    }
#pragma unroll
    for (int q = 0; q < 4; ++q) {
        const int row = row0 + q * stride;
        if (row >= MP) continue;
        const float inv = 1.0f / (dg[q][0] + dg[q][1] + dg[q][2]);
        const float a0 = dg[q][0] * inv, a1 = dg[q][1] * inv, a2 = dg[q][2] * inv;
        u32x4 o;
#define MRG(c) pk2(a0 * __uint_as_float(x[q][0].c << 16) + a1 * __uint_as_float(x[q][1].c << 16) + a2 * __uint_as_float(x[q][2].c << 16), \
                   a0 * __uint_as_float(x[q][0].c & 0xffff0000u) + a1 * __uint_as_float(x[q][1].c & 0xffff0000u) + a2 * __uint_as_float(x[q][2].c & 0xffff0000u))
        o.x = MRG(x); o.y = MRG(y); o.z = MRG(z); o.w = MRG(w);
#undef MRG
        *(u32x4*)(YA + (size_t)row * 512 + 8 * lane) = o;
    }
}
typedef float f32x16 __attribute__((ext_vector_type(16)));
template <class EpiS>
__device__ __forceinline__ void skinny_gemm(LAS unsigned char* lds, const bf16* A, const bf16* Bt, int K, int j, const EpiS& e, int wid, int lane, int tid) {
    const int r = lane & 31, hi = lane >> 5, ks = K >> 3;
    const bf16* ap = A + (size_t)r * K + wid * ks + 8 * hi;
    const bf16* bp = Bt + (size_t)(32 * j + r) * K + wid * ks + 8 * hi;
    f32x16 acc;
#pragma unroll
    for (int i = 0; i < 16; ++i) acc[i] = 0.f;
#pragma unroll 4
    for (int k = 0; k < ks; k += 16) {
        const bf16x8 a = *(const bf16x8*)(ap + k), b = *(const bf16x8*)(bp + k);
        acc = __builtin_amdgcn_mfma_f32_32x32x16_bf16(a, b, acc, 0, 0, 0);
    }
    LAS float* red = (LAS float*)lds;
#pragma unroll
    for (int i = 0; i < 16; ++i) red[wid * 1056 + ((i & 3) + 8 * (i >> 2) + 4 * hi) * 33 + r] = acc[i];
    LDS_WAIT(); __syncthreads();
    for (int e2 = tid; e2 < 1024; e2 += NTHREADS) {
        const int row = e2 >> 5, col = e2 & 31;
        float sum = 0.f;
#pragma unroll
        for (int w = 0; w < 8; ++w) sum += red[w * 1056 + row * 33 + col];
        e(row, 32 * j + col, sum);
    }
    LDS_WAIT(); __syncthreads();
}
struct SkAda { float* MOD; const float* b_ada; int rg; __device__ __forceinline__ void operator()(int sr, int col, float v) const { const int layer = col / NADA, c = col - layer * NADA; const int mrow = rg == 0 ? 4 + sr : sr; if (rg == 0 || sr < 4) MOD[((size_t)layer * 36 + mrow) * NADA + c] = v + b_ada[(size_t)layer * NADA + c]; } };
struct SkGate1 { const bf16* G; float* T1; __device__ __forceinline__ void operator()(int sr, int col, float v) const { const size_t row = (size_t)MP + sr; T1[row * DM + col] = bf2f(G[row * 2048 + col]) * v; } };
struct SkGate2 { const bf16* G; const float* T1; bf16* MG; __device__ __forceinline__ void operator()(int sr, int col, float v) const { const size_t row = (size_t)MP + sr; MG[row * DM + col] = (bf16)(pk2(T1[row * DM + col] + bf2f(G[row * 2048 + 1024 + col]) * v, 0.f) & 0xffffu); } };
struct SkRes { const float* bs; float* os; const float* gate; __device__ __forceinline__ void operator()(int sr, int col, float v) const { os[(size_t)sr * DM + col] = bs[(size_t)sr * DM + col] + gate[(size_t)(4 + sr) * NADA + col] * v; } };


#define RLX_AGENT __ATOMIC_RELAXED, __HIP_MEMORY_SCOPE_AGENT
#define XB_TMO      128
#define XB_XCNT(j)  (256  + 64 * (j))
#define XB_XSUB(j)  (1280 + 64 * (j))
#define XB_XGEN(j)  (2304 + 64 * (j))
#define XB_TOP      3328
#define XB_TOPGEN   3392
#define XCD_BAR_WORDS 3456
#define XB_SPIN_CAP (1u << 18)

__device__ __forceinline__ unsigned xb_ld(unsigned* p)              { return __hip_atomic_load(p, __ATOMIC_RELAXED, __HIP_MEMORY_SCOPE_AGENT); }
__device__ __forceinline__ unsigned xb_add(unsigned* p, unsigned v) { return __hip_atomic_fetch_add(p, v, __ATOMIC_RELAXED, __HIP_MEMORY_SCOPE_AGENT); }
__device__ __forceinline__ unsigned xb_xcc_id() { return (unsigned)__builtin_amdgcn_s_getreg((3 << 11) | 20) & 0xFu; }
#define XB_SPIN(cond, bar) do { unsigned _sp = 0; while (cond) { __builtin_amdgcn_s_sleep(1); \
    if ((++_sp & 255u) == 0u) { if (xb_ld(&(bar)[XB_TMO])) break; if (_sp > XB_SPIN_CAP) { atomicAdd(&(bar)[XB_TMO], 1u); break; } } } } while (0)

struct XcdBarrier {
    unsigned* bar; unsigned x;
    volatile LAS unsigned* st;
};

__device__ __forceinline__ XcdBarrier xcd_barrier_post(unsigned* bar, volatile LAS unsigned* st) {
    XcdBarrier b; b.bar = bar; b.x = xb_xcc_id(); b.st = st;
    if (threadIdx.x == 0) (void)xb_add(&bar[XB_XCNT(b.x)], 1u);
    return b;
}
__device__ __forceinline__ void xcd_barrier_complete(unsigned* bar, unsigned x, unsigned& nloc, unsigned& nx) {
    const unsigned G = gridDim.x * gridDim.y * gridDim.z;
    unsigned sum, cnt, mine, sp = 0u;
    for (;;) {
        sum = 0u; cnt = 0u; mine = 0u;
#pragma unroll
        for (unsigned j = 0; j < 16; ++j) { const unsigned c = xb_ld(&bar[XB_XCNT(j)]); sum += c; cnt += (c > 0u) ? 1u : 0u; mine = (j == x) ? c : mine; }
        if (sum == G) break;
        __builtin_amdgcn_s_sleep(1);
        if ((++sp & 255u) == 0u) { if (xb_ld(&bar[XB_TMO])) break; if (sp > XB_SPIN_CAP) { atomicAdd(&bar[XB_TMO], 1u); break; } }
    }
    nloc = mine > 0u ? mine : 1u; nx = cnt > 0u ? cnt : 1u;
}

__device__ __forceinline__ void xcd_barrier(const XcdBarrier& b) {
    asm volatile("s_waitcnt vmcnt(0)" ::: "memory");
    __syncthreads();
    if (threadIdx.x == 0) {
        unsigned* bar = b.bar;
        __builtin_amdgcn_s_waitcnt(0);
        unsigned nloc = b.st[0], nx = b.st[1];
        if (nloc == 0u) { xcd_barrier_complete(bar, b.x, nloc, nx); b.st[0] = nloc; b.st[1] = nx; }
        const unsigned old = xb_add(&bar[XB_XSUB(b.x)], 1u);
        const unsigned gen = old / nloc;
        if (old + 1u == (gen + 1u) * nloc) {
            __builtin_amdgcn_fence(__ATOMIC_RELEASE, "agent");
            asm volatile("s_waitcnt vmcnt(0)" ::: "memory");
            const unsigned og = xb_add(&bar[XB_TOP], 1u);
            const unsigned tg = og / nx;
            if (og + 1u == (tg + 1u) * nx) xb_add(&bar[XB_TOPGEN], 1u);
            else XB_SPIN(xb_ld(&bar[XB_TOPGEN]) == tg, bar);
            __builtin_amdgcn_fence(__ATOMIC_ACQUIRE, "agent");
            xb_add(&bar[XB_XGEN(b.x)], 1u);
            asm volatile("s_waitcnt vmcnt(0)" ::: "memory");
        } else {
            XB_SPIN(xb_ld(&bar[XB_XGEN(b.x)]) == gen, bar);
            __builtin_amdgcn_fence(__ATOMIC_ACQUIRE, "agent");
            asm volatile("s_waitcnt vmcnt(0)" ::: "memory");
        }
    }
    __syncthreads();
}

constexpr int LDS_MISC = LDS_EXCH + 8192;
constexpr size_t WS_CTL = 0, CTL_ZERO_BYTES = 65536;
#ifndef PROBE_REP_MASK
#define PROBE_REP_MASK 0
#endif
#define PHON(k) for (int rep_ = 0; rep_ <= (((PROBE_REP_MASK) >> (k)) & 1); ++rep_) if constexpr (((PHM) >> (k)) & 1)
#define GSYNC() do { if constexpr (COOP) { CAS const Args* ap_ = (CAS const Args*)__builtin_amdgcn_kernarg_segment_ptr(); asm volatile("" : "+s"(ap_)); \
    XcdBarrier xb_; xb_.bar = (unsigned*)((unsigned char*)ap_->ws + WS_CTL); xb_.x = xb_xcc_id(); xb_.st = (volatile LAS unsigned*)(lds + LDS_MISC); xcd_barrier(xb_); } } while (0)
#define GSYNC_CG() do { if constexpr (COOP) cg::this_grid().sync(); } while (0)
#define GAS __attribute__((address_space(1)))
#define CAS __attribute__((address_space(4)))
struct Args { GAS const float* in[23]; GAS float* out; GAS unsigned char* ws; };

constexpr int I_ADA = 16 * 192, I_IN = 16 * 240, I_PA = 8 * 32, I_OUT = 16 * 32, I_FI = 16 * 176, I_FO = 44 * 32;
constexpr int I_LAYER = I_ADA + I_IN + 2 * I_PA + I_OUT + I_FI + I_FO;
__device__ __forceinline__ void weight_copy_item(CAS const Args* ap, unsigned char* ws, int l, int r, LAS float* scr, int lane) {
    unsigned char* wl = ws + WS_WL0 + (size_t)l * WL_SIZE;
    if (r < I_IN) { transpose_item(((const float*)ap->in[10]) + (size_t)l * DM * DIN, DM, DIN, (bf16*)(wl + WL_WIN), 0, scr, r, lane); return; } r -= I_IN;
    if (r < I_PA) { transpose_item(((const float*)ap->in[17]) + (size_t)l * 512 * DM, 512, DM, (bf16*)(wl + WL_WPA), 0, scr, r, lane); return; } r -= I_PA;
    if (r < I_PA) { transpose_item(((const float*)ap->in[18]) + (size_t)l * 512 * DM, 512, DM, (bf16*)(wl + WL_WPS), 0, scr, r, lane); return; } r -= I_PA;
    if (r < I_OUT) { transpose_item(((const float*)ap->in[19]) + (size_t)l * DM * DM, DM, DM, (bf16*)(wl + WL_WOUT), 0, scr, r, lane); return; } r -= I_OUT;
    if (r < I_FI) { transpose_item(((const float*)ap->in[21]) + (size_t)l * DM * 2 * DFF, DM, 2 * DFF, (bf16*)(wl + WL_WFI), 1, scr, r, lane); return; } r -= I_FI;
    transpose_item(((const float*)ap->in[22]) + (size_t)l * DFF * DM, DFF, DM, (bf16*)(wl + WL_WFO), 0, scr, r, lane);
}
#define PHASE_ENV() \
    CAS const Args* ap = (CAS const Args*)__builtin_amdgcn_kernarg_segment_ptr(); asm volatile("" : "+s"(ap)); \
    int tid = threadIdx.x; asm volatile("" : "+v"(tid)); \
    const int lane = tid & 63, wid = __builtin_amdgcn_readfirstlane(tid >> 6); \
    int G_ = gridDim.x, bx_ = blockIdx.x; asm volatile("" : "+s"(G_), "+s"(bx_)); const int G = G_, bx = bx_; const int gw = bx * NWAVES + wid, NGW = G * NWAVES; \
    unsigned char* const ws = (unsigned char*)ap->ws; (void)lane; (void)wid; (void)gw; (void)NGW; (void)ws; (void)G; (void)bx
#define WL(l) (ws + WS_WL0 + (size_t)(l) * WL_SIZE)

template <int PHM, bool COOP>
__global__ void __launch_bounds__(NTHREADS, 2) fwd_megakernel(Args args_unused, int l_lo, int l_hi) {
    extern __shared__ __attribute__((aligned(16))) unsigned char lds_raw[];
    LAS unsigned char* lds = (LAS unsigned char*)lds_raw;
    if constexpr (COOP) { if (l_lo < 0) cg::this_grid().sync(); }
    if constexpr (COOP) {
        PHASE_ENV();
        if (tid < 32) ((LAS unsigned*)(lds + LDS_MISC))[tid] = 0u;
        __syncthreads();
        (void)xcd_barrier_post((unsigned*)(ws + WS_CTL), (volatile LAS unsigned*)(lds + LDS_MISC));
    }

    PHON(0) {
        PHASE_ENV();
        bf16* WADA = (bf16*)(ws + WS_WADA); bf16* SC = (bf16*)(ws + WS_SC);
        LAS float* scr = (LAS float*)(lds + wid * 16384);
        for (int it = gw; it < 2 * I_ADA + I_IN; it += NGW) {
            if (it < 2 * I_ADA) { const int l = it / I_ADA; transpose_item(((const float*)ap->in[7]) + (size_t)l * DM * NADA, DM, NADA, WADA + (size_t)l * NADA * DM, 0, scr, it - l * I_ADA, lane); }
            else weight_copy_item(ap, ws, 0, it - 2 * I_ADA, scr, lane);
        }
        const int gt = bx * NTHREADS + tid, NGT = G * NTHREADS;
        const float* wsp = ((const float*)ap->in[15]);
        for (int i = gt; i < 2 * 8 * 128 * 128; i += NGT) {
            const int l = i >> 17, r = i & 131071, t = (r >> 7) & 127, s = r & 127;
            const float w = wsp[i];
            ((bf16*)(WL(l) + WL_WSP))[r] = (bf16)(s <= t ? (pk2(w, 0.f) & 0xffffu) : 0u);
        }
        const float* cpr = ((const float*)ap->in[5]); const float* csm = ((const float*)ap->in[6]);
        for (int i = gt; i < 64 * DM; i += NGT) {
            const int r = i >> 10, k = i & 1023;
            float v = 0.f;
            if (r < 32) v = csm[r * DM + k]; else if (r < 36) v = cpr[(r - 32) * DM + k];
            SC[i] = (bf16)(pk2(v * sigmoidf_(v), 0.f) & 0xffffu);
        }
    }
    GSYNC();
    PHON(1) {
        PHASE_ENV();
        for (int t = bx; t < 768; t += G) {
            const int rg = t / 384, j = t - rg * 384;
            SkAda e{(float*)(ws + WS_MOD), ((const float*)ap->in[8]), rg};
            skinny_gemm(lds, (const bf16*)(ws + WS_SC) + (size_t)rg * 32 * DM, (const bf16*)(ws + WS_WADA), DM, j, e, wid, lane, tid);
        }
    }
    GSYNC();

    for (int l = l_lo; l < l_hi; ++l) {
        PHON(2) {
            PHASE_ENV();
            const float* X2 = (const float*)(ws + WS_X2);
            const float* xin_p = l == 0 ? ((const float*)ap->in[0]) : X2;
            const float* xin_s = l == 0 ? ((const float*)ap->in[1]) : X2 + (size_t)MP * DM;
            norm_mod_phase(xin_p, xin_s, ((const float*)ap->in[9]) + l * DM, (const float*)(ws + WS_MOD) + (size_t)l * 36 * NADA, 0, (bf16*)(ws + WS_XN), gw, NGW, lane);
        }
        GSYNC();
        PHON(3) {
            PHASE_ENV();
            pg8::Gemm g{(const bf16*)(ws + WS_XN), (const bf16*)(WL(l) + WL_WIN), MT, DIN, DM}; pg8::StaticOrder S; S.init(MT, DIN, G, bx);
            EpiIn E{ws, ((const float*)ap->in[11]) + l * 384, ((const float*)ap->in[12]) + l * 384, ((float*)ap->out), l, (LAS float*)(lds + LDS_EXCH)};
            pg8::gemm_phase<EpiIn, pg8::StaticOrder, true, true>(lds + LDS_RING, g, S, E);
        }
        PHON(3) {
            if (l == 0) {
                PHASE_ENV();
                constexpr int NU = (MT / 256) * (DIN / 256);
                const int nfull = NU % G;
                if (nfull > 0 && bx >= nfull) {
                    LAS float* scr = (LAS float*)(lds + wid * 16384);
                    const int nw = (G - nfull) * NWAVES, w0 = (bx - nfull) * NWAVES + wid;
                    for (int it = w0; it < I_LAYER - I_ADA; it += nw) { if (it < I_IN) weight_copy_item(ap, ws, 1, it, scr, lane); else weight_copy_item(ap, ws, 0, it, scr, lane); }
                } else if (nfull == 0) {
                    LAS float* scr = (LAS float*)(lds + wid * 16384);
                    for (int it = gw; it < I_LAYER - I_ADA; it += NGW) { if (it < I_IN) weight_copy_item(ap, ws, 1, it, scr, lane); else weight_copy_item(ap, ws, 0, it, scr, lane); }
                }
            }
        }
        GSYNC();
        PHON(4) {
            PHASE_ENV();
            const bf16 *Qb = (const bf16*)(ws + WS_Q), *Kb = (const bf16*)(ws + WS_K), *Vb = (const bf16*)(ws + WS_V);
            float mq = 0.f, mk = 0.f;
            for (int i = lane; i < 384; i += 64) { mq = fmaxf(mq, fabsf(((const float*)ap->in[11])[l * 384 + i])); mk = fmaxf(mk, fabsf(((const float*)ap->in[12])[l * 384 + i])); }
            mq = wave_max(mq); mk = wave_max(mk);
            const float cshift = 11.3137085f * LOG2E * mq * mk;
            if (G == 256) { const int u0 = bx < 128 ? bx * 7 : 896 + (bx - 128) * 5, nu = bx < 128 ? 7 : 5;
                attn_units(lds, Qb, Kb, Vb, (bf16*)(ws + WS_OG), (float*)(ws + WS_DG), u0, nu, cshift, wid, lane, tid); }
            else { const int per = (1536 + G - 1) / G, u0 = bx * per; attn_units(lds, Qb, Kb, Vb, (bf16*)(ws + WS_OG), (float*)(ws + WS_DG), u0, min(per, 1536 - u0), cshift, wid, lane, tid); }
        }
        PHON(4) {
            PHASE_ENV();
            if (bx >= G / 2) {
                for (int it = bx - G / 2; it < NSMP * 4; it += G - G / 2)
                    attn_sample_item(lds, (const bf16*)(ws + WS_Q), (const bf16*)(ws + WS_K), (const bf16*)(ws + WS_V), ((const float*)ap->in[2]), ((const float*)ap->in[3]), ((const float*)ap->in[4]), l, (bf16*)(ws + WS_YY) + (size_t)MP * 512  , it, wid, lane, tid);
            }
        }
        GSYNC();
        PHON(5) {
            PHASE_ENV();
            const bf16 *Ub = (const bf16*)(ws + WS_U), *VSb = (const bf16*)(ws + WS_VS); bf16 *YS = (bf16*)(ws + WS_YY) + (size_t)MP * 512;
            const bf16* WSP = (const bf16*)(WL(l) + WL_WSP);
            const float* lnw = ((const float*)ap->in[13]) + l * 512; const float* lnb = ((const float*)ap->in[14]) + l * 512; const float* bsp = ((const float*)ap->in[16]) + l * 8 * 128;
            for (int u = bx; u < 256; u += G) sgu_unit(lds, Ub, VSb, lnw, lnb, WSP, bsp, YS, u, wid, lane);
            for (int b = gw; b < NSMP; b += NGW) sgu_sample_row(Ub, VSb, lnw, lnb, ((const float*)ap->in[15]) + (size_t)l * 8 * 128 * 128, bsp, YS + (size_t)32 * 512  , ((float*)ap->out) + O_SV + (size_t)(l * NSMP + b) * 512, b, lane);
            for (int row = gw; row < MP; row += 4 * NGW) merge_rows4((const bf16*)(ws + WS_OG), (const float*)(ws + WS_DG), (bf16*)(ws + WS_YY), row, NGW, lane);
        }
        GSYNC();
        PHON(6) {
            PHASE_ENV();
            if (bx < 32) { SkGate1 e{(const bf16*)(ws + WS_G), (float*)(ws + WS_T1)};
                skinny_gemm(lds, (const bf16*)(ws + WS_YY) + (size_t)(2 * MP) * 512, (const bf16*)(WL(l) + WL_WPA), 512, bx, e, wid, lane, tid); }
        }
        PHON(6) {
            PHASE_ENV();
            PairOrder S; S.S0.init(MP, DM, G, bx);
            pg8::Gemm g{(const bf16*)(ws + WS_YY), (const bf16*)(WL(l) + WL_WPA), 2 * MP, 2 * DM, 512}; EpiMerged E{(const bf16*)(ws + WS_G), (bf16*)(ws + WS_MG)};
            pg8::gemm_phase<EpiMerged, PairOrder, true, true>(lds + LDS_RING, g, S, E);
        }
        PHON(6) {
            PHASE_ENV();
            if (bx < 32) { SkGate2 e{(const bf16*)(ws + WS_G), (const float*)(ws + WS_T1), (bf16*)(ws + WS_MG)};
                skinny_gemm(lds, (const bf16*)(ws + WS_YY) + (size_t)(2 * MP + 32) * 512, (const bf16*)(WL(l) + WL_WPS), 512, bx, e, wid, lane, tid); }
        }
        GSYNC();
        PHON(7) {
            PHASE_ENV();
            const float* X2 = (const float*)(ws + WS_X2); float* X1 = (float*)(ws + WS_X1);
            const float* xin_p = l == 0 ? ((const float*)ap->in[0]) : X2;
            const float* xin_s = l == 0 ? ((const float*)ap->in[1]) : X2 + (size_t)MP * DM;
            pg8::Gemm g{(const bf16*)(ws + WS_MG), (const bf16*)(WL(l) + WL_WOUT), MP, DM, DM}; pg8::StaticOrder S; S.init(MP, DM, G, bx);
            EpiRes E{xin_p, xin_s, X1, X1 + (size_t)MP * DM, (const float*)(ws + WS_MOD) + (size_t)l * 36 * NADA + 2048};
            pg8::gemm_phase<EpiRes, pg8::StaticOrder, true, true>(lds + LDS_RING, g, S, E);
        }
        PHON(7) {
            PHASE_ENV();
            if (bx < 32) { const float* X2 = (const float*)(ws + WS_X2);
                SkRes e{l == 0 ? ((const float*)ap->in[1]) : X2 + (size_t)MP * DM, (float*)(ws + WS_X1) + (size_t)MP * DM, (const float*)(ws + WS_MOD) + (size_t)l * 36 * NADA + 2048};
                skinny_gemm(lds, (const bf16*)(ws + WS_MG) + (size_t)MP * DM, (const bf16*)(WL(l) + WL_WOUT), DM, bx, e, wid, lane, tid); }
        }
        GSYNC();
        PHON(8) {
            PHASE_ENV();
            const float* X1 = (const float*)(ws + WS_X1);
            norm_mod_phase(X1, X1 + (size_t)MP * DM, ((const float*)ap->in[20]) + l * DM, (const float*)(ws + WS_MOD) + (size_t)l * 36 * NADA, 3072, (bf16*)(ws + WS_XN), gw, NGW, lane);
        }
        GSYNC();
        PHON(9) {
            PHASE_ENV();
            pg8::Gemm g{(const bf16*)(ws + WS_XN), (const bf16*)(WL(l) + WL_WFI), MT, 2 * DFF, DM}; pg8::StaticOrder S; S.init(MT, 2 * DFF, G, bx);
            EpiSwiglu E{(bf16*)(ws + WS_H)};
            pg8::gemm_phase<EpiSwiglu, pg8::StaticOrder, true, true>(lds + LDS_RING, g, S, E);
        }
        PHON(9) {
            if (l == 0) {
                PHASE_ENV();
                constexpr int NU = (MT / 256) * (2 * DFF / 256);
                const int nfull = NU % G;
                LAS float* scr = (LAS float*)(lds + wid * 16384);
                if (nfull > 0 && bx >= nfull) { const int nw = (G - nfull) * NWAVES, w0 = (bx - nfull) * NWAVES + wid;
                    for (int it = I_IN + w0; it < I_LAYER - I_ADA; it += nw) weight_copy_item(ap, ws, 1, it, scr, lane); }
                else if (nfull == 0) { for (int it = I_IN + gw; it < I_LAYER - I_ADA; it += NGW) weight_copy_item(ap, ws, 1, it, scr, lane); }
            }
        }
        GSYNC();
        PHON(10) {
            PHASE_ENV();
            const float* X1 = (const float*)(ws + WS_X1); float* X2 = (float*)(ws + WS_X2);
            float* xout_p = l == 0 ? X2 : ((float*)ap->out) + O_YP;
            float* xout_s = l == 0 ? X2 + (size_t)MP * DM : ((float*)ap->out) + O_YS;
            pg8::Gemm g{(const bf16*)(ws + WS_H), (const bf16*)(WL(l) + WL_WFO), MP, DM, DFF}; pg8::StaticOrder S; S.init(MP, DM, G, bx);
            EpiRes E{X1, X1 + (size_t)MP * DM, xout_p, xout_s, (const float*)(ws + WS_MOD) + (size_t)l * 36 * NADA + 5120};
            pg8::gemm_phase<EpiRes, pg8::StaticOrder, true, true>(lds + LDS_RING, g, S, E);
        }
        PHON(10) {
            PHASE_ENV();
            if (bx < 32) { float* X2 = (float*)(ws + WS_X2);
                SkRes e{(const float*)(ws + WS_X1) + (size_t)MP * DM, l == 0 ? X2 + (size_t)MP * DM : ((float*)ap->out) + O_YS, (const float*)(ws + WS_MOD) + (size_t)l * 36 * NADA + 5120};
                skinny_gemm(lds, (const bf16*)(ws + WS_H) + (size_t)MP * DFF, (const bf16*)(WL(l) + WL_WFO), DFF, bx, e, wid, lane, tid); }
        }
        if (l + 1 < l_hi) GSYNC();
    }
}


#ifdef EXP_MASK
__global__ void __launch_bounds__(256) dbg_checksum(const unsigned char* ws, float* out) {
    const int lane = threadIdx.x & 63, gw = (blockIdx.x * 256 + threadIdx.x) >> 6, ngw = gridDim.x * 4;
    struct B { size_t off; int cols; int isf; };
    const B bufs[16] = {{WS_XN, 1024, 0}, {WS_Q, 1536, 0}, {WS_K, 1536, 0}, {WS_V, 1536, 0}, {WS_U, 512, 0}, {WS_VS, 512, 0}, {WS_G, 2048, 0}, {WS_OG, 1536, 0},
                        {WS_DG, 12, 1}, {WS_YY, 512, 0}, {WS_YY + (size_t)MP * 1024, 512, 0}, {WS_T1, 1024, 1}, {WS_MG, 1024, 0}, {WS_X1, 1024, 1}, {WS_H, 2816, 0}, {WS_X2, 1024, 1}};
    for (int b = 0; b < 16; ++b) {
        if (!((EXP_MASK >> b) & 1)) continue;
        for (int row = gw; row < MV; row += ngw) {
            float s = 0.f;
            for (int c = lane; c < bufs[b].cols; c += 64) {
                const float v = bufs[b].isf ? ((const float*)(ws + bufs[b].off))[(size_t)row * bufs[b].cols + c] : bf2f(((const bf16*)(ws + bufs[b].off))[(size_t)row * bufs[b].cols + c]);
                s += v * (float)(1 + (c % 7));
            }
            s = wave_sum(s);
            if (lane == 0) out[(size_t)b * MT + row] = s;
        }
    }
    if ((EXP_MASK >> 16) & 1) for (int i = blockIdx.x * 256 + threadIdx.x; i < 72 * NADA; i += gridDim.x * 256) out[16 * MT + i] = ((const float*)(ws + WS_MOD))[i];
}
#endif
#ifndef N_LAUNCH_MODE
#define N_LAUNCH_MODE 1
#endif
template <int PHM> static void launch_phase(const Args& a, int l_lo, int l_hi, int grid, hipStream_t stream) {
    static bool attr = false;
    if (!attr) { (void)hipFuncSetAttribute((const void*)fwd_megakernel<PHM, false>, hipFuncAttributeMaxDynamicSharedMemorySize, LDS_BYTES); attr = true; }
    hipLaunchKernelGGL((fwd_megakernel<PHM, false>), dim3(grid), dim3(NTHREADS), LDS_BYTES, stream, a, l_lo, l_hi);
}
extern "C" void kernel_launch(void* const* d_in, const int* in_sizes, int n_in, void* d_out, int out_size, void* d_ws, size_t ws_size, hipStream_t stream) {
    static int grid = 0;
    if (grid == 0) {
        if (n_in != 23 || (size_t)out_size != O_END || ws_size < WS_END) { fprintf(stderr, "kernel_launch: unexpected shapes (n_in %d out %d ws %zu need %zu)\n", n_in, out_size, ws_size, (size_t)WS_END); grid = -1; return; }
        int dev = 0, cus = 0, per_cu = 0;
        (void)hipGetDevice(&dev);
        (void)hipDeviceGetAttribute(&cus, hipDeviceAttributeMultiprocessorCount, dev);
#if N_LAUNCH_MODE == 1
        if (hipFuncSetAttribute((const void*)fwd_megakernel<0x7FF, true>, hipFuncAttributeMaxDynamicSharedMemorySize, LDS_BYTES) != hipSuccess) { fprintf(stderr, "kernel_launch: hipFuncSetAttribute failed\n"); grid = -1; return; }
        (void)hipOccupancyMaxActiveBlocksPerMultiprocessor(&per_cu, (const void*)fwd_megakernel<0x7FF, true>, NTHREADS, LDS_BYTES);
        (void)hipGetLastError();
        if (per_cu < 1) fprintf(stderr, "kernel_launch: occupancy query says %d blocks per CU\n", per_cu);
#endif
        grid = cus;
    }
    if (grid < 0) return;
    Args a{};
    for (int i = 0; i < 23; ++i) a.in[i] = (GAS const float*)d_in[i];
    a.out = (GAS float*)d_out; a.ws = (GAS unsigned char*)d_ws;
#if N_LAUNCH_MODE == 1
    (void)hipMemsetAsync((unsigned char*)d_ws + WS_CTL, 0, CTL_ZERO_BYTES, stream);
    int l_lo = 0, l_hi = 2;
    void* kargs[] = {&a, &l_lo, &l_hi};
    hipError_t e = hipLaunchCooperativeKernel((const void*)fwd_megakernel<0x7FF, true>, dim3(grid), dim3(NTHREADS), kargs, LDS_BYTES, stream);
    if (e != hipSuccess) fprintf(stderr, "cooperative launch failed: %s (grid %d)\n", hipGetErrorString(e), grid);
#else
#ifdef EXP_MASK
    (void)hipMemsetAsync(d_out, 0, (size_t)out_size * 4, stream);
#endif
    launch_phase<0x001>(a, 0, 0, grid, stream);
    launch_phase<0x002>(a, 0, 0, grid, stream);
#ifdef EXP_MASK
    const int NL = 1;
#else
    const int NL = 2;
#endif
    for (int l = 0; l < NL; ++l) {
        launch_phase<0x004>(a, l, l + 1, grid, stream);
        launch_phase<0x008>(a, l, l + 1, grid, stream);
        launch_phase<0x010>(a, l, l + 1, grid, stream);
        launch_phase<0x020>(a, l, l + 1, grid, stream);
        launch_phase<0x040>(a, l, l + 1, grid, stream);
        launch_phase<0x080>(a, l, l + 1, grid, stream);
        launch_phase<0x100>(a, l, l + 1, grid, stream);
        launch_phase<0x200>(a, l, l + 1, grid, stream);
        launch_phase<0x400>(a, l, l + 1, grid, stream);
    }
#ifdef EXP_MASK
    hipLaunchKernelGGL(dbg_checksum, dim3(1024), dim3(256), 0, stream, (const unsigned char*)d_ws, (float*)d_out);
#endif
#endif
}
```
